# Optimizing an MI355X kernel written in HIP

```python
import math
import jax, jax.numpy as jnp
from jax import lax
import numpy as np

D_MODEL = 1024
BATCH = 8
SEQ = 2048
DEPTH = 2

GRID_W = 64
CTX_LEN = 256
N_EVEN = (DEPTH + 1) // 2
N_ODD = DEPTH // 2
HEAD_DIM = 64
MIX_WIDTH = D_MODEL
HALF_MIX = MIX_WIDTH // 2
Q_BLOCK = 128
ROPE_THETA = 10000.0
EPS = 1e-6
N_MOD = 6
LRU_WIDTH = HALF_MIX
LRU_BLOCKS = LRU_WIDTH // HEAD_DIM
LRU_BLOCK_SIZE = LRU_WIDTH // LRU_BLOCKS
LRU_CONV = 4
LRU_C = 8.0
GQA_Q_HEADS = HALF_MIX // HEAD_DIM
GQA_KV_HEADS = 2
AB_IN = 2 * LRU_WIDTH + (GQA_Q_HEADS + 2 * GQA_KV_HEADS) * HEAD_DIM
HY_WIDTH = HALF_MIX
HY_ORDER = 2
HY_CONV = 3
HY_BANDS = 16
HY_POS_DIM = 1 + 2 * HY_BANDS
HY_FILTER_HIDDEN = 64
HY_TARGET = 1e-2
HY_FAST_PCT = 0.3
HY_SLOW_PCT = 1.5
HY_MIN_DECAY = math.log(HY_TARGET) / HY_SLOW_PCT
HY_MAX_DECAY = math.log(HY_TARGET) / HY_FAST_PCT
HY_SHIFT = 0.05
MLA_HEADS = HALF_MIX // HEAD_DIM
MLA_Q_RANK = D_MODEL // 4
MLA_KV_RANK = D_MODEL // 8
MLA_NOPE = HEAD_DIM
MLA_ROPE = HEAD_DIM // 2
MLA_V = HEAD_DIM
MLA_QK = MLA_NOPE + MLA_ROPE
CD_IN = (HY_ORDER + 1) * HY_WIDTH + MLA_Q_RANK + MLA_KV_RANK + MLA_ROPE
D_FF = 2816
N_EXPERTS = 8
TOP_K = 2
D_FF_EXPERT = 3584
MOE_BLOCK = 128

kernel_name = 'hybrid_lru_gqa_hyena_mla_moe'

F32 = jnp.float32


def rms_norm(x, g):
    xf = x.astype(F32)
    y = xf * lax.rsqrt(jnp.mean(xf * xf, axis=-1, keepdims=True) + EPS)
    return (y * g.astype(F32)).astype(x.dtype)


def modulate(h, shift, scale):
    return h * (1 + scale) + shift


def grid_angles(rows, rot_dim):
    n_freq = rot_dim // 4
    inv_freq = ROPE_THETA ** (-jnp.arange(n_freq, dtype=F32) / n_freq)
    t = jnp.arange(rows * GRID_W)
    row = (t // GRID_W).astype(F32)
    col = (t % GRID_W).astype(F32)
    ang = jnp.concatenate([row[:, None] * inv_freq, col[:, None] * inv_freq], axis=-1)
    return jnp.cos(ang), jnp.sin(ang)


def apply_rope(x, cos, sin):
    half = x.shape[-1] // 2
    shape = (1, cos.shape[0]) + (1,) * (x.ndim - 3) + (half,)
    cs = cos.reshape(shape).astype(x.dtype)
    sn = sin.reshape(shape).astype(x.dtype)
    x1, x2 = x[..., :half], x[..., half:]
    return jnp.concatenate([x1 * cs - x2 * sn, x1 * sn + x2 * cs], axis=-1)


def depthwise_conv(x, w, b, pad):
    y = lax.conv_general_dilated(x, w[:, None, :].astype(x.dtype), (1,), [pad],
                                 dimension_numbers=('NWC', 'WIO', 'NWC'),
                                 feature_group_count=x.shape[-1])
    return y + b.astype(x.dtype)


def attend_blocked(q, k, v):
    b_, sq, hk, g, dq = q.shape
    nb = sq // Q_BLOCK
    scale = dq ** -0.5
    qb = jnp.moveaxis(q.reshape(b_, nb, Q_BLOCK, hk, g, dq), 1, 0)

    def one_block(qi):
        s = jnp.einsum('bqhgd,bkhd->bhgqk', qi, k).astype(F32) * scale
        p = jax.nn.softmax(s, axis=-1).astype(v.dtype)
        return jnp.einsum('bhgqk,bkhe->bqhge', p, v)

    o = lax.map(one_block, qb)
    return jnp.moveaxis(o, 0, 1).reshape(b_, sq, hk, g, v.shape[-1])


def block_diag_linear(x, w, b):
    b_, l = x.shape[:2]
    xb = x.reshape(b_, l, LRU_BLOCKS, LRU_BLOCK_SIZE)
    y = jnp.einsum('blni,nij->blnj', xb, w.astype(F32)) + b.astype(F32)
    return y.reshape(b_, l, LRU_WIDTH)


def _linear_combine(left, right):
    return left[0] * right[0], right[0] * left[1] + right[1]


def rglru_scan(u, w_a, b_a, w_x, b_x, lam, h0):
    uf = u.astype(F32)
    r = jax.nn.sigmoid(block_diag_linear(uf, w_a, b_a))
    i = jax.nn.sigmoid(block_diag_linear(uf, w_x, b_x))
    log_a = -LRU_C * r * jax.nn.softplus(-lam.astype(F32))
    a = jnp.exp(log_a)
    bterm = jnp.sqrt(-jnp.expm1(2.0 * log_a)) * (i * uf)
    a_cum, b_cum = lax.associative_scan(_linear_combine, (a, bterm), axis=1)
    return a_cum * h0[:, None, :] + b_cum


def bidir_rglru(u, w_a, b_a, w_x, b_x, lam, h0_fwd, h0_bwd):
    h_f = rglru_scan(u, w_a[0], b_a[0], w_x[0], b_x[0], lam[0], h0_fwd)
    h_b = rglru_scan(u[:, ::-1], w_a[1], b_a[1], w_x[1], b_x[1], lam[1], h0_bwd)
    return h_f + h_b[:, ::-1], h_f[:, -1], h_b[:, -1]


def hyena_filters(length, w1, b1, w2, b2, w3, freq):
    t = jnp.arange(length, dtype=F32)[:, None]
    t_norm = t / max(length - 1, 1)
    bands = jnp.linspace(1e-4, HY_BANDS - 1, HY_BANDS, dtype=F32)
    ang = 2.0 * math.pi * t * bands / length
    z = jnp.concatenate([t_norm, jnp.cos(ang), -jnp.sin(ang)], axis=-1)
    fr = freq.astype(F32)
    h = jnp.sin(fr * (z @ w1.astype(F32) + b1.astype(F32)))
    h = jnp.sin(fr * (h @ w2.astype(F32) + b2.astype(F32)))
    h = h @ w3.astype(F32)
    deltas = jnp.abs(jnp.linspace(HY_MIN_DECAY, HY_MAX_DECAY, HY_WIDTH, dtype=F32))
    window = jnp.exp(-t_norm * deltas) + HY_SHIFT
    return h.reshape(length, HY_ORDER, 2, HY_WIDTH) * window[:, None, None, :]


def bidir_long_conv(u, h_fwd, h_bwd, skip):
    l, ch = h_fwd.shape
    uf = u.astype(F32)
    two_sided = jnp.concatenate([h_fwd, jnp.zeros((1, ch), F32), h_bwd[:0:-1]], axis=0)
    spec = jnp.fft.rfft(uf, n=2 * l, axis=1) * jnp.fft.rfft(two_sided, axis=0)[None]
    y = jnp.fft.irfft(spec, n=2 * l, axis=1)[:, :l]
    return (y + uf * skip.astype(F32)).astype(u.dtype)


def swiglu(h, w1, w3, w2):
    return (jax.nn.silu(h @ w1) * (h @ w3)) @ w2


def moe_swiglu(h, router, w1, w3, w2):
    b_, l, d = h.shape
    t = h.reshape(-1, d)
    n_assign = t.shape[0] * TOP_K
    logits = t.astype(F32) @ router.astype(F32)
    top_logit, top_e = lax.top_k(logits, TOP_K)
    gates = jax.nn.softmax(top_logit, axis=-1)
    flat_e = top_e.reshape(-1)
    flat_tok = jnp.arange(n_assign, dtype=jnp.int32) // TOP_K
    flat_g = gates.reshape(-1)
    order = jnp.argsort(flat_e)
    se = flat_e[order]
    counts = jnp.bincount(flat_e, length=N_EXPERTS)
    padded = (counts + MOE_BLOCK - 1) // MOE_BLOCK * MOE_BLOCK
    start = jnp.cumsum(counts) - counts
    pend = jnp.cumsum(padded)
    pstart = pend - padded
    dest = pstart[se] + jnp.arange(n_assign, dtype=jnp.int32) - start[se]
    n_blocks = -(-n_assign // MOE_BLOCK) + N_EXPERTS
    n_slots = n_blocks * MOE_BLOCK
    slot_tok = jnp.zeros((n_slots,), jnp.int32).at[dest].set(flat_tok[order])
    slot_gate = jnp.zeros((n_slots,), F32).at[dest].set(flat_g[order])
    block_expert = jnp.minimum(
        jnp.searchsorted(pend, jnp.arange(n_blocks, dtype=jnp.int32) * MOE_BLOCK, side='right'),
        N_EXPERTS - 1)
    xs = t[slot_tok].reshape(n_blocks, MOE_BLOCK, d)

    def expert_block(args):
        xb, e = args
        return swiglu(xb, w1[e], w3[e], w2[e])

    ys = lax.map(expert_block, (xs, block_expert)).reshape(n_slots, d)
    out = jnp.zeros_like(t).at[slot_tok].add(ys * slot_gate[:, None].astype(t.dtype))
    return out.reshape(b_, l, d)


def ab_mixer(hc, hl, w_in, w_out, conv_w, conv_b, w_a, b_a, w_x, b_x, lam, q_norm, k_norm,
             cos, sin, need_ctx):
    g = GQA_Q_HEADS // GQA_KV_HEADS
    cuts = [LRU_WIDTH, 2 * LRU_WIDTH, 2 * LRU_WIDTH + GQA_Q_HEADS * HEAD_DIM,
            2 * LRU_WIDTH + (GQA_Q_HEADS + GQA_KV_HEADS) * HEAD_DIM]

    def project(h):
        b_, l = h.shape[:2]
        xr, gate, q, k, v = jnp.split(h @ w_in, cuts, axis=-1)
        u = depthwise_conv(xr, conv_w, conv_b, (LRU_CONV // 2, LRU_CONV - 1 - LRU_CONV // 2))
        q = rms_norm(q.reshape(b_, l, GQA_KV_HEADS, g, HEAD_DIM), q_norm)
        k = rms_norm(k.reshape(b_, l, GQA_KV_HEADS, HEAD_DIM), k_norm)
        return u, gate, q, k, v.reshape(b_, l, GQA_KV_HEADS, HEAD_DIM)

    def merge(rec, gate, att):
        b_, l = rec.shape[:2]
        y = jnp.concatenate([rec.astype(gate.dtype) * jax.nn.gelu(gate),
                             att.reshape(b_, l, GQA_Q_HEADS * HEAD_DIM)], axis=-1)
        return y @ w_out

    uc, gc, qc, kc, vc = project(hc)
    h0 = jnp.zeros((hc.shape[0], LRU_WIDTH), F32)
    rc, s_fwd, s_bwd = bidir_rglru(uc, w_a, b_a, w_x, b_x, lam, h0, h0)
    ul, gl, ql, kl, vl = project(hl)
    rl, _, _ = bidir_rglru(ul, w_a, b_a, w_x, b_x, lam, s_fwd, s_bwd)
    ql = apply_rope(ql, cos, sin)
    kl = apply_rope(kl, cos, sin)
    al = attend_blocked(ql, jnp.concatenate([kc, kl], axis=1), jnp.concatenate([vc, vl], axis=1))
    out_l = merge(rl, gl, al)
    out_c = merge(rc, gc, attend_blocked(qc, kc, vc)) if need_ctx else None
    return out_l, out_c


def cd_mixer(hc, hl, w_in, w_out, conv_w, conv_b, fw1, fb1, fw2, fb2, fw3, freq, skip,
             q_a_norm, q_b, kv_a_norm, kv_b, q_norm, k_norm, cos, sin, need_ctx):
    hy_in = (HY_ORDER + 1) * HY_WIDTH
    col_q = hy_in
    col_kv = hy_in + MLA_Q_RANK

    def hyena(z):
        l = z.shape[1]
        z = depthwise_conv(z, conv_w, conv_b, (HY_CONV // 2, HY_CONV // 2))
        parts = jnp.split(z, HY_ORDER + 1, axis=-1)
        filt = hyena_filters(l, fw1, fb1, fw2, fb2, fw3, freq)
        y = parts[0]
        for o in range(HY_ORDER):
            y = parts[o + 1] * bidir_long_conv(y, filt[:, o, 0], filt[:, o, 1], skip[o])
        return y

    def queries(q_a):
        b_, l = q_a.shape[:2]
        q = (rms_norm(q_a, q_a_norm) @ q_b).reshape(b_, l, MLA_HEADS, 1, MLA_QK)
        return rms_norm(q, q_norm)

    def keys_values(kv_a, k_rope):
        b_, l = kv_a.shape[:2]
        kv = (rms_norm(kv_a, kv_a_norm) @ kv_b).reshape(b_, l, MLA_HEADS, MLA_NOPE + MLA_V)
        k_nope, v = jnp.split(kv, [MLA_NOPE], axis=-1)
        k_r = jnp.broadcast_to(k_rope[:, :, None, :], (b_, l, MLA_HEADS, MLA_ROPE))
        return rms_norm(jnp.concatenate([k_nope, k_r], axis=-1), k_norm), v

    def rope_tail(t):
        return jnp.concatenate([t[..., :MLA_NOPE], apply_rope(t[..., MLA_NOPE:], cos, sin)], axis=-1)

    def merge(hy, att):
        b_, l = hy.shape[:2]
        return jnp.concatenate([hy, att.reshape(b_, l, MLA_HEADS * MLA_V)], axis=-1) @ w_out

    if need_ctx:
        zc = hc @ w_in
        kc, vc = keys_values(zc[..., col_kv:col_kv + MLA_KV_RANK], zc[..., col_kv + MLA_KV_RANK:])
        out_c = merge(hyena(zc[..., :hy_in]), attend_blocked(queries(zc[..., col_q:col_kv]), kc, vc))
    else:
        zc = hc @ w_in[:, col_kv:]
        kc, vc = keys_values(zc[..., :MLA_KV_RANK], zc[..., MLA_KV_RANK:])
        out_c = None
    zl = hl @ w_in
    ql = rope_tail(queries(zl[..., col_q:col_kv]))
    kl, vl = keys_values(zl[..., col_kv:col_kv + MLA_KV_RANK], zl[..., col_kv + MLA_KV_RANK:])
    kl = rope_tail(kl)
    att = attend_blocked(ql, jnp.concatenate([kc, kl], axis=1), jnp.concatenate([vc, vl], axis=1))
    out_l = merge(hyena(zl[..., :hy_in]), att)
    return out_l, out_c


def setup_inputs(seed: int = 0) -> dict:
    key = jax.random.key(seed)
    ks = iter(jax.random.split(key, 64))

    def nrm(shape, scale):
        return scale * jax.random.normal(next(ks), shape, F32)

    def gain(shape):
        return 1.0 + nrm(shape, 0.02)

    d, ne, no = D_MODEL, N_EVEN, N_ODD
    a0 = jax.random.uniform(next(ks), (ne, 2, LRU_WIDTH), F32, 0.9, 0.999) ** (1.0 / LRU_C)
    inp = {}
    inp['x'] = nrm((BATCH, SEQ, d), 1.0)
    inp['c'] = nrm((BATCH, d), 1.0)
    inp['ctx'] = nrm((BATCH, CTX_LEN, d), 1.0)
    inp['c_ctx'] = nrm((d,), 1.0)
    inp['mod_w'] = nrm((DEPTH, d, N_MOD * d), 0.5 * d ** -0.5)
    inp['mod_b'] = nrm((DEPTH, N_MOD * d), 0.02)
    inp['norm1_g'] = gain((DEPTH, d))
    inp['norm2_g'] = gain((DEPTH, d))
    inp['ab_w_in'] = nrm((ne, d, AB_IN), d ** -0.5)
    inp['ab_w_out'] = nrm((ne, MIX_WIDTH, d), MIX_WIDTH ** -0.5)
    inp['lru_conv_w'] = nrm((ne, LRU_CONV, LRU_WIDTH), LRU_CONV ** -0.5)
    inp['lru_conv_b'] = nrm((ne, LRU_WIDTH), 0.02)
    inp['lru_w_a'] = nrm((ne, 2, LRU_BLOCKS, LRU_BLOCK_SIZE, LRU_BLOCK_SIZE), LRU_BLOCK_SIZE ** -0.5)
    inp['lru_b_a'] = nrm((ne, 2, LRU_BLOCKS, LRU_BLOCK_SIZE), 0.02)
    inp['lru_w_x'] = nrm((ne, 2, LRU_BLOCKS, LRU_BLOCK_SIZE, LRU_BLOCK_SIZE), LRU_BLOCK_SIZE ** -0.5)
    inp['lru_b_x'] = nrm((ne, 2, LRU_BLOCKS, LRU_BLOCK_SIZE), 0.02)
    inp['lru_lambda'] = jnp.log(a0) - jnp.log1p(-a0)
    inp['gqa_q_norm'] = gain((ne, HEAD_DIM))
    inp['gqa_k_norm'] = gain((ne, HEAD_DIM))
    inp['ffn_w1'] = nrm((ne, d, D_FF), d ** -0.5)
    inp['ffn_w3'] = nrm((ne, d, D_FF), d ** -0.5)
    inp['ffn_w2'] = nrm((ne, D_FF, d), D_FF ** -0.5)
    inp['cd_w_in'] = nrm((no, d, CD_IN), d ** -0.5)
    inp['cd_w_out'] = nrm((no, MIX_WIDTH, d), MIX_WIDTH ** -0.5)
    inp['hy_conv_w'] = nrm((no, HY_CONV, (HY_ORDER + 1) * HY_WIDTH), HY_CONV ** -0.5)
    inp['hy_conv_b'] = nrm((no, (HY_ORDER + 1) * HY_WIDTH), 0.02)
    inp['hy_filt_w1'] = nrm((no, HY_POS_DIM, HY_FILTER_HIDDEN), HY_POS_DIM ** -0.5)
    inp['hy_filt_b1'] = nrm((no, HY_FILTER_HIDDEN), 0.02)
    inp['hy_filt_w2'] = nrm((no, HY_FILTER_HIDDEN, HY_FILTER_HIDDEN), HY_FILTER_HIDDEN ** -0.5)
    inp['hy_filt_b2'] = nrm((no, HY_FILTER_HIDDEN), 0.02)
    inp['hy_filt_w3'] = nrm((no, HY_FILTER_HIDDEN, HY_ORDER * 2 * HY_WIDTH), 0.05 * HY_FILTER_HIDDEN ** -0.5)
    inp['hy_sin_freq'] = gain((no, HY_FILTER_HIDDEN))
    inp['hy_skip'] = nrm((no, HY_ORDER, HY_WIDTH), 0.5)
    inp['mla_q_a_norm'] = gain((no, MLA_Q_RANK))
    inp['mla_q_b'] = nrm((no, MLA_Q_RANK, MLA_HEADS * MLA_QK), MLA_Q_RANK ** -0.5)
    inp['mla_kv_a_norm'] = gain((no, MLA_KV_RANK))
    inp['mla_kv_b'] = nrm((no, MLA_KV_RANK, MLA_HEADS * (MLA_NOPE + MLA_V)), MLA_KV_RANK ** -0.5)
    inp['mla_q_norm'] = gain((no, MLA_QK))
    inp['mla_k_norm'] = gain((no, MLA_QK))
    inp['moe_router'] = nrm((no, d, N_EXPERTS), d ** -0.5)
    inp['moe_w1'] = nrm((no, N_EXPERTS, d, D_FF_EXPERT), d ** -0.5)
    inp['moe_w3'] = nrm((no, N_EXPERTS, d, D_FF_EXPERT), d ** -0.5)
    inp['moe_w2'] = nrm((no, N_EXPERTS, D_FF_EXPERT, d), D_FF_EXPERT ** -0.5)
    return inp


def reference(x, c, ctx, c_ctx, mod_w, mod_b, norm1_g, norm2_g,
              ab_w_in, ab_w_out, lru_conv_w, lru_conv_b, lru_w_a, lru_b_a, lru_w_x, lru_b_x, lru_lambda,
              gqa_q_norm, gqa_k_norm, ffn_w1, ffn_w3, ffn_w2,
              cd_w_in, cd_w_out, hy_conv_w, hy_conv_b, hy_filt_w1, hy_filt_b1, hy_filt_w2, hy_filt_b2,
              hy_filt_w3, hy_sin_freq, hy_skip, mla_q_a_norm, mla_q_b, mla_kv_a_norm, mla_kv_b,
              mla_q_norm, mla_k_norm, moe_router, moe_w1, moe_w3, moe_w2):
    rows = x.shape[1] // GRID_W
    cos_g, sin_g = grid_angles(rows, HEAD_DIM)
    cos_m, sin_m = grid_angles(rows, MLA_ROPE)
    silu_l = jax.nn.silu(c)
    silu_c = jax.nn.silu(c_ctx)[None, :]
    xl, xc = x, ctx
    for layer in range(DEPTH):
        j = layer // 2
        even = layer % 2 == 0
        need_ctx = layer < DEPTH - 1
        mod_l = [m[:, None, :] for m in jnp.split(silu_l @ mod_w[layer] + mod_b[layer], N_MOD, axis=-1)]
        mod_c = [m[:, None, :] for m in jnp.split(silu_c @ mod_w[layer] + mod_b[layer], N_MOD, axis=-1)]
        hl = modulate(rms_norm(xl, norm1_g[layer]), mod_l[0], mod_l[1])
        hc = modulate(rms_norm(xc, norm1_g[layer]), mod_c[0], mod_c[1])
        if even:
            mix_l, mix_c = ab_mixer(hc, hl, ab_w_in[j], ab_w_out[j], lru_conv_w[j], lru_conv_b[j],
                                    lru_w_a[j], lru_b_a[j], lru_w_x[j], lru_b_x[j], lru_lambda[j],
                                    gqa_q_norm[j], gqa_k_norm[j], cos_g, sin_g, need_ctx)
        else:
            mix_l, mix_c = cd_mixer(hc, hl, cd_w_in[j], cd_w_out[j], hy_conv_w[j], hy_conv_b[j],
                                    hy_filt_w1[j], hy_filt_b1[j], hy_filt_w2[j], hy_filt_b2[j],
                                    hy_filt_w3[j], hy_sin_freq[j], hy_skip[j],
                                    mla_q_a_norm[j], mla_q_b[j], mla_kv_a_norm[j], mla_kv_b[j],
                                    mla_q_norm[j], mla_k_norm[j], cos_m, sin_m, need_ctx)

        def channel_mix(h):
            if even:
                return swiglu(h, ffn_w1[j], ffn_w3[j], ffn_w2[j])
            return moe_swiglu(h, moe_router[j], moe_w1[j], moe_w3[j], moe_w2[j])

        xl = xl + mod_l[2] * mix_l
        xl = xl + mod_l[5] * channel_mix(modulate(rms_norm(xl, norm2_g[layer]), mod_l[3], mod_l[4]))
        if need_ctx:
            xc = xc + mod_c[2] * mix_c
            xc = xc + mod_c[5] * channel_mix(modulate(rms_norm(xc, norm2_g[layer]), mod_c[3], mod_c[4]))
    return xl
```

```cpp
#include <hip/hip_runtime.h>
#include <hip/hip_cooperative_groups.h>
#include <cstdio>
#include <cstdint>
#include <cmath>

constexpr int NB = 8, SEQ = 2048, CTX = 256, RPB = SEQ + CTX, MROWS = NB * RPB, DM = 1024, NLAT = NB * SEQ;
constexpr int NMOD = 6, MODLD = NMOD * DM;
constexpr int AB_IN = 1792, CD_IN = 1952, CD_LD = 2048, DFF = 2816, NEXP = 8, DFE = 3584;
constexpr float EPS = 1e-6f;
constexpr float LOG2E = 1.4426950408889634f;
constexpr float QSCALE0 = 0.125f * LOG2E;
constexpr float QSCALE1 = 0.10206207261596577f * LOG2E;

typedef unsigned short bf16_t;
typedef float f32x4 __attribute__((ext_vector_type(4)));
typedef unsigned u32x4 __attribute__((ext_vector_type(4)));
typedef unsigned u32x2 __attribute__((ext_vector_type(2)));

__device__ __forceinline__ int mod_row(int r) { int b = r / RPB, s = r % RPB; return s < CTX ? 8 : b; }
__device__ __forceinline__ int latent_row(int m) { return (m / SEQ) * RPB + CTX + (m % SEQ); }

__device__ __forceinline__ float bf2f(bf16_t v) { return __uint_as_float((unsigned)v << 16); }
typedef float hd_f32x2 __attribute__((ext_vector_type(2))); typedef __bf16 hd_bf16x2 __attribute__((ext_vector_type(2)));
__device__ __forceinline__ unsigned pk2(float lo, float hi) { hd_f32x2 v = {lo, hi}; hd_bf16x2 b = __builtin_convertvector(v, hd_bf16x2); return __builtin_bit_cast(unsigned, b); }
__device__ __forceinline__ bf16_t f2bf(float f) { return (bf16_t)(pk2(f, 0.f) & 0xffffu); }
__device__ __forceinline__ float ldf(const float* p) { return *p; }
__device__ __forceinline__ float ldf(const bf16_t* p) { return bf2f(*p); }
__device__ __forceinline__ void stf(float* p, float v) { *p = v; }
__device__ __forceinline__ void stf(bf16_t* p, float v) { *p = f2bf(v); }

__device__ __forceinline__ float silu_f(float x) { return x / (1.f + expf(-x)); }
__device__ __forceinline__ float sigmoid_f(float x) { return 1.f / (1.f + expf(-x)); }
__device__ __forceinline__ float gelu_tanh(float x) { return 0.5f * x * (1.f + tanhf(0.7978845608028654f * (x + 0.044715f * x * x * x))); }
__device__ __forceinline__ float softplus_f(float x) { return fmaxf(x, 0.f) + log1pf(expf(-fabsf(x))); }

__device__ __forceinline__ float wave_sum(float v) {
#pragma unroll
    for (int o = 1; o < 64; o <<= 1) v += __shfl_xor(v, o);
    return v;
}
__device__ __forceinline__ float wave_max(float v) {
#pragma unroll
    for (int o = 1; o < 64; o <<= 1) v = fmaxf(v, __shfl_xor(v, o));
    return v;
}

constexpr size_t MiB = 1ull << 20;
constexpr size_t WS_CTL = 0, CTL_BYTES = 256 * 1024;
constexpr size_t WS_MOD = 1 * MiB;
constexpr size_t WS_SC = WS_MOD + 512 * 1024;
constexpr size_t WS_W13M = 4 * MiB;
constexpr size_t WS_W2M = 116 * MiB;
constexpr size_t WS_WIN0 = 172 * MiB;
constexpr size_t WS_WOUT0 = WS_WIN0 + (size_t)1792 * 1024 * 2;
constexpr size_t WS_WF13 = WS_WOUT0 + (size_t)1024 * 1024 * 2;
constexpr size_t WS_WF2 = WS_WF13 + (size_t)5632 * 1024 * 2;
constexpr size_t WS_WIN1 = WS_WF2 + (size_t)1024 * 2816 * 2;
constexpr size_t WS_WOUT1 = WS_WIN1 + (size_t)2048 * 1024 * 2;
constexpr size_t WS_WQB = WS_WOUT1 + (size_t)1024 * 1024 * 2;
constexpr size_t WS_WKVB = WS_WQB + (size_t)768 * 256 * 2;
constexpr size_t WS_WLRU = WS_WKVB + (size_t)1024 * 256 * 2;
constexpr size_t WS_WEND = WS_WLRU + (size_t)2 * 8 * 2 * 64 * 64 * 2;
static_assert(WS_WEND <= 202 * MiB, "weights region");
constexpr size_t WS_X = 202 * MiB;
constexpr size_t WS_H = 274 * MiB;
constexpr size_t WS_Z = 310 * MiB;
constexpr size_t WS_Y = 382 * MiB;
constexpr size_t WS_ACT = WS_Z;
constexpr size_t WS_R2 = 418 * MiB;
constexpr size_t WS_END = 502 * MiB;
static_assert(WS_ACT + (size_t)MROWS * DFF * 2 <= WS_R2, "ACT overlay");
constexpr size_t WS_QB = WS_R2;
constexpr size_t WS_KB = WS_QB + (size_t)MROWS * 512 * 2;
constexpr size_t WS_VB = WS_KB + (size_t)MROWS * 128 * 2;
constexpr size_t WS_AGG = WS_VB + (size_t)MROWS * 128 * 2;
constexpr size_t WS_R2L0END = WS_AGG + (size_t)2 * 8 * 72 * 2 * 512 * 4;
constexpr size_t WS_ZT = WS_R2;
constexpr size_t WS_HT = WS_ZT + (size_t)1536 * NLAT * 2;
constexpr size_t WS_GT = WS_HT + (size_t)512 * NLAT * 2;
constexpr int GT_LD = 4224;
constexpr size_t WS_R2L1END = WS_GT + (size_t)2 * 512 * GT_LD * 2;
static_assert(WS_R2L0END <= WS_END && WS_R2L1END <= WS_END, "R2");
constexpr size_t WS_QA = WS_Y;
constexpr size_t WS_KVA = WS_QA + (size_t)MROWS * 256 * 2;
constexpr size_t WS_KR = WS_KVA + (size_t)MROWS * 256 * 2;
constexpr size_t WS_QR = WS_Z;
constexpr size_t WS_KVR = WS_QR + (size_t)MROWS * 768 * 2;
static_assert(WS_KVR + (size_t)MROWS * 1024 * 2 <= WS_Y && WS_KR + (size_t)MROWS * 32 * 2 <= WS_R2, "layer-1 overlays");
constexpr size_t WS_QM = WS_H;
static_assert((size_t)MROWS * 768 * 2 <= 36 * MiB, "QM in H");
constexpr size_t DO_KM = 0;
constexpr size_t DO_VM = (size_t)MROWS * 768 * 2;
static_assert(DO_VM + (size_t)MROWS * 512 * 2 <= (size_t)NLAT * DM * 4, "d_out scratch");
constexpr int MAXSLOT = 34816;
constexpr size_t WS_XG = WS_WIN0;
constexpr size_t WS_ACT2 = WS_XG + (size_t)MAXSLOT * 1024 * 2;
constexpr size_t WS_H2 = WS_ACT2 + (size_t)MAXSLOT * 3584 * 2 - (size_t)NLAT * 1024 * 2;
static_assert(WS_ACT2 + (size_t)MAXSLOT * 3584 * 2 <= WS_END, "MoE overlay");
constexpr size_t CT_BAR = 0;
constexpr size_t CT_PCNT = 16 * 1024;
constexpr size_t CT_MCNT = 48 * 1024;
constexpr size_t CT_HIST = 32 * 1024;
constexpr size_t CT_CNT = 48 * 1024;
constexpr size_t CT_CURSOR = 80 * 1024;
constexpr size_t CT_DONE = 80 * 1024 + 256;
constexpr size_t CT_SSQA = 96 * 1024;
constexpr size_t CT_SSQB = CT_SSQA + (size_t)MROWS * 4;
static_assert(CT_SSQB + (size_t)MROWS * 4 <= CTL_BYTES, "ssq in the zeroed control region");
constexpr size_t WS_SLOTTOK = 2 * MiB;
constexpr size_t WS_SLOTGATE = WS_SLOTTOK + (size_t)MAXSLOT * 4;
constexpr size_t WS_SEL = WS_SLOTGATE + (size_t)MAXSLOT * 4;
constexpr size_t WS_TOKSLOT = WS_SEL + (size_t)NLAT * 16;
static_assert(WS_TOKSLOT + (size_t)NLAT * 8 <= WS_W13M, "small tables");
constexpr size_t WS_ROPE0 = 3 * MiB;
constexpr size_t WS_ROPE1 = 3 * MiB + 512 * 1024;
static_assert(WS_TOKSLOT + (size_t)NLAT * 8 <= WS_ROPE0 && WS_ROPE1 + 256 * 1024 <= WS_W13M, "rope tables");
constexpr size_t WS_CBF1 = WS_SC + 64 * 1024;
constexpr size_t WS_CBIN1 = WS_CBF1 + 9 * 5632 * 4;
static_assert(WS_CBIN1 + 9 * 2048 * 4 <= WS_SLOTTOK, "bias vectors");
constexpr size_t WS_Y2 = WS_XG;
namespace pg8 {
#define PG8_LAS __attribute__((address_space(3)))
typedef unsigned short bf16_t;
typedef short bf16x8 __attribute__((ext_vector_type(8)));
typedef float f32x4 __attribute__((ext_vector_type(4)));
typedef unsigned u32x4 __attribute__((ext_vector_type(4)));
constexpr int BM = 256, BK = 64, HALF = 128, HTB = HALF * BK * 2  , STAGE_BYTES = 8 * HTB, NXCD = 8, WGM = 8;

__host__ __device__ __forceinline__ int lds_byte(int r, int c) { const int st = (r >> 4) * 2 + (c >> 5), rr = r & 15, cc = c & 31, ob = rr * 64 + cc * 2; return st * 1024 + (ob ^ (((ob >> 9) & 1) << 5)); }
__host__ __device__ __forceinline__ void stage_rc(int b, int& R, int& C) { const int st = b / 1024, sb = b % 1024, swz = sb ^ (((sb >> 9) & 1) << 5); R = (st >> 1) * 16 + swz / 64; C = (st & 1) * 32 + (swz % 64) / 2; }
__host__ __device__ __forceinline__ int perm32(int rho) { const int n = rho >> 4, i = rho & 15; return 8 * (i >> 2) + 4 * n + (i & 3); }

struct Unit { int pm, pn; };
struct Gemm { const bf16_t* A; const bf16_t* Bt; int M, N, K; };

struct StaticOrder {
    int nM, nN, nwg, G, c;
    __host__ __device__ void init(int M, int N, int G_, int c_) { nM = M / BM; nN = N / BM; nwg = nM * nN; G = G_; c = c_; }
    __host__ __device__ bool next(int i, Unit& u) const {
        const long L = (long)i * G + c; if (L >= nwg) return false;
        int wgid = (int)L; { const int q = nwg / NXCD, r = nwg % NXCD, xcd = wgid % NXCD, off = wgid / NXCD; wgid = (xcd < r ? xcd * (q + 1) : r * (q + 1) + (xcd - r) * q) + off; }
        const int nig = WGM * nN, gid = wgid / nig, fm = gid * WGM, gsz = (nM - fm) < WGM ? (nM - fm) : WGM;
        u.pm = fm + ((wgid % nig) % gsz); u.pn = (wgid % nig) / gsz; return true;
    }
    __device__ __forceinline__ void a_ready(const Unit&) const {}
    __device__ __forceinline__ void done(const Unit&) const {}
};

__device__ __forceinline__ unsigned cvt_pk_bf16(float lo, float hi) { unsigned r; asm volatile("v_cvt_pk_bf16_f32 %0, %1, %2" : "=v"(r) : "v"(lo), "v"(hi)); return r; }
typedef float f32x2 __attribute__((ext_vector_type(2)));
__device__ __forceinline__ f32x2 gelu_pk(f32x2 v) {
    const f32x2 av = __builtin_elementwise_abs(v), d = av * 0.2316418882f + 1.0f;
    f32x2 t; t.x = __builtin_amdgcn_rcpf(d.x); t.y = __builtin_amdgcn_rcpf(d.y);
    f32x2 q = t * 0.5307027145f + (-0.7265760135f); q = q * t + 0.7107068705f; q = q * t + (-0.142248368f); q = q * t + 0.127414796f; q = q * t;
    const f32x2 s = (v * v) * (-0.72134752044f);
    f32x2 e; e.x = __builtin_amdgcn_exp2f(s.x); e.y = __builtin_amdgcn_exp2f(s.y);
    const f32x2 m = v * (q * e), r = v - m;
    f32x2 o; o.x = v.x < 0.f ? m.x : r.x; o.y = v.y < 0.f ? m.y : r.y; return o;
}

template <int ACT  > struct EpiBf16 {
    static constexpr bool PERM = true, AFTER_DRAIN = false; static_assert(ACT == 0 || ACT == 1, "EpiBf16: ACT is 0 (none) or 1 (gelu_pk)");
    bf16_t* O; int ldc; const float* bias; int split_cols; size_t split_stride; float scale0;
    __device__ __forceinline__ void operator()(const f32x4 (&acc)[2][2][4][2], const Unit& u, int wr, int wc, int fr, int fq) const {
        const int row0 = u.pm * BM + wr * 64 + fr; int colt = u.pn * BM; bf16_t* base = O;
        float sc = 1.f; if (split_cols) { const int t = colt / split_cols; base += (size_t)t * split_stride; colt -= t * split_cols; if (t == 0) sc = scale0; }
        const int col0 = colt + wc * 32 + 8 * fq, bcol0 = u.pn * BM + wc * 32 + 8 * fq;
        f32x4 bv[2][2];
#pragma unroll
        for (int bj = 0; bj < 2; ++bj)
#pragma unroll
            for (int n = 0; n < 2; ++n) bv[bj][n] = bias ? *(const f32x4*)(bias + bcol0 + bj * HALF + 4 * n) : (f32x4){0.f, 0.f, 0.f, 0.f};
#pragma unroll
        for (int ai = 0; ai < 2; ++ai)
#pragma unroll
            for (int m = 0; m < 4; ++m) { bf16_t* rowp = base + (size_t)(row0 + ai * HALF + m * 16) * ldc + col0;
#pragma unroll
                for (int bj = 0; bj < 2; ++bj) { f32x4 v0 = acc[ai][bj][m][0] + bv[bj][0], v1 = acc[ai][bj][m][1] + bv[bj][1];
                    if (ACT == 1) { f32x2 a = gelu_pk((f32x2){v0[0], v0[1]}), b = gelu_pk((f32x2){v0[2], v0[3]}), c = gelu_pk((f32x2){v1[0], v1[1]}), d = gelu_pk((f32x2){v1[2], v1[3]});
                        v0 = (f32x4){a.x, a.y, b.x, b.y}; v1 = (f32x4){c.x, c.y, d.x, d.y}; }
                    v0 = v0 * sc; v1 = v1 * sc; u32x4 w; w.x = cvt_pk_bf16(v0[0], v0[1]); w.y = cvt_pk_bf16(v0[2], v0[3]); w.z = cvt_pk_bf16(v1[0], v1[1]); w.w = cvt_pk_bf16(v1[2], v1[3]);
                    *(u32x4*)(rowp + bj * HALF) = w; } }
    }
};

template <class Epi, class Sched, bool ALIGN_EPI = false, bool SP2 = false>
__device__ __forceinline__ void gemm_phase(PG8_LAS unsigned char* lds, const Gemm g, const Sched& S, const Epi& E) {
    int tid_ = threadIdx.x; asm volatile("" : "+v"(tid_));
    const int tid = tid_, wid = __builtin_amdgcn_readfirstlane(tid >> 6), lane = tid & 63, wr = wid >> 2, wc = wid & 3, fr = lane & 15, fq = lane >> 4;
    const int K = g.K, nt = K / BK;
    unsigned voffA[2], voffB[2];
#pragma unroll
    for (int i = 0; i < 2; ++i) { int R, C; stage_rc(tid * 16 + i * 8192, R, C); const int Rb = Epi::PERM ? ((R & ~31) + perm32(R & 31)) : R;
        voffA[i] = (unsigned)(R * K + C) * 2u; voffB[i] = (unsigned)(Rb * K + C) * 2u; }
    const size_t kstep = (size_t)(BK * 2);
    const size_t hstep = (size_t)HALF * K * 2;
    const size_t tstep = 2 * hstep;
    const unsigned ldsw = (unsigned)wid * 1024u;
    const int aoff = lds_byte(wr * 64 + fr, fq * 8), boff = lds_byte(wc * 32 + fr, fq * 8);
#define PG8_SA(b, h) (((b) * 2 + (h)) * HTB)
#define PG8_SB(b, h) ((4 + (b) * 2 + (h)) * HTB)
#define PG8_STAGE(bufoff, gbase, voff) do { _Pragma("unroll") for (int _i = 0; _i < 2; ++_i) \
        __builtin_amdgcn_global_load_lds((const unsigned*)((const char*)(gbase) + (voff)[_i]), (PG8_LAS unsigned*)(lds + (bufoff) + ldsw + _i * 8192), 16, 0, 0); } while (0)
#define PG8_LDA(dst, b, h) do { _Pragma("unroll") for (int m = 0; m < 4; ++m) _Pragma("unroll") for (int k = 0; k < 2; ++k) dst[m][k] = *(const PG8_LAS bf16x8*)(lds + PG8_SA(b, h) + aoff + m * 2048 + k * 1024); } while (0)
#define PG8_LDB(dst, b, h) do { _Pragma("unroll") for (int n = 0; n < 2; ++n) _Pragma("unroll") for (int k = 0; k < 2; ++k) dst[n][k] = *(const PG8_LAS bf16x8*)(lds + PG8_SB(b, h) + boff + n * 2048 + k * 1024); } while (0)
#define PG8_MMA(ai, bj, At, Bt) do { __builtin_amdgcn_s_setprio(1); _Pragma("unroll") for (int m = 0; m < 4; ++m) _Pragma("unroll") for (int n = 0; n < 2; ++n) _Pragma("unroll") for (int k = 0; k < 2; ++k) \
        acc[ai][bj][m][n] = __builtin_amdgcn_mfma_f32_16x16x32_bf16(Bt[n][k], At[m][k], acc[ai][bj][m][n], 0, 0, 0); __builtin_amdgcn_s_setprio(0); } while (0)
#define PG8_WAIT_V(n) asm volatile("s_waitcnt vmcnt(" #n ")" ::: "memory")
#define PG8_WAIT_L(n) asm volatile("s_waitcnt lgkmcnt(" #n ")" ::: "memory")
#define PG8_BAR __builtin_amdgcn_s_barrier()
#define PG8_SCHED __builtin_amdgcn_sched_barrier(0)
    Unit cur, nxt; int ui = 0;
    if (!S.next(0, cur)) return;
    f32x4 acc[2][2][4][2];
#pragma unroll
    for (int a = 0; a < 2; ++a)
#pragma unroll
        for (int b = 0; b < 2; ++b)
#pragma unroll
            for (int m = 0; m < 4; ++m)
#pragma unroll
                for (int n = 0; n < 2; ++n) acc[a][b][m][n] = (f32x4){0.f, 0.f, 0.f, 0.f};
    bf16x8 At[4][2], B0[2][2], B1[2][2];
    const char* cA = (const char*)g.A + (size_t)cur.pm * tstep; const char* cB = (const char*)g.Bt + (size_t)cur.pn * tstep;
    S.a_ready(cur);
    if constexpr (SP2) {
        PG8_STAGE(PG8_SB(0, 0), cB, voffB); PG8_STAGE(PG8_SB(0, 1), cB + hstep, voffB); PG8_STAGE(PG8_SA(0, 0), cA, voffA); PG8_STAGE(PG8_SA(0, 1), cA + hstep, voffA);
        if (wr == 1) PG8_BAR;
        PG8_WAIT_V(2); PG8_BAR;
        PG8_STAGE(PG8_SB(1, 0), cB + kstep, voffB); PG8_STAGE(PG8_SA(1, 0), cA + kstep, voffA); PG8_STAGE(PG8_SB(1, 1), cB + hstep + kstep, voffB);
        PG8_WAIT_V(6); PG8_BAR;
    } else {
        PG8_STAGE(PG8_SB(0, 0), cB, voffB); PG8_STAGE(PG8_SA(0, 0), cA, voffA); PG8_STAGE(PG8_SB(0, 1), cB + hstep, voffB); PG8_STAGE(PG8_SA(0, 1), cA + hstep, voffA);
        if (wr == 1) PG8_BAR;
        PG8_WAIT_V(4); PG8_BAR;
        PG8_STAGE(PG8_SB(1, 0), cB + kstep, voffB); PG8_STAGE(PG8_SA(1, 0), cA + kstep, voffA); PG8_STAGE(PG8_SB(1, 1), cB + hstep + kstep, voffB);
        PG8_WAIT_V(6); PG8_BAR;
    }
    for (;;) {
        const bool has_next = S.next(ui + 1, nxt);
        const char* nA = has_next ? (const char*)g.A + (size_t)nxt.pm * tstep : cA; const char* nB = has_next ? (const char*)g.Bt + (size_t)nxt.pn * tstep : cB;
        for (int t = 0; t < nt; t += 2) {
            const bool last = (t == nt - 2);
            const char* a1 = cA + (size_t)(t + 1) * kstep;
            const char* a2 = last ? nA : cA + (size_t)(t + 2) * kstep; const char* b2 = last ? nB : cB + (size_t)(t + 2) * kstep;
            const char* a3 = a2 + kstep; const char* b3 = b2 + kstep;
            if (last && has_next) S.a_ready(nxt);
            if constexpr (SP2) {
            PG8_LDB(B0, 0, 0); PG8_LDB(B1, 0, 1); PG8_SCHED; PG8_LDA(At, 0, 0); PG8_STAGE(PG8_SA(1, 1), a1 + hstep, voffA);
            PG8_WAIT_V(8); PG8_WAIT_L(0); PG8_BAR; PG8_MMA(0, 0, At, B0); PG8_MMA(0, 1, At, B1); PG8_BAR; PG8_SCHED;
            PG8_LDA(At, 0, 1); PG8_STAGE(PG8_SB(0, 0), b2, voffB); PG8_STAGE(PG8_SB(0, 1), b2 + hstep, voffB); PG8_STAGE(PG8_SA(0, 0), a2, voffA);
            PG8_WAIT_V(8); PG8_WAIT_L(0); PG8_BAR; PG8_MMA(1, 0, At, B0); PG8_MMA(1, 1, At, B1); PG8_BAR; PG8_SCHED;
            PG8_LDB(B0, 1, 0); PG8_LDB(B1, 1, 1); PG8_SCHED; PG8_LDA(At, 1, 0); PG8_STAGE(PG8_SA(0, 1), a2 + hstep, voffA);
            PG8_WAIT_V(8); PG8_WAIT_L(0); PG8_BAR; PG8_MMA(0, 0, At, B0); PG8_MMA(0, 1, At, B1); PG8_BAR; PG8_SCHED;
            PG8_LDA(At, 1, 1); PG8_STAGE(PG8_SB(1, 0), b3, voffB); PG8_STAGE(PG8_SB(1, 1), b3 + hstep, voffB); PG8_STAGE(PG8_SA(1, 0), a3, voffA);
            PG8_WAIT_V(8); PG8_WAIT_L(0); PG8_BAR; PG8_MMA(1, 0, At, B0); PG8_MMA(1, 1, At, B1); PG8_BAR; PG8_SCHED;
            } else {
            PG8_LDB(B0, 0, 0); PG8_SCHED; PG8_LDA(At, 0, 0); PG8_STAGE(PG8_SA(1, 1), a1 + hstep, voffA);
            PG8_WAIT_L(8); PG8_BAR; PG8_WAIT_L(0); PG8_MMA(0, 0, At, B0); PG8_BAR; PG8_SCHED;
            PG8_LDB(B1, 0, 1); PG8_STAGE(PG8_SB(0, 0), b2, voffB);
            PG8_BAR; PG8_WAIT_L(0); PG8_MMA(0, 1, At, B1); PG8_BAR;
            PG8_LDA(At, 0, 1); PG8_STAGE(PG8_SA(0, 0), a2, voffA);
            PG8_BAR; PG8_WAIT_L(0); PG8_MMA(1, 0, At, B0); PG8_BAR; PG8_SCHED;
            PG8_STAGE(PG8_SB(0, 1), b2 + hstep, voffB);
            PG8_WAIT_V(6); PG8_BAR; PG8_MMA(1, 1, At, B1); PG8_BAR;
            PG8_LDB(B0, 1, 0); PG8_SCHED; PG8_LDA(At, 1, 0); PG8_STAGE(PG8_SA(0, 1), a2 + hstep, voffA);
            PG8_WAIT_L(8); PG8_BAR; PG8_WAIT_L(0); PG8_MMA(0, 0, At, B0); PG8_BAR; PG8_SCHED;
            PG8_LDB(B1, 1, 1); PG8_STAGE(PG8_SB(1, 0), b3, voffB);
            PG8_BAR; PG8_WAIT_L(0); PG8_MMA(0, 1, At, B1); PG8_BAR;
            PG8_LDA(At, 1, 1); PG8_STAGE(PG8_SA(1, 0), a3, voffA);
            PG8_BAR; PG8_WAIT_L(0); PG8_MMA(1, 0, At, B0); PG8_BAR; PG8_SCHED;
            PG8_STAGE(PG8_SB(1, 1), b3 + hstep, voffB);
            PG8_WAIT_V(6); PG8_BAR; PG8_MMA(1, 1, At, B1); PG8_BAR;
            }
        }
        if constexpr (ALIGN_EPI) { if (wr == 0) PG8_BAR; }
        if constexpr (!Epi::AFTER_DRAIN) { E(acc, cur, wr, wc, fr, fq); S.done(cur); }
        if (!has_next) break;
#pragma unroll
        for (int a = 0; a < 2; ++a)
#pragma unroll
            for (int b = 0; b < 2; ++b)
#pragma unroll
                for (int m = 0; m < 4; ++m)
#pragma unroll
                    for (int n = 0; n < 2; ++n) acc[a][b][m][n] = (f32x4){0.f, 0.f, 0.f, 0.f};
        cur = nxt; cA = nA; cB = nB; ++ui;
        if constexpr (ALIGN_EPI) { if (wr == 1) PG8_BAR; }
    }
    PG8_WAIT_V(0);
    if constexpr (!ALIGN_EPI) { if (wr == 0) PG8_BAR; }
    PG8_BAR;
    if constexpr (Epi::AFTER_DRAIN) { E.fused(acc, cur, wr, wc, fr, fq, lds, wid, lane); S.done(cur); }
#undef PG8_SA
#undef PG8_SB
#undef PG8_STAGE
#undef PG8_LDA
#undef PG8_LDB
#undef PG8_MMA
#undef PG8_WAIT_V
#undef PG8_WAIT_L
#undef PG8_BAR
#undef PG8_SCHED
}
}
namespace pg8 {
__device__ __forceinline__ float fast_silu(float v) { return v * __builtin_amdgcn_rcpf(1.f + __builtin_amdgcn_exp2f(-1.4426950408889634f * v)); }

struct DenseOrder {
    int nM, nN, nreg, nwg, G, c, mode, wgm;
    __device__ __forceinline__ void init(int nM_, int nN_, int G_, int c_, int mode_) { nM = nM_; nN = nN_; G = G_; c = c_; mode = mode_; nreg = nM * nN; nwg = nreg + (mode == 2 ? 8 : 0); wgm = WGM; }
    __device__ __forceinline__ bool next(int i, Unit& u) const {
        const long L = (long)i * G + c; if (L >= nwg) return false;
        if (mode == 2 && L >= nreg) { u.pm = 9 * (int)(L - nreg); u.pn = nN - 1; return true; }
        int wgid = (int)L; { const int q = nreg / NXCD, r = nreg % NXCD, xcd = wgid % NXCD, off = wgid / NXCD; wgid = (xcd < r ? xcd * (q + 1) : r * (q + 1) + (xcd - r) * q) + off; }
        const int nig = wgm * nN, gid = wgid / nig, fm = gid * wgm, gsz = (nM - fm) < wgm ? (nM - fm) : wgm;
        int pm = fm + ((wgid % nig) % gsz); u.pn = (wgid % nig) / gsz;
        if (mode != 0) pm = 9 * (pm >> 3) + 1 + (pm & 7);
        u.pm = pm; return true;
    }
    __device__ __forceinline__ void a_ready(const Unit&) const {}
    __device__ __forceinline__ void done(const Unit&) const {}
};
struct MoeOrder {
    const PG8_LAS int* tb; int nN, G, c;
    __device__ __forceinline__ bool next(int i, Unit& u) const {
        const int nwg = tb[8] * nN; long L = (long)i * G + c; if (L >= nwg) return false;
        { const int wg = (int)L, q = nwg / NXCD, r = nwg % NXCD, xcd = wg % NXCD, off = wg / NXCD; L = (xcd < r ? xcd * (q + 1) : r * (q + 1) + (xcd - r) * q) + off; }
        int e = 0;
#pragma unroll
        for (int k = 1; k < 8; ++k) if (L >= (long)tb[k] * nN) e = k;
        const int Le = (int)(L - (long)tb[e] * nN), mt = tb[e + 1] - tb[e];
        const int nig = WGM * nN, gid = Le / nig, fm = gid * WGM, gsz = (mt - fm) < WGM ? (mt - fm) : WGM;
        u.pm = tb[e] + fm + ((Le % nig) % gsz); u.pn = e * nN + (Le % nig) / gsz; return true;
    }
    __device__ __forceinline__ void a_ready(const Unit&) const {}
    __device__ __forceinline__ void done(const Unit&) const {}
};

template <bool SRCIN, bool FUSE> struct EpiResGate {
    static constexpr bool PERM = true, AFTER_DRAIN = false;
    const float* xin; float* xout; const float* modbase; int compact;
    const float* xsrc_lat; const float* xsrc_ctx; bf16_t* hraw; const float* gnext; const float* nscale; float* ssq;
    __device__ __forceinline__ void operator()(const f32x4 (&acc)[2][2][4][2], const Unit& u, int wr, int wc, int fr, int fq) const {
        const int b = u.pm / 9, pj = u.pm - 9 * b; const int mrow = (pj == 0) ? 8 : b;
        const float* g = modbase + (size_t)mrow * 6144;
        const int col0 = u.pn * BM + wc * 32 + 8 * fq;
        f32x4 gv[2][2];
#pragma unroll
        for (int bj = 0; bj < 2; ++bj)
#pragma unroll
            for (int n = 0; n < 2; ++n) gv[bj][n] = *(const f32x4*)(g + col0 + bj * HALF + n * 4);
        const int row0 = u.pm * BM + wr * 64 + fr; const int oshift = compact ? 256 * (b + 1) : 0;
        const float* xbase = SRCIN ? (pj == 0 ? xsrc_ctx + (size_t)b * 256 * 1024 : xsrc_lat + ((size_t)b * 2048 + (pj - 1) * 256) * 1024) - (size_t)u.pm * BM * 1024 : xin;
        const float* ns = nscale + (size_t)mrow * 6144;
#pragma unroll
        for (int am = 0; am < 4; ++am) { const int ai = am >> 1;
            f32x4 xv[2][2][2];
#pragma unroll
            for (int mm = 0; mm < 2; ++mm) { const int m = (am & 1) * 2 + mm; const float* xi = xbase + (size_t)(row0 + ai * HALF + m * 16) * 1024 + col0;
#pragma unroll
                for (int bj = 0; bj < 2; ++bj)
#pragma unroll
                    for (int n = 0; n < 2; ++n) xv[mm][bj][n] = *(const f32x4*)(xi + bj * HALF + n * 4); }
#pragma unroll
            for (int mm = 0; mm < 2; ++mm) { const int m = (am & 1) * 2 + mm; const int row = row0 + ai * HALF + m * 16; float* xo = xout + (size_t)(row - oshift) * 1024 + col0; float ss = 0.f;
#pragma unroll
                for (int bj = 0; bj < 2; ++bj)
#pragma unroll
                    for (int n = 0; n < 2; ++n) { const f32x4 v = xv[mm][bj][n] + gv[bj][n] * acc[ai][bj][m][n]; *(f32x4*)(xo + bj * HALF + n * 4) = v;
                        if (FUSE) { const int c = col0 + bj * HALF + n * 4; const f32x4 hv = v * (*(const f32x4*)(gnext + c) * (*(const f32x4*)(ns + c) + 1.f));
                            ss += (v[0] * v[0] + v[1] * v[1]) + (v[2] * v[2] + v[3] * v[3]);
                            u32x2 w; w.x = cvt_pk_bf16(hv[0], hv[1]); w.y = cvt_pk_bf16(hv[2], hv[3]); *(u32x2*)(hraw + (size_t)row * 1024 + c) = w; } }
                if (FUSE) { ss += __shfl_xor(ss, 16); ss += __shfl_xor(ss, 32); if (fq == 0) unsafeAtomicAdd(ssq + row, ss); } }
            asm volatile("" ::: "memory"); }
    }
};
struct EpiSwiGLU {
    static constexpr bool PERM = true, AFTER_DRAIN = false;
    bf16_t* O; int ldc; int npn; const float* ssq; const float* cbias; int cbld;
    __device__ __forceinline__ void operator()(const f32x4 (&acc)[2][2][4][2], const Unit& u, int wr, int wc, int fr, int fq) const {
        const int row0 = u.pm * BM + wr * 64 + fr; const int col0 = (u.pn % npn) * HALF + wc * 32 + 8 * fq;
        f32x4 cb[2][2];
        if (ssq) { const int b = u.pm / 9; const int mrow = (u.pm - 9 * b == 0) ? 8 : b; const float* cp = cbias + (size_t)mrow * cbld + u.pn * BM + wc * 32 + 8 * fq;
#pragma unroll
            for (int bj = 0; bj < 2; ++bj)
#pragma unroll
                for (int n = 0; n < 2; ++n) cb[bj][n] = *(const f32x4*)(cp + bj * HALF + 4 * n); }
        float rsv[2][4];
        if (ssq) {
#pragma unroll
            for (int ai = 0; ai < 2; ++ai)
#pragma unroll
                for (int m = 0; m < 4; ++m) rsv[ai][m] = ssq[row0 + ai * HALF + m * 16];
#pragma unroll
            for (int ai = 0; ai < 2; ++ai)
#pragma unroll
                for (int m = 0; m < 4; ++m) rsv[ai][m] = rsqrtf(rsv[ai][m] * (1.f / 1024.f) + 1e-6f); }
#pragma unroll
        for (int ai = 0; ai < 2; ++ai)
#pragma unroll
            for (int m = 0; m < 4; ++m) { const int row = row0 + ai * HALF + m * 16; bf16_t* rowp = O + (size_t)row * ldc + col0;
                f32x4 a0 = acc[ai][0][m][0], a1 = acc[ai][0][m][1], g0 = acc[ai][1][m][0], g1 = acc[ai][1][m][1];
                if (ssq) { const float rs = rsv[ai][m]; a0 = a0 * rs + cb[0][0]; a1 = a1 * rs + cb[0][1]; g0 = g0 * rs + cb[1][0]; g1 = g1 * rs + cb[1][1]; }
                u32x4 w; w.x = cvt_pk_bf16(fast_silu(a0[0]) * g0[0], fast_silu(a0[1]) * g0[1]); w.y = cvt_pk_bf16(fast_silu(a0[2]) * g0[2], fast_silu(a0[3]) * g0[3]);
                w.z = cvt_pk_bf16(fast_silu(a1[0]) * g1[0], fast_silu(a1[1]) * g1[1]); w.w = cvt_pk_bf16(fast_silu(a1[2]) * g1[2], fast_silu(a1[3]) * g1[3]);
                *(u32x4*)rowp = w; }
    }
};
struct EpiBf16Norm {
    static constexpr bool PERM = true, AFTER_DRAIN = false;
    bf16_t* O; int ldc; const float* ssq; const float* cbias; int cbld;
    __device__ __forceinline__ void operator()(const f32x4 (&acc)[2][2][4][2], const Unit& u, int wr, int wc, int fr, int fq) const {
        const int row0 = u.pm * BM + wr * 64 + fr; const int col0 = u.pn * BM + wc * 32 + 8 * fq;
        const int b = u.pm / 9; const int mrow = (u.pm - 9 * b == 0) ? 8 : b; const float* cp = cbias + (size_t)mrow * cbld + col0;
        f32x4 cb[2][2];
#pragma unroll
        for (int bj = 0; bj < 2; ++bj)
#pragma unroll
            for (int n = 0; n < 2; ++n) cb[bj][n] = *(const f32x4*)(cp + bj * HALF + 4 * n);
        float rsv[2][4];
#pragma unroll
        for (int ai = 0; ai < 2; ++ai)
#pragma unroll
            for (int m = 0; m < 4; ++m) rsv[ai][m] = ssq[row0 + ai * HALF + m * 16];
#pragma unroll
        for (int ai = 0; ai < 2; ++ai)
#pragma unroll
            for (int m = 0; m < 4; ++m) { const int row = row0 + ai * HALF + m * 16; bf16_t* rowp = O + (size_t)row * ldc + col0; const float rs = rsqrtf(rsv[ai][m] * (1.f / 1024.f) + 1e-6f);
#pragma unroll
                for (int bj = 0; bj < 2; ++bj) { const f32x4 v0 = acc[ai][bj][m][0] * rs + cb[bj][0], v1 = acc[ai][bj][m][1] * rs + cb[bj][1];
                    u32x4 w; w.x = cvt_pk_bf16(v0[0], v0[1]); w.y = cvt_pk_bf16(v0[2], v0[3]); w.z = cvt_pk_bf16(v1[0], v1[1]); w.w = cvt_pk_bf16(v1[2], v1[3]); *(u32x4*)(rowp + bj * HALF) = w; } }
    }
};
struct EpiMoeY2 {
    static constexpr bool PERM = true, AFTER_DRAIN = false;
    const float* slot_gate; bf16_t* Y2;
    __device__ __forceinline__ void operator()(const f32x4 (&acc)[2][2][4][2], const Unit& u, int wr, int wc, int fr, int fq) const {
        const int col0 = (u.pn & 3) * BM + wc * 32 + 8 * fq; const int slot0 = u.pm * BM + wr * 64 + fr;
#pragma unroll
        for (int ai = 0; ai < 2; ++ai)
#pragma unroll
            for (int m = 0; m < 4; ++m) { const int slot = slot0 + ai * HALF + m * 16; const float g = slot_gate[slot]; bf16_t* rowp = Y2 + (size_t)slot * 1024 + col0;
#pragma unroll
                for (int bj = 0; bj < 2; ++bj) { const f32x4 v0 = acc[ai][bj][m][0] * g, v1 = acc[ai][bj][m][1] * g;
                    u32x4 w; w.x = cvt_pk_bf16(v0[0], v0[1]); w.y = cvt_pk_bf16(v0[2], v0[3]); w.z = cvt_pk_bf16(v1[0], v1[1]); w.w = cvt_pk_bf16(v1[2], v1[3]);
                    *(u32x4*)(rowp + bj * HALF) = w; } }
    }
};
enum EpiMode { E_BF16 = 0, E_BF16NORM, E_RES, E_SWIGLU, E_MOEY2 };
struct EpiAny {
    static constexpr bool PERM = true, AFTER_DRAIN = false;
    int mode;
    bf16_t* O; int ldc, npn; const float* ssq; const float* cbias; int cbld;
    const float* xin; float* xout; const float* modbase; int compact, srcin, fuse; const float* xsrc_lat; const float* xsrc_ctx; const float* gnext; const float* nscale; float* ssqw;
    const float* slot_gate;
    __device__ __forceinline__ void res(const f32x4 (&acc)[2][2][4][2], const Unit& u, int wr, int wc, int fr, int fq) const {
        const int b = u.pm / 9, pj = u.pm - 9 * b; const int mrow = (pj == 0) ? 8 : b;
        const float* g = modbase + (size_t)mrow * 6144;
        const int col0 = u.pn * BM + wc * 32 + 8 * fq;
        f32x4 gv[2][2];
#pragma unroll
        for (int bj = 0; bj < 2; ++bj)
#pragma unroll
            for (int n = 0; n < 2; ++n) gv[bj][n] = *(const f32x4*)(g + col0 + bj * HALF + n * 4);
        const int row0 = u.pm * BM + wr * 64 + fr; const int oshift = compact ? 256 * (b + 1) : 0;
        const float* xbase = srcin ? (pj == 0 ? xsrc_ctx + (size_t)b * 256 * 1024 : xsrc_lat + ((size_t)b * 2048 + (pj - 1) * 256) * 1024) - (size_t)u.pm * BM * 1024 : xin;
        const float* ns = nscale + (size_t)mrow * 6144; bf16_t* hraw = O;
#pragma unroll
        for (int ai = 0; ai < 2; ++ai)
#pragma unroll
            for (int m = 0; m < 4; ++m) { const int row = row0 + ai * HALF + m * 16; const float* xi = xbase + (size_t)row * 1024 + col0; float* xo = xout + (size_t)(row - oshift) * 1024 + col0; float ss = 0.f;
#pragma unroll
                for (int bj = 0; bj < 2; ++bj)
#pragma unroll
                    for (int n = 0; n < 2; ++n) { const f32x4 v = *(const f32x4*)(xi + bj * HALF + n * 4) + gv[bj][n] * acc[ai][bj][m][n]; *(f32x4*)(xo + bj * HALF + n * 4) = v;
                        if (fuse) { const int c = col0 + bj * HALF + n * 4; const f32x4 hv = v * (*(const f32x4*)(gnext + c) * (*(const f32x4*)(ns + c) + 1.f));
                            ss += (v[0] * v[0] + v[1] * v[1]) + (v[2] * v[2] + v[3] * v[3]);
                            u32x2 w; w.x = cvt_pk_bf16(hv[0], hv[1]); w.y = cvt_pk_bf16(hv[2], hv[3]); *(u32x2*)(hraw + (size_t)row * 1024 + c) = w; } }
                if (fuse) { ss += __shfl_xor(ss, 16); ss += __shfl_xor(ss, 32); if (fq == 0) unsafeAtomicAdd(ssqw + row, ss); }
                if (m & 1) asm volatile("" ::: "memory"); }
    }
    __device__ __forceinline__ void operator()(const f32x4 (&acc)[2][2][4][2], const Unit& u, int wr, int wc, int fr, int fq) const {
        if (mode == E_BF16) { EpiBf16<0> e{O, ldc, nullptr, 0, 0, 1.f}; e(acc, u, wr, wc, fr, fq); }
        else if (mode == E_BF16NORM) { EpiBf16Norm e{O, ldc, ssq, cbias, cbld}; e(acc, u, wr, wc, fr, fq); }
        else if (mode == E_SWIGLU) { EpiSwiGLU e{O, ldc, npn, ssq, cbias, cbld}; e(acc, u, wr, wc, fr, fq); }
        else if (mode == E_MOEY2) { EpiMoeY2 e{slot_gate, O}; e(acc, u, wr, wc, fr, fq); }
        else res(acc, u, wr, wc, fr, fq);
    }
};
struct ChainOrder {
    int stage, c;
    __device__ __forceinline__ bool next(int i, Unit& u) const {
        const int x = c & 7, r = c >> 3; int lu = -1, nN = 4;
        if (stage == 0) { if (i == 0) lu = r; else if (i == 1 && r >= 16 && r < 20) lu = 16 + r; }
        else if (stage == 1) { nN = 22;
            if (i < 3) lu = 32 * i + r; else if (i == 3) { if (r < 30) lu = 96 + r; }
            else if (r < 28) { if (i < 6) lu = 126 + 28 * (i - 4) + r; else if (i == 6 && r < 16) lu = 182 + r; } }
        else if (stage == 2) { if (r >= 28) { if (i == 0) lu = r - 28; else if (i == 1) lu = r - 16; }
               else if (i == 0) { if (r < 16) lu = 20 + r; else { const int k = r - 16; lu = k < 8 ? 4 + k : 8 + k; } } }
        else {
            if (i < 2) lu = 32 * i + r; else if (i == 2 && r == 31) lu = 64;
            if (lu < 0) return false;
            if (lu == 64) { u.pm = 9 * x; u.pn = 7; } else { u.pm = 9 * x + 1 + (lu & 7); u.pn = lu >> 3; }
            return true; }
        if (lu < 0) return false;
        const int g = lu / (3 * nN), w = lu - g * 3 * nN; u.pm = 9 * x + 3 * g + w % 3; u.pn = w / 3; return true;
    }
};
struct MoeChainOrder {
    const PG8_LAS int* tb; int stage, c;
    __device__ __forceinline__ bool next(int i, Unit& u) const {
        const int x = c & 7, r = c >> 3, T = tb[8];
        const int t0 = (T * x) >> 3, n = ((T * (x + 1)) >> 3) - t0, j = r & 7, cc = r >> 3;
        int tile, col, nN;
        if (stage == 1) { nN = 4; tile = 8 * i + j; col = cc; if (tile >= n) return false; }
        else { nN = 28;
            const int kb = ((n & 7) == 1) ? 1 : 0, H = 4 * kb, tot = 28 * n + 12 * kb, A0 = tot >> 5, rem = tot & 31, ah = A0 - 3 * kb;
            const bool heavy = kb && j == 0;
            const int nr = r - (kb ? cc + (j > 0 ? 1 : 0) : 0);
            int m;
            if (i < ah) m = 32 * i + r;
            else { if (heavy) return false;
                   if (i < A0) m = 32 * ah + (32 - H) * (i - ah) + nr;
                   else if (i == A0 && nr < rem) m = 32 * ah + (32 - H) * (A0 - ah) + nr;
                   else return false; }
            if (m >= 28 * n) return false;
            const int g = m / 112, w = m - g * 112, gs = (n - 4 * g) < 4 ? (n - 4 * g) : 4; tile = 4 * g + w % gs; col = w / gs; }
        const int t = t0 + tile; int e = 0;
#pragma unroll
        for (int k = 1; k < 8; ++k) if (t >= tb[k]) e = k;
        u.pm = t; u.pn = e * nN + col; return true;
    }
};
struct OrderAny {
    int omode;
    DenseOrder d; MoeOrder m; ChainOrder ch; MoeChainOrder mch;
    mutable unsigned early;
    __device__ __forceinline__ bool next(int i, Unit& u) const {
        const bool ok = omode == 3 ? m.next(i, u) : omode == 4 ? ch.next(i, u) : omode == 5 ? mch.next(i, u) : d.next(i, u);
        if (ok && wcnt != nullptr) {
            early = __hip_atomic_load(wcnt + u.pm * 16, __ATOMIC_RELAXED, __HIP_MEMORY_SCOPE_AGENT);
            if (w2kind != 0) { int lo, hi; war_range(u, lo, hi);
                for (int q = lo; q <= hi; ++q) { const unsigned v = __hip_atomic_load(w2cnt + q * 16, __ATOMIC_RELAXED, __HIP_MEMORY_SCOPE_AGENT); early = v < early ? v : early; } }
        }
        return ok;
    }
    unsigned* wcnt; unsigned wtarget; unsigned* dcnt; int rel_agent;
    unsigned* w2cnt; int w2kind;
    __device__ __forceinline__ void war_range(const Unit& u, int& lo, int& hi) const {
        if (w2kind == 1) { const int a0 = u.pm * 1441792 - 75497472, a1 = a0 + 1441791; lo = (a0 > 0 ? a0 : 0) >> 19; hi = a1 < 0 ? -1 : (a1 >> 19); }
        else { const int b0 = u.pm << 20; lo = b0 / 1441792; hi = (b0 + 1048575) / 1441792; }
    }
    __device__ __forceinline__ void a_ready(const Unit& u) const {
        if (wcnt != nullptr) {
            unsigned* p = wcnt + u.pm * 16; unsigned sp = 0u;
            if (early < wtarget) {
                while (__hip_atomic_load(p, __ATOMIC_RELAXED, __HIP_MEMORY_SCOPE_AGENT) < wtarget) { __builtin_amdgcn_s_sleep(1); if (++sp > (1u << 22)) break; }
                if (w2kind != 0) { int lo, hi; war_range(u, lo, hi);
                    for (int q = lo; q <= hi; ++q) while (__hip_atomic_load(w2cnt + q * 16, __ATOMIC_RELAXED, __HIP_MEMORY_SCOPE_AGENT) < wtarget) { __builtin_amdgcn_s_sleep(1); if (++sp > (1u << 22)) break; } }
            }
            if (rel_agent) __builtin_amdgcn_fence(__ATOMIC_ACQUIRE, "agent");
            asm volatile("" ::: "memory");
        }
    }
    __device__ __forceinline__ void done(const Unit& u) const {
        if (dcnt != nullptr) {
            if (rel_agent) __builtin_amdgcn_fence(__ATOMIC_RELEASE, "agent");
            asm volatile("s_waitcnt vmcnt(0)" ::: "memory");
            if ((threadIdx.x & 63) == 0) (void)__hip_atomic_fetch_add(dcnt + u.pm * 16, 1u, __ATOMIC_RELAXED, __HIP_MEMORY_SCOPE_AGENT);
        }
    }
};
}
#define GAS __attribute__((address_space(1)))
#define LAS __attribute__((address_space(3)))
typedef unsigned v4u __attribute__((ext_vector_type(4)));
typedef short bf16x8 __attribute__((ext_vector_type(8)));
namespace att {
using f32x16 = __attribute__((ext_vector_type(16))) float;
using s16x4 = __attribute__((ext_vector_type(4))) short;
typedef float f32x2_t __attribute__((ext_vector_type(2))); typedef __bf16 bf16x2_t __attribute__((ext_vector_type(2)));
__device__ __forceinline__ int crow(int r, int hi) { return (r & 3) + 8 * (r >> 2) + 4 * hi; }
__device__ __forceinline__ void glds16(const void* gsrc, unsigned lds_dst) { unsigned keep;
    asm volatile("s_mov_b32 %0, m0\n\ts_mov_b32 m0, %2\n\ts_nop 0\n\tglobal_load_lds_dwordx4 %1, off\n\ts_mov_b32 m0, %0" : "=&s"(keep) : "v"(gsrc), "s"(lds_dst) : "memory"); }
__device__ __forceinline__ unsigned cvtpk_s(float lo, float hi) { f32x2_t v = {lo, hi}; bf16x2_t b = __builtin_convertvector(v, bf16x2_t); return __builtin_bit_cast(unsigned, b); }
#define ATT_MX3(a, b, c) __builtin_fmaxf(__builtin_fmaxf((a), (b)), (c))
__device__ __forceinline__ float rowmax32(const f32x16& p0, const f32x16& p1) {
    float a = ATT_MX3(p0[0], p0[1], p1[0]), b = ATT_MX3(p0[2], p0[3], p1[1]); a = ATT_MX3(a, p1[2], p1[3]);
#pragma unroll
    for (int r = 4; r < 16; r += 4) { a = ATT_MX3(a, p0[r], p0[r + 1]); b = ATT_MX3(b, p0[r + 2], p0[r + 3]); a = ATT_MX3(a, p1[r], p1[r + 1]); b = ATT_MX3(b, p1[r + 2], p1[r + 3]); }
    a = __builtin_fmaxf(a, b);
    auto rr = __builtin_amdgcn_permlane32_swap(__float_as_uint(a), __float_as_uint(a), false, false);
    return fmaxf(__uint_as_float(rr[0]), __uint_as_float(rr[1]));
}
__device__ __forceinline__ void pv(f32x16* o, int vb, bf16x8 pa0, bf16x8 pa1, bf16x8 pa2, bf16x8 pa3) {
    s16x4 lo[2][4], hi[2][4];
#pragma unroll
    for (int d0 = 0; d0 < 2; ++d0)
#pragma unroll
        for (int ks = 0; ks < 4; ++ks) {
            asm volatile("ds_read_b64_tr_b16 %0,%1 offset:%c2" : "=&v"(lo[d0][ks]) : "v"(vb), "i"(d0 * 4096 + ks * 1024) : "memory");
            asm volatile("ds_read_b64_tr_b16 %0,%1 offset:%c2" : "=&v"(hi[d0][ks]) : "v"(vb), "i"(d0 * 4096 + ks * 1024 + 512) : "memory"); }
    asm volatile("s_waitcnt lgkmcnt(0)" ::: "memory"); __builtin_amdgcn_sched_barrier(0);
#define ATT_PK(d, k) (bf16x8){lo[d][k][0], lo[d][k][1], lo[d][k][2], lo[d][k][3], hi[d][k][0], hi[d][k][1], hi[d][k][2], hi[d][k][3]}
    o[0] = __builtin_amdgcn_mfma_f32_32x32x16_bf16(pa0, ATT_PK(0, 0), o[0], 0, 0, 0); o[1] = __builtin_amdgcn_mfma_f32_32x32x16_bf16(pa0, ATT_PK(1, 0), o[1], 0, 0, 0);
    o[0] = __builtin_amdgcn_mfma_f32_32x32x16_bf16(pa1, ATT_PK(0, 1), o[0], 0, 0, 0); o[1] = __builtin_amdgcn_mfma_f32_32x32x16_bf16(pa1, ATT_PK(1, 1), o[1], 0, 0, 0);
    o[0] = __builtin_amdgcn_mfma_f32_32x32x16_bf16(pa2, ATT_PK(0, 2), o[0], 0, 0, 0); o[1] = __builtin_amdgcn_mfma_f32_32x32x16_bf16(pa2, ATT_PK(1, 2), o[1], 0, 0, 0);
    o[0] = __builtin_amdgcn_mfma_f32_32x32x16_bf16(pa3, ATT_PK(0, 3), o[0], 0, 0, 0); o[1] = __builtin_amdgcn_mfma_f32_32x32x16_bf16(pa3, ATT_PK(1, 3), o[1], 0, 0, 0);
#undef ATT_PK
}
template <int DQ> struct Geo {
    static constexpr int NCH = DQ / 8, KSLOT = NCH * 1024, VSLOT = 8192;
    static constexpr int LDS_K = 0, LDS_V = 2 * KSLOT, LDS_WS = LDS_V + 2 * VSLOT, LDS_OST = LDS_WS + 8 * 256, LDS_BYTES = LDS_OST + 8 * 4096;
};
template <int DQ>
__device__ __forceinline__ void unit(int b, int hq, int hk, int qb, int NT, const bf16_t* __restrict__ Q, int ldq, const bf16_t* __restrict__ K, int ldk, const bf16_t* __restrict__ V, int ldv,
                                     bf16_t* __restrict__ O, int ldo, LAS unsigned char* shm) {
    typedef Geo<DQ> G; constexpr int ND0 = DQ / 16;
    const int tid = threadIdx.x, lane = tid & 63, r32 = lane & 31, hi = lane >> 5; const int wid = __builtin_amdgcn_readfirstlane(tid >> 6);
    const long rowbase = (long)b * RPB; const int q0 = qb * 256;
    const bf16_t* Qw = Q + (rowbase + q0 + wid * 32) * ldq + hq * DQ;
    const bf16_t* Kh = K + rowbase * ldk + hk * DQ; const bf16_t* Vh = V + rowbase * ldv + hk * 64;
    const unsigned lds0 = (unsigned)(uintptr_t)shm;
    LAS float* wsf = (LAS float*)(shm + G::LDS_WS) + wid * 64;
    const bf16_t* ksrc = Kh + (long)lane * ldk + wid * 8;
    const bf16_t* vsrc = Vh + (long)(16 * (wid & 3) + (lane >> 2)) * ldv + (wid >> 2) * 32 + (lane & 3) * 8;
    const unsigned kdst = lds0 + G::LDS_K + wid * 1024, vdst = lds0 + G::LDS_V + wid * 1024;
    const int vb0 = (int)(lds0 + G::LDS_V) + ((lane >> 4) & 1) * 32 + (lane & 3) * 8 + (4 * hi + ((lane & 15) >> 2)) * 64;
#define ATT_DMA(t, s) do { const bf16_t* kp_ = ksrc + (long)(t) * 64 * ldk; glds16(kp_, (unsigned)__builtin_amdgcn_readfirstlane(kdst + (s) * G::KSLOT)); \
        if (DQ == 96 && wid < 4) glds16(kp_ + 64, (unsigned)__builtin_amdgcn_readfirstlane(kdst + (s) * G::KSLOT + 8192)); \
        glds16(vsrc + (long)(t) * 64 * ldv, (unsigned)__builtin_amdgcn_readfirstlane(vdst + (s) * G::VSLOT)); } while (0)
    ATT_DMA(0, 0);
    bf16x8 qr[ND0];
#pragma unroll
    for (int d0 = 0; d0 < ND0; ++d0) qr[d0] = *reinterpret_cast<const bf16x8*>(&Qw[(long)r32 * ldq + d0 * 16 + hi * 8]);
    constexpr float THR = 8.f;
    float mref = 0.f, l_reg = 0.f; f32x16 o[2]; o[0] = f32x16{}; o[1] = f32x16{}; f32x16 negm = f32x16{};
    for (int t = 0; t < NT; ++t) {
        const int s = t & 1;
        asm volatile("s_waitcnt vmcnt(0) lgkmcnt(0)\n\ts_barrier" ::: "memory");
        if (t + 1 < NT) ATT_DMA(t + 1, s ^ 1);
        f32x16 p0, p1;
        { const LAS unsigned char* kb = shm + G::LDS_K + s * G::KSLOT + hi * 1024 + r32 * 16;
#pragma unroll
          for (int d0 = 0; d0 < ND0; ++d0) { const bf16x8 b0 = *(const LAS bf16x8*)(kb + d0 * 2048); const bf16x8 b1 = *(const LAS bf16x8*)(kb + d0 * 2048 + 512);
              p0 = __builtin_amdgcn_mfma_f32_32x32x16_bf16(b0, qr[d0], d0 == 0 ? negm : p0, 0, 0, 0); p1 = __builtin_amdgcn_mfma_f32_32x32x16_bf16(b1, qr[d0], d0 == 0 ? negm : p1, 0, 0, 0); } }
        const float rm = rowmax32(p0, p1);
        if (__builtin_expect(t == 0 || __any(rm > THR), 0)) {
            const float dl = t == 0 ? rm : __builtin_fmaxf(rm, 0.f); mref += dl;
#pragma unroll
            for (int r = 0; r < 16; ++r) { p0[r] -= dl; p1[r] -= dl; negm[r] = -mref; }
            const float alpha = t == 0 ? 1.f : __builtin_amdgcn_exp2f(-dl); l_reg *= alpha;
            if (hi == 0) wsf[r32] = alpha;
            asm volatile("s_waitcnt lgkmcnt(0)" ::: "memory");
#pragma unroll
            for (int r = 0; r < 16; ++r) { const float a = wsf[crow(r, hi)]; o[0][r] *= a; o[1][r] *= a; }
        }
        f32x2_t sacc = {0.f, 0.f};
#pragma unroll
        for (int r = 0; r < 16; r += 2) { p0[r] = __builtin_amdgcn_exp2f(p0[r]); p0[r + 1] = __builtin_amdgcn_exp2f(p0[r + 1]); p1[r] = __builtin_amdgcn_exp2f(p1[r]); p1[r + 1] = __builtin_amdgcn_exp2f(p1[r + 1]);
            sacc += (f32x2_t){p0[r], p0[r + 1]}; sacc += (f32x2_t){p1[r], p1[r + 1]}; }
        l_reg += sacc[0] + sacc[1];
        u32x4 pw0, pw1, pw2, pw3;
        pw0 = (u32x4){cvtpk_s(p0[0], p0[1]), cvtpk_s(p0[2], p0[3]), cvtpk_s(p0[4], p0[5]), cvtpk_s(p0[6], p0[7])};
        pw1 = (u32x4){cvtpk_s(p0[8], p0[9]), cvtpk_s(p0[10], p0[11]), cvtpk_s(p0[12], p0[13]), cvtpk_s(p0[14], p0[15])};
        pw2 = (u32x4){cvtpk_s(p1[0], p1[1]), cvtpk_s(p1[2], p1[3]), cvtpk_s(p1[4], p1[5]), cvtpk_s(p1[6], p1[7])};
        pw3 = (u32x4){cvtpk_s(p1[8], p1[9]), cvtpk_s(p1[10], p1[11]), cvtpk_s(p1[12], p1[13]), cvtpk_s(p1[14], p1[15])};
        pv(o, vb0 + s * G::VSLOT, __builtin_bit_cast(bf16x8, pw0), __builtin_bit_cast(bf16x8, pw1), __builtin_bit_cast(bf16x8, pw2), __builtin_bit_cast(bf16x8, pw3));
    }
#undef ATT_DMA
    { auto rr = __builtin_amdgcn_permlane32_swap(__float_as_uint(l_reg), __float_as_uint(l_reg), false, false); l_reg = __uint_as_float(rr[0]) + __uint_as_float(rr[1]); }
    if (hi == 0) wsf[32 + r32] = l_reg;
    asm volatile("s_waitcnt lgkmcnt(0)" ::: "memory");
    float rli[16];
#pragma unroll
    for (int r = 0; r < 16; ++r) rli[r] = __builtin_amdgcn_rcpf(wsf[32 + crow(r, hi)]);
    bf16_t* Ow = O + (rowbase + q0 + wid * 32) * ldo + hq * 64;
    { LAS bf16_t* stg = (LAS bf16_t*)(shm + G::LDS_OST) + wid * 2048;
#pragma unroll
      for (int r = 0; r < 16; ++r) { const int orow = crow(r, hi);
#pragma unroll
          for (int d0 = 0; d0 < 2; ++d0) stg[orow * 64 + d0 * 32 + r32] = f2bf(o[d0][r] * rli[r]); }
      asm volatile("s_waitcnt lgkmcnt(0)" ::: "memory");
#pragma unroll
      for (int i = 0; i < 4; ++i) { const int row = i * 8 + (lane >> 3), ch = lane & 7; const u32x4 v = *(const LAS u32x4*)(stg + row * 64 + ch * 8); *(u32x4*)(Ow + (long)row * ldo + ch * 8) = v; } }
    asm volatile("s_waitcnt lgkmcnt(0)\n\ts_barrier" ::: "memory");
}
}
#define LDS_WAIT() asm volatile("s_waitcnt lgkmcnt(0)" ::: "memory")
#define VM_WAIT() asm volatile("s_waitcnt vmcnt(0)" ::: "memory")
constexpr int NWAVES = 8, NTHREADS = 512;
constexpr int RING_OFF = 0, RING_BYTES = 131072;
constexpr int MISC_OFF = RING_BYTES;
constexpr int LDS_BYTES = 147456;

enum Phase { PH_P0 = 0, PH_NORM0, PH_G_IN0, PH_LRUPREP, PH_MIX0, PH_G_OUT0, PH_G_F1, PH_G_F2, PH_G_IN1, PH_PREP1, PH_G_QKVB, PH_PREP2, PH_MIX1, PH_G_OUT1,
             PH_ROUTE, PH_SLOT, PH_MOE1, PH_MOE2, PH_COMBINE, PH_COUNT,
             PH_G_QB = 100, PH_G_KVB = 101 };

struct Params { const float* i0; const float* i1; const float* i2; const float* i3; const float* i4; const float* i5; const float* i6; const float* i7; const float* i8; const float* i9; const float* i10; const float* i11; const float* i12; const float* i13; const float* i14; const float* i15; const float* i16; const float* i17; const float* i18; const float* i19; const float* i20; const float* i21; const float* i22; const float* i23; const float* i24; const float* i25; const float* i26; const float* i27; const float* i28; const float* i29; const float* i30; const float* i31; const float* i32; const float* i33; const float* i34; const float* i35; const float* i36; const float* i37; const float* i38; const float* i39; const float* i40; const float* i41; const float* i42; float* out; char* ws; int ph_lo, ph_hi; };
#define PIN(k) (P.i##k)
static_assert(sizeof(Params) == 43 * 8 + 8 + 8 + 8, "Params has no padding");

struct Frame { LAS unsigned char* lds; int tid, lane, wave, G, bid, even; char* ws; };

__device__ __forceinline__ void tr_item(const float* __restrict__ W, int N, bf16_t* __restrict__ WT, int ldk, int kb, int nb, int dst_row0, LAS float* scr, int lane) {
    const int k0 = 64 * kb, n0 = 32 * nb;
    f32x4 v[8]; const float* wp = W + (size_t)(k0 + (lane >> 3)) * N + n0 + 4 * (lane & 7);
#pragma unroll
    for (int i = 0; i < 8; ++i) v[i] = __builtin_nontemporal_load((const f32x4*)(wp + (size_t)(8 * i) * N));
#pragma unroll
    for (int i = 0; i < 8; ++i) { LAS float* sp = scr + (8 * i + (lane >> 3)) * 33 + 4 * (lane & 7); sp[0] = v[i][0]; sp[1] = v[i][1]; sp[2] = v[i][2]; sp[3] = v[i][3]; }
    LDS_WAIT(); asm volatile("" ::: "memory");
    const int c = lane & 7;
#pragma unroll
    for (int j = 0; j < 4; ++j) { const int n = (lane >> 3) + 8 * j; const LAS float* s = scr + (8 * c) * 33 + n;
        v4u o; o.x = pk2(s[0 * 33], s[1 * 33]); o.y = pk2(s[2 * 33], s[3 * 33]); o.z = pk2(s[4 * 33], s[5 * 33]); o.w = pk2(s[6 * 33], s[7 * 33]);
        *(v4u*)(WT + (size_t)(dst_row0 + n) * ldk + k0 + 8 * c) = o; }
    LDS_WAIT(); asm volatile("" ::: "memory");
}
constexpr int MOE_ITEMS = 8 * 3 * 1792, MOE_CHUNK = 32, MOE_NCHUNK = MOE_ITEMS / MOE_CHUNK;
__device__ __forceinline__ void moe_conv_item(const Frame& F, const Params& P, int it, LAS float* scr) {
    const int e = it / 5376, r = it % 5376, which = r / 1792, q = r % 1792; char* ws = F.ws;
    const float* src; bf16_t* dst; int N, ldk, kb, nb, dr;
    if (which < 2) { kb = q / 112; nb = q % 112; const int n0 = nb * 32; dr = (n0 >> 7) * 256 + (n0 & 127) + (which == 1 ? 128 : 0);
        src = (which == 0 ? PIN(40) : PIN(41)) + (size_t)e * 1024 * 3584; N = 3584; dst = (bf16_t*)(ws + WS_W13M) + (size_t)e * 7168 * 1024; ldk = 1024; }
    else { kb = q / 32; nb = q % 32; dr = nb * 32; src = PIN(42) + (size_t)e * 3584 * 1024; N = 1024; dst = (bf16_t*)(ws + WS_W2M) + (size_t)e * 1024 * 3584; ldk = 3584; }
    tr_item(src, N, dst, ldk, kb, nb, dr, scr, F.lane);
}
__device__ __forceinline__ void moe_conv_all(const Frame& F, const Params& P) {
    LAS float* scr = (LAS float*)(F.lds + RING_OFF + F.wave * 16384); const int gw = F.bid * NWAVES + F.wave, NGW = F.G * NWAVES;
    __syncthreads();
#pragma unroll 1
    for (int it = gw; it < MOE_ITEMS; it += NGW) moe_conv_item(F, P, it, scr);
    __syncthreads();
}
struct ConvDesc { const float* src; bf16_t* dst; int N, ldk, nblk, start, il, pad; };
__device__ __forceinline__ void phase_conv(const Frame& F, const Params& P, bool moe) {
    LAS float* scr = (LAS float*)(F.lds + RING_OFF + F.wave * 16384); char* ws = F.ws;
    LAS ConvDesc* tab = (LAS ConvDesc*)(F.lds + MISC_OFF);
    if (F.tid < 41) { const int t = F.tid; ConvDesc d; d.il = 0; d.pad = 0;
        if (t == 0) { d.src = PIN(8); d.dst = (bf16_t*)(ws + WS_WIN0); d.N = 1792; d.ldk = 1024; d.start = 16 * 56; }
        else if (t == 1) { d.src = PIN(9); d.dst = (bf16_t*)(ws + WS_WOUT0); d.N = 1024; d.ldk = 1024; d.start = 16 * 32; }
        else if (t == 2) { d.src = PIN(19); d.dst = (bf16_t*)(ws + WS_WF13); d.N = 2816; d.ldk = 1024; d.start = 16 * 88; d.il = 1; }
        else if (t == 3) { d.src = PIN(20); d.dst = (bf16_t*)(ws + WS_WF13); d.N = 2816; d.ldk = 1024; d.start = 16 * 88; d.il = 2; }
        else if (t == 4) { d.src = PIN(21); d.dst = (bf16_t*)(ws + WS_WF2); d.N = 1024; d.ldk = 2816; d.start = 44 * 32; }
        else if (t == 5) { d.src = PIN(22); d.dst = (bf16_t*)(ws + WS_WIN1); d.N = 1952; d.ldk = 1024; d.start = 16 * 61; }
        else if (t == 6) { d.src = PIN(23); d.dst = (bf16_t*)(ws + WS_WOUT1); d.N = 1024; d.ldk = 1024; d.start = 16 * 32; }
        else if (t == 7) { d.src = PIN(34); d.dst = (bf16_t*)(ws + WS_WQB); d.N = 768; d.ldk = 256; d.start = 4 * 24; }
        else if (t == 8) { d.src = PIN(36); d.dst = (bf16_t*)(ws + WS_WKVB); d.N = 1024; d.ldk = 256; d.start = 2 * 32; }
        else { const int q = t - 9, dn = q >> 1, g = q & 1; d.src = (g ? PIN(14) : PIN(12)) + (size_t)dn * 4096; d.dst = (bf16_t*)(ws + WS_WLRU) + (size_t)(dn * 2 + g) * 4096; d.N = 64; d.ldk = 64; d.start = 2; }
        d.nblk = d.N / 32;
        tab[t].src = d.src; tab[t].dst = d.dst; tab[t].N = d.N; tab[t].ldk = d.ldk; tab[t].nblk = d.nblk; tab[t].start = d.start; tab[t].il = d.il; tab[t].pad = 0; }
    __syncthreads();
    if (F.tid == 0) { int s = 0; for (int t = 0; t < 41; ++t) { const int c = tab[t].start; tab[t].start = s; s += c; } tab[0].pad = s; }
    __syncthreads();
    const int total = tab[0].pad; const int gw = F.bid * NWAVES + F.wave, NGW = F.G * NWAVES;
#pragma unroll 1
    for (int it = gw; it < total; it += NGW) { int e = 0;
#pragma unroll 1
        for (int t = 1; t < 41; ++t) if (it >= tab[t].start) e = t;
        ConvDesc d; d.src = tab[e].src; d.dst = tab[e].dst; d.N = tab[e].N; d.ldk = tab[e].ldk; d.nblk = tab[e].nblk; d.start = tab[e].start; d.il = tab[e].il;
        const int loc = it - d.start, kb = loc / d.nblk, nb = loc % d.nblk, n0 = nb * 32;
        const int dr = d.il == 0 ? n0 : ((n0 >> 7) * 256 + (n0 & 127) + (d.il == 2 ? 128 : 0));
        tr_item(d.src, d.N, d.dst, d.ldk, kb, nb, dr, scr, F.lane); }
    const int gt = F.bid * NTHREADS + F.tid, NGT = F.G * NTHREADS;
    { v4u* z = (v4u*)((bf16_t*)(ws + WS_WIN1) + (size_t)1952 * 1024); for (int i = gt; i < 96 * 1024 / 8; i += NGT) z[i] = (v4u){0u, 0u, 0u, 0u}; }
    { bf16_t* wk = (bf16_t*)(ws + WS_WKVB); for (int i = gt; i < 1024 * 16; i += NGT) { const int r = i >> 4, cc = i & 15; *(v4u*)(wk + (size_t)r * 256 + 128 + cc * 8) = (v4u){0u, 0u, 0u, 0u}; } }
    __syncthreads();
}

constexpr size_t CT_TB = 64 * 1024;
enum GemmId { G_IN0 = 0, G_OUT0, G_F1, G_F2, G_IN1, G_QB, G_KVB, G_OUT1, G_MOE1, G_MOE2 };
__device__ __forceinline__ void run_gemm(const Frame& F, const Params& P, int gid) {
    char* ws = F.ws; float* MOD = (float*)(ws + WS_MOD); const float* MOD1 = MOD + 9 * MODLD; LAS unsigned char* lds = F.lds + RING_OFF;
    float* X = (float*)(ws + WS_X); bf16_t* H = (bf16_t*)(ws + WS_H); LAS int* tb = (LAS int*)(F.lds + MISC_OFF);
    pg8::Gemm g; pg8::OrderAny S; pg8::EpiAny E;
    E.mode = pg8::E_BF16; E.O = nullptr; E.ldc = 0; E.npn = 1; E.ssq = nullptr; E.cbias = nullptr; E.cbld = 0; E.xin = X; E.xout = X; E.modbase = MOD; E.compact = 0; E.srcin = 0; E.fuse = 0;
    E.xsrc_lat = PIN(0); E.xsrc_ctx = PIN(2); E.gnext = PIN(7); E.nscale = MOD; E.ssqw = (float*)(ws + WS_CTL + CT_SSQA); E.slot_gate = (const float*)(ws + WS_SLOTGATE);
    S.wcnt = nullptr; S.dcnt = nullptr; S.wtarget = 0u; S.w2cnt = nullptr; S.w2kind = 0; S.rel_agent = F.even ? 0 : 1; unsigned* PCNT = (unsigned*)(ws + WS_CTL + CT_PCNT);
    S.omode = 0; S.m.tb = tb; S.m.nN = 28; S.m.G = F.G; S.m.c = F.bid; g.M = MROWS; g.N = 0;
    if (gid == G_IN0) { g.A = H; g.Bt = (const bf16_t*)(ws + WS_WIN0); g.K = 1024; S.d.init(72, 7, F.G, F.bid, 0); E.O = (bf16_t*)(ws + WS_Z); E.ldc = 1792; }
    else if (gid == G_OUT0) { g.A = (const bf16_t*)(ws + WS_Y); g.Bt = (const bf16_t*)(ws + WS_WOUT0); g.K = 1024; S.d.init(72, 4, F.G, F.bid, 0); S.omode = 4; S.ch.stage = 0; S.ch.c = F.bid; S.dcnt = PCNT;
        E.mode = pg8::E_RES; E.modbase = MOD + 2 * DM; E.srcin = 1; E.fuse = 1; E.O = H; E.gnext = PIN(7); E.nscale = MOD + 4 * DM; E.ssqw = (float*)(ws + WS_CTL + CT_SSQA); }
    else if (gid == G_F1) { g.A = H; g.Bt = (const bf16_t*)(ws + WS_WF13); g.K = 1024; S.d.init(72, 22, F.G, F.bid, 0); S.omode = 4; S.ch.stage = 1; S.ch.c = F.bid; S.wcnt = PCNT; S.wtarget = 32u; S.dcnt = PCNT + 72 * 16; S.w2cnt = PCNT; S.w2kind = 1;
        E.mode = pg8::E_SWIGLU; E.O = (bf16_t*)(ws + WS_ACT); E.ldc = DFF; E.npn = 22; E.ssq = (const float*)(ws + WS_CTL + CT_SSQA); E.cbias = (const float*)(ws + WS_CBF1); E.cbld = 5632; }
    else if (gid == G_F2) { g.A = (const bf16_t*)(ws + WS_ACT); g.Bt = (const bf16_t*)(ws + WS_WF2); g.K = 2816; S.d.init(72, 4, F.G, F.bid, 0); S.omode = 4; S.ch.stage = 2; S.ch.c = F.bid; S.wcnt = PCNT + 72 * 16; S.wtarget = 176u;
        E.mode = pg8::E_RES; E.modbase = MOD + 5 * DM; E.fuse = 1; E.O = H; E.gnext = PIN(6) + DM; E.nscale = MOD1 + 1 * DM; E.ssqw = (float*)(ws + WS_CTL + CT_SSQB); }
    else if (gid == G_IN1) { g.A = H; g.Bt = (const bf16_t*)(ws + WS_WIN1); g.K = 1024; S.d.init(64, 8, F.G, F.bid, 2); S.omode = 2;
        E.mode = pg8::E_BF16NORM; E.O = (bf16_t*)(ws + WS_Z); E.ldc = 2048; E.ssq = (const float*)(ws + WS_CTL + CT_SSQB); E.cbias = (const float*)(ws + WS_CBIN1); E.cbld = 2048; }
    else if (gid == G_QB) { g.A = (const bf16_t*)(ws + WS_QA); g.Bt = (const bf16_t*)(ws + WS_WQB); g.K = 256; S.d.init(64, 3, F.G, F.bid, 1); S.omode = 1; E.O = (bf16_t*)(ws + WS_QR); E.ldc = 768; }
    else if (gid == G_KVB) { g.A = (const bf16_t*)(ws + WS_KVA); g.Bt = (const bf16_t*)(ws + WS_WKVB); g.K = 256; S.d.init(72, 4, F.G, F.bid, 0); E.O = (bf16_t*)(ws + WS_KVR); E.ldc = 1024; }
    else if (gid == G_OUT1) { g.A = (const bf16_t*)(ws + WS_Y); g.Bt = (const bf16_t*)(ws + WS_WOUT1); g.K = 1024; S.d.init(64, 4, F.G, F.bid, 1); S.omode = 1;
        E.mode = pg8::E_RES; E.xout = P.out; E.modbase = MOD1 + 2 * DM; E.compact = 1; }
    else { if (F.tid < 9) tb[F.tid] = ((const int*)(ws + WS_CTL + CT_TB))[F.tid];
        __syncthreads();
        S.omode = 5; S.d.init(1, 1, F.G, F.bid, 0); S.mch.tb = tb; S.mch.c = F.bid; unsigned* MCNT = (unsigned*)(ws + WS_CTL + CT_MCNT);
        if (gid == G_MOE1) { g.A = (const bf16_t*)(ws + WS_XG); g.Bt = (const bf16_t*)(ws + WS_W13M); g.K = 1024; S.m.nN = 28; S.mch.stage = 0; S.dcnt = MCNT; E.mode = pg8::E_SWIGLU; E.O = (bf16_t*)(ws + WS_ACT2); E.ldc = DFE; E.npn = 28; }
        else { g.A = (const bf16_t*)(ws + WS_ACT2); g.Bt = (const bf16_t*)(ws + WS_W2M); g.K = 3584; S.m.nN = 4; S.mch.stage = 1; S.wcnt = MCNT; S.wtarget = 224u; E.mode = pg8::E_MOEY2; E.O = (bf16_t*)(ws + WS_Y2); } }
    if (S.wcnt != nullptr) __builtin_amdgcn_fence(__ATOMIC_ACQUIRE, "agent");
    pg8::gemm_phase<pg8::EpiAny, pg8::OrderAny, true, true>(lds, g, S, E);
    __syncthreads();
}

__device__ __forceinline__ void phase_attn0(const Frame& F) {
    char* ws = F.ws; LAS unsigned char* lds = F.lds + RING_OFF;
    for (int i = 0;; ++i) { const int L = i * F.G + F.bid; if (L >= 576) break; const int b = L & 7, idx = L >> 3;
        const int h = idx < 64 ? (idx >> 3) : idx - 64, qb = idx < 64 ? 1 + (idx & 7) : 0, NT = idx < 64 ? 36 : 4;
        att::unit<64>(b, h, h >> 2, qb, NT, (const bf16_t*)(ws + WS_QB), 512, (const bf16_t*)(ws + WS_KB), 128, (const bf16_t*)(ws + WS_VB), 128, (bf16_t*)(ws + WS_Y) + 512, DM, lds); }
}
__device__ __forceinline__ void phase_attn1(const Frame& F, const Params& P) {
    char* ws = F.ws; char* dob = (char*)P.out; LAS unsigned char* lds = F.lds + RING_OFF;
    for (int i = 0;; ++i) { const int L = i * F.G + F.bid; if (L >= 512) break; const int b = L & 7, idx = L >> 3; const int h = idx >> 3, qb = 1 + (idx & 7);
        att::unit<96>(b, h, h, qb, 36, (const bf16_t*)(ws + WS_QM), 768, (const bf16_t*)(dob + DO_KM), 768, (const bf16_t*)(dob + DO_VM), 512, (bf16_t*)(ws + WS_Y) + 512, DM, lds); }
}

__device__ __forceinline__ void phase_route(const Frame& F, const Params& P) {
    char* ws = F.ws; const float* X = P.out; const float* g = PIN(7) + DM; const float* MODL = (const float*)(ws + WS_MOD) + 9 * MODLD; const float* router = PIN(39);
    bf16_t* H2 = (bf16_t*)(ws + WS_H2); int* SEL = (int*)(ws + WS_SEL); int* HIST = (int*)(ws + WS_CTL + CT_HIST);
    LAS int* hist = (LAS int*)(F.lds + MISC_OFF);
    if (F.tid < 8) hist[F.tid] = 0;
    __syncthreads();
    const int rpb = NLAT / F.G, rpw = rpb / NWAVES;
    const int lane = F.lane;
    f32x4 rw[4][4][2], gsc[4], shv[4];
    { const float* md = MODL + (size_t)((F.bid * rpb) / SEQ) * MODLD;
#pragma unroll
      for (int j4 = 0; j4 < 4; ++j4) { const int k = 4 * lane + 256 * j4; gsc[j4] = *(const f32x4*)(g + k) * (*(const f32x4*)(md + 4 * DM + k) + 1.f); shv[j4] = *(const f32x4*)(md + 3 * DM + k);
#pragma unroll
          for (int c = 0; c < 4; ++c) { rw[j4][c][0] = *(const f32x4*)(router + (size_t)(k + c) * 8); rw[j4][c][1] = *(const f32x4*)(router + (size_t)(k + c) * 8 + 4); } } }
#pragma unroll 1
    for (int q0 = 0; q0 < rpw; q0 += 2) {
      f32x4 vv[2][4];
#pragma unroll
      for (int qq = 0; qq < 2; ++qq) { const float* xr = X + (size_t)(F.bid * rpb + F.wave * rpw + q0 + qq) * DM;
#pragma unroll
          for (int j4 = 0; j4 < 4; ++j4) vv[qq][j4] = *(const f32x4*)(xr + 4 * lane + 256 * j4); }
#pragma unroll
      for (int qq = 0; qq < 2; ++qq) {
        const int m = F.bid * rpb + F.wave * rpw + q0 + qq;
        f32x4 (&v)[4] = vv[qq]; float ss = 0.f;
#pragma unroll
        for (int j4 = 0; j4 < 4; ++j4) ss += (v[j4][0] * v[j4][0] + v[j4][1] * v[j4][1]) + (v[j4][2] * v[j4][2] + v[j4][3] * v[j4][3]);
        const float rstd = rsqrtf(wave_sum(ss) / DM + EPS);
        f32x4 a03 = {0.f, 0.f, 0.f, 0.f}, a47 = {0.f, 0.f, 0.f, 0.f};
#pragma unroll
        for (int j4 = 0; j4 < 4; ++j4) { const int k = 4 * lane + 256 * j4; const f32x4 hv = v[j4] * rstd * gsc[j4] + shv[j4];
#pragma unroll
            for (int c = 0; c < 4; ++c) { a03 += rw[j4][c][0] * hv[c]; a47 += rw[j4][c][1] * hv[c]; }
            u32x2 w; w.x = pk2(hv[0], hv[1]); w.y = pk2(hv[2], hv[3]); *(u32x2*)(H2 + (size_t)m * DM + k) = w; }
        float acc[8] = {a03[0], a03[1], a03[2], a03[3], a47[0], a47[1], a47[2], a47[3]};
#pragma unroll
        for (int e = 0; e < 8; ++e) acc[e] = wave_sum(acc[e]);
        if (lane == 0) {
            int e0 = 0; float b0 = acc[0];
#pragma unroll
            for (int e = 1; e < 8; ++e) if (acc[e] > b0) { b0 = acc[e]; e0 = e; }
            int e1 = -1; float b1 = -INFINITY;
#pragma unroll
            for (int e = 0; e < 8; ++e) if (e != e0 && acc[e] > b1) { b1 = acc[e]; e1 = e; }
            const float ex = expf(b1 - b0); const float g0 = 1.f / (1.f + ex), g1 = ex / (1.f + ex);
            SEL[4 * m + 0] = e0; SEL[4 * m + 1] = e1; SEL[4 * m + 2] = __float_as_int(g0); SEL[4 * m + 3] = __float_as_int(g1);
            atomicAdd((int*)&hist[e0], 1); atomicAdd((int*)&hist[e1], 1);
        }
      }
    }
    __syncthreads();
    if (F.tid < 8) HIST[F.bid * 8 + F.tid] = hist[F.tid];
}
__device__ __forceinline__ void phase_slot(const Frame& F, const Params& P) {
    char* ws = F.ws; const int* HIST = (const int*)(ws + WS_CTL + CT_HIST); const int* SEL = (const int*)(ws + WS_SEL); int* TB = (int*)(ws + WS_CTL + CT_TB);
    const bf16_t* H2 = (const bf16_t*)(ws + WS_H2); bf16_t* XG = (bf16_t*)(ws + WS_XG); int* slot_tok = (int*)(ws + WS_SLOTTOK); float* slot_gate = (float*)(ws + WS_SLOTGATE);
    LAS int* sm = (LAS int*)(F.lds + MISC_OFF);
    if (F.tid < 16) sm[F.tid] = 0;
    { const int rpb0 = NLAT / F.G; for (int i = F.tid; i < 4 * rpb0; i += NTHREADS) sm[512 + i] = SEL[4 * F.bid * rpb0 + i]; }
    __syncthreads();
    for (int t = F.tid; t < 2 * F.G; t += NTHREADS) {
        const int j = t % F.G, hf = t / F.G; const int4 c = *(const int4*)(HIST + j * 8 + 4 * hf); const int mk = j < F.bid ? 1 : 0;
        int v[8] = {c.x, c.y, c.z, c.w, c.x * mk, c.y * mk, c.z * mk, c.w * mk};
#pragma unroll
        for (int q = 0; q < 8; ++q) {
#pragma unroll
            for (int o = 1; o < 64; o <<= 1) v[q] += __shfl_xor(v[q], o); }
        if (F.lane == 0) {
#pragma unroll
            for (int q = 0; q < 4; ++q) { atomicAdd((int*)&sm[4 * hf + q], v[q]); atomicAdd((int*)&sm[8 + 4 * hf + q], v[4 + q]); } }
    }
    __syncthreads();
    if (F.tid == 0) { int s = 0; for (int e = 0; e < 8; ++e) { sm[16 + e] = s; s += (sm[e] + 255) & ~255; } sm[24] = s; }
    __syncthreads();
    const int rpb = NLAT / F.G, na = 2 * rpb;
    if (F.tid == 0) { int run[8];
#pragma unroll
        for (int e = 0; e < 8; ++e) run[e] = sm[16 + e] + sm[8 + e];
        for (int a = 0; a < na; ++a) { const int e = sm[512 + 4 * (a >> 1) + (a & 1)]; int sl = 0;
#pragma unroll
            for (int q = 0; q < 8; ++q) if (q == e) { sl = run[q]; run[q] = sl + 1; }
            sm[32 + a] = sl; } }
    __syncthreads();
    for (int a0 = F.wave * 4; a0 < na; a0 += NWAVES * 4) { v4u va[4][2];
#pragma unroll
        for (int q = 0; q < 4; ++q) { const int a = a0 + q; const int m = F.bid * rpb + (a >> 1); const v4u* src = (const v4u*)(H2 + (size_t)m * DM); va[q][0] = src[F.lane]; va[q][1] = src[64 + F.lane]; }
#pragma unroll
        for (int q = 0; q < 4; ++q) { const int a = a0 + q; const int m = F.bid * rpb + (a >> 1), sl = sm[32 + a]; v4u* dst = (v4u*)(XG + (size_t)sl * DM); dst[F.lane] = va[q][0]; dst[64 + F.lane] = va[q][1];
            if (F.lane == 0) { slot_tok[sl] = m; ((int*)(ws + WS_TOKSLOT))[2 * m + (a & 1)] = sl; slot_gate[sl] = __int_as_float(sm[512 + 4 * (a >> 1) + 2 + (a & 1)]); } } }
    if (F.bid < 8) { const int e = F.bid; for (int sl = sm[16 + e] + sm[e] + F.tid; sl < sm[16 + e + 1]; sl += NTHREADS) slot_tok[sl] = -1; }
    if (F.bid == 0 && F.tid < 9) TB[F.tid] = sm[16 + F.tid] >> 8;
}
__device__ __forceinline__ void phase_combine(const Frame& F, const Params& P) {
    char* ws = F.ws; float* out = P.out; const bf16_t* Y2 = (const bf16_t*)(ws + WS_Y2); const int* TS = (const int*)(ws + WS_TOKSLOT); const float* mod5 = (const float*)(ws + WS_MOD) + 9 * MODLD + 5 * DM;
    const int gw = F.bid * NWAVES + F.wave, lane = F.lane; const int mb = gw * 8;
    f32x4 mv[2][2];
    { const float* md = mod5 + (size_t)(mb >> 11) * MODLD;
#pragma unroll
      for (int jj = 0; jj < 2; ++jj)
#pragma unroll
          for (int hlf = 0; hlf < 2; ++hlf) mv[jj][hlf] = *(const f32x4*)(md + 8 * lane + 512 * jj + 4 * hlf); }
#pragma unroll 1
    for (int q0 = 0; q0 < 8; q0 += 2) {
        f32x4 xv[2][4]; v4u ya[2][2], yb[2][2];
#pragma unroll
        for (int q = 0; q < 2; ++q) { const int m = mb + q0 + q; const int sa = TS[2 * m], sb = TS[2 * m + 1];
#pragma unroll
            for (int jj = 0; jj < 4; ++jj) xv[q][jj] = *(const f32x4*)(out + (size_t)m * DM + 8 * lane + 512 * (jj >> 1) + 4 * (jj & 1));
#pragma unroll
            for (int jj = 0; jj < 2; ++jj) { ya[q][jj] = *(const v4u*)(Y2 + (size_t)sa * DM + 8 * lane + 512 * jj); yb[q][jj] = *(const v4u*)(Y2 + (size_t)sb * DM + 8 * lane + 512 * jj); } }
#pragma unroll
        for (int q = 0; q < 2; ++q) { const int m = mb + q0 + q;
#pragma unroll
            for (int jj = 0; jj < 2; ++jj) { const int k = 8 * lane + 512 * jj;
#pragma unroll
                for (int hlf = 0; hlf < 2; ++hlf) { f32x4 o = xv[q][2 * jj + hlf]; const f32x4 mm = mv[jj][hlf];
                    const unsigned a0 = ya[q][jj][2 * hlf], a1 = ya[q][jj][2 * hlf + 1], b0 = yb[q][jj][2 * hlf], b1 = yb[q][jj][2 * hlf + 1];
                    o[0] += mm[0] * (__uint_as_float(a0 << 16) + __uint_as_float(b0 << 16)); o[1] += mm[1] * (__uint_as_float(a0 & 0xffff0000u) + __uint_as_float(b0 & 0xffff0000u));
                    o[2] += mm[2] * (__uint_as_float(a1 << 16) + __uint_as_float(b1 << 16)); o[3] += mm[3] * (__uint_as_float(a1 & 0xffff0000u) + __uint_as_float(b1 & 0xffff0000u));
                    *(f32x4*)(out + (size_t)m * DM + k + 4 * hlf) = o; } } }
    }
}

#define XB_TMO      128
#define XB_XCNT(j)  (256  + 64 * (j))
#define XB_XSUB(j)  (1280 + 64 * (j))
#define XB_XGEN(j)  (2304 + 64 * (j))
#define XB_TOP      3328
#define XB_TOPGEN   3392
#define XCD_BAR_WORDS 3456
#define XB_SPIN_CAP (1u << 18)

__device__ __forceinline__ unsigned xb_ld(unsigned* p)              { return __hip_atomic_load(p, __ATOMIC_RELAXED, __HIP_MEMORY_SCOPE_AGENT); }
__device__ __forceinline__ unsigned xb_add(unsigned* p, unsigned v) { return __hip_atomic_fetch_add(p, v, __ATOMIC_RELAXED, __HIP_MEMORY_SCOPE_AGENT); }
__device__ __forceinline__ unsigned xb_xcc_id() { return (unsigned)__builtin_amdgcn_s_getreg((3 << 11) | 20) & 0xFu; }
#define XB_SPIN(cond, bar) do { unsigned _sp = 0; while (cond) { __builtin_amdgcn_s_sleep(1); \
    if ((++_sp & 255u) == 0u) { if (xb_ld(&(bar)[XB_TMO])) break; if (_sp > XB_SPIN_CAP) { atomicAdd(&(bar)[XB_TMO], 1u); break; } } } } while (0)

struct XcdBarrier {
    unsigned* bar; unsigned x;
    volatile LAS unsigned* st;
};

__device__ __forceinline__ XcdBarrier xcd_barrier_post(unsigned* bar, volatile LAS unsigned* st) {
    XcdBarrier b; b.bar = bar; b.x = xb_xcc_id(); b.st = st;
    if (threadIdx.x == 0) st[2] = xb_add(&bar[XB_XCNT(b.x)], 1u);
    return b;
}
__device__ __forceinline__ void xcd_barrier_complete(unsigned* bar, unsigned x, unsigned& nloc, unsigned& nx, unsigned& even) {
    const unsigned G = gridDim.x * gridDim.y * gridDim.z;
    unsigned sum, cnt, mine, bal, sp = 0u;
    for (;;) {
        sum = 0u; cnt = 0u; mine = 0u; bal = 1u;
#pragma unroll
        for (unsigned j = 0; j < 16; ++j) { const unsigned c = xb_ld(&bar[XB_XCNT(j)]); sum += c; cnt += (c > 0u) ? 1u : 0u; mine = (j == x) ? c : mine; bal = (j < 8u && c * 8u != G) ? 0u : bal; }
        if (sum == G) break;
        __builtin_amdgcn_s_sleep(1);
        if ((++sp & 255u) == 0u) { if (xb_ld(&bar[XB_TMO])) break; if (sp > XB_SPIN_CAP) { atomicAdd(&bar[XB_TMO], 1u); break; } }
    }
    nloc = mine > 0u ? mine : 1u; nx = cnt > 0u ? cnt : 1u; even = (sum == G) ? bal : 0u;
}

__device__ __forceinline__ void xcd_barrier(const XcdBarrier& b) {
    asm volatile("s_waitcnt vmcnt(0)" ::: "memory");
    __syncthreads();
    if (threadIdx.x == 0) {
        unsigned* bar = b.bar;
        __builtin_amdgcn_s_waitcnt(0);
        unsigned nloc = b.st[0], nx = b.st[1];
        if (nloc == 0u) { unsigned ev; xcd_barrier_complete(bar, b.x, nloc, nx, ev); b.st[0] = nloc; b.st[1] = nx; b.st[3] = ev; }
        const unsigned old = xb_add(&bar[XB_XSUB(b.x)], 1u);
        const unsigned gen = old / nloc;
        if (old + 1u == (gen + 1u) * nloc) {
            __builtin_amdgcn_fence(__ATOMIC_RELEASE, "agent");
            asm volatile("s_waitcnt vmcnt(0)" ::: "memory");
            const unsigned og = xb_add(&bar[XB_TOP], 1u);
            const unsigned tg = og / nx;
            if (og + 1u == (tg + 1u) * nx) xb_add(&bar[XB_TOPGEN], 1u);
            else XB_SPIN(xb_ld(&bar[XB_TOPGEN]) == tg, bar);
            __builtin_amdgcn_fence(__ATOMIC_ACQUIRE, "agent");
            xb_add(&bar[XB_XGEN(b.x)], 1u);
            asm volatile("s_waitcnt vmcnt(0)" ::: "memory");
        } else {
            XB_SPIN(xb_ld(&bar[XB_XGEN(b.x)]) == gen, bar);
            __builtin_amdgcn_fence(__ATOMIC_ACQUIRE, "agent");
            asm volatile("s_waitcnt vmcnt(0)" ::: "memory");
        }
    }
    __syncthreads();
}
namespace hy {
using f32x16 = __attribute__((ext_vector_type(16))) float;
constexpr int UL = 2088, ULB = UL * 2;
constexpr int GOFF = 2064;
constexpr int L_U = 0, L_U2 = 8 * ULB, L_X = 2 * 8 * ULB, L_G0 = L_X + 8 * 2048 * 2, L_G1 = L_G0 + GT_LD * 2, L_END = L_G1 + GT_LD * 2;
static_assert(L_END <= RING_BYTES, "hyena LDS");
__device__ __forceinline__ void prep(const Frame& F, const Params& P) {
    char* ws = F.ws; const bf16_t* Z = (const bf16_t*)(ws + WS_Z); bf16_t* ZT = (bf16_t*)(ws + WS_ZT); const float* cw = PIN(24); const float* cb = PIN(25);
    const int gw = F.bid * NWAVES + F.wave, NGW = F.G * NWAVES, lane = F.lane; LAS unsigned char* tl = F.lds + RING_OFF + F.wave * 8192;
    for (int it = gw; it < 24 * 8 * 64; it += NGW) { const int cg = it % 24, b = (it / 24) & 7, tt = it / 192; const int c = cg * 64 + lane, t0 = tt * 32;
        const float w0 = cw[c], w1 = cw[1536 + c], w2 = cw[3072 + c], bias = cb[c];
        const bf16_t* zp = Z + ((size_t)b * RPB + CTX) * CD_LD + cg * 64;
        v4u pc[5];
#pragma unroll
        for (int k = 0; k < 5; ++k) { const int p = lane + 64 * k, row = p >> 3, c8 = p & 7, t = t0 - 1 + row; pc[k] = (p < 272 && t >= 0 && t < SEQ) ? *(const v4u*)(zp + (size_t)t * CD_LD + c8 * 8) : (v4u){0u, 0u, 0u, 0u}; }
#pragma unroll
        for (int k = 0; k < 5; ++k) { const int p = lane + 64 * k, row = p >> 3, c8 = p & 7; if (p < 272) *(LAS v4u*)(tl + row * 144 + c8 * 16) = pc[k]; }
        LDS_WAIT(); asm volatile("" ::: "memory");
        float xr[34];
#pragma unroll
        for (int i = 0; i < 34; ++i) xr[i] = bf2f(*(const LAS bf16_t*)(tl + i * 144 + lane * 2));
        LDS_WAIT(); asm volatile("" ::: "memory");
        bf16_t* op = ZT + ((size_t)c * NB + b) * SEQ + t0;
#pragma unroll
        for (int j8 = 0; j8 < 4; ++j8) { float y[8];
#pragma unroll
            for (int jj = 0; jj < 8; ++jj) { const int i = j8 * 8 + jj; y[jj] = bias + w0 * xr[i] + w1 * xr[i + 1] + w2 * xr[i + 2]; }
            v4u o; o.x = pk2(y[0], y[1]); o.y = pk2(y[2], y[3]); o.z = pk2(y[4], y[5]); o.w = pk2(y[6], y[7]); *(v4u*)(op + j8 * 8) = o; } }
}
__device__ __forceinline__ void filt(const Frame& F, const Params& P) {
    char* ws = F.ws; bf16_t* GT = (bf16_t*)(ws + WS_GT);
    const float *w1 = PIN(26), *b1 = PIN(27), *w2 = PIN(28), *b2 = PIN(29), *w3 = PIN(30), *freq = PIN(31);
    LAS float* z = (LAS float*)(F.lds + RING_OFF); LAS float* h1 = z + 9 * 64; LAS float* h2 = h1 + 9 * 64;
    const int tid = F.tid;
    for (int tb = F.bid; tb < SEQ / 8; tb += F.G) {
        const int t0 = tb * 8;
        __syncthreads();
        if (tid < 9 * 33) { const int tt = tid / 33, k = tid % 33, t = t0 + tt; float zv = (float)t / (float)(SEQ - 1);
            if (k > 0) { const int bi = (k - 1) & 15; const double band = 1e-4 + (15.0 - 1e-4) * (double)bi / 15.0; const double rev = (double)t * band * (1.0 / (double)SEQ);
                const float fr = (float)(rev - floor(rev)); zv = k <= 16 ? __builtin_amdgcn_cosf(fr) : -__builtin_amdgcn_sinf(fr); }
            z[tt * 64 + k] = zv; }
        __syncthreads();
        for (int idx = tid; idx < 9 * 64; idx += NTHREADS) { const int tt = idx >> 6, j = idx & 63; float a = b1[j];
#pragma unroll
            for (int i = 0; i < 33; ++i) a += z[tt * 64 + i] * w1[i * 64 + j];
            h1[idx] = __sinf(freq[j] * a); }
        __syncthreads();
        for (int idx = tid; idx < 9 * 64; idx += NTHREADS) { const int tt = idx >> 6, j = idx & 63; float a = b2[j];
#pragma unroll 16
            for (int i = 0; i < 64; ++i) a += h1[tt * 64 + i] * w2[i * 64 + j];
            h2[idx] = __sinf(freq[j] * a); }
        __syncthreads();
        float acc[4][9];
#pragma unroll
        for (int q = 0; q < 4; ++q)
#pragma unroll
            for (int tt = 0; tt < 9; ++tt) acc[q][tt] = 0.f;
#pragma unroll 16
        for (int i = 0; i < 64; ++i) { float wv[4];
#pragma unroll
            for (int q = 0; q < 4; ++q) wv[q] = w3[(size_t)i * 2048 + tid + 512 * q];
#pragma unroll
            for (int tt = 0; tt < 9; ++tt) { const float hv = h2[tt * 64 + i];
#pragma unroll
                for (int q = 0; q < 4; ++q) acc[q][tt] += hv * wv[q]; } }
        const double mind = log(1e-2) / 1.5, maxd = log(1e-2) / 0.3; const int ch = tid; const float delta = fabsf((float)(mind + (maxd - mind) * (double)ch / 511.0));
        float win[9];
#pragma unroll
        for (int tt = 0; tt < 9; ++tt) { const int t = t0 + tt; win[tt] = t < SEQ ? __expf(-((float)t / (float)(SEQ - 1)) * delta) + 0.05f : 0.f; }
#pragma unroll
        for (int ord = 0; ord < 2; ++ord) { bf16_t* gp = GT + ((size_t)ord * 512 + ch) * GT_LD + GOFF; float fw[9], bw[9];
#pragma unroll
            for (int tt = 0; tt < 9; ++tt) { fw[tt] = acc[2 * ord][tt] * win[tt]; bw[tt] = acc[2 * ord + 1][tt] * win[tt]; }
            if (t0 == 0) bw[0] = fw[0];
            v4u ob; ob.x = pk2(bw[0], bw[1]); ob.y = pk2(bw[2], bw[3]); ob.z = pk2(bw[4], bw[5]); ob.w = pk2(bw[6], bw[7]); *(v4u*)(gp + t0) = ob;
            v4u of; of.x = pk2(fw[8], fw[7]); of.y = pk2(fw[6], fw[5]); of.z = pk2(fw[4], fw[3]); of.w = pk2(fw[2], fw[1]); *(v4u*)(gp - t0 - 8) = of; }
    }
    const int gt = F.bid * NTHREADS + F.tid, NGT = F.G * NTHREADS; constexpr int NZ = 16 + (GT_LD - GOFF - 2048);
    for (int i = gt; i < 1024 * NZ; i += NGT) { const int oc = i / NZ, k = i % NZ; GT[(size_t)oc * GT_LD + (k < 16 ? k : GOFF + 2048 + (k - 16))] = 0; }
}
__device__ __forceinline__ void conv_mfma(f32x16 (&acc)[2], LAS unsigned char* Ub, LAS unsigned char* Gb, int wave, int lane) {
    const int n = lane & 31, h = lane >> 5, b = n >> 2, dl = n & 3;
    const LAS unsigned char* up = Ub + b * ULB + 16 * h;
    const int i = lane & 31;
    const LAS unsigned char* gp0 = Gb + 2 * (GOFF + 8 * h - 4 * i - 16 * (8 * (2 * wave) + 1));
    const LAS unsigned char* gp1 = gp0 - 2 * 16 * 8;
    acc[0] = f32x16{}; acc[1] = f32x16{};
    const bool sh2 = dl >= 2; const unsigned sb = (dl & 1) * 2;
    const LAS unsigned char* upq = up + 8 * (dl < 3 ? dl : 2);
    u32x4 ring[8];
#pragma unroll
    for (int b8 = 0; b8 < 8; ++b8) { const u32x2 a0 = *(const LAS u32x2*)(gp1 + 32 * b8), a1 = *(const LAS u32x2*)(gp1 + 32 * b8 + 8); ring[b8] = (u32x4){a0[0], a0[1], a1[0], a1[1]}; }
#define HY_STEP(J, b8) do { \
          \
        const u32x2 qx = *(const LAS u32x2*)(upq + 32 * (J)); \
        unsigned q[6]; \
        q[0] = __builtin_amdgcn_mov_dpp((int)qx[0], 0x00, 0xF, 0xF, false); q[1] = __builtin_amdgcn_mov_dpp((int)qx[1], 0x00, 0xF, 0xF, false); \
        q[2] = __builtin_amdgcn_mov_dpp((int)qx[0], 0x55, 0xF, 0xF, false); q[3] = __builtin_amdgcn_mov_dpp((int)qx[1], 0x55, 0xF, 0xF, false); \
        q[4] = __builtin_amdgcn_mov_dpp((int)qx[0], 0xAA, 0xF, 0xF, false); q[5] = __builtin_amdgcn_mov_dpp((int)qx[1], 0xAA, 0xF, 0xF, false); \
        u32x4 bw; \
        _Pragma("unroll") for (int w = 0; w < 4; ++w) { const unsigned lo = sh2 ? q[w + 1] : q[w], hi_ = sh2 ? q[w + 2] : q[w + 1]; bw[w] = __builtin_amdgcn_alignbyte(hi_, lo, sb); } \
        const u32x2 a00 = *(const LAS u32x2*)(gp0 + 32 * (J)), a01 = *(const LAS u32x2*)(gp0 + 32 * (J) + 8); \
        const u32x4 A1 = ring[b8]; const u32x4 A0 = {a00[0], a00[1], a01[0], a01[1]}; ring[b8] = A0; \
        acc[0] = __builtin_amdgcn_mfma_f32_32x32x16_bf16(__builtin_bit_cast(bf16x8, A0), __builtin_bit_cast(bf16x8, bw), acc[0], 0, 0, 0); \
        acc[1] = __builtin_amdgcn_mfma_f32_32x32x16_bf16(__builtin_bit_cast(bf16x8, A1), __builtin_bit_cast(bf16x8, bw), acc[1], 0, 0, 0); } while (0)
#pragma unroll 1
    for (int J8 = 0; J8 < 128; J8 += 8) {
#pragma unroll
        for (int b8 = 0; b8 < 8; ++b8) HY_STEP(J8 + b8, b8); }
    HY_STEP(128, 0);
#undef HY_STEP
}
__device__ __forceinline__ void main_phase(const Frame& F, const Params& P) {
    char* ws = F.ws; const bf16_t* ZT = (const bf16_t*)(ws + WS_ZT); const bf16_t* GT = (const bf16_t*)(ws + WS_GT); bf16_t* HT = (bf16_t*)(ws + WS_HT); const float* skip = PIN(32);
    LAS unsigned char* lds = F.lds + RING_OFF; const int tid = F.tid, lane = F.lane, wave = F.wave;
    const int n = lane & 31, h = lane >> 5, b = n >> 2, dl = n & 3;
    for (int c = F.bid; c < 512; c += F.G) {
        __syncthreads();
        for (int i = tid; i < 8 * 256; i += NTHREADS) { const int bb = i >> 8, k = i & 255; *(LAS v4u*)(lds + L_U + bb * ULB + 32 + k * 16) = *(const v4u*)(ZT + ((size_t)c * NB + bb) * SEQ + k * 8);
            *(LAS v4u*)(lds + L_X + (bb * 2048 + k * 8) * 2) = *(const v4u*)(ZT + ((size_t)(512 + c) * NB + bb) * SEQ + k * 8); }
        for (int i = tid; i < GT_LD / 8; i += NTHREADS) { *(LAS v4u*)(lds + L_G0 + i * 16) = *(const v4u*)(GT + (size_t)c * GT_LD + i * 8); *(LAS v4u*)(lds + L_G1 + i * 16) = *(const v4u*)(GT + (size_t)(512 + c) * GT_LD + i * 8); }
        if (tid < 80) { const int bb = tid / 10, k = tid % 10, which = k / 5, part = k % 5; const int off = bb * ULB + (part < 2 ? part * 16 : (16 + 2048) * 2 + (part - 2) * 16);
            *(LAS v4u*)(lds + (which ? L_U2 : L_U) + off) = (v4u){0u, 0u, 0u, 0u}; }
        __syncthreads();
        const float sk0 = skip[c], sk1 = skip[512 + c];
        f32x16 acc[2];
        conv_mfma(acc, lds + L_U, lds + L_G0, wave, lane);
#pragma unroll
        for (int ip = 0; ip < 2; ++ip)
#pragma unroll
            for (int r = 0; r < 16; ++r) { const int t = 128 * (2 * wave + ip) + 4 * att::crow(r, h) + dl;
                const float v = bf2f(*(const LAS bf16_t*)(lds + L_U + b * ULB + (16 + t) * 2)), x1 = bf2f(*(const LAS bf16_t*)(lds + L_X + (b * 2048 + t) * 2));
                *(LAS bf16_t*)(lds + L_U2 + b * ULB + (16 + t) * 2) = f2bf(x1 * (acc[ip][r] + sk0 * v)); }
        __syncthreads();
        for (int i = tid; i < 8 * 256; i += NTHREADS) { const int bb = i >> 8, k = i & 255; *(LAS v4u*)(lds + L_X + (bb * 2048 + k * 8) * 2) = *(const v4u*)(ZT + ((size_t)(1024 + c) * NB + bb) * SEQ + k * 8); }
        conv_mfma(acc, lds + L_U2, lds + L_G1, wave, lane);
        __syncthreads();
#pragma unroll
        for (int ip = 0; ip < 2; ++ip)
#pragma unroll
            for (int r = 0; r < 16; ++r) { const int t = 128 * (2 * wave + ip) + 4 * att::crow(r, h) + dl;
                const float y1 = bf2f(*(const LAS bf16_t*)(lds + L_U2 + b * ULB + (16 + t) * 2)), x2 = bf2f(*(const LAS bf16_t*)(lds + L_X + (b * 2048 + t) * 2));
                *(LAS bf16_t*)(lds + L_U + (b * 2048 + t) * 2) = f2bf(x2 * (acc[ip][r] + sk1 * y1)); }
        __syncthreads();
        for (int i = tid; i < 8 * 256; i += NTHREADS) *(v4u*)(HT + (size_t)c * NLAT + i * 8) = *(const LAS v4u*)(lds + L_U + i * 16);
    }
}
__device__ __forceinline__ void untranspose(const Frame& F) {
    char* ws = F.ws; const bf16_t* HT = (const bf16_t*)(ws + WS_HT); bf16_t* Y = (bf16_t*)(ws + WS_Y);
    const int gw = F.bid * NWAVES + F.wave, NGW = F.G * NWAVES, lane = F.lane; LAS unsigned char* tl = F.lds + RING_OFF + F.wave * 16384;
    __syncthreads();
    for (int it = gw; it < 8 * 8 * 32; it += NGW) { const int cg = it & 7, b = (it >> 3) & 7, tt = it >> 6; const int c = cg * 64 + lane, t0 = tt * 64;
        const bf16_t* hp = HT + ((size_t)c * NB + b) * SEQ + t0; bf16_t* yp = Y + ((size_t)b * RPB + CTX + t0) * DM + cg * 64;
        v4u q[8];
#pragma unroll
        for (int j8 = 0; j8 < 8; ++j8) q[j8] = *(const v4u*)(hp + j8 * 8);
#pragma unroll
        for (int j8 = 0; j8 < 8; ++j8)
#pragma unroll
            for (int jj = 0; jj < 4; ++jj) { *(LAS bf16_t*)(tl + (j8 * 8 + 2 * jj) * 144 + lane * 2) = (bf16_t)(q[j8][jj] & 0xffffu); *(LAS bf16_t*)(tl + (j8 * 8 + 2 * jj + 1) * 144 + lane * 2) = (bf16_t)(q[j8][jj] >> 16); }
        LDS_WAIT(); asm volatile("" ::: "memory");
#pragma unroll
        for (int k = 0; k < 8; ++k) { const int p = lane + 64 * k, row = p >> 3, c8 = p & 7; *(v4u*)(yp + (size_t)row * DM + c8 * 8) = *(const LAS v4u*)(tl + row * 144 + c8 * 16); }
        LDS_WAIT(); asm volatile("" ::: "memory"); }
}
}
namespace lru {
using f32x16 = __attribute__((ext_vector_type(16))) float;
typedef float f32x2 __attribute__((ext_vector_type(2)));
constexpr int T = 32, NCH = RPB / T;
constexpr int UPITCH = 1040;
constexpr int L_UT = 0, L_GL = 34816, L_END = L_GL + 2 * T * 512 * 2;
static_assert(L_END <= RING_BYTES, "lru LDS");
__device__ __forceinline__ float fsigmoid(float x) { return __builtin_amdgcn_rcpf(1.f + __builtin_amdgcn_exp2f(-LOG2E * x)); }
__device__ __forceinline__ float gelu_fast(float x) { const float y = 0.7978845608028654f * (x + 0.044715f * x * x * x); const float e = __builtin_amdgcn_exp2f(2.f * LOG2E * y); const float th = 1.f - 2.f * __builtin_amdgcn_rcpf(1.f + e); return 0.5f * x * (1.f + th); }
__device__ __forceinline__ int chunk_of_order(int d, int q) { return d == 0 ? q : (q < 8 ? 7 - q : 79 - q); }
__device__ __forceinline__ int order_of_chunk(int d, int j) { return d == 0 ? j : (j < 8 ? 7 - j : 79 - j); }

__device__ __forceinline__ void unit0(const Frame& F, const Params& P, int b, int j) {
    char* ws = F.ws; const bf16_t* Z = (const bf16_t*)(ws + WS_Z); float* AGG = (float*)(ws + WS_AGG); const bf16_t* WL = (const bf16_t*)(ws + WS_WLRU);
    bf16_t* LAB = (bf16_t*)P.out; bf16_t* BTB = (bf16_t*)(ws + WS_H);
    LAS unsigned char* lds = F.lds + RING_OFF; const int ch = F.tid, lane = F.lane, wave = F.wave;
    const int s0 = j * T, seg_lo = s0 < CTX ? 0 : CTX, seg_hi = s0 < CTX ? CTX : RPB; const size_t row0 = (size_t)b * RPB + s0;
    LDS_WAIT(); asm volatile("" ::: "memory");
    float u[T];
    { const float w0 = PIN(10)[ch], w1 = PIN(10)[512 + ch], w2 = PIN(10)[1024 + ch], w3 = PIN(10)[1536 + ch], cb = PIN(11)[ch];
      float xw[T + 3];
#pragma unroll
      for (int i = 0; i < T + 3; ++i) { const int s = s0 + i - 2; xw[i] = (s >= seg_lo && s < seg_hi) ? bf2f(Z[((size_t)b * RPB + s) * AB_IN + ch]) : 0.f; }
#pragma unroll
      for (int t = 0; t < T; ++t) { u[t] = cb + w0 * xw[t] + w1 * xw[t + 1] + w2 * xw[t + 2] + w3 * xw[t + 3]; *(LAS bf16_t*)(lds + L_UT + t * UPITCH + ch * 2) = f2bf(u[t]); } }
#pragma unroll
    for (int d = 0; d < 2; ++d) {
        LDS_WAIT(); asm volatile("" ::: "memory");
        { const int n = wave, r32 = lane & 31, h = lane >> 5; bf16x8 af[4];
#pragma unroll
          for (int ks = 0; ks < 4; ++ks) af[ks] = *(const LAS bf16x8*)(lds + L_UT + r32 * UPITCH + (64 * n + 16 * ks + 8 * h) * 2);
#pragma unroll
          for (int g = 0; g < 2; ++g)
#pragma unroll
              for (int cb = 0; cb < 2; ++cb) { f32x16 acc = f32x16{}; const bf16_t* wp = WL + ((size_t)((d * 8 + n) * 2 + g) * 64 + 32 * cb + r32) * 64 + 8 * h;
#pragma unroll
                  for (int ks = 0; ks < 4; ++ks) { const bf16x8 bfr = *(const bf16x8*)(wp + 16 * ks); acc = __builtin_amdgcn_mfma_f32_32x32x16_bf16(af[ks], bfr, acc, 0, 0, 0); }
                  const float bias = (g == 0 ? PIN(13) : PIN(15))[(d * 8 + n) * 64 + 32 * cb + r32];
#pragma unroll
                  for (int r = 0; r < 16; ++r) *(LAS bf16_t*)(lds + L_GL + ((g * T + att::crow(r, h)) * 512 + 64 * n + 32 * cb + r32) * 2) = f2bf(fsigmoid(acc[r] + bias)); } }
        LDS_WAIT(); asm volatile("" ::: "memory");
        const float cl = -8.f * softplus_f(-PIN(16)[d * 512 + ch]);
        float h = 0.f, sumlog = 0.f; bf16_t* lap = LAB + ((size_t)d * MROWS + row0) * 512 + ch; bf16_t* btp = BTB + ((size_t)d * MROWS + row0) * 512 + ch;
#pragma unroll
        for (int st = 0; st < T; ++st) { const int t = d == 0 ? st : T - 1 - st;
            const float rg = bf2f(*(const LAS bf16_t*)(lds + L_GL + (t * 512 + ch) * 2)), ig = bf2f(*(const LAS bf16_t*)(lds + L_GL + ((T + t) * 512 + ch) * 2));
            const bf16_t lab = f2bf(cl * rg); const float la = bf2f(lab); const float a = __builtin_amdgcn_exp2f(LOG2E * la);
            const bf16_t btb = f2bf(__builtin_amdgcn_sqrtf(fmaf(-a, a, 1.f)) * (ig * u[t])); const float bt = bf2f(btb);
            lap[(size_t)t * 512] = lab; btp[(size_t)t * 512] = btb;
            h = a * h + bt; sumlog += la; }
        { f32x2* ag = (f32x2*)AGG + ((size_t)(d * 8 + b) * NCH + j) * 512 + ch; *ag = (f32x2){sumlog, h}; }
    }
}
__device__ __forceinline__ void unit1(const Frame& F, const Params& P, int b, int j) {
    char* ws = F.ws; const bf16_t* Z = (const bf16_t*)(ws + WS_Z); bf16_t* Y = (bf16_t*)(ws + WS_Y); const float* AGG = (const float*)(ws + WS_AGG);
    const bf16_t* LAB = (const bf16_t*)P.out; const bf16_t* BTB = (const bf16_t*)(ws + WS_H);
    const int ch = F.tid; const size_t row0 = (size_t)b * RPB + j * T;
    float hf[T];
#pragma unroll
    for (int d = 0; d < 2; ++d) {
        const bf16_t* lap = LAB + ((size_t)d * MROWS + row0) * 512 + ch; const bf16_t* btp = BTB + ((size_t)d * MROWS + row0) * 512 + ch;
        bf16_t lav[T], btv[T]; bf16_t gv[T];
#pragma unroll
        for (int t = 0; t < T; ++t) { lav[t] = lap[(size_t)t * 512]; btv[t] = btp[(size_t)t * 512]; if (d == 1) gv[t] = Z[(row0 + t) * AB_IN + 512 + ch]; }
        float h = 0.f;
        { const int q = order_of_chunk(d, j); const f32x2* ag = (const f32x2*)AGG + (size_t)(d * 8 + b) * NCH * 512 + ch;
#pragma unroll 24
          for (int qq = 0; qq < q; ++qq) { const int jj = chunk_of_order(d, qq); const f32x2 av = ag[(size_t)jj * 512]; h = __builtin_amdgcn_exp2f(LOG2E * av[0]) * h + av[1]; } }
#pragma unroll
        for (int st = 0; st < T; ++st) { const int t = d == 0 ? st : T - 1 - st;
            h = __builtin_amdgcn_exp2f(LOG2E * bf2f(lav[t])) * h + bf2f(btv[t]);
            if (d == 0) hf[t] = h; else Y[(row0 + t) * DM + ch] = f2bf((hf[t] + h) * gelu_fast(bf2f(gv[t]))); }
    }
}
template <int MODE>
__device__ __forceinline__ void phase(const Frame& F, const Params& P) {
    const int first = MODE == 0 ? F.bid : (F.bid + 192) % F.G;
    for (int L = first; L < NB * NCH; L += F.G) { if (MODE == 0) unit0(F, P, L & 7, L >> 3); else unit1(F, P, L & 7, L >> 3); }
}
}
namespace el {
__device__ __forceinline__ void mod_phase(const Frame& F, const Params& P) {
    char* ws = F.ws; float* MOD = (float*)(ws + WS_MOD); const float* c = PIN(1); const float* cctx = PIN(3); const float* mw = PIN(4); const float* mb = PIN(5);
    LAS float* sc = (LAS float*)(F.lds + RING_OFF); LAS float* part = sc + 9 * DM;
    if (F.bid >= 192) return;
    for (int i = F.tid; i < 9 * DM; i += NTHREADS) { const int j = i >> 10, k = i & 1023; const float v = j < 8 ? c[j * DM + k] : cctx[k]; sc[i] = v / (1.f + expf(-v)); }
    __syncthreads();
    const int cg = F.lane & 15, kr = F.lane >> 4; const int col = F.bid * 64 + 4 * cg, l = col / MODLD, n = col % MODLD; const float* w = mw + (size_t)l * DM * MODLD + n; const int k0 = F.wave * 128 + kr;
    f32x4 acc[9];
#pragma unroll
    for (int j = 0; j < 9; ++j) acc[j] = (f32x4){0.f, 0.f, 0.f, 0.f};
#pragma unroll 8
    for (int i = 0; i < 32; ++i) { const int k = k0 + 4 * i; const f32x4 wv = __builtin_nontemporal_load((const f32x4*)(w + (size_t)k * MODLD));
#pragma unroll
        for (int j = 0; j < 9; ++j) acc[j] += wv * sc[j * DM + k]; }
#pragma unroll
    for (int j = 0; j < 9; ++j) {
#pragma unroll
        for (int c = 0; c < 4; ++c) { float v = acc[j][c]; v += __shfl_xor(v, 16); v += __shfl_xor(v, 32); acc[j][c] = v; }
        if (kr == 0) *(LAS f32x4*)(part + (F.wave * 9 + j) * 64 + 4 * cg) = acc[j]; }
    __syncthreads();
    for (int i = F.tid; i < 9 * 64; i += NTHREADS) { const int j = i >> 6, ln = i & 63; float s = 0.f;
#pragma unroll
        for (int wv = 0; wv < 8; ++wv) s += part[(wv * 9 + j) * 64 + ln];
        const int cc = F.bid * 64 + ln; MOD[((size_t)(cc / MODLD) * 9 + j) * MODLD + cc % MODLD] = s + mb[cc]; }
    __syncthreads();
}
__device__ __forceinline__ void bias_phase(const Frame& F, const Params& P) {
    char* ws = F.ws; const float* MOD = (const float*)(ws + WS_MOD);
    LAS float* sc = (LAS float*)(F.lds + RING_OFF); LAS float* part = sc + 9 * DM;
    if (F.bid >= 120) return;
    const bool f1 = F.bid < 88; const float* shb = f1 ? MOD + 3 * DM : MOD + 9 * MODLD;
    __syncthreads();
    for (int i = F.tid; i < 9 * DM; i += NTHREADS) sc[i] = shb[(size_t)(i >> 10) * MODLD + (i & 1023)];
    __syncthreads();
    const int cg = F.lane & 15, kr = F.lane >> 4; const int cc = (f1 ? F.bid : F.bid - 88) * 64 + 4 * cg; const float* w; int ldw; bool valid = true;
    if (f1) { const int pn = cc >> 8, c = cc & 255; w = (c < 128 ? PIN(19) : PIN(20)) + pn * 128 + (c & 127); ldw = DFF; } else { valid = cc < CD_IN; w = PIN(22) + (valid ? cc : 0); ldw = CD_IN; }
    const int k0 = F.wave * 128 + kr; f32x4 acc[9];
#pragma unroll
    for (int j = 0; j < 9; ++j) acc[j] = (f32x4){0.f, 0.f, 0.f, 0.f};
#pragma unroll 8
    for (int i = 0; i < 32; ++i) { const int k = k0 + 4 * i; const f32x4 wv = *(const f32x4*)(w + (size_t)k * ldw);
#pragma unroll
        for (int j = 0; j < 9; ++j) acc[j] += wv * sc[j * DM + k]; }
#pragma unroll
    for (int j = 0; j < 9; ++j) {
#pragma unroll
        for (int c = 0; c < 4; ++c) { float v = acc[j][c]; v += __shfl_xor(v, 16); v += __shfl_xor(v, 32); acc[j][c] = valid ? v : 0.f; }
        if (kr == 0) *(LAS f32x4*)(part + (F.wave * 9 + j) * 64 + 4 * cg) = acc[j]; }
    __syncthreads();
    for (int i = F.tid; i < 9 * 64; i += NTHREADS) { const int j = i >> 6, ln = i & 63; float s = 0.f;
#pragma unroll
        for (int wv = 0; wv < 8; ++wv) s += part[(wv * 9 + j) * 64 + ln];
        if (f1) ((float*)(ws + WS_CBF1))[(size_t)j * 5632 + F.bid * 64 + ln] = s; else ((float*)(ws + WS_CBIN1))[(size_t)j * 2048 + (F.bid - 88) * 64 + ln] = s; }
    __syncthreads();
}
template <int SRC>
__device__ __forceinline__ void norm_phase(const Frame& F, const Params& P, const float* g, const float* MODL, int ish, int isc) {
    char* ws = F.ws; bf16_t* H = (bf16_t*)(ws + WS_H); const int gw = F.bid * NWAVES + F.wave, lane = F.lane; const int rb = gw * 9;
    f32x4 gg[4], gs[4], sh[4]; int cur = -1;
#pragma unroll
    for (int j = 0; j < 4; ++j) gg[j] = *(const f32x4*)(g + 4 * lane + 256 * j);
#pragma unroll 1
    for (int r0 = rb; r0 < rb + 9; r0 += 3) {
        f32x4 v[3][4];
#pragma unroll
        for (int q = 0; q < 3; ++q) { const int r = r0 + q, b = r / RPB, s = r - b * RPB;
            const float* xr = s < CTX ? PIN(2) + ((size_t)b * CTX + s) * DM : PIN(0) + ((size_t)b * SEQ + (s - CTX)) * DM;
#pragma unroll
            for (int j = 0; j < 4; ++j) v[q][j] = *(const f32x4*)(xr + 4 * lane + 256 * j); }
#pragma unroll
        for (int q = 0; q < 3; ++q) { const int r = r0 + q, b = r / RPB, s = r - b * RPB; const int mrow = s < CTX ? 8 : b;
            if (mrow != cur) { cur = mrow; const float* md = MODL + (size_t)mrow * MODLD;
#pragma unroll
                for (int j = 0; j < 4; ++j) { const int k = 4 * lane + 256 * j; gs[j] = gg[j] * (*(const f32x4*)(md + isc * DM + k) + 1.f); sh[j] = *(const f32x4*)(md + ish * DM + k); } }
            float ss = 0.f;
#pragma unroll
            for (int j = 0; j < 4; ++j) ss += (v[q][j][0] * v[q][j][0] + v[q][j][1] * v[q][j][1]) + (v[q][j][2] * v[q][j][2] + v[q][j][3] * v[q][j][3]);
            const float rstd = rsqrtf(wave_sum(ss) / DM + EPS);
#pragma unroll
            for (int j = 0; j < 4; ++j) { const int k = 4 * lane + 256 * j; const f32x4 hv = v[q][j] * rstd * gs[j] + sh[j];
                u32x2 w; w.x = pk2(hv[0], hv[1]); w.y = pk2(hv[2], hv[3]); *(u32x2*)(H + (size_t)r * DM + k) = w; } }
    }
}
__device__ __forceinline__ void rope_tables(const Frame& F) {
    float* R0 = (float*)(F.ws + WS_ROPE0); float* R1 = (float*)(F.ws + WS_ROPE1); const int gt = F.bid * NTHREADS + F.tid, NGT = F.G * NTHREADS;
    for (int i = gt; i < SEQ * 48; i += NGT) { const int t = i / 48, k = i % 48; const float row = (float)(t >> 6), col = (float)(t & 63);
        const bool l0 = k < 32; const int kk = l0 ? k : k - 32; const int half = l0 ? 16 : 8;
        const float invf = exp2f(-(float)(kk & (half - 1)) * (13.287712379549449f / (float)half)); const float ang = (kk < half ? row : col) * invf; const float cv = cosf(ang), sv = sinf(ang);
        if (l0) { R0[t * 64 + kk] = cv; R0[t * 64 + 32 + kk] = sv; } else { R1[t * 32 + kk] = cv; R1[t * 32 + 16 + kk] = sv; } }
}
__device__ __forceinline__ void gqa_prep(const Frame& F, const Params& P) {
    char* ws = F.ws; const bf16_t* Z = (const bf16_t*)(ws + WS_Z); bf16_t* Q = (bf16_t*)(ws + WS_QB); bf16_t* K = (bf16_t*)(ws + WS_KB); bf16_t* V = (bf16_t*)(ws + WS_VB); const float* R0 = (const float*)(ws + WS_ROPE0);
    const int gw = F.bid * NWAVES + F.wave, NGW = F.G * NWAVES, lane = F.lane; const int d0 = 8 * (lane & 7), i0 = d0 & 31;
    float qn[8], kn[8];
#pragma unroll
    for (int e = 0; e < 8; ++e) { qn[e] = PIN(17)[d0 + e] * QSCALE0; kn[e] = PIN(18)[d0 + e]; }
    constexpr int R1 = 6912; const int nb2 = F.G - 64; const int gw2 = (F.bid - 64) * NWAVES + F.wave, NGW2 = nb2 * NWAVES;
    for (int pass = 0; pass < 2; ++pass) { const int base = pass == 0 ? 0 : R1, lim = pass == 0 ? R1 : MROWS, g0 = pass == 0 ? gw : gw2, ng = pass == 0 ? NGW : NGW2; if (pass == 1 && F.bid < 64) break;
    for (int r0 = base + g0; r0 < lim; r0 += 2 * ng) {
        v4u qv[2], kv[2]; f32x4 cs[2][2], sn[2][2];
#pragma unroll
        for (int q = 0; q < 2; ++q) { const int r = r0 + q * ng; if (r < lim) { const bf16_t* z = Z + (size_t)r * AB_IN + 1024; const int s = r % RPB;
            qv[q] = *(const v4u*)(z + 8 * lane); kv[q] = lane < 32 ? *(const v4u*)(z + 512 + 8 * lane) : (v4u){0u, 0u, 0u, 0u};
            if (s >= CTX) { const float* rp = R0 + (size_t)(s - CTX) * 64 + i0; cs[q][0] = *(const f32x4*)rp; cs[q][1] = *(const f32x4*)(rp + 4); sn[q][0] = *(const f32x4*)(rp + 32); sn[q][1] = *(const f32x4*)(rp + 36); } } }
#pragma unroll
        for (int q = 0; q < 2; ++q) { const int r = r0 + q * ng; if (r < lim) { const bool lat = (r % RPB) >= CTX;
#pragma unroll
            for (int ps = 0; ps < 2; ++ps) { const v4u raw = ps == 0 ? qv[q] : kv[q]; float x[8];
#pragma unroll
                for (int e = 0; e < 4; ++e) { x[2 * e] = __uint_as_float(raw[e] << 16); x[2 * e + 1] = __uint_as_float(raw[e] & 0xffff0000u); }
                float ss = 0.f;
#pragma unroll
                for (int e = 0; e < 8; ++e) ss += x[e] * x[e];
                ss += __shfl_xor(ss, 1); ss += __shfl_xor(ss, 2); ss += __shfl_xor(ss, 4);
                const float rs = rsqrtf(ss * (1.f / 64.f) + EPS); float y[8];
#pragma unroll
                for (int e = 0; e < 8; ++e) y[e] = x[e] * rs * (ps == 0 ? qn[e] : kn[e]);
                if (lat) {
#pragma unroll
                    for (int e = 0; e < 8; ++e) { const float other = __shfl_xor(y[e], 4); const float c = cs[q][e >> 2][e & 3], s_ = sn[q][e >> 2][e & 3]; y[e] = (lane & 4) ? (other * s_ + y[e] * c) : (y[e] * c - other * s_); } }
                v4u o; o.x = pk2(y[0], y[1]); o.y = pk2(y[2], y[3]); o.z = pk2(y[4], y[5]); o.w = pk2(y[6], y[7]);
                if (ps == 0) *(v4u*)(Q + (size_t)r * 512 + 8 * lane) = o;
                else if (lane < 16) *(v4u*)(K + (size_t)r * 128 + 8 * lane) = o;
                else if (lane < 32) *(v4u*)(V + (size_t)r * 128 + 8 * (lane - 16)) = raw; } } }
    } }
}
__device__ __forceinline__ void mla_prep1(const Frame& F, const Params& P) {
    char* ws = F.ws; const bf16_t* Z = (const bf16_t*)(ws + WS_Z); bf16_t* QA = (bf16_t*)(ws + WS_QA); bf16_t* KVA = (bf16_t*)(ws + WS_KVA); bf16_t* KR = (bf16_t*)(ws + WS_KR);
    const int gw = F.bid * NWAVES + F.wave, NGW = F.G * NWAVES, lane = F.lane; const float* gq = PIN(33); const float* gkv = PIN(35);
    const f32x4 g4 = *(const f32x4*)(gq + 4 * lane); const float gk0 = gkv[2 * lane], gk1 = gkv[2 * lane + 1];
    for (int r0 = gw; r0 < MROWS; r0 += 3 * NGW) {
        u32x2 qw[3]; unsigned kw[3], krw[3];
#pragma unroll
        for (int q = 0; q < 3; ++q) { const int r = r0 + q * NGW; if (r < MROWS) { const bf16_t* z = Z + (size_t)r * CD_LD; qw[q] = *(const u32x2*)(z + 1536 + 4 * lane); kw[q] = *(const unsigned*)(z + 1792 + 2 * lane); krw[q] = lane < 16 ? *(const unsigned*)(z + 1920 + 2 * lane) : 0u; } }
#pragma unroll
        for (int q = 0; q < 3; ++q) { const int r = r0 + q * NGW; if (r < MROWS) {
            const float q0 = __uint_as_float(qw[q].x << 16), q1 = __uint_as_float(qw[q].x & 0xffff0000u), q2 = __uint_as_float(qw[q].y << 16), q3 = __uint_as_float(qw[q].y & 0xffff0000u);
            const float k0 = __uint_as_float(kw[q] << 16), k1 = __uint_as_float(kw[q] & 0xffff0000u);
            const float rq = rsqrtf(wave_sum((q0 * q0 + q1 * q1) + (q2 * q2 + q3 * q3)) * (1.f / 256.f) + EPS), rk = rsqrtf(wave_sum(k0 * k0 + k1 * k1) * (1.f / 128.f) + EPS);
            u32x2 o; o.x = pk2(q0 * rq * g4[0], q1 * rq * g4[1]); o.y = pk2(q2 * rq * g4[2], q3 * rq * g4[3]); *(u32x2*)(QA + (size_t)r * 256 + 4 * lane) = o;
            *(unsigned*)(KVA + (size_t)r * 256 + 2 * lane) = pk2(k0 * rk * gk0, k1 * rk * gk1); *(unsigned*)(KVA + (size_t)r * 256 + 128 + 2 * lane) = 0u;
            if (lane < 16) *(unsigned*)(KR + (size_t)r * 32 + 2 * lane) = krw[q]; } }
    }
}
__device__ __forceinline__ void mla_prep2(const Frame& F, const Params& P) {
    char* ws = F.ws; char* dob = (char*)P.out; const bf16_t* QR = (const bf16_t*)(ws + WS_QR); const bf16_t* KVR = (const bf16_t*)(ws + WS_KVR); const bf16_t* KR = (const bf16_t*)(ws + WS_KR);
    bf16_t* QM = (bf16_t*)(ws + WS_QM); bf16_t* KM = (bf16_t*)(dob + DO_KM); bf16_t* VM = (bf16_t*)(dob + DO_VM); const float* R1 = (const float*)(ws + WS_ROPE1);
    const int gw = F.bid * NWAVES + F.wave, NGW = F.G * NWAVES, lane = F.lane; const int h = lane >> 3, sub = lane & 7; const bool rl = sub < 4; const int rs8 = 8 * (sub & 3), ti = rs8 & 15;
    float qn0[8], qn1[8], kn0[8], kn1[8];
#pragma unroll
    for (int e = 0; e < 8; ++e) { qn0[e] = PIN(37)[8 * sub + e] * QSCALE1; qn1[e] = PIN(37)[64 + rs8 + e] * QSCALE1; kn0[e] = PIN(38)[8 * sub + e]; kn1[e] = PIN(38)[64 + rs8 + e]; }
#define MP2_UNPK(raw, x) _Pragma("unroll") for (int e_ = 0; e_ < 4; ++e_) { x[2 * e_] = __uint_as_float(raw[e_] << 16); x[2 * e_ + 1] = __uint_as_float(raw[e_] & 0xffff0000u); }
#define MP2_PK(y) (v4u){pk2(y[0], y[1]), pk2(y[2], y[3]), pk2(y[4], y[5]), pk2(y[6], y[7])}
    for (int r = gw; r < MROWS; r += NGW) { const int s = r % RPB; const bool lat = s >= CTX;
        const v4u kraw = *(const v4u*)(KVR + (size_t)r * 1024 + h * 128 + 8 * sub), vraw = *(const v4u*)(KVR + (size_t)r * 1024 + h * 128 + 64 + 8 * sub);
        const v4u rraw = *(const v4u*)(KR + (size_t)r * 32 + rs8);
        v4u qraw = {0u, 0u, 0u, 0u}, qrr = {0u, 0u, 0u, 0u}; f32x4 cs[2], sn[2];
        if (lat) { qraw = *(const v4u*)(QR + (size_t)r * 768 + h * 96 + 8 * sub); qrr = *(const v4u*)(QR + (size_t)r * 768 + h * 96 + 64 + rs8);
            const float* rp = R1 + (size_t)(s - CTX) * 32 + ti; cs[0] = *(const f32x4*)rp; cs[1] = *(const f32x4*)(rp + 4); sn[0] = *(const f32x4*)(rp + 16); sn[1] = *(const f32x4*)(rp + 20); }
        *(v4u*)(VM + (size_t)r * 512 + h * 64 + 8 * sub) = vraw;
#pragma unroll
        for (int which = 0; which < 2; ++which) {
            if (which == 1 && !lat) break;
            float a[8], bq[8]; { const v4u ra = which == 0 ? kraw : qraw, rb = which == 0 ? rraw : qrr; MP2_UNPK(ra, a) MP2_UNPK(rb, bq) }
            float ss = 0.f;
#pragma unroll
            for (int e = 0; e < 8; ++e) ss += a[e] * a[e] + (rl ? bq[e] * bq[e] : 0.f);
            ss += __shfl_xor(ss, 1); ss += __shfl_xor(ss, 2); ss += __shfl_xor(ss, 4);
            const float rsd = rsqrtf(ss * (1.f / 96.f) + EPS);
#pragma unroll
            for (int e = 0; e < 8; ++e) { a[e] = a[e] * rsd * (which == 0 ? kn0[e] : qn0[e]); bq[e] = bq[e] * rsd * (which == 0 ? kn1[e] : qn1[e]); }
            if (lat) {
#pragma unroll
                for (int e = 0; e < 8; ++e) { const float other = __shfl_xor(bq[e], 2); const float c = cs[e >> 2][e & 3], sv = sn[e >> 2][e & 3]; bq[e] = (sub & 2) ? (other * sv + bq[e] * c) : (bq[e] * c - other * sv); } }
            bf16_t* o = (which == 0 ? KM : QM) + (size_t)r * 768 + h * 96;
            *(v4u*)(o + 8 * sub) = MP2_PK(a); if (rl) *(v4u*)(o + 64 + rs8) = MP2_PK(bq); }
    }
#undef MP2_UNPK
#undef MP2_PK
}
}
__global__ void __launch_bounds__(NTHREADS, 2) mk_kernel(Params prm) {
    extern __shared__ __attribute__((aligned(16))) unsigned char lds_raw[];
    Frame F; F.lds = (LAS unsigned char*)lds_raw; F.tid = threadIdx.x; F.lane = F.tid & 63; F.wave = __builtin_amdgcn_readfirstlane(F.tid >> 6);
    F.G = gridDim.x; F.bid = blockIdx.x; F.even = 0; F.ws = prm.ws;
    const Params& P = prm;
    const float* MOD0 = (const float*)(prm.ws + WS_MOD);
    const int lo = prm.ph_lo, hi = prm.ph_hi;
    volatile LAS unsigned* MISCW = (volatile LAS unsigned*)(F.lds + MISC_OFF + 8192);
    if (F.tid < 64) MISCW[F.tid] = 0u;
    __syncthreads();
    if (prm.ph_lo == 123456) cooperative_groups::this_grid().sync();
    XcdBarrier bar = xcd_barrier_post((unsigned*)(prm.ws + WS_CTL + CT_BAR), MISCW + 8);
#define RUN(k, body) if (lo <= (k) && (k) < hi) { body; if ((k) + 1 < hi) xcd_barrier(bar); }
#define RUN_GEMMS(PH0, NPH, G0) { _Pragma("unroll 1") for (int i_ = 0; i_ < (NPH); ++i_) { const int k_ = (PH0) + i_; if (lo <= k_ && k_ < hi) { run_gemm(F, prm, (G0) + i_); if (k_ + 1 < hi) xcd_barrier(bar); } } }
    RUN(PH_P0, { el::rope_tables(F); el::mod_phase(F, prm); phase_conv(F, prm, false); hy::filt(F, prm); moe_conv_all(F, prm); })
    if (MISCW[8 + 3] != 0u) { F.bid = __builtin_amdgcn_readfirstlane((int)(MISCW[8 + 2] * 8u + bar.x)); F.even = 1; }
    RUN(PH_NORM0, { el::norm_phase<0>(F, prm, PIN(6), MOD0, 0, 1); el::bias_phase(F, prm); })
    RUN(PH_G_IN0, run_gemm(F, prm, G_IN0))
    RUN(PH_LRUPREP, { lru::phase<0>(F, prm); el::gqa_prep(F, prm); })
    RUN(PH_MIX0, { phase_attn0(F); lru::phase<1>(F, prm); })
    RUN(PH_G_OUT0, { run_gemm(F, prm, G_OUT0); run_gemm(F, prm, G_F1); run_gemm(F, prm, G_F2); })
    RUN(PH_G_IN1, run_gemm(F, prm, G_IN1))
    RUN(PH_PREP1, { hy::prep(F, prm); el::mla_prep1(F, prm); })
    RUN(PH_G_QKVB, { run_gemm(F, prm, G_QB); run_gemm(F, prm, G_KVB); })
    RUN(PH_PREP2, { el::mla_prep2(F, prm); hy::main_phase(F, prm); })
    RUN(PH_MIX1, { phase_attn1(F, prm); hy::untranspose(F); })
    RUN(PH_G_OUT1, run_gemm(F, prm, G_OUT1))
    RUN(PH_ROUTE, phase_route(F, prm))
    RUN(PH_SLOT, phase_slot(F, prm))
    RUN(PH_MOE1, { run_gemm(F, prm, G_MOE1); run_gemm(F, prm, G_MOE2); })
    RUN(PH_COMBINE, phase_combine(F, prm))
#undef RUN
#undef RUN_GEMMS
}
#ifndef SPLIT_LAUNCH
#define SPLIT_LAUNCH 0
#endif
extern "C" void kernel_launch(void* const* d_in, const int* in_sizes, int n_in, void* d_out, int out_size, void* d_ws, size_t ws_size, hipStream_t st) {
    static int grid = 0;
    if (grid == 0) {
        if (n_in != 43 || out_size != NLAT * DM || ws_size < WS_END) { fprintf(stderr, "kernel_launch: unexpected problem (n_in %d, out %d, ws %zu < %zu)\n", n_in, out_size, ws_size, (size_t)WS_END); grid = -1; return; }
        int dev = 0, cus = 0, per_cu = 0;
        (void)hipGetDevice(&dev); (void)hipDeviceGetAttribute(&cus, hipDeviceAttributeMultiprocessorCount, dev);
        (void)hipFuncSetAttribute((const void*)mk_kernel, hipFuncAttributeMaxDynamicSharedMemorySize, LDS_BYTES);
        (void)hipOccupancyMaxActiveBlocksPerMultiprocessor(&per_cu, (const void*)mk_kernel, NTHREADS, LDS_BYTES);
        grid = cus;
        if (grid != 256 || per_cu < 1) { fprintf(stderr, "kernel_launch: grid %d (CUs %d, occupancy query %d): this kernel is written for 256 resident workgroups; nothing launched\n", grid, cus, per_cu); grid = -1; return; }
    }
    if (grid < 0) return;
    (void)hipMemsetAsync((char*)d_ws + WS_CTL, 0, CTL_BYTES, st);
    Params prm{}; prm.i0 = (const float*)d_in[0]; prm.i1 = (const float*)d_in[1]; prm.i2 = (const float*)d_in[2]; prm.i3 = (const float*)d_in[3]; prm.i4 = (const float*)d_in[4]; prm.i5 = (const float*)d_in[5]; prm.i6 = (const float*)d_in[6]; prm.i7 = (const float*)d_in[7]; prm.i8 = (const float*)d_in[8]; prm.i9 = (const float*)d_in[9]; prm.i10 = (const float*)d_in[10]; prm.i11 = (const float*)d_in[11]; prm.i12 = (const float*)d_in[12]; prm.i13 = (const float*)d_in[13]; prm.i14 = (const float*)d_in[14]; prm.i15 = (const float*)d_in[15]; prm.i16 = (const float*)d_in[16]; prm.i17 = (const float*)d_in[17]; prm.i18 = (const float*)d_in[18]; prm.i19 = (const float*)d_in[19]; prm.i20 = (const float*)d_in[20]; prm.i21 = (const float*)d_in[21]; prm.i22 = (const float*)d_in[22]; prm.i23 = (const float*)d_in[23]; prm.i24 = (const float*)d_in[24]; prm.i25 = (const float*)d_in[25]; prm.i26 = (const float*)d_in[26]; prm.i27 = (const float*)d_in[27]; prm.i28 = (const float*)d_in[28]; prm.i29 = (const float*)d_in[29]; prm.i30 = (const float*)d_in[30]; prm.i31 = (const float*)d_in[31]; prm.i32 = (const float*)d_in[32]; prm.i33 = (const float*)d_in[33]; prm.i34 = (const float*)d_in[34]; prm.i35 = (const float*)d_in[35]; prm.i36 = (const float*)d_in[36]; prm.i37 = (const float*)d_in[37]; prm.i38 = (const float*)d_in[38]; prm.i39 = (const float*)d_in[39]; prm.i40 = (const float*)d_in[40]; prm.i41 = (const float*)d_in[41]; prm.i42 = (const float*)d_in[42]; prm.out = (float*)d_out; prm.ws = (char*)d_ws;
#if SPLIT_LAUNCH
    for (int ph = 0; ph < PH_COUNT; ++ph) { prm.ph_lo = ph; prm.ph_hi = ph + 1; hipLaunchKernelGGL(mk_kernel, dim3(grid), dim3(NTHREADS), LDS_BYTES, st, prm); }
#else
    prm.ph_lo = 0; prm.ph_hi = PH_COUNT;
    void* args[] = {&prm};
    hipError_t e = hipLaunchCooperativeKernel((const void*)mk_kernel, dim3(grid), dim3(NTHREADS), args, LDS_BYTES, st);
    if (e != hipSuccess) fprintf(stderr, "kernel_launch: cooperative launch failed: %s (grid %d)\n", hipGetErrorString(e), grid);
#endif
}
```

```cpp
#include <hip/hip_runtime.h>
#include <hip/hip_cooperative_groups.h>
#include <cstdio>
#include <cstdint>
#include <cmath>

constexpr int NB = 8, SEQ = 2048, CTX = 256, RPB = SEQ + CTX, MROWS = NB * RPB, DM = 1024, NLAT = NB * SEQ;
constexpr int NMOD = 6, MODLD = NMOD * DM;
constexpr int AB_IN = 1792, CD_IN = 1952, CD_LD = 2048, DFF = 2816, NEXP = 8, DFE = 3584;
constexpr float EPS = 1e-6f;
constexpr float LOG2E = 1.4426950408889634f;
constexpr float QSCALE0 = 0.125f * LOG2E;
constexpr float QSCALE1 = 0.10206207261596577f * LOG2E;

typedef unsigned short bf16_t;
typedef float f32x4 __attribute__((ext_vector_type(4)));
typedef unsigned u32x4 __attribute__((ext_vector_type(4)));
typedef unsigned u32x2 __attribute__((ext_vector_type(2)));

__device__ __forceinline__ int mod_row(int r) { int b = r / RPB, s = r % RPB; return s < CTX ? 8 : b; }
__device__ __forceinline__ int latent_row(int m) { return (m / SEQ) * RPB + CTX + (m % SEQ); }

__device__ __forceinline__ float bf2f(bf16_t v) { return __uint_as_float((unsigned)v << 16); }
typedef float hd_f32x2 __attribute__((ext_vector_type(2))); typedef __bf16 hd_bf16x2 __attribute__((ext_vector_type(2)));
__device__ __forceinline__ unsigned pk2(float lo, float hi) { hd_f32x2 v = {lo, hi}; hd_bf16x2 b = __builtin_convertvector(v, hd_bf16x2); return __builtin_bit_cast(unsigned, b); }
__device__ __forceinline__ bf16_t f2bf(float f) { return (bf16_t)(pk2(f, 0.f) & 0xffffu); }
__device__ __forceinline__ float ldf(const float* p) { return *p; }
__device__ __forceinline__ float ldf(const bf16_t* p) { return bf2f(*p); }
__device__ __forceinline__ void stf(float* p, float v) { *p = v; }
__device__ __forceinline__ void stf(bf16_t* p, float v) { *p = f2bf(v); }

__device__ __forceinline__ float silu_f(float x) { return x / (1.f + expf(-x)); }
__device__ __forceinline__ float sigmoid_f(float x) { return 1.f / (1.f + expf(-x)); }
__device__ __forceinline__ float gelu_tanh(float x) { return 0.5f * x * (1.f + tanhf(0.7978845608028654f * (x + 0.044715f * x * x * x))); }
__device__ __forceinline__ float softplus_f(float x) { return fmaxf(x, 0.f) + log1pf(expf(-fabsf(x))); }

__device__ __forceinline__ float wave_sum(float v) {
#pragma unroll
    for (int o = 1; o < 64; o <<= 1) v += __shfl_xor(v, o);
    return v;
}
__device__ __forceinline__ float wave_max(float v) {
#pragma unroll
    for (int o = 1; o < 64; o <<= 1) v = fmaxf(v, __shfl_xor(v, o));
    return v;
}

constexpr size_t MiB = 1ull << 20;
constexpr size_t WS_CTL = 0, CTL_BYTES = 256 * 1024;
constexpr size_t WS_MOD = 1 * MiB;
constexpr size_t WS_SC = WS_MOD + 512 * 1024;
constexpr size_t WS_W13M = 4 * MiB;
constexpr size_t WS_W2M = 116 * MiB;
constexpr size_t WS_WIN0 = 172 * MiB;
constexpr size_t WS_WOUT0 = WS_WIN0 + (size_t)1792 * 1024 * 2;
constexpr size_t WS_WF13 = WS_WOUT0 + (size_t)1024 * 1024 * 2;
constexpr size_t WS_WF2 = WS_WF13 + (size_t)5632 * 1024 * 2;
constexpr size_t WS_WIN1 = WS_WF2 + (size_t)1024 * 2816 * 2;
constexpr size_t WS_WOUT1 = WS_WIN1 + (size_t)2048 * 1024 * 2;
constexpr size_t WS_WQB = WS_WOUT1 + (size_t)1024 * 1024 * 2;
constexpr size_t WS_WKVB = WS_WQB + (size_t)768 * 256 * 2;
constexpr size_t WS_WLRU = WS_WKVB + (size_t)1024 * 256 * 2;
constexpr size_t WS_WEND = WS_WLRU + (size_t)2 * 8 * 2 * 64 * 64 * 2;
static_assert(WS_WEND <= 202 * MiB, "weights region");
constexpr size_t WS_X = 202 * MiB;
constexpr size_t WS_H = 274 * MiB;
constexpr size_t WS_Z = 310 * MiB;
constexpr size_t WS_Y = 382 * MiB;
constexpr size_t WS_ACT = WS_Z;
constexpr size_t WS_R2 = 418 * MiB;
constexpr size_t WS_END = 502 * MiB;
static_assert(WS_ACT + (size_t)MROWS * DFF * 2 <= WS_R2, "ACT overlay");
constexpr size_t WS_QB = WS_R2;
constexpr size_t WS_KB = WS_QB + (size_t)MROWS * 512 * 2;
constexpr size_t WS_VB = WS_KB + (size_t)MROWS * 128 * 2;
constexpr size_t WS_AGG = WS_VB + (size_t)MROWS * 128 * 2;
constexpr size_t WS_R2L0END = WS_AGG + (size_t)2 * 8 * 72 * 2 * 512 * 4;
constexpr size_t WS_ZT = WS_R2;
constexpr size_t WS_HT = WS_ZT + (size_t)1536 * NLAT * 2;
constexpr size_t WS_GT = WS_HT + (size_t)512 * NLAT * 2;
constexpr int GT_LD = 4224;
constexpr size_t WS_R2L1END = WS_GT + (size_t)2 * 512 * GT_LD * 2;
static_assert(WS_R2L0END <= WS_END && WS_R2L1END <= WS_END, "R2");
constexpr size_t WS_QA = WS_Y;
constexpr size_t WS_KVA = WS_QA + (size_t)MROWS * 256 * 2;
constexpr size_t WS_KR = WS_KVA + (size_t)MROWS * 256 * 2;
constexpr size_t WS_QR = WS_Z;
constexpr size_t WS_KVR = WS_QR + (size_t)MROWS * 768 * 2;
static_assert(WS_KVR + (size_t)MROWS * 1024 * 2 <= WS_Y && WS_KR + (size_t)MROWS * 32 * 2 <= WS_R2, "layer-1 overlays");
constexpr size_t WS_QM = WS_H;
static_assert((size_t)MROWS * 768 * 2 <= 36 * MiB, "QM in H");
constexpr size_t DO_KM = 0;
constexpr size_t DO_VM = (size_t)MROWS * 768 * 2;
static_assert(DO_VM + (size_t)MROWS * 512 * 2 <= (size_t)NLAT * DM * 4, "d_out scratch");
constexpr int MAXSLOT = 34816;
constexpr size_t WS_XG = WS_WIN0;
constexpr size_t WS_ACT2 = WS_XG + (size_t)MAXSLOT * 1024 * 2;
constexpr size_t WS_H2 = WS_ACT2 + (size_t)MAXSLOT * 3584 * 2 - (size_t)NLAT * 1024 * 2;
static_assert(WS_ACT2 + (size_t)MAXSLOT * 3584 * 2 <= WS_END, "MoE overlay");
constexpr size_t CT_BAR = 0;
constexpr size_t CT_PCNT = 16 * 1024;
constexpr size_t CT_MCNT = 48 * 1024;
constexpr size_t CT_HIST = 32 * 1024;
constexpr size_t CT_CNT = 48 * 1024;
constexpr size_t CT_CURSOR = 80 * 1024;
constexpr size_t CT_DONE = 80 * 1024 + 256;
constexpr size_t CT_SSQA = 96 * 1024;
constexpr size_t CT_SSQB = CT_SSQA + (size_t)MROWS * 4;
static_assert(CT_SSQB + (size_t)MROWS * 4 <= CTL_BYTES, "ssq in the zeroed control region");
constexpr size_t WS_SLOTTOK = 2 * MiB;
constexpr size_t WS_SLOTGATE = WS_SLOTTOK + (size_t)MAXSLOT * 4;
constexpr size_t WS_SEL = WS_SLOTGATE + (size_t)MAXSLOT * 4;
constexpr size_t WS_TOKSLOT = WS_SEL + (size_t)NLAT * 16;
static_assert(WS_TOKSLOT + (size_t)NLAT * 8 <= WS_W13M, "small tables");
constexpr size_t WS_ROPE0 = 3 * MiB;
constexpr size_t WS_ROPE1 = 3 * MiB + 512 * 1024;
static_assert(WS_TOKSLOT + (size_t)NLAT * 8 <= WS_ROPE0 && WS_ROPE1 + 256 * 1024 <= WS_W13M, "rope tables");
constexpr size_t WS_CBF1 = WS_SC + 64 * 1024;
constexpr size_t WS_CBIN1 = WS_CBF1 + 9 * 5632 * 4;
static_assert(WS_CBIN1 + 9 * 2048 * 4 <= WS_SLOTTOK, "bias vectors");
constexpr size_t WS_Y2 = WS_XG;
namespace pg8 {
#define PG8_LAS __attribute__((address_space(3)))
typedef unsigned short bf16_t;
typedef short bf16x8 __attribute__((ext_vector_type(8)));
typedef float f32x4 __attribute__((ext_vector_type(4)));
typedef unsigned u32x4 __attribute__((ext_vector_type(4)));
constexpr int BM = 256, BK = 64, HALF = 128, HTB = HALF * BK * 2  , STAGE_BYTES = 8 * HTB, NXCD = 8, WGM = 8;

__host__ __device__ __forceinline__ int lds_byte(int r, int c) { const int st = (r >> 4) * 2 + (c >> 5), rr = r & 15, cc = c & 31, ob = rr * 64 + cc * 2; return st * 1024 + (ob ^ (((ob >> 9) & 1) << 5)); }
__host__ __device__ __forceinline__ void stage_rc(int b, int& R, int& C) { const int st = b / 1024, sb = b % 1024, swz = sb ^ (((sb >> 9) & 1) << 5); R = (st >> 1) * 16 + swz / 64; C = (st & 1) * 32 + (swz % 64) / 2; }
__host__ __device__ __forceinline__ int perm32(int rho) { const int n = rho >> 4, i = rho & 15; return 8 * (i >> 2) + 4 * n + (i & 3); }

struct Unit { int pm, pn; };
struct Gemm { const bf16_t* A; const bf16_t* Bt; int M, N, K; };

struct StaticOrder {
    int nM, nN, nwg, G, c;
    __host__ __device__ void init(int M, int N, int G_, int c_) { nM = M / BM; nN = N / BM; nwg = nM * nN; G = G_; c = c_; }
    __host__ __device__ bool next(int i, Unit& u) const {
        const long L = (long)i * G + c; if (L >= nwg) return false;
        int wgid = (int)L; { const int q = nwg / NXCD, r = nwg % NXCD, xcd = wgid % NXCD, off = wgid / NXCD; wgid = (xcd < r ? xcd * (q + 1) : r * (q + 1) + (xcd - r) * q) + off; }
        const int nig = WGM * nN, gid = wgid / nig, fm = gid * WGM, gsz = (nM - fm) < WGM ? (nM - fm) : WGM;
        u.pm = fm + ((wgid % nig) % gsz); u.pn = (wgid % nig) / gsz; return true;
    }
    __device__ __forceinline__ void a_ready(const Unit&) const {}
    __device__ __forceinline__ void done(const Unit&) const {}
};

__device__ __forceinline__ unsigned cvt_pk_bf16(float lo, float hi) { unsigned r; asm volatile("v_cvt_pk_bf16_f32 %0, %1, %2" : "=v"(r) : "v"(lo), "v"(hi)); return r; }
typedef float f32x2 __attribute__((ext_vector_type(2)));
__device__ __forceinline__ f32x2 gelu_pk(f32x2 v) {
    const f32x2 av = __builtin_elementwise_abs(v), d = av * 0.2316418882f + 1.0f;
    f32x2 t; t.x = __builtin_amdgcn_rcpf(d.x); t.y = __builtin_amdgcn_rcpf(d.y);
    f32x2 q = t * 0.5307027145f + (-0.7265760135f); q = q * t + 0.7107068705f; q = q * t + (-0.142248368f); q = q * t + 0.127414796f; q = q * t;
    const f32x2 s = (v * v) * (-0.72134752044f);
    f32x2 e; e.x = __builtin_amdgcn_exp2f(s.x); e.y = __builtin_amdgcn_exp2f(s.y);
    const f32x2 m = v * (q * e), r = v - m;
    f32x2 o; o.x = v.x < 0.f ? m.x : r.x; o.y = v.y < 0.f ? m.y : r.y; return o;
}

template <int ACT  > struct EpiBf16 {
    static constexpr bool PERM = true, AFTER_DRAIN = false; static_assert(ACT == 0 || ACT == 1, "EpiBf16: ACT is 0 (none) or 1 (gelu_pk)");
    bf16_t* O; int ldc; const float* bias; int split_cols; size_t split_stride; float scale0;
    __device__ __forceinline__ void operator()(const f32x4 (&acc)[2][2][4][2], const Unit& u, int wr, int wc, int fr, int fq) const {
        const int row0 = u.pm * BM + wr * 64 + fr; int colt = u.pn * BM; bf16_t* base = O;
        float sc = 1.f; if (split_cols) { const int t = colt / split_cols; base += (size_t)t * split_stride; colt -= t * split_cols; if (t == 0) sc = scale0; }
        const int col0 = colt + wc * 32 + 8 * fq, bcol0 = u.pn * BM + wc * 32 + 8 * fq;
        f32x4 bv[2][2];
#pragma unroll
        for (int bj = 0; bj < 2; ++bj)
#pragma unroll
            for (int n = 0; n < 2; ++n) bv[bj][n] = bias ? *(const f32x4*)(bias + bcol0 + bj * HALF + 4 * n) : (f32x4){0.f, 0.f, 0.f, 0.f};
#pragma unroll
        for (int ai = 0; ai < 2; ++ai)
#pragma unroll
            for (int m = 0; m < 4; ++m) { bf16_t* rowp = base + (size_t)(row0 + ai * HALF + m * 16) * ldc + col0;
#pragma unroll
                for (int bj = 0; bj < 2; ++bj) { f32x4 v0 = acc[ai][bj][m][0] + bv[bj][0], v1 = acc[ai][bj][m][1] + bv[bj][1];
                    if (ACT == 1) { f32x2 a = gelu_pk((f32x2){v0[0], v0[1]}), b = gelu_pk((f32x2){v0[2], v0[3]}), c = gelu_pk((f32x2){v1[0], v1[1]}), d = gelu_pk((f32x2){v1[2], v1[3]});
                        v0 = (f32x4){a.x, a.y, b.x, b.y}; v1 = (f32x4){c.x, c.y, d.x, d.y}; }
                    v0 = v0 * sc; v1 = v1 * sc; u32x4 w; w.x = cvt_pk_bf16(v0[0], v0[1]); w.y = cvt_pk_bf16(v0[2], v0[3]); w.z = cvt_pk_bf16(v1[0], v1[1]); w.w = cvt_pk_bf16(v1[2], v1[3]);
                    *(u32x4*)(rowp + bj * HALF) = w; } }
    }
};

template <class Epi, class Sched, bool ALIGN_EPI = false, bool SP2 = false>
__device__ __forceinline__ void gemm_phase(PG8_LAS unsigned char* lds, const Gemm g, const Sched& S, const Epi& E) {
    int tid_ = threadIdx.x; asm volatile("" : "+v"(tid_));
    const int tid = tid_, wid = __builtin_amdgcn_readfirstlane(tid >> 6), lane = tid & 63, wr = wid >> 2, wc = wid & 3, fr = lane & 15, fq = lane >> 4;
    const int K = g.K, nt = K / BK;
    unsigned voffA[2], voffB[2];
#pragma unroll
    for (int i = 0; i < 2; ++i) { int R, C; stage_rc(tid * 16 + i * 8192, R, C); const int Rb = Epi::PERM ? ((R & ~31) + perm32(R & 31)) : R;
        voffA[i] = (unsigned)(R * K + C) * 2u; voffB[i] = (unsigned)(Rb * K + C) * 2u; }
    const size_t kstep = (size_t)(BK * 2);
    const size_t hstep = (size_t)HALF * K * 2;
    const size_t tstep = 2 * hstep;
    const unsigned ldsw = (unsigned)wid * 1024u;
    const int aoff = lds_byte(wr * 64 + fr, fq * 8), boff = lds_byte(wc * 32 + fr, fq * 8);
#define PG8_SA(b, h) (((b) * 2 + (h)) * HTB)
#define PG8_SB(b, h) ((4 + (b) * 2 + (h)) * HTB)
#define PG8_STAGE(bufoff, gbase, voff) do { _Pragma("unroll") for (int _i = 0; _i < 2; ++_i) \
        __builtin_amdgcn_global_load_lds((const unsigned*)((const char*)(gbase) + (voff)[_i]), (PG8_LAS unsigned*)(lds + (bufoff) + ldsw + _i * 8192), 16, 0, 0); } while (0)
#define PG8_LDA(dst, b, h) do { _Pragma("unroll") for (int m = 0; m < 4; ++m) _Pragma("unroll") for (int k = 0; k < 2; ++k) dst[m][k] = *(const PG8_LAS bf16x8*)(lds + PG8_SA(b, h) + aoff + m * 2048 + k * 1024); } while (0)
#define PG8_LDB(dst, b, h) do { _Pragma("unroll") for (int n = 0; n < 2; ++n) _Pragma("unroll") for (int k = 0; k < 2; ++k) dst[n][k] = *(const PG8_LAS bf16x8*)(lds + PG8_SB(b, h) + boff + n * 2048 + k * 1024); } while (0)
#define PG8_MMA(ai, bj, At, Bt) do { __builtin_amdgcn_s_setprio(1); _Pragma("unroll") for (int m = 0; m < 4; ++m) _Pragma("unroll") for (int n = 0; n < 2; ++n) _Pragma("unroll") for (int k = 0; k < 2; ++k) \
        acc[ai][bj][m][n] = __builtin_amdgcn_mfma_f32_16x16x32_bf16(Bt[n][k], At[m][k], acc[ai][bj][m][n], 0, 0, 0); __builtin_amdgcn_s_setprio(0); } while (0)
#define PG8_WAIT_V(n) asm volatile("s_waitcnt vmcnt(" #n ")" ::: "memory")
#define PG8_WAIT_L(n) asm volatile("s_waitcnt lgkmcnt(" #n ")" ::: "memory")
#define PG8_BAR __builtin_amdgcn_s_barrier()
#define PG8_SCHED __builtin_amdgcn_sched_barrier(0)
    Unit cur, nxt; int ui = 0;
    if (!S.next(0, cur)) return;
    f32x4 acc[2][2][4][2];
#pragma unroll
    for (int a = 0; a < 2; ++a)
#pragma unroll
        for (int b = 0; b < 2; ++b)
#pragma unroll
            for (int m = 0; m < 4; ++m)
#pragma unroll
                for (int n = 0; n < 2; ++n) acc[a][b][m][n] = (f32x4){0.f, 0.f, 0.f, 0.f};
    bf16x8 At[4][2], B0[2][2], B1[2][2];
    const char* cA = (const char*)g.A + (size_t)cur.pm * tstep; const char* cB = (const char*)g.Bt + (size_t)cur.pn * tstep;
    S.a_ready(cur);
    if constexpr (SP2) {
        PG8_STAGE(PG8_SB(0, 0), cB, voffB); PG8_STAGE(PG8_SB(0, 1), cB + hstep, voffB); PG8_STAGE(PG8_SA(0, 0), cA, voffA); PG8_STAGE(PG8_SA(0, 1), cA + hstep, voffA);
        if (wr == 1) PG8_BAR;
        PG8_WAIT_V(2); PG8_BAR;
        PG8_STAGE(PG8_SB(1, 0), cB + kstep, voffB); PG8_STAGE(PG8_SA(1, 0), cA + kstep, voffA); PG8_STAGE(PG8_SB(1, 1), cB + hstep + kstep, voffB);
        PG8_WAIT_V(6); PG8_BAR;
    } else {
        PG8_STAGE(PG8_SB(0, 0), cB, voffB); PG8_STAGE(PG8_SA(0, 0), cA, voffA); PG8_STAGE(PG8_SB(0, 1), cB + hstep, voffB); PG8_STAGE(PG8_SA(0, 1), cA + hstep, voffA);
        if (wr == 1) PG8_BAR;
        PG8_WAIT_V(4); PG8_BAR;
        PG8_STAGE(PG8_SB(1, 0), cB + kstep, voffB); PG8_STAGE(PG8_SA(1, 0), cA + kstep, voffA); PG8_STAGE(PG8_SB(1, 1), cB + hstep + kstep, voffB);
        PG8_WAIT_V(6); PG8_BAR;
    }
    for (;;) {
        const bool has_next = S.next(ui + 1, nxt);
        const char* nA = has_next ? (const char*)g.A + (size_t)nxt.pm * tstep : cA; const char* nB = has_next ? (const char*)g.Bt + (size_t)nxt.pn * tstep : cB;
        for (int t = 0; t < nt; t += 2) {
            const bool last = (t == nt - 2);
            const char* a1 = cA + (size_t)(t + 1) * kstep;
            const char* a2 = last ? nA : cA + (size_t)(t + 2) * kstep; const char* b2 = last ? nB : cB + (size_t)(t + 2) * kstep;
            const char* a3 = a2 + kstep; const char* b3 = b2 + kstep;
            if (last && has_next) S.a_ready(nxt);
            if constexpr (SP2) {
            PG8_LDB(B0, 0, 0); PG8_LDB(B1, 0, 1); PG8_SCHED; PG8_LDA(At, 0, 0); PG8_STAGE(PG8_SA(1, 1), a1 + hstep, voffA);
            PG8_WAIT_V(8); PG8_WAIT_L(0); PG8_BAR; PG8_MMA(0, 0, At, B0); PG8_MMA(0, 1, At, B1); PG8_BAR; PG8_SCHED;
            PG8_LDA(At, 0, 1); PG8_STAGE(PG8_SB(0, 0), b2, voffB); PG8_STAGE(PG8_SB(0, 1), b2 + hstep, voffB); PG8_STAGE(PG8_SA(0, 0), a2, voffA);
            PG8_WAIT_V(8); PG8_WAIT_L(0); PG8_BAR; PG8_MMA(1, 0, At, B0); PG8_MMA(1, 1, At, B1); PG8_BAR; PG8_SCHED;
            PG8_LDB(B0, 1, 0); PG8_LDB(B1, 1, 1); PG8_SCHED; PG8_LDA(At, 1, 0); PG8_STAGE(PG8_SA(0, 1), a2 + hstep, voffA);
            PG8_WAIT_V(8); PG8_WAIT_L(0); PG8_BAR; PG8_MMA(0, 0, At, B0); PG8_MMA(0, 1, At, B1); PG8_BAR; PG8_SCHED;
            PG8_LDA(At, 1, 1); PG8_STAGE(PG8_SB(1, 0), b3, voffB); PG8_STAGE(PG8_SB(1, 1), b3 + hstep, voffB); PG8_STAGE(PG8_SA(1, 0), a3, voffA);
            PG8_WAIT_V(8); PG8_WAIT_L(0); PG8_BAR; PG8_MMA(1, 0, At, B0); PG8_MMA(1, 1, At, B1); PG8_BAR; PG8_SCHED;
            } else {
            PG8_LDB(B0, 0, 0); PG8_SCHED; PG8_LDA(At, 0, 0); PG8_STAGE(PG8_SA(1, 1), a1 + hstep, voffA);
            PG8_WAIT_L(8); PG8_BAR; PG8_WAIT_L(0); PG8_MMA(0, 0, At, B0); PG8_BAR; PG8_SCHED;
            PG8_LDB(B1, 0, 1); PG8_STAGE(PG8_SB(0, 0), b2, voffB);
            PG8_BAR; PG8_WAIT_L(0); PG8_MMA(0, 1, At, B1); PG8_BAR;
            PG8_LDA(At, 0, 1); PG8_STAGE(PG8_SA(0, 0), a2, voffA);
            PG8_BAR; PG8_WAIT_L(0); PG8_MMA(1, 0, At, B0); PG8_BAR; PG8_SCHED;
            PG8_STAGE(PG8_SB(0, 1), b2 + hstep, voffB);
            PG8_WAIT_V(6); PG8_BAR; PG8_MMA(1, 1, At, B1); PG8_BAR;
            PG8_LDB(B0, 1, 0); PG8_SCHED; PG8_LDA(At, 1, 0); PG8_STAGE(PG8_SA(0, 1), a2 + hstep, voffA);
            PG8_WAIT_L(8); PG8_BAR; PG8_WAIT_L(0); PG8_MMA(0, 0, At, B0); PG8_BAR; PG8_SCHED;
            PG8_LDB(B1, 1, 1); PG8_STAGE(PG8_SB(1, 0), b3, voffB);
            PG8_BAR; PG8_WAIT_L(0); PG8_MMA(0, 1, At, B1); PG8_BAR;
            PG8_LDA(At, 1, 1); PG8_STAGE(PG8_SA(1, 0), a3, voffA);
            PG8_BAR; PG8_WAIT_L(0); PG8_MMA(1, 0, At, B0); PG8_BAR; PG8_SCHED;
            PG8_STAGE(PG8_SB(1, 1), b3 + hstep, voffB);
            PG8_WAIT_V(6); PG8_BAR; PG8_MMA(1, 1, At, B1); PG8_BAR;
            }
        }
        if constexpr (ALIGN_EPI) { if (wr == 0) PG8_BAR; }
        if constexpr (!Epi::AFTER_DRAIN) { E(acc, cur, wr, wc, fr, fq); S.done(cur); }
        if (!has_next) break;
#pragma unroll
        for (int a = 0; a < 2; ++a)
#pragma unroll
            for (int b = 0; b < 2; ++b)
#pragma unroll
                for (int m = 0; m < 4; ++m)
#pragma unroll
                    for (int n = 0; n < 2; ++n) acc[a][b][m][n] = (f32x4){0.f, 0.f, 0.f, 0.f};
        cur = nxt; cA = nA; cB = nB; ++ui;
        if constexpr (ALIGN_EPI) { if (wr == 1) PG8_BAR; }
    }
    PG8_WAIT_V(0);
    if constexpr (!ALIGN_EPI) { if (wr == 0) PG8_BAR; }
    PG8_BAR;
    if constexpr (Epi::AFTER_DRAIN) { E.fused(acc, cur, wr, wc, fr, fq, lds, wid, lane); S.done(cur); }
#undef PG8_SA
#undef PG8_SB
#undef PG8_STAGE
#undef PG8_LDA
#undef PG8_LDB
#undef PG8_MMA
#undef PG8_WAIT_V
#undef PG8_WAIT_L
#undef PG8_BAR
#undef PG8_SCHED
}
}
namespace pg8 {
__device__ __forceinline__ float fast_silu(float v) { return v * __builtin_amdgcn_rcpf(1.f + __builtin_amdgcn_exp2f(-1.4426950408889634f * v)); }

struct DenseOrder {
    int nM, nN, nreg, nwg, G, c, mode, wgm;
    __device__ __forceinline__ void init(int nM_, int nN_, int G_, int c_, int mode_) { nM = nM_; nN = nN_; G = G_; c = c_; mode = mode_; nreg = nM * nN; nwg = nreg + (mode == 2 ? 8 : 0); wgm = WGM; }
    __device__ __forceinline__ bool next(int i, Unit& u) const {
        const long L = (long)i * G + c; if (L >= nwg) return false;
        if (mode == 2 && L >= nreg) { u.pm = 9 * (int)(L - nreg); u.pn = nN - 1; return true; }
        int wgid = (int)L; { const int q = nreg / NXCD, r = nreg % NXCD, xcd = wgid % NXCD, off = wgid / NXCD; wgid = (xcd < r ? xcd * (q + 1) : r * (q + 1) + (xcd - r) * q) + off; }
        const int nig = wgm * nN, gid = wgid / nig, fm = gid * wgm, gsz = (nM - fm) < wgm ? (nM - fm) : wgm;
        int pm = fm + ((wgid % nig) % gsz); u.pn = (wgid % nig) / gsz;
        if (mode != 0) pm = 9 * (pm >> 3) + 1 + (pm & 7);
        u.pm = pm; return true;
    }
    __device__ __forceinline__ void a_ready(const Unit&) const {}
    __device__ __forceinline__ void done(const Unit&) const {}
};
struct MoeOrder {
    const PG8_LAS int* tb; int nN, G, c;
    __device__ __forceinline__ bool next(int i, Unit& u) const {
        const int nwg = tb[8] * nN; long L = (long)i * G + c; if (L >= nwg) return false;
        { const int wg = (int)L, q = nwg / NXCD, r = nwg % NXCD, xcd = wg % NXCD, off = wg / NXCD; L = (xcd < r ? xcd * (q + 1) : r * (q + 1) + (xcd - r) * q) + off; }
        int e = 0;
#pragma unroll
        for (int k = 1; k < 8; ++k) if (L >= (long)tb[k] * nN) e = k;
        const int Le = (int)(L - (long)tb[e] * nN), mt = tb[e + 1] - tb[e];
        const int nig = WGM * nN, gid = Le / nig, fm = gid * WGM, gsz = (mt - fm) < WGM ? (mt - fm) : WGM;
        u.pm = tb[e] + fm + ((Le % nig) % gsz); u.pn = e * nN + (Le % nig) / gsz; return true;
    }
    __device__ __forceinline__ void a_ready(const Unit&) const {}
    __device__ __forceinline__ void done(const Unit&) const {}
};

template <bool SRCIN, bool FUSE> struct EpiResGate {
    static constexpr bool PERM = true, AFTER_DRAIN = false;
    const float* xin; float* xout; const float* modbase; int compact;
    const float* xsrc_lat; const float* xsrc_ctx; bf16_t* hraw; const float* gnext; const float* nscale; float* ssq;
    __device__ __forceinline__ void operator()(const f32x4 (&acc)[2][2][4][2], const Unit& u, int wr, int wc, int fr, int fq) const {
        const int b = u.pm / 9, pj = u.pm - 9 * b; const int mrow = (pj == 0) ? 8 : b;
        const float* g = modbase + (size_t)mrow * 6144;
        const int col0 = u.pn * BM + wc * 32 + 8 * fq;
        f32x4 gv[2][2];
#pragma unroll
        for (int bj = 0; bj < 2; ++bj)
#pragma unroll
            for (int n = 0; n < 2; ++n) gv[bj][n] = *(const f32x4*)(g + col0 + bj * HALF + n * 4);
        const int row0 = u.pm * BM + wr * 64 + fr; const int oshift = compact ? 256 * (b + 1) : 0;
        const float* xbase = SRCIN ? (pj == 0 ? xsrc_ctx + (size_t)b * 256 * 1024 : xsrc_lat + ((size_t)b * 2048 + (pj - 1) * 256) * 1024) - (size_t)u.pm * BM * 1024 : xin;
        const float* ns = nscale + (size_t)mrow * 6144;
#pragma unroll
        for (int am = 0; am < 4; ++am) { const int ai = am >> 1;
            f32x4 xv[2][2][2];
#pragma unroll
            for (int mm = 0; mm < 2; ++mm) { const int m = (am & 1) * 2 + mm; const float* xi = xbase + (size_t)(row0 + ai * HALF + m * 16) * 1024 + col0;
#pragma unroll
                for (int bj = 0; bj < 2; ++bj)
#pragma unroll
                    for (int n = 0; n < 2; ++n) xv[mm][bj][n] = *(const f32x4*)(xi + bj * HALF + n * 4); }
#pragma unroll
            for (int mm = 0; mm < 2; ++mm) { const int m = (am & 1) * 2 + mm; const int row = row0 + ai * HALF + m * 16; float* xo = xout + (size_t)(row - oshift) * 1024 + col0; float ss = 0.f;
#pragma unroll
                for (int bj = 0; bj < 2; ++bj)
#pragma unroll
                    for (int n = 0; n < 2; ++n) { const f32x4 v = xv[mm][bj][n] + gv[bj][n] * acc[ai][bj][m][n]; *(f32x4*)(xo + bj * HALF + n * 4) = v;
                        if (FUSE) { const int c = col0 + bj * HALF + n * 4; const f32x4 hv = v * (*(const f32x4*)(gnext + c) * (*(const f32x4*)(ns + c) + 1.f));
                            ss += (v[0] * v[0] + v[1] * v[1]) + (v[2] * v[2] + v[3] * v[3]);
                            u32x2 w; w.x = cvt_pk_bf16(hv[0], hv[1]); w.y = cvt_pk_bf16(hv[2], hv[3]); *(u32x2*)(hraw + (size_t)row * 1024 + c) = w; } }
                if (FUSE) { ss += __shfl_xor(ss, 16); ss += __shfl_xor(ss, 32); if (fq == 0) unsafeAtomicAdd(ssq + row, ss); } }
            asm volatile("" ::: "memory"); }
    }
};
struct EpiSwiGLU {
    static constexpr bool PERM = true, AFTER_DRAIN = false;
    bf16_t* O; int ldc; int npn; const float* ssq; const float* cbias; int cbld;
    __device__ __forceinline__ void operator()(const f32x4 (&acc)[2][2][4][2], const Unit& u, int wr, int wc, int fr, int fq) const {
        const int row0 = u.pm * BM + wr * 64 + fr; const int col0 = (u.pn % npn) * HALF + wc * 32 + 8 * fq;
        f32x4 cb[2][2];
        if (ssq) { const int b = u.pm / 9; const int mrow = (u.pm - 9 * b == 0) ? 8 : b; const float* cp = cbias + (size_t)mrow * cbld + u.pn * BM + wc * 32 + 8 * fq;
#pragma unroll
            for (int bj = 0; bj < 2; ++bj)
#pragma unroll
                for (int n = 0; n < 2; ++n) cb[bj][n] = *(const f32x4*)(cp + bj * HALF + 4 * n); }
        float rsv[2][4];
        if (ssq) {
#pragma unroll
            for (int ai = 0; ai < 2; ++ai)
#pragma unroll
                for (int m = 0; m < 4; ++m) rsv[ai][m] = ssq[row0 + ai * HALF + m * 16];
#pragma unroll
            for (int ai = 0; ai < 2; ++ai)
#pragma unroll
                for (int m = 0; m < 4; ++m) rsv[ai][m] = rsqrtf(rsv[ai][m] * (1.f / 1024.f) + 1e-6f); }
#pragma unroll
        for (int ai = 0; ai < 2; ++ai)
#pragma unroll
            for (int m = 0; m < 4; ++m) { const int row = row0 + ai * HALF + m * 16; bf16_t* rowp = O + (size_t)row * ldc + col0;
                f32x4 a0 = acc[ai][0][m][0], a1 = acc[ai][0][m][1], g0 = acc[ai][1][m][0], g1 = acc[ai][1][m][1];
                if (ssq) { const float rs = rsv[ai][m]; a0 = a0 * rs + cb[0][0]; a1 = a1 * rs + cb[0][1]; g0 = g0 * rs + cb[1][0]; g1 = g1 * rs + cb[1][1]; }
                u32x4 w; w.x = cvt_pk_bf16(fast_silu(a0[0]) * g0[0], fast_silu(a0[1]) * g0[1]); w.y = cvt_pk_bf16(fast_silu(a0[2]) * g0[2], fast_silu(a0[3]) * g0[3]);
                w.z = cvt_pk_bf16(fast_silu(a1[0]) * g1[0], fast_silu(a1[1]) * g1[1]); w.w = cvt_pk_bf16(fast_silu(a1[2]) * g1[2], fast_silu(a1[3]) * g1[3]);
                *(u32x4*)rowp = w; }
    }
};
struct EpiBf16Norm {
    static constexpr bool PERM = true, AFTER_DRAIN = false;
    bf16_t* O; int ldc; const float* ssq; const float* cbias; int cbld;
    __device__ __forceinline__ void operator()(const f32x4 (&acc)[2][2][4][2], const Unit& u, int wr, int wc, int fr, int fq) const {
        const int row0 = u.pm * BM + wr * 64 + fr; const int col0 = u.pn * BM + wc * 32 + 8 * fq;
        const int b = u.pm / 9; const int mrow = (u.pm - 9 * b == 0) ? 8 : b; const float* cp = cbias + (size_t)mrow * cbld + col0;
        f32x4 cb[2][2];
#pragma unroll
        for (int bj = 0; bj < 2; ++bj)
#pragma unroll
            for (int n = 0; n < 2; ++n) cb[bj][n] = *(const f32x4*)(cp + bj * HALF + 4 * n);
        float rsv[2][4];
#pragma unroll
        for (int ai = 0; ai < 2; ++ai)
#pragma unroll
            for (int m = 0; m < 4; ++m) rsv[ai][m] = ssq[row0 + ai * HALF + m * 16];
#pragma unroll
        for (int ai = 0; ai < 2; ++ai)
#pragma unroll
            for (int m = 0; m < 4; ++m) { const int row = row0 + ai * HALF + m * 16; bf16_t* rowp = O + (size_t)row * ldc + col0; const float rs = rsqrtf(rsv[ai][m] * (1.f / 1024.f) + 1e-6f);
#pragma unroll
                for (int bj = 0; bj < 2; ++bj) { const f32x4 v0 = acc[ai][bj][m][0] * rs + cb[bj][0], v1 = acc[ai][bj][m][1] * rs + cb[bj][1];
                    u32x4 w; w.x = cvt_pk_bf16(v0[0], v0[1]); w.y = cvt_pk_bf16(v0[2], v0[3]); w.z = cvt_pk_bf16(v1[0], v1[1]); w.w = cvt_pk_bf16(v1[2], v1[3]); *(u32x4*)(rowp + bj * HALF) = w; } }
    }
};
struct EpiMoeY2 {
    static constexpr bool PERM = true, AFTER_DRAIN = false;
    const float* slot_gate; bf16_t* Y2;
    __device__ __forceinline__ void operator()(const f32x4 (&acc)[2][2][4][2], const Unit& u, int wr, int wc, int fr, int fq) const {
        const int col0 = (u.pn & 3) * BM + wc * 32 + 8 * fq; const int slot0 = u.pm * BM + wr * 64 + fr;
#pragma unroll
        for (int ai = 0; ai < 2; ++ai)
#pragma unroll
            for (int m = 0; m < 4; ++m) { const int slot = slot0 + ai * HALF + m * 16; const float g = slot_gate[slot]; bf16_t* rowp = Y2 + (size_t)slot * 1024 + col0;
#pragma unroll
                for (int bj = 0; bj < 2; ++bj) { const f32x4 v0 = acc[ai][bj][m][0] * g, v1 = acc[ai][bj][m][1] * g;
                    u32x4 w; w.x = cvt_pk_bf16(v0[0], v0[1]); w.y = cvt_pk_bf16(v0[2], v0[3]); w.z = cvt_pk_bf16(v1[0], v1[1]); w.w = cvt_pk_bf16(v1[2], v1[3]);
                    *(u32x4*)(rowp + bj * HALF) = w; } }
    }
};
enum EpiMode { E_BF16 = 0, E_BF16NORM, E_RES, E_SWIGLU, E_MOEY2 };
struct EpiAny {
    static constexpr bool PERM = true, AFTER_DRAIN = false;
    int mode;
    bf16_t* O; int ldc, npn; const float* ssq; const float* cbias; int cbld;
    const float* xin; float* xout; const float* modbase; int compact, srcin, fuse; const float* xsrc_lat; const float* xsrc_ctx; const float* gnext; const float* nscale; float* ssqw;
    const float* slot_gate;
    __device__ __forceinline__ void res(const f32x4 (&acc)[2][2][4][2], const Unit& u, int wr, int wc, int fr, int fq) const {
        const int b = u.pm / 9, pj = u.pm - 9 * b; const int mrow = (pj == 0) ? 8 : b;
        const float* g = modbase + (size_t)mrow * 6144;
        const int col0 = u.pn * BM + wc * 32 + 8 * fq;
        f32x4 gv[2][2];
#pragma unroll
        for (int bj = 0; bj < 2; ++bj)
#pragma unroll
            for (int n = 0; n < 2; ++n) gv[bj][n] = *(const f32x4*)(g + col0 + bj * HALF + n * 4);
        const int row0 = u.pm * BM + wr * 64 + fr; const int oshift = compact ? 256 * (b + 1) : 0;
        const float* xbase = srcin ? (pj == 0 ? xsrc_ctx + (size_t)b * 256 * 1024 : xsrc_lat + ((size_t)b * 2048 + (pj - 1) * 256) * 1024) - (size_t)u.pm * BM * 1024 : xin;
        const float* ns = nscale + (size_t)mrow * 6144; bf16_t* hraw = O;
#pragma unroll
        for (int ai = 0; ai < 2; ++ai)
#pragma unroll
            for (int m = 0; m < 4; ++m) { const int row = row0 + ai * HALF + m * 16; const float* xi = xbase + (size_t)row * 1024 + col0; float* xo = xout + (size_t)(row - oshift) * 1024 + col0; float ss = 0.f;
#pragma unroll
                for (int bj = 0; bj < 2; ++bj)
#pragma unroll
                    for (int n = 0; n < 2; ++n) { const f32x4 v = *(const f32x4*)(xi + bj * HALF + n * 4) + gv[bj][n] * acc[ai][bj][m][n]; *(f32x4*)(xo + bj * HALF + n * 4) = v;
                        if (fuse) { const int c = col0 + bj * HALF + n * 4; const f32x4 hv = v * (*(const f32x4*)(gnext + c) * (*(const f32x4*)(ns + c) + 1.f));
                            ss += (v[0] * v[0] + v[1] * v[1]) + (v[2] * v[2] + v[3] * v[3]);
                            u32x2 w; w.x = cvt_pk_bf16(hv[0], hv[1]); w.y = cvt_pk_bf16(hv[2], hv[3]); *(u32x2*)(hraw + (size_t)row * 1024 + c) = w; } }
                if (fuse) { ss += __shfl_xor(ss, 16); ss += __shfl_xor(ss, 32); if (fq == 0) unsafeAtomicAdd(ssqw + row, ss); }
                if (m & 1) asm volatile("" ::: "memory"); }
    }
    __device__ __forceinline__ void operator()(const f32x4 (&acc)[2][2][4][2], const Unit& u, int wr, int wc, int fr, int fq) const {
        if (mode == E_BF16) { EpiBf16<0> e{O, ldc, nullptr, 0, 0, 1.f}; e(acc, u, wr, wc, fr, fq); }
        else if (mode == E_BF16NORM) { EpiBf16Norm e{O, ldc, ssq, cbias, cbld}; e(acc, u, wr, wc, fr, fq); }
        else if (mode == E_SWIGLU) { EpiSwiGLU e{O, ldc, npn, ssq, cbias, cbld}; e(acc, u, wr, wc, fr, fq); }
        else if (mode == E_MOEY2) { EpiMoeY2 e{slot_gate, O}; e(acc, u, wr, wc, fr, fq); }
        else res(acc, u, wr, wc, fr, fq);
    }
};
struct ChainOrder {
    int stage, c;
    __device__ __forceinline__ bool next(int i, Unit& u) const {
        const int x = c & 7, r = c >> 3; int lu = -1, nN = 4;
        if (stage == 0) { if (i == 0) lu = r; else if (i == 1 && r >= 16 && r < 20) lu = 16 + r; }
        else if (stage == 1) { nN = 22;
            if (i < 3) lu = 32 * i + r; else if (i == 3) { if (r < 30) lu = 96 + r; }
            else if (r < 28) { if (i < 6) lu = 126 + 28 * (i - 4) + r; else if (i == 6 && r < 16) lu = 182 + r; } }
        else if (stage == 2) { if (r >= 28) { if (i == 0) lu = r - 28; else if (i == 1) lu = r - 16; }
               else if (i == 0) { if (r < 16) lu = 20 + r; else { const int k = r - 16; lu = k < 8 ? 4 + k : 8 + k; } } }
        else {
            if (i < 2) lu = 32 * i + r; else if (i == 2 && r == 31) lu = 64;
            if (lu < 0) return false;
            if (lu == 64) { u.pm = 9 * x; u.pn = 7; } else { u.pm = 9 * x + 1 + (lu & 7); u.pn = lu >> 3; }
            return true; }
        if (lu < 0) return false;
        const unsigned long long perm = x == 6 ? 0x874310652ull : x == 7 ? 0x875421630ull : 0x876543210ull;
        const int g = lu / (3 * nN), w = lu - g * 3 * nN; u.pm = 9 * x + (int)((perm >> (4 * (3 * g + w % 3))) & 15ull); u.pn = w / 3; return true;
    }
};
struct MoeChainOrder {
    const PG8_LAS int* tb; int stage, c;
    __device__ __forceinline__ bool next(int i, Unit& u) const {
        const int x = c & 7, r = c >> 3, T = tb[8];
        const int t0 = (T * x) >> 3, n = ((T * (x + 1)) >> 3) - t0, j = r & 7, cc = r >> 3;
        int tile, col, nN;
        if (stage == 1) { nN = 4; tile = 8 * i + j; col = cc; if (tile >= n) return false; }
        else { nN = 28;
            const int kb = ((n & 7) == 1) ? 1 : 0, H = 4 * kb, tot = 28 * n + 12 * kb, A0 = tot >> 5, rem = tot & 31, ah = A0 - 3 * kb;
            const bool heavy = kb && j == 0;
            const int nr = r - (kb ? cc + (j > 0 ? 1 : 0) : 0);
            int m;
            if (i < ah) m = 32 * i + r;
            else { if (heavy) return false;
                   if (i < A0) m = 32 * ah + (32 - H) * (i - ah) + nr;
                   else if (i == A0 && nr < rem) m = 32 * ah + (32 - H) * (A0 - ah) + nr;
                   else return false; }
            if (m >= 28 * n) return false;
            const int g = m / 112, w = m - g * 112, gs = (n - 4 * g) < 4 ? (n - 4 * g) : 4; tile = 4 * g + w % gs; col = w / gs; }
        const int t = t0 + tile; int e = 0;
#pragma unroll
        for (int k = 1; k < 8; ++k) if (t >= tb[k]) e = k;
        u.pm = t; u.pn = e * nN + col; return true;
    }
};
struct OrderAny {
    int omode;
    DenseOrder d; MoeOrder m; ChainOrder ch; MoeChainOrder mch;
    mutable unsigned early, ew0, ew1, ew2, ew3;
    __device__ __forceinline__ bool next(int i, Unit& u) const {
        const bool ok = omode == 3 ? m.next(i, u) : omode == 4 ? ch.next(i, u) : omode == 5 ? mch.next(i, u) : d.next(i, u);
        if (ok && wcnt != nullptr) {
            early = __hip_atomic_load(wcnt + u.pm * 16, __ATOMIC_RELAXED, __HIP_MEMORY_SCOPE_AGENT);
            if (w2kind != 0) { int lo, hi; war_range(u, lo, hi);
                ew0 = __hip_atomic_load(w2cnt + (lo     <= hi ? lo     : u.pm) * 16, __ATOMIC_RELAXED, __HIP_MEMORY_SCOPE_AGENT);
                ew1 = __hip_atomic_load(w2cnt + (lo + 1 <= hi ? lo + 1 : u.pm) * 16, __ATOMIC_RELAXED, __HIP_MEMORY_SCOPE_AGENT);
                ew2 = __hip_atomic_load(w2cnt + (lo + 2 <= hi ? lo + 2 : u.pm) * 16, __ATOMIC_RELAXED, __HIP_MEMORY_SCOPE_AGENT);
                ew3 = __hip_atomic_load(w2cnt + (lo + 3 <= hi ? lo + 3 : u.pm) * 16, __ATOMIC_RELAXED, __HIP_MEMORY_SCOPE_AGENT); }
        }
        return ok;
    }
    unsigned* wcnt; unsigned wtarget; unsigned* dcnt; int rel_agent;
    unsigned* w2cnt; int w2kind;
    __device__ __forceinline__ void war_range(const Unit& u, int& lo, int& hi) const {
        if (w2kind == 1) { const int a0 = u.pm * 1441792 - 75497472, a1 = a0 + 1441791; lo = (a0 > 0 ? a0 : 0) >> 19; hi = a1 < 0 ? -1 : (a1 >> 19); }
        else { const int b0 = u.pm << 20; lo = b0 / 1441792; hi = (b0 + 1048575) / 1441792; }
    }
    __device__ __forceinline__ void a_ready(const Unit& u) const {
        if (wcnt != nullptr) {
            unsigned* p = wcnt + u.pm * 16; unsigned sp = 0u;
            unsigned mn = early;
            if (w2kind != 0) { const unsigned a = ew0 < ew1 ? ew0 : ew1, b = ew2 < ew3 ? ew2 : ew3, c2 = a < b ? a : b; mn = c2 < mn ? c2 : mn; }
            if (mn < wtarget) {
                while (__hip_atomic_load(p, __ATOMIC_RELAXED, __HIP_MEMORY_SCOPE_AGENT) < wtarget) { __builtin_amdgcn_s_sleep(1); if (++sp > (1u << 22)) break; }
                if (w2kind != 0) { int lo, hi; war_range(u, lo, hi);
                    for (int q = lo; q <= hi; ++q) while (__hip_atomic_load(w2cnt + q * 16, __ATOMIC_RELAXED, __HIP_MEMORY_SCOPE_AGENT) < wtarget) { __builtin_amdgcn_s_sleep(1); if (++sp > (1u << 22)) break; } }
            }
            if (rel_agent) __builtin_amdgcn_fence(__ATOMIC_ACQUIRE, "agent");
            asm volatile("" ::: "memory");
        }
    }
    __device__ __forceinline__ void done(const Unit& u) const {
        if (dcnt != nullptr) {
            if (rel_agent) __builtin_amdgcn_fence(__ATOMIC_RELEASE, "agent");
            asm volatile("s_waitcnt vmcnt(0)" ::: "memory");
            if ((threadIdx.x & 63) == 0) (void)__hip_atomic_fetch_add(dcnt + u.pm * 16, 1u, __ATOMIC_RELAXED, __HIP_MEMORY_SCOPE_AGENT);
        }
    }
};
}
#define GAS __attribute__((address_space(1)))
#define LAS __attribute__((address_space(3)))
typedef unsigned v4u __attribute__((ext_vector_type(4)));
typedef short bf16x8 __attribute__((ext_vector_type(8)));
namespace att {
using f32x16 = __attribute__((ext_vector_type(16))) float;
using s16x4 = __attribute__((ext_vector_type(4))) short;
typedef float f32x2_t __attribute__((ext_vector_type(2))); typedef __bf16 bf16x2_t __attribute__((ext_vector_type(2)));
__device__ __forceinline__ int crow(int r, int hi) { return (r & 3) + 8 * (r >> 2) + 4 * hi; }
__device__ __forceinline__ void glds16(const void* gsrc, unsigned lds_dst) { unsigned keep;
    asm volatile("s_mov_b32 %0, m0\n\ts_mov_b32 m0, %2\n\ts_nop 0\n\tglobal_load_lds_dwordx4 %1, off\n\ts_mov_b32 m0, %0" : "=&s"(keep) : "v"(gsrc), "s"(lds_dst) : "memory"); }
__device__ __forceinline__ unsigned cvtpk_s(float lo, float hi) { f32x2_t v = {lo, hi}; bf16x2_t b = __builtin_convertvector(v, bf16x2_t); return __builtin_bit_cast(unsigned, b); }
#define ATT_MX3(a, b, c) __builtin_fmaxf(__builtin_fmaxf((a), (b)), (c))
__device__ __forceinline__ float rowmax32(const f32x16& p0, const f32x16& p1) {
    float a = ATT_MX3(p0[0], p0[1], p1[0]), b = ATT_MX3(p0[2], p0[3], p1[1]); a = ATT_MX3(a, p1[2], p1[3]);
#pragma unroll
    for (int r = 4; r < 16; r += 4) { a = ATT_MX3(a, p0[r], p0[r + 1]); b = ATT_MX3(b, p0[r + 2], p0[r + 3]); a = ATT_MX3(a, p1[r], p1[r + 1]); b = ATT_MX3(b, p1[r + 2], p1[r + 3]); }
    a = __builtin_fmaxf(a, b);
    auto rr = __builtin_amdgcn_permlane32_swap(__float_as_uint(a), __float_as_uint(a), false, false);
    return fmaxf(__uint_as_float(rr[0]), __uint_as_float(rr[1]));
}
__device__ __forceinline__ void pv(f32x16* o, int vb, bf16x8 pa0, bf16x8 pa1, bf16x8 pa2, bf16x8 pa3) {
    s16x4 lo[2][4], hi[2][4];
#pragma unroll
    for (int d0 = 0; d0 < 2; ++d0)
#pragma unroll
        for (int ks = 0; ks < 4; ++ks) {
            asm volatile("ds_read_b64_tr_b16 %0,%1 offset:%c2" : "=&v"(lo[d0][ks]) : "v"(vb), "i"(d0 * 4096 + ks * 1024) : "memory");
            asm volatile("ds_read_b64_tr_b16 %0,%1 offset:%c2" : "=&v"(hi[d0][ks]) : "v"(vb), "i"(d0 * 4096 + ks * 1024 + 512) : "memory"); }
    asm volatile("s_waitcnt lgkmcnt(0)" ::: "memory"); __builtin_amdgcn_sched_barrier(0);
#define ATT_PK(d, k) (bf16x8){lo[d][k][0], lo[d][k][1], lo[d][k][2], lo[d][k][3], hi[d][k][0], hi[d][k][1], hi[d][k][2], hi[d][k][3]}
    o[0] = __builtin_amdgcn_mfma_f32_32x32x16_bf16(pa0, ATT_PK(0, 0), o[0], 0, 0, 0); o[1] = __builtin_amdgcn_mfma_f32_32x32x16_bf16(pa0, ATT_PK(1, 0), o[1], 0, 0, 0);
    o[0] = __builtin_amdgcn_mfma_f32_32x32x16_bf16(pa1, ATT_PK(0, 1), o[0], 0, 0, 0); o[1] = __builtin_amdgcn_mfma_f32_32x32x16_bf16(pa1, ATT_PK(1, 1), o[1], 0, 0, 0);
    o[0] = __builtin_amdgcn_mfma_f32_32x32x16_bf16(pa2, ATT_PK(0, 2), o[0], 0, 0, 0); o[1] = __builtin_amdgcn_mfma_f32_32x32x16_bf16(pa2, ATT_PK(1, 2), o[1], 0, 0, 0);
    o[0] = __builtin_amdgcn_mfma_f32_32x32x16_bf16(pa3, ATT_PK(0, 3), o[0], 0, 0, 0); o[1] = __builtin_amdgcn_mfma_f32_32x32x16_bf16(pa3, ATT_PK(1, 3), o[1], 0, 0, 0);
#undef ATT_PK
}
template <int DQ> struct Geo {
    static constexpr int NCH = DQ / 8, KSLOT = NCH * 1024, VSLOT = 8192;
    static constexpr int LDS_K = 0, LDS_V = 2 * KSLOT, LDS_WS = LDS_V + 2 * VSLOT, LDS_OST = LDS_WS + 8 * 256, LDS_BYTES = LDS_OST + 8 * 4096;
};
template <int DQ>
__device__ __forceinline__ void unit(int b, int hq, int hk, int qb, int NT, const bf16_t* __restrict__ Q, int ldq, const bf16_t* __restrict__ K, int ldk, const bf16_t* __restrict__ V, int ldv,
                                     bf16_t* __restrict__ O, int ldo, LAS unsigned char* shm) {
    typedef Geo<DQ> G; constexpr int ND0 = DQ / 16;
    const int tid = threadIdx.x, lane = tid & 63, r32 = lane & 31, hi = lane >> 5; const int wid = __builtin_amdgcn_readfirstlane(tid >> 6);
    const long rowbase = (long)b * RPB; const int q0 = qb * 256;
    const bf16_t* Qw = Q + (rowbase + q0 + wid * 32) * ldq + hq * DQ;
    const bf16_t* Kh = K + rowbase * ldk + hk * DQ; const bf16_t* Vh = V + rowbase * ldv + hk * 64;
    const unsigned lds0 = (unsigned)(uintptr_t)shm;
    LAS float* wsf = (LAS float*)(shm + G::LDS_WS) + wid * 64;
    const bf16_t* ksrc = Kh + (long)lane * ldk + wid * 8;
    const bf16_t* vsrc = Vh + (long)(16 * (wid & 3) + (lane >> 2)) * ldv + (wid >> 2) * 32 + (lane & 3) * 8;
    const unsigned kdst = lds0 + G::LDS_K + wid * 1024, vdst = lds0 + G::LDS_V + wid * 1024;
    const int vb0 = (int)(lds0 + G::LDS_V) + ((lane >> 4) & 1) * 32 + (lane & 3) * 8 + (4 * hi + ((lane & 15) >> 2)) * 64;
#define ATT_DMA(t, s) do { const bf16_t* kp_ = ksrc + (long)(t) * 64 * ldk; glds16(kp_, (unsigned)__builtin_amdgcn_readfirstlane(kdst + (s) * G::KSLOT)); \
        if (DQ == 96 && wid < 4) glds16(kp_ + 64, (unsigned)__builtin_amdgcn_readfirstlane(kdst + (s) * G::KSLOT + 8192)); \
        glds16(vsrc + (long)(t) * 64 * ldv, (unsigned)__builtin_amdgcn_readfirstlane(vdst + (s) * G::VSLOT)); } while (0)
    ATT_DMA(0, 0);
    bf16x8 qr[ND0];
#pragma unroll
    for (int d0 = 0; d0 < ND0; ++d0) qr[d0] = *reinterpret_cast<const bf16x8*>(&Qw[(long)r32 * ldq + d0 * 16 + hi * 8]);
    constexpr float THR = 8.f;
    float mref = 0.f, l_reg = 0.f; f32x16 o[2]; o[0] = f32x16{}; o[1] = f32x16{}; f32x16 negm = f32x16{};
    for (int t = 0; t < NT; ++t) {
        const int s = t & 1;
        asm volatile("s_waitcnt vmcnt(0) lgkmcnt(0)\n\ts_barrier" ::: "memory");
        if (t + 1 < NT) ATT_DMA(t + 1, s ^ 1);
        f32x16 p0, p1;
        { const LAS unsigned char* kb = shm + G::LDS_K + s * G::KSLOT + hi * 1024 + r32 * 16;
#pragma unroll
          for (int d0 = 0; d0 < ND0; ++d0) { const bf16x8 b0 = *(const LAS bf16x8*)(kb + d0 * 2048); const bf16x8 b1 = *(const LAS bf16x8*)(kb + d0 * 2048 + 512);
              p0 = __builtin_amdgcn_mfma_f32_32x32x16_bf16(b0, qr[d0], d0 == 0 ? negm : p0, 0, 0, 0); p1 = __builtin_amdgcn_mfma_f32_32x32x16_bf16(b1, qr[d0], d0 == 0 ? negm : p1, 0, 0, 0); } }
        const float rm = rowmax32(p0, p1);
        if (__builtin_expect(t == 0 || __any(rm > THR), 0)) {
            const float dl = t == 0 ? rm : __builtin_fmaxf(rm, 0.f); mref += dl;
#pragma unroll
            for (int r = 0; r < 16; ++r) { p0[r] -= dl; p1[r] -= dl; negm[r] = -mref; }
            const float alpha = t == 0 ? 1.f : __builtin_amdgcn_exp2f(-dl); l_reg *= alpha;
            if (hi == 0) wsf[r32] = alpha;
            asm volatile("s_waitcnt lgkmcnt(0)" ::: "memory");
#pragma unroll
            for (int r = 0; r < 16; ++r) { const float a = wsf[crow(r, hi)]; o[0][r] *= a; o[1][r] *= a; }
        }
        f32x2_t sacc = {0.f, 0.f};
#pragma unroll
        for (int r = 0; r < 16; r += 2) { p0[r] = __builtin_amdgcn_exp2f(p0[r]); p0[r + 1] = __builtin_amdgcn_exp2f(p0[r + 1]); p1[r] = __builtin_amdgcn_exp2f(p1[r]); p1[r + 1] = __builtin_amdgcn_exp2f(p1[r + 1]);
            sacc += (f32x2_t){p0[r], p0[r + 1]}; sacc += (f32x2_t){p1[r], p1[r + 1]}; }
        l_reg += sacc[0] + sacc[1];
        u32x4 pw0, pw1, pw2, pw3;
        pw0 = (u32x4){cvtpk_s(p0[0], p0[1]), cvtpk_s(p0[2], p0[3]), cvtpk_s(p0[4], p0[5]), cvtpk_s(p0[6], p0[7])};
        pw1 = (u32x4){cvtpk_s(p0[8], p0[9]), cvtpk_s(p0[10], p0[11]), cvtpk_s(p0[12], p0[13]), cvtpk_s(p0[14], p0[15])};
        pw2 = (u32x4){cvtpk_s(p1[0], p1[1]), cvtpk_s(p1[2], p1[3]), cvtpk_s(p1[4], p1[5]), cvtpk_s(p1[6], p1[7])};
        pw3 = (u32x4){cvtpk_s(p1[8], p1[9]), cvtpk_s(p1[10], p1[11]), cvtpk_s(p1[12], p1[13]), cvtpk_s(p1[14], p1[15])};
        pv(o, vb0 + s * G::VSLOT, __builtin_bit_cast(bf16x8, pw0), __builtin_bit_cast(bf16x8, pw1), __builtin_bit_cast(bf16x8, pw2), __builtin_bit_cast(bf16x8, pw3));
    }
#undef ATT_DMA
    { auto rr = __builtin_amdgcn_permlane32_swap(__float_as_uint(l_reg), __float_as_uint(l_reg), false, false); l_reg = __uint_as_float(rr[0]) + __uint_as_float(rr[1]); }
    if (hi == 0) wsf[32 + r32] = l_reg;
    asm volatile("s_waitcnt lgkmcnt(0)" ::: "memory");
    float rli[16];
#pragma unroll
    for (int r = 0; r < 16; ++r) rli[r] = __builtin_amdgcn_rcpf(wsf[32 + crow(r, hi)]);
    bf16_t* Ow = O + (rowbase + q0 + wid * 32) * ldo + hq * 64;
    { LAS bf16_t* stg = (LAS bf16_t*)(shm + G::LDS_OST) + wid * 2048;
#pragma unroll
      for (int r = 0; r < 16; ++r) { const int orow = crow(r, hi);
#pragma unroll
          for (int d0 = 0; d0 < 2; ++d0) stg[orow * 64 + d0 * 32 + r32] = f2bf(o[d0][r] * rli[r]); }
      asm volatile("s_waitcnt lgkmcnt(0)" ::: "memory");
#pragma unroll
      for (int i = 0; i < 4; ++i) { const int row = i * 8 + (lane >> 3), ch = lane & 7; const u32x4 v = *(const LAS u32x4*)(stg + row * 64 + ch * 8); *(u32x4*)(Ow + (long)row * ldo + ch * 8) = v; } }
    asm volatile("s_waitcnt lgkmcnt(0)\n\ts_barrier" ::: "memory");
}
}
#define LDS_WAIT() asm volatile("s_waitcnt lgkmcnt(0)" ::: "memory")
#define VM_WAIT() asm volatile("s_waitcnt vmcnt(0)" ::: "memory")
constexpr int NWAVES = 8, NTHREADS = 512;
constexpr int RING_OFF = 0, RING_BYTES = 131072;
constexpr int MISC_OFF = RING_BYTES;
constexpr int LDS_BYTES = 147456;

enum Phase { PH_P0 = 0, PH_NORM0, PH_G_IN0, PH_LRUPREP, PH_MIX0, PH_G_OUT0, PH_G_F1, PH_G_F2, PH_G_IN1, PH_PREP1, PH_G_QKVB, PH_PREP2, PH_MIX1, PH_G_OUT1,
             PH_ROUTE, PH_SLOT, PH_MOE1, PH_MOE2, PH_COMBINE, PH_COUNT,
             PH_G_QB = 100, PH_G_KVB = 101 };

struct Params { const float* i0; const float* i1; const float* i2; const float* i3; const float* i4; const float* i5; const float* i6; const float* i7; const float* i8; const float* i9; const float* i10; const float* i11; const float* i12; const float* i13; const float* i14; const float* i15; const float* i16; const float* i17; const float* i18; const float* i19; const float* i20; const float* i21; const float* i22; const float* i23; const float* i24; const float* i25; const float* i26; const float* i27; const float* i28; const float* i29; const float* i30; const float* i31; const float* i32; const float* i33; const float* i34; const float* i35; const float* i36; const float* i37; const float* i38; const float* i39; const float* i40; const float* i41; const float* i42; float* out; char* ws; int ph_lo, ph_hi; };
#define PIN(k) (P.i##k)
static_assert(sizeof(Params) == 43 * 8 + 8 + 8 + 8, "Params has no padding");

struct Frame { LAS unsigned char* lds; int tid, lane, wave, G, bid, even; char* ws; };

__device__ __forceinline__ void tr_item(const float* __restrict__ W, int N, bf16_t* __restrict__ WT, int ldk, int kb, int nb, int dst_row0, LAS float* scr, int lane) {
    const int k0 = 64 * kb, n0 = 32 * nb;
    f32x4 v[8]; const float* wp = W + (size_t)(k0 + (lane >> 3)) * N + n0 + 4 * (lane & 7);
#pragma unroll
    for (int i = 0; i < 8; ++i) v[i] = __builtin_nontemporal_load((const f32x4*)(wp + (size_t)(8 * i) * N));
#pragma unroll
    for (int i = 0; i < 8; ++i) { LAS float* sp = scr + (8 * i + (lane >> 3)) * 33 + 4 * (lane & 7); sp[0] = v[i][0]; sp[1] = v[i][1]; sp[2] = v[i][2]; sp[3] = v[i][3]; }
    LDS_WAIT(); asm volatile("" ::: "memory");
    const int c = lane & 7;
#pragma unroll
    for (int j = 0; j < 4; ++j) { const int n = (lane >> 3) + 8 * j; const LAS float* s = scr + (8 * c) * 33 + n;
        v4u o; o.x = pk2(s[0 * 33], s[1 * 33]); o.y = pk2(s[2 * 33], s[3 * 33]); o.z = pk2(s[4 * 33], s[5 * 33]); o.w = pk2(s[6 * 33], s[7 * 33]);
        *(v4u*)(WT + (size_t)(dst_row0 + n) * ldk + k0 + 8 * c) = o; }
    LDS_WAIT(); asm volatile("" ::: "memory");
}
constexpr int MOE_ITEMS = 8 * 3 * 1792, MOE_CHUNK = 32, MOE_NCHUNK = MOE_ITEMS / MOE_CHUNK;
__device__ __forceinline__ void moe_conv_item(const Frame& F, const Params& P, int it, LAS float* scr) {
    const int e = it / 5376, r = it % 5376, which = r / 1792, q = r % 1792; char* ws = F.ws;
    const float* src; bf16_t* dst; int N, ldk, kb, nb, dr;
    if (which < 2) { kb = q / 112; nb = q % 112; const int n0 = nb * 32; dr = (n0 >> 7) * 256 + (n0 & 127) + (which == 1 ? 128 : 0);
        src = (which == 0 ? PIN(40) : PIN(41)) + (size_t)e * 1024 * 3584; N = 3584; dst = (bf16_t*)(ws + WS_W13M) + (size_t)e * 7168 * 1024; ldk = 1024; }
    else { kb = q / 32; nb = q % 32; dr = nb * 32; src = PIN(42) + (size_t)e * 3584 * 1024; N = 1024; dst = (bf16_t*)(ws + WS_W2M) + (size_t)e * 1024 * 3584; ldk = 3584; }
    tr_item(src, N, dst, ldk, kb, nb, dr, scr, F.lane);
}
__device__ __forceinline__ void moe_conv_all(const Frame& F, const Params& P) {
    LAS float* scr = (LAS float*)(F.lds + RING_OFF + F.wave * 16384); const int gw = F.bid * NWAVES + F.wave, NGW = F.G * NWAVES;
    __syncthreads();
#pragma unroll 1
    for (int it = gw; it < MOE_ITEMS; it += NGW) moe_conv_item(F, P, it, scr);
    __syncthreads();
}
struct ConvDesc { const float* src; bf16_t* dst; int N, ldk, nblk, start, il, pad; };
__device__ __forceinline__ void phase_conv(const Frame& F, const Params& P, bool moe) {
    LAS float* scr = (LAS float*)(F.lds + RING_OFF + F.wave * 16384); char* ws = F.ws;
    LAS ConvDesc* tab = (LAS ConvDesc*)(F.lds + MISC_OFF);
    if (F.tid < 41) { const int t = F.tid; ConvDesc d; d.il = 0; d.pad = 0;
        if (t == 0) { d.src = PIN(8); d.dst = (bf16_t*)(ws + WS_WIN0); d.N = 1792; d.ldk = 1024; d.start = 16 * 56; }
        else if (t == 1) { d.src = PIN(9); d.dst = (bf16_t*)(ws + WS_WOUT0); d.N = 1024; d.ldk = 1024; d.start = 16 * 32; }
        else if (t == 2) { d.src = PIN(19); d.dst = (bf16_t*)(ws + WS_WF13); d.N = 2816; d.ldk = 1024; d.start = 16 * 88; d.il = 1; }
        else if (t == 3) { d.src = PIN(20); d.dst = (bf16_t*)(ws + WS_WF13); d.N = 2816; d.ldk = 1024; d.start = 16 * 88; d.il = 2; }
        else if (t == 4) { d.src = PIN(21); d.dst = (bf16_t*)(ws + WS_WF2); d.N = 1024; d.ldk = 2816; d.start = 44 * 32; }
        else if (t == 5) { d.src = PIN(22); d.dst = (bf16_t*)(ws + WS_WIN1); d.N = 1952; d.ldk = 1024; d.start = 16 * 61; }
        else if (t == 6) { d.src = PIN(23); d.dst = (bf16_t*)(ws + WS_WOUT1); d.N = 1024; d.ldk = 1024; d.start = 16 * 32; }
        else if (t == 7) { d.src = PIN(34); d.dst = (bf16_t*)(ws + WS_WQB); d.N = 768; d.ldk = 256; d.start = 4 * 24; }
        else if (t == 8) { d.src = PIN(36); d.dst = (bf16_t*)(ws + WS_WKVB); d.N = 1024; d.ldk = 256; d.start = 2 * 32; }
        else { const int q = t - 9, dn = q >> 1, g = q & 1; d.src = (g ? PIN(14) : PIN(12)) + (size_t)dn * 4096; d.dst = (bf16_t*)(ws + WS_WLRU) + (size_t)(dn * 2 + g) * 4096; d.N = 64; d.ldk = 64; d.start = 2; }
        d.nblk = d.N / 32;
        tab[t].src = d.src; tab[t].dst = d.dst; tab[t].N = d.N; tab[t].ldk = d.ldk; tab[t].nblk = d.nblk; tab[t].start = d.start; tab[t].il = d.il; tab[t].pad = 0; }
    __syncthreads();
    if (F.tid == 0) { int s = 0; for (int t = 0; t < 41; ++t) { const int c = tab[t].start; tab[t].start = s; s += c; } tab[0].pad = s; }
    __syncthreads();
    const int total = tab[0].pad; const int gw = F.bid * NWAVES + F.wave, NGW = F.G * NWAVES;
#pragma unroll 1
    for (int it = gw; it < total; it += NGW) { int e = 0;
#pragma unroll 1
        for (int t = 1; t < 41; ++t) if (it >= tab[t].start) e = t;
        ConvDesc d; d.src = tab[e].src; d.dst = tab[e].dst; d.N = tab[e].N; d.ldk = tab[e].ldk; d.nblk = tab[e].nblk; d.start = tab[e].start; d.il = tab[e].il;
        const int loc = it - d.start, kb = loc / d.nblk, nb = loc % d.nblk, n0 = nb * 32;
        const int dr = d.il == 0 ? n0 : ((n0 >> 7) * 256 + (n0 & 127) + (d.il == 2 ? 128 : 0));
        tr_item(d.src, d.N, d.dst, d.ldk, kb, nb, dr, scr, F.lane); }
    const int gt = F.bid * NTHREADS + F.tid, NGT = F.G * NTHREADS;
    { v4u* z = (v4u*)((bf16_t*)(ws + WS_WIN1) + (size_t)1952 * 1024); for (int i = gt; i < 96 * 1024 / 8; i += NGT) z[i] = (v4u){0u, 0u, 0u, 0u}; }
    { bf16_t* wk = (bf16_t*)(ws + WS_WKVB); for (int i = gt; i < 1024 * 16; i += NGT) { const int r = i >> 4, cc = i & 15; *(v4u*)(wk + (size_t)r * 256 + 128 + cc * 8) = (v4u){0u, 0u, 0u, 0u}; } }
    __syncthreads();
}

constexpr size_t CT_TB = 64 * 1024;
enum GemmId { G_IN0 = 0, G_OUT0, G_F1, G_F2, G_IN1, G_QB, G_KVB, G_OUT1, G_MOE1, G_MOE2 };
__device__ __forceinline__ void run_gemm(const Frame& F, const Params& P, int gid) {
    char* ws = F.ws; float* MOD = (float*)(ws + WS_MOD); const float* MOD1 = MOD + 9 * MODLD; LAS unsigned char* lds = F.lds + RING_OFF;
    float* X = (float*)(ws + WS_X); bf16_t* H = (bf16_t*)(ws + WS_H); LAS int* tb = (LAS int*)(F.lds + MISC_OFF);
    pg8::Gemm g; pg8::OrderAny S; pg8::EpiAny E;
    E.mode = pg8::E_BF16; E.O = nullptr; E.ldc = 0; E.npn = 1; E.ssq = nullptr; E.cbias = nullptr; E.cbld = 0; E.xin = X; E.xout = X; E.modbase = MOD; E.compact = 0; E.srcin = 0; E.fuse = 0;
    E.xsrc_lat = PIN(0); E.xsrc_ctx = PIN(2); E.gnext = PIN(7); E.nscale = MOD; E.ssqw = (float*)(ws + WS_CTL + CT_SSQA); E.slot_gate = (const float*)(ws + WS_SLOTGATE);
    S.wcnt = nullptr; S.dcnt = nullptr; S.wtarget = 0u; S.w2cnt = nullptr; S.w2kind = 0; S.rel_agent = F.even ? 0 : 1; unsigned* PCNT = (unsigned*)(ws + WS_CTL + CT_PCNT);
    S.omode = 0; S.m.tb = tb; S.m.nN = 28; S.m.G = F.G; S.m.c = F.bid; g.M = MROWS; g.N = 0;
    if (gid == G_IN0) { g.A = H; g.Bt = (const bf16_t*)(ws + WS_WIN0); g.K = 1024; S.d.init(72, 7, F.G, F.bid, 0); E.O = (bf16_t*)(ws + WS_Z); E.ldc = 1792; }
    else if (gid == G_OUT0) { g.A = (const bf16_t*)(ws + WS_Y); g.Bt = (const bf16_t*)(ws + WS_WOUT0); g.K = 1024; S.d.init(72, 4, F.G, F.bid, 0); S.omode = 4; S.ch.stage = 0; S.ch.c = F.bid; S.dcnt = PCNT;
        E.mode = pg8::E_RES; E.modbase = MOD + 2 * DM; E.srcin = 1; E.fuse = 1; E.O = H; E.gnext = PIN(7); E.nscale = MOD + 4 * DM; E.ssqw = (float*)(ws + WS_CTL + CT_SSQA); }
    else if (gid == G_F1) { g.A = H; g.Bt = (const bf16_t*)(ws + WS_WF13); g.K = 1024; S.d.init(72, 22, F.G, F.bid, 0); S.omode = 4; S.ch.stage = 1; S.ch.c = F.bid; S.wcnt = PCNT; S.wtarget = 32u; S.dcnt = PCNT + 72 * 16; S.w2cnt = PCNT; S.w2kind = 1;
        E.mode = pg8::E_SWIGLU; E.O = (bf16_t*)(ws + WS_ACT); E.ldc = DFF; E.npn = 22; E.ssq = (const float*)(ws + WS_CTL + CT_SSQA); E.cbias = (const float*)(ws + WS_CBF1); E.cbld = 5632; }
    else if (gid == G_F2) { g.A = (const bf16_t*)(ws + WS_ACT); g.Bt = (const bf16_t*)(ws + WS_WF2); g.K = 2816; S.d.init(72, 4, F.G, F.bid, 0); S.omode = 4; S.ch.stage = 2; S.ch.c = F.bid; S.wcnt = PCNT + 72 * 16; S.wtarget = 176u;
        E.mode = pg8::E_RES; E.modbase = MOD + 5 * DM; E.fuse = 1; E.O = H; E.gnext = PIN(6) + DM; E.nscale = MOD1 + 1 * DM; E.ssqw = (float*)(ws + WS_CTL + CT_SSQB); }
    else if (gid == G_IN1) { g.A = H; g.Bt = (const bf16_t*)(ws + WS_WIN1); g.K = 1024; S.d.init(64, 8, F.G, F.bid, 2); S.omode = 2;
        E.mode = pg8::E_BF16NORM; E.O = (bf16_t*)(ws + WS_Z); E.ldc = 2048; E.ssq = (const float*)(ws + WS_CTL + CT_SSQB); E.cbias = (const float*)(ws + WS_CBIN1); E.cbld = 2048; }
    else if (gid == G_QB) { g.A = (const bf16_t*)(ws + WS_QA); g.Bt = (const bf16_t*)(ws + WS_WQB); g.K = 256; S.d.init(64, 3, F.G, F.bid, 1); S.omode = 1; E.O = (bf16_t*)(ws + WS_QR); E.ldc = 768; }
    else if (gid == G_KVB) { g.A = (const bf16_t*)(ws + WS_KVA); g.Bt = (const bf16_t*)(ws + WS_WKVB); g.K = 256; S.d.init(72, 4, F.G, F.bid, 0); E.O = (bf16_t*)(ws + WS_KVR); E.ldc = 1024; }
    else if (gid == G_OUT1) { g.A = (const bf16_t*)(ws + WS_Y); g.Bt = (const bf16_t*)(ws + WS_WOUT1); g.K = 1024; S.d.init(64, 4, F.G, F.bid, 1); S.omode = 1;
        E.mode = pg8::E_RES; E.xout = P.out; E.modbase = MOD1 + 2 * DM; E.compact = 1; }
    else { if (F.tid < 9) tb[F.tid] = ((const int*)(ws + WS_CTL + CT_TB))[F.tid];
        __syncthreads();
        S.omode = 5; S.d.init(1, 1, F.G, F.bid, 0); S.mch.tb = tb; S.mch.c = F.bid; unsigned* MCNT = (unsigned*)(ws + WS_CTL + CT_MCNT);
        if (gid == G_MOE1) { g.A = (const bf16_t*)(ws + WS_XG); g.Bt = (const bf16_t*)(ws + WS_W13M); g.K = 1024; S.m.nN = 28; S.mch.stage = 0; S.dcnt = MCNT; E.mode = pg8::E_SWIGLU; E.O = (bf16_t*)(ws + WS_ACT2); E.ldc = DFE; E.npn = 28; }
        else { g.A = (const bf16_t*)(ws + WS_ACT2); g.Bt = (const bf16_t*)(ws + WS_W2M); g.K = 3584; S.m.nN = 4; S.mch.stage = 1; S.wcnt = MCNT; S.wtarget = 224u; E.mode = pg8::E_MOEY2; E.O = (bf16_t*)(ws + WS_Y2); } }
    if (S.wcnt != nullptr) __builtin_amdgcn_fence(__ATOMIC_ACQUIRE, "agent");
    pg8::gemm_phase<pg8::EpiAny, pg8::OrderAny, true, true>(lds, g, S, E);
    __syncthreads();
}

__device__ __forceinline__ void phase_attn0(const Frame& F) {
    char* ws = F.ws; LAS unsigned char* lds = F.lds + RING_OFF;
    for (int i = 0;; ++i) { const int L = i * F.G + F.bid; if (L >= 576) break; const int b = L & 7, idx = L >> 3;
        const int h = idx < 64 ? (idx >> 3) : idx - 64, qb = idx < 64 ? 1 + (idx & 7) : 0, NT = idx < 64 ? 36 : 4;
        att::unit<64>(b, h, h >> 2, qb, NT, (const bf16_t*)(ws + WS_QB), 512, (const bf16_t*)(ws + WS_KB), 128, (const bf16_t*)(ws + WS_VB), 128, (bf16_t*)(ws + WS_Y) + 512, DM, lds); }
}
__device__ __forceinline__ void phase_attn1(const Frame& F, const Params& P) {
    char* ws = F.ws; char* dob = (char*)P.out; LAS unsigned char* lds = F.lds + RING_OFF;
    for (int i = 0;; ++i) { const int L = i * F.G + F.bid; if (L >= 512) break; const int b = L & 7, idx = L >> 3; const int h = idx >> 3, qb = 1 + (idx & 7);
        att::unit<96>(b, h, h, qb, 36, (const bf16_t*)(ws + WS_QM), 768, (const bf16_t*)(dob + DO_KM), 768, (const bf16_t*)(dob + DO_VM), 512, (bf16_t*)(ws + WS_Y) + 512, DM, lds); }
}

__device__ __forceinline__ void phase_route(const Frame& F, const Params& P) {
    char* ws = F.ws; const float* X = P.out; const float* g = PIN(7) + DM; const float* MODL = (const float*)(ws + WS_MOD) + 9 * MODLD; const float* router = PIN(39);
    bf16_t* H2 = (bf16_t*)(ws + WS_H2); int* SEL = (int*)(ws + WS_SEL); int* HIST = (int*)(ws + WS_CTL + CT_HIST);
    LAS int* hist = (LAS int*)(F.lds + MISC_OFF);
    if (F.tid < 8) hist[F.tid] = 0;
    __syncthreads();
    const int rpb = NLAT / F.G, rpw = rpb / NWAVES;
    const int lane = F.lane;
    f32x4 rw[4][4][2], gsc[4], shv[4];
    { const float* md = MODL + (size_t)((F.bid * rpb) / SEQ) * MODLD;
#pragma unroll
      for (int j4 = 0; j4 < 4; ++j4) { const int k = 4 * lane + 256 * j4; gsc[j4] = *(const f32x4*)(g + k) * (*(const f32x4*)(md + 4 * DM + k) + 1.f); shv[j4] = *(const f32x4*)(md + 3 * DM + k);
#pragma unroll
          for (int c = 0; c < 4; ++c) { rw[j4][c][0] = *(const f32x4*)(router + (size_t)(k + c) * 8); rw[j4][c][1] = *(const f32x4*)(router + (size_t)(k + c) * 8 + 4); } } }
#pragma unroll 1
    for (int q0 = 0; q0 < rpw; q0 += 2) {
      f32x4 vv[2][4];
#pragma unroll
      for (int qq = 0; qq < 2; ++qq) { const float* xr = X + (size_t)(F.bid * rpb + F.wave * rpw + q0 + qq) * DM;
#pragma unroll
          for (int j4 = 0; j4 < 4; ++j4) vv[qq][j4] = *(const f32x4*)(xr + 4 * lane + 256 * j4); }
#pragma unroll
      for (int qq = 0; qq < 2; ++qq) {
        const int m = F.bid * rpb + F.wave * rpw + q0 + qq;
        f32x4 (&v)[4] = vv[qq]; float ss = 0.f;
#pragma unroll
        for (int j4 = 0; j4 < 4; ++j4) ss += (v[j4][0] * v[j4][0] + v[j4][1] * v[j4][1]) + (v[j4][2] * v[j4][2] + v[j4][3] * v[j4][3]);
        const float rstd = rsqrtf(wave_sum(ss) / DM + EPS);
        f32x4 a03 = {0.f, 0.f, 0.f, 0.f}, a47 = {0.f, 0.f, 0.f, 0.f};
#pragma unroll
        for (int j4 = 0; j4 < 4; ++j4) { const int k = 4 * lane + 256 * j4; const f32x4 hv = v[j4] * rstd * gsc[j4] + shv[j4];
#pragma unroll
            for (int c = 0; c < 4; ++c) { a03 += rw[j4][c][0] * hv[c]; a47 += rw[j4][c][1] * hv[c]; }
            u32x2 w; w.x = pk2(hv[0], hv[1]); w.y = pk2(hv[2], hv[3]); *(u32x2*)(H2 + (size_t)m * DM + k) = w; }
        float acc[8] = {a03[0], a03[1], a03[2], a03[3], a47[0], a47[1], a47[2], a47[3]};
#pragma unroll
        for (int e = 0; e < 8; ++e) acc[e] = wave_sum(acc[e]);
        if (lane == 0) {
            int e0 = 0; float b0 = acc[0];
#pragma unroll
            for (int e = 1; e < 8; ++e) if (acc[e] > b0) { b0 = acc[e]; e0 = e; }
            int e1 = -1; float b1 = -INFINITY;
#pragma unroll
            for (int e = 0; e < 8; ++e) if (e != e0 && acc[e] > b1) { b1 = acc[e]; e1 = e; }
            const float ex = expf(b1 - b0); const float g0 = 1.f / (1.f + ex), g1 = ex / (1.f + ex);
            SEL[4 * m + 0] = e0; SEL[4 * m + 1] = e1; SEL[4 * m + 2] = __float_as_int(g0); SEL[4 * m + 3] = __float_as_int(g1);
            atomicAdd((int*)&hist[e0], 1); atomicAdd((int*)&hist[e1], 1);
        }
      }
    }
    __syncthreads();
    if (F.tid < 8) HIST[F.bid * 8 + F.tid] = hist[F.tid];
}
__device__ __forceinline__ void phase_slot(const Frame& F, const Params& P) {
    char* ws = F.ws; const int* HIST = (const int*)(ws + WS_CTL + CT_HIST); const int* SEL = (const int*)(ws + WS_SEL); int* TB = (int*)(ws + WS_CTL + CT_TB);
    const bf16_t* H2 = (const bf16_t*)(ws + WS_H2); bf16_t* XG = (bf16_t*)(ws + WS_XG); int* slot_tok = (int*)(ws + WS_SLOTTOK); float* slot_gate = (float*)(ws + WS_SLOTGATE);
    LAS int* sm = (LAS int*)(F.lds + MISC_OFF);
    if (F.tid < 16) sm[F.tid] = 0;
    { const int rpb0 = NLAT / F.G; for (int i = F.tid; i < 4 * rpb0; i += NTHREADS) sm[512 + i] = SEL[4 * F.bid * rpb0 + i]; }
    __syncthreads();
    for (int t = F.tid; t < 2 * F.G; t += NTHREADS) {
        const int j = t % F.G, hf = t / F.G; const int4 c = *(const int4*)(HIST + j * 8 + 4 * hf); const int mk = j < F.bid ? 1 : 0;
        int v[8] = {c.x, c.y, c.z, c.w, c.x * mk, c.y * mk, c.z * mk, c.w * mk};
#pragma unroll
        for (int q = 0; q < 8; ++q) {
#pragma unroll
            for (int o = 1; o < 64; o <<= 1) v[q] += __shfl_xor(v[q], o); }
        if (F.lane == 0) {
#pragma unroll
            for (int q = 0; q < 4; ++q) { atomicAdd((int*)&sm[4 * hf + q], v[q]); atomicAdd((int*)&sm[8 + 4 * hf + q], v[4 + q]); } }
    }
    __syncthreads();
    if (F.tid == 0) { int s = 0; for (int e = 0; e < 8; ++e) { sm[16 + e] = s; s += (sm[e] + 255) & ~255; } sm[24] = s; }
    __syncthreads();
    const int rpb = NLAT / F.G, na = 2 * rpb;
    if (F.tid == 0) { int run[8];
#pragma unroll
        for (int e = 0; e < 8; ++e) run[e] = sm[16 + e] + sm[8 + e];
        for (int a = 0; a < na; ++a) { const int e = sm[512 + 4 * (a >> 1) + (a & 1)]; int sl = 0;
#pragma unroll
            for (int q = 0; q < 8; ++q) if (q == e) { sl = run[q]; run[q] = sl + 1; }
            sm[32 + a] = sl; } }
    __syncthreads();
    for (int a0 = F.wave * 4; a0 < na; a0 += NWAVES * 4) { v4u va[4][2];
#pragma unroll
        for (int q = 0; q < 4; ++q) { const int a = a0 + q; const int m = F.bid * rpb + (a >> 1); const v4u* src = (const v4u*)(H2 + (size_t)m * DM); va[q][0] = src[F.lane]; va[q][1] = src[64 + F.lane]; }
#pragma unroll
        for (int q = 0; q < 4; ++q) { const int a = a0 + q; const int m = F.bid * rpb + (a >> 1), sl = sm[32 + a]; v4u* dst = (v4u*)(XG + (size_t)sl * DM); dst[F.lane] = va[q][0]; dst[64 + F.lane] = va[q][1];
            if (F.lane == 0) { slot_tok[sl] = m; ((int*)(ws + WS_TOKSLOT))[2 * m + (a & 1)] = sl; slot_gate[sl] = __int_as_float(sm[512 + 4 * (a >> 1) + 2 + (a & 1)]); } } }
    if (F.bid < 8) { const int e = F.bid; for (int sl = sm[16 + e] + sm[e] + F.tid; sl < sm[16 + e + 1]; sl += NTHREADS) slot_tok[sl] = -1; }
    if (F.bid == 0 && F.tid < 9) TB[F.tid] = sm[16 + F.tid] >> 8;
}
__device__ __forceinline__ void phase_combine(const Frame& F, const Params& P) {
    char* ws = F.ws; float* out = P.out; const bf16_t* Y2 = (const bf16_t*)(ws + WS_Y2); const int* TS = (const int*)(ws + WS_TOKSLOT); const float* mod5 = (const float*)(ws + WS_MOD) + 9 * MODLD + 5 * DM;
    const int gw = F.bid * NWAVES + F.wave, lane = F.lane; const int mb = gw * 8;
    f32x4 mv[2][2];
    { const float* md = mod5 + (size_t)(mb >> 11) * MODLD;
#pragma unroll
      for (int jj = 0; jj < 2; ++jj)
#pragma unroll
          for (int hlf = 0; hlf < 2; ++hlf) mv[jj][hlf] = *(const f32x4*)(md + 8 * lane + 512 * jj + 4 * hlf); }
#pragma unroll 1
    for (int q0 = 0; q0 < 8; q0 += 2) {
        f32x4 xv[2][4]; v4u ya[2][2], yb[2][2];
#pragma unroll
        for (int q = 0; q < 2; ++q) { const int m = mb + q0 + q; const int sa = TS[2 * m], sb = TS[2 * m + 1];
#pragma unroll
            for (int jj = 0; jj < 4; ++jj) xv[q][jj] = *(const f32x4*)(out + (size_t)m * DM + 8 * lane + 512 * (jj >> 1) + 4 * (jj & 1));
#pragma unroll
            for (int jj = 0; jj < 2; ++jj) { ya[q][jj] = *(const v4u*)(Y2 + (size_t)sa * DM + 8 * lane + 512 * jj); yb[q][jj] = *(const v4u*)(Y2 + (size_t)sb * DM + 8 * lane + 512 * jj); } }
#pragma unroll
        for (int q = 0; q < 2; ++q) { const int m = mb + q0 + q;
#pragma unroll
            for (int jj = 0; jj < 2; ++jj) { const int k = 8 * lane + 512 * jj;
#pragma unroll
                for (int hlf = 0; hlf < 2; ++hlf) { f32x4 o = xv[q][2 * jj + hlf]; const f32x4 mm = mv[jj][hlf];
                    const unsigned a0 = ya[q][jj][2 * hlf], a1 = ya[q][jj][2 * hlf + 1], b0 = yb[q][jj][2 * hlf], b1 = yb[q][jj][2 * hlf + 1];
                    o[0] += mm[0] * (__uint_as_float(a0 << 16) + __uint_as_float(b0 << 16)); o[1] += mm[1] * (__uint_as_float(a0 & 0xffff0000u) + __uint_as_float(b0 & 0xffff0000u));
                    o[2] += mm[2] * (__uint_as_float(a1 << 16) + __uint_as_float(b1 << 16)); o[3] += mm[3] * (__uint_as_float(a1 & 0xffff0000u) + __uint_as_float(b1 & 0xffff0000u));
                    *(f32x4*)(out + (size_t)m * DM + k + 4 * hlf) = o; } } }
    }
}

#define XB_TMO      128
#define XB_XCNT(j)  (256  + 64 * (j))
#define XB_XSUB(j)  (1280 + 64 * (j))
#define XB_XGEN(j)  (2304 + 64 * (j))
#define XB_TOP      3328
#define XB_TOPGEN   3392
#define XCD_BAR_WORDS 3456
#define XB_SPIN_CAP (1u << 18)

__device__ __forceinline__ unsigned xb_ld(unsigned* p)              { return __hip_atomic_load(p, __ATOMIC_RELAXED, __HIP_MEMORY_SCOPE_AGENT); }
__device__ __forceinline__ unsigned xb_add(unsigned* p, unsigned v) { return __hip_atomic_fetch_add(p, v, __ATOMIC_RELAXED, __HIP_MEMORY_SCOPE_AGENT); }
__device__ __forceinline__ unsigned xb_xcc_id() { return (unsigned)__builtin_amdgcn_s_getreg((3 << 11) | 20) & 0xFu; }
#define XB_SPIN(cond, bar) do { unsigned _sp = 0; while (cond) { __builtin_amdgcn_s_sleep(1); \
    if ((++_sp & 255u) == 0u) { if (xb_ld(&(bar)[XB_TMO])) break; if (_sp > XB_SPIN_CAP) { atomicAdd(&(bar)[XB_TMO], 1u); break; } } } } while (0)

struct XcdBarrier {
    unsigned* bar; unsigned x;
    volatile LAS unsigned* st;
};

__device__ __forceinline__ XcdBarrier xcd_barrier_post(unsigned* bar, volatile LAS unsigned* st) {
    XcdBarrier b; b.bar = bar; b.x = xb_xcc_id(); b.st = st;
    if (threadIdx.x == 0) st[2] = xb_add(&bar[XB_XCNT(b.x)], 1u);
    return b;
}
__device__ __forceinline__ void xcd_barrier_complete(unsigned* bar, unsigned x, unsigned& nloc, unsigned& nx, unsigned& even) {
    const unsigned G = gridDim.x * gridDim.y * gridDim.z;
    unsigned sum, cnt, mine, bal, sp = 0u;
    for (;;) {
        sum = 0u; cnt = 0u; mine = 0u; bal = 1u;
#pragma unroll
        for (unsigned j = 0; j < 16; ++j) { const unsigned c = xb_ld(&bar[XB_XCNT(j)]); sum += c; cnt += (c > 0u) ? 1u : 0u; mine = (j == x) ? c : mine; bal = (j < 8u && c * 8u != G) ? 0u : bal; }
        if (sum == G) break;
        __builtin_amdgcn_s_sleep(1);
        if ((++sp & 255u) == 0u) { if (xb_ld(&bar[XB_TMO])) break; if (sp > XB_SPIN_CAP) { atomicAdd(&bar[XB_TMO], 1u); break; } }
    }
    nloc = mine > 0u ? mine : 1u; nx = cnt > 0u ? cnt : 1u; even = (sum == G) ? bal : 0u;
}

__device__ __forceinline__ void xcd_barrier(const XcdBarrier& b) {
    asm volatile("s_waitcnt vmcnt(0)" ::: "memory");
    __syncthreads();
    if (threadIdx.x == 0) {
        unsigned* bar = b.bar;
        __builtin_amdgcn_s_waitcnt(0);
        unsigned nloc = b.st[0], nx = b.st[1];
        if (nloc == 0u) { unsigned ev; xcd_barrier_complete(bar, b.x, nloc, nx, ev); b.st[0] = nloc; b.st[1] = nx; b.st[3] = ev; }
        const unsigned old = xb_add(&bar[XB_XSUB(b.x)], 1u);
        const unsigned gen = old / nloc;
        if (old + 1u == (gen + 1u) * nloc) {
            __builtin_amdgcn_fence(__ATOMIC_RELEASE, "agent");
            asm volatile("s_waitcnt vmcnt(0)" ::: "memory");
            const unsigned og = xb_add(&bar[XB_TOP], 1u);
            const unsigned tg = og / nx;
            if (og + 1u == (tg + 1u) * nx) xb_add(&bar[XB_TOPGEN], 1u);
            else XB_SPIN(xb_ld(&bar[XB_TOPGEN]) == tg, bar);
            __builtin_amdgcn_fence(__ATOMIC_ACQUIRE, "agent");
            xb_add(&bar[XB_XGEN(b.x)], 1u);
            asm volatile("s_waitcnt vmcnt(0)" ::: "memory");
        } else {
            XB_SPIN(xb_ld(&bar[XB_XGEN(b.x)]) == gen, bar);
            __builtin_amdgcn_fence(__ATOMIC_ACQUIRE, "agent");
            asm volatile("s_waitcnt vmcnt(0)" ::: "memory");
        }
    }
    __syncthreads();
}
namespace hy {
using f32x16 = __attribute__((ext_vector_type(16))) float;
constexpr int UL = 2088, ULB = UL * 2;
constexpr int GOFF = 2064;
constexpr int L_U = 0, L_U2 = 8 * ULB, L_X = 2 * 8 * ULB, L_G0 = L_X + 8 * 2048 * 2, L_G1 = L_G0 + GT_LD * 2, L_END = L_G1 + GT_LD * 2;
static_assert(L_END <= RING_BYTES, "hyena LDS");
__device__ __forceinline__ void prep(const Frame& F, const Params& P) {
    char* ws = F.ws; const bf16_t* Z = (const bf16_t*)(ws + WS_Z); bf16_t* ZT = (bf16_t*)(ws + WS_ZT); const float* cw = PIN(24); const float* cb = PIN(25);
    const int gw = F.bid * NWAVES + F.wave, NGW = F.G * NWAVES, lane = F.lane; LAS unsigned char* tl = F.lds + RING_OFF + F.wave * 8192;
    for (int it = gw; it < 24 * 8 * 64; it += NGW) { const int cg = it % 24, b = (it / 24) & 7, tt = it / 192; const int c = cg * 64 + lane, t0 = tt * 32;
        const float w0 = cw[c], w1 = cw[1536 + c], w2 = cw[3072 + c], bias = cb[c];
        const bf16_t* zp = Z + ((size_t)b * RPB + CTX) * CD_LD + cg * 64;
        v4u pc[5];
#pragma unroll
        for (int k = 0; k < 5; ++k) { const int p = lane + 64 * k, row = p >> 3, c8 = p & 7, t = t0 - 1 + row; pc[k] = (p < 272 && t >= 0 && t < SEQ) ? *(const v4u*)(zp + (size_t)t * CD_LD + c8 * 8) : (v4u){0u, 0u, 0u, 0u}; }
#pragma unroll
        for (int k = 0; k < 5; ++k) { const int p = lane + 64 * k, row = p >> 3, c8 = p & 7; if (p < 272) *(LAS v4u*)(tl + row * 144 + c8 * 16) = pc[k]; }
        LDS_WAIT(); asm volatile("" ::: "memory");
        float xr[34];
#pragma unroll
        for (int i = 0; i < 34; ++i) xr[i] = bf2f(*(const LAS bf16_t*)(tl + i * 144 + lane * 2));
        LDS_WAIT(); asm volatile("" ::: "memory");
        bf16_t* op = ZT + ((size_t)c * NB + b) * SEQ + t0;
#pragma unroll
        for (int j8 = 0; j8 < 4; ++j8) { float y[8];
#pragma unroll
            for (int jj = 0; jj < 8; ++jj) { const int i = j8 * 8 + jj; y[jj] = bias + w0 * xr[i] + w1 * xr[i + 1] + w2 * xr[i + 2]; }
            v4u o; o.x = pk2(y[0], y[1]); o.y = pk2(y[2], y[3]); o.z = pk2(y[4], y[5]); o.w = pk2(y[6], y[7]); *(v4u*)(op + j8 * 8) = o; } }
}
__device__ __forceinline__ void filt(const Frame& F, const Params& P) {
    char* ws = F.ws; bf16_t* GT = (bf16_t*)(ws + WS_GT);
    const float *w1 = PIN(26), *b1 = PIN(27), *w2 = PIN(28), *b2 = PIN(29), *w3 = PIN(30), *freq = PIN(31);
    LAS float* z = (LAS float*)(F.lds + RING_OFF); LAS float* h1 = z + 9 * 64; LAS float* h2 = h1 + 9 * 64;
    const int tid = F.tid;
    for (int tb = F.bid; tb < SEQ / 8; tb += F.G) {
        const int t0 = tb * 8;
        __syncthreads();
        if (tid < 9 * 33) { const int tt = tid / 33, k = tid % 33, t = t0 + tt; float zv = (float)t / (float)(SEQ - 1);
            if (k > 0) { const int bi = (k - 1) & 15; const double band = 1e-4 + (15.0 - 1e-4) * (double)bi / 15.0; const double rev = (double)t * band * (1.0 / (double)SEQ);
                const float fr = (float)(rev - floor(rev)); zv = k <= 16 ? __builtin_amdgcn_cosf(fr) : -__builtin_amdgcn_sinf(fr); }
            z[tt * 64 + k] = zv; }
        __syncthreads();
        for (int idx = tid; idx < 9 * 64; idx += NTHREADS) { const int tt = idx >> 6, j = idx & 63; float a = b1[j];
#pragma unroll
            for (int i = 0; i < 33; ++i) a += z[tt * 64 + i] * w1[i * 64 + j];
            h1[idx] = __sinf(freq[j] * a); }
        __syncthreads();
        for (int idx = tid; idx < 9 * 64; idx += NTHREADS) { const int tt = idx >> 6, j = idx & 63; float a = b2[j];
#pragma unroll 16
            for (int i = 0; i < 64; ++i) a += h1[tt * 64 + i] * w2[i * 64 + j];
            h2[idx] = __sinf(freq[j] * a); }
        __syncthreads();
        float acc[4][9];
#pragma unroll
        for (int q = 0; q < 4; ++q)
#pragma unroll
            for (int tt = 0; tt < 9; ++tt) acc[q][tt] = 0.f;
#pragma unroll 16
        for (int i = 0; i < 64; ++i) { float wv[4];
#pragma unroll
            for (int q = 0; q < 4; ++q) wv[q] = w3[(size_t)i * 2048 + tid + 512 * q];
#pragma unroll
            for (int tt = 0; tt < 9; ++tt) { const float hv = h2[tt * 64 + i];
#pragma unroll
                for (int q = 0; q < 4; ++q) acc[q][tt] += hv * wv[q]; } }
        const double mind = log(1e-2) / 1.5, maxd = log(1e-2) / 0.3; const int ch = tid; const float delta = fabsf((float)(mind + (maxd - mind) * (double)ch / 511.0));
        float win[9];
#pragma unroll
        for (int tt = 0; tt < 9; ++tt) { const int t = t0 + tt; win[tt] = t < SEQ ? __expf(-((float)t / (float)(SEQ - 1)) * delta) + 0.05f : 0.f; }
#pragma unroll
        for (int ord = 0; ord < 2; ++ord) { bf16_t* gp = GT + ((size_t)ord * 512 + ch) * GT_LD + GOFF; float fw[9], bw[9];
#pragma unroll
            for (int tt = 0; tt < 9; ++tt) { fw[tt] = acc[2 * ord][tt] * win[tt]; bw[tt] = acc[2 * ord + 1][tt] * win[tt]; }
            if (t0 == 0) bw[0] = fw[0];
            v4u ob; ob.x = pk2(bw[0], bw[1]); ob.y = pk2(bw[2], bw[3]); ob.z = pk2(bw[4], bw[5]); ob.w = pk2(bw[6], bw[7]); *(v4u*)(gp + t0) = ob;
            v4u of; of.x = pk2(fw[8], fw[7]); of.y = pk2(fw[6], fw[5]); of.z = pk2(fw[4], fw[3]); of.w = pk2(fw[2], fw[1]); *(v4u*)(gp - t0 - 8) = of; }
    }
    const int gt = F.bid * NTHREADS + F.tid, NGT = F.G * NTHREADS; constexpr int NZ = 16 + (GT_LD - GOFF - 2048);
    for (int i = gt; i < 1024 * NZ; i += NGT) { const int oc = i / NZ, k = i % NZ; GT[(size_t)oc * GT_LD + (k < 16 ? k : GOFF + 2048 + (k - 16))] = 0; }
}
__device__ __forceinline__ void conv_mfma(f32x16 (&acc)[2], LAS unsigned char* Ub, LAS unsigned char* Gb, int wave, int lane) {
    const int n = lane & 31, h = lane >> 5, b = n >> 2, dl = n & 3;
    const LAS unsigned char* up = Ub + b * ULB + 16 * h;
    const int i = lane & 31;
    const LAS unsigned char* gp0 = Gb + 2 * (GOFF + 8 * h - 4 * i - 16 * (8 * (2 * wave) + 1));
    const LAS unsigned char* gp1 = gp0 - 2 * 16 * 8;
    acc[0] = f32x16{}; acc[1] = f32x16{};
    const bool sh2 = dl >= 2; const unsigned sb = (dl & 1) * 2;
    const LAS unsigned char* upq = up + 8 * (dl < 3 ? dl : 2);
    u32x4 ring[8];
#pragma unroll
    for (int b8 = 0; b8 < 8; ++b8) { const u32x2 a0 = *(const LAS u32x2*)(gp1 + 32 * b8), a1 = *(const LAS u32x2*)(gp1 + 32 * b8 + 8); ring[b8] = (u32x4){a0[0], a0[1], a1[0], a1[1]}; }
#define HY_STEP(J, b8) do { \
          \
        const u32x2 qx = *(const LAS u32x2*)(upq + 32 * (J)); \
        unsigned q[6]; \
        q[0] = __builtin_amdgcn_mov_dpp((int)qx[0], 0x00, 0xF, 0xF, false); q[1] = __builtin_amdgcn_mov_dpp((int)qx[1], 0x00, 0xF, 0xF, false); \
        q[2] = __builtin_amdgcn_mov_dpp((int)qx[0], 0x55, 0xF, 0xF, false); q[3] = __builtin_amdgcn_mov_dpp((int)qx[1], 0x55, 0xF, 0xF, false); \
        q[4] = __builtin_amdgcn_mov_dpp((int)qx[0], 0xAA, 0xF, 0xF, false); q[5] = __builtin_amdgcn_mov_dpp((int)qx[1], 0xAA, 0xF, 0xF, false); \
        u32x4 bw; \
        _Pragma("unroll") for (int w = 0; w < 4; ++w) { const unsigned lo = sh2 ? q[w + 1] : q[w], hi_ = sh2 ? q[w + 2] : q[w + 1]; bw[w] = __builtin_amdgcn_alignbyte(hi_, lo, sb); } \
        const u32x2 a00 = *(const LAS u32x2*)(gp0 + 32 * (J)), a01 = *(const LAS u32x2*)(gp0 + 32 * (J) + 8); \
        const u32x4 A1 = ring[b8]; const u32x4 A0 = {a00[0], a00[1], a01[0], a01[1]}; ring[b8] = A0; \
        acc[0] = __builtin_amdgcn_mfma_f32_32x32x16_bf16(__builtin_bit_cast(bf16x8, A0), __builtin_bit_cast(bf16x8, bw), acc[0], 0, 0, 0); \
        acc[1] = __builtin_amdgcn_mfma_f32_32x32x16_bf16(__builtin_bit_cast(bf16x8, A1), __builtin_bit_cast(bf16x8, bw), acc[1], 0, 0, 0); } while (0)
#pragma unroll 1
    for (int J8 = 0; J8 < 128; J8 += 8) {
#pragma unroll
        for (int b8 = 0; b8 < 8; ++b8) HY_STEP(J8 + b8, b8); }
    HY_STEP(128, 0);
#undef HY_STEP
}
__device__ __forceinline__ void main_phase(const Frame& F, const Params& P) {
    char* ws = F.ws; const bf16_t* ZT = (const bf16_t*)(ws + WS_ZT); const bf16_t* GT = (const bf16_t*)(ws + WS_GT); bf16_t* HT = (bf16_t*)(ws + WS_HT); const float* skip = PIN(32);
    LAS unsigned char* lds = F.lds + RING_OFF; const int tid = F.tid, lane = F.lane, wave = F.wave;
    const int n = lane & 31, h = lane >> 5, b = n >> 2, dl = n & 3;
    for (int c = F.bid; c < 512; c += F.G) {
        __syncthreads();
        for (int i = tid; i < 8 * 256; i += NTHREADS) { const int bb = i >> 8, k = i & 255; *(LAS v4u*)(lds + L_U + bb * ULB + 32 + k * 16) = *(const v4u*)(ZT + ((size_t)c * NB + bb) * SEQ + k * 8);
            *(LAS v4u*)(lds + L_X + (bb * 2048 + k * 8) * 2) = *(const v4u*)(ZT + ((size_t)(512 + c) * NB + bb) * SEQ + k * 8); }
        for (int i = tid; i < GT_LD / 8; i += NTHREADS) { *(LAS v4u*)(lds + L_G0 + i * 16) = *(const v4u*)(GT + (size_t)c * GT_LD + i * 8); *(LAS v4u*)(lds + L_G1 + i * 16) = *(const v4u*)(GT + (size_t)(512 + c) * GT_LD + i * 8); }
        if (tid < 80) { const int bb = tid / 10, k = tid % 10, which = k / 5, part = k % 5; const int off = bb * ULB + (part < 2 ? part * 16 : (16 + 2048) * 2 + (part - 2) * 16);
            *(LAS v4u*)(lds + (which ? L_U2 : L_U) + off) = (v4u){0u, 0u, 0u, 0u}; }
        __syncthreads();
        const float sk0 = skip[c], sk1 = skip[512 + c];
        f32x16 acc[2];
        conv_mfma(acc, lds + L_U, lds + L_G0, wave, lane);
#pragma unroll
        for (int ip = 0; ip < 2; ++ip)
#pragma unroll
            for (int r = 0; r < 16; ++r) { const int t = 128 * (2 * wave + ip) + 4 * att::crow(r, h) + dl;
                const float v = bf2f(*(const LAS bf16_t*)(lds + L_U + b * ULB + (16 + t) * 2)), x1 = bf2f(*(const LAS bf16_t*)(lds + L_X + (b * 2048 + t) * 2));
                *(LAS bf16_t*)(lds + L_U2 + b * ULB + (16 + t) * 2) = f2bf(x1 * (acc[ip][r] + sk0 * v)); }
        __syncthreads();
        for (int i = tid; i < 8 * 256; i += NTHREADS) { const int bb = i >> 8, k = i & 255; *(LAS v4u*)(lds + L_X + (bb * 2048 + k * 8) * 2) = *(const v4u*)(ZT + ((size_t)(1024 + c) * NB + bb) * SEQ + k * 8); }
        conv_mfma(acc, lds + L_U2, lds + L_G1, wave, lane);
        __syncthreads();
#pragma unroll
        for (int ip = 0; ip < 2; ++ip)
#pragma unroll
            for (int r = 0; r < 16; ++r) { const int t = 128 * (2 * wave + ip) + 4 * att::crow(r, h) + dl;
                const float y1 = bf2f(*(const LAS bf16_t*)(lds + L_U2 + b * ULB + (16 + t) * 2)), x2 = bf2f(*(const LAS bf16_t*)(lds + L_X + (b * 2048 + t) * 2));
                *(LAS bf16_t*)(lds + L_U + (b * 2048 + t) * 2) = f2bf(x2 * (acc[ip][r] + sk1 * y1)); }
        __syncthreads();
        for (int i = tid; i < 8 * 256; i += NTHREADS) *(v4u*)(HT + (size_t)c * NLAT + i * 8) = *(const LAS v4u*)(lds + L_U + i * 16);
    }
}
__device__ __forceinline__ void untranspose(const Frame& F) {
    char* ws = F.ws; const bf16_t* HT = (const bf16_t*)(ws + WS_HT); bf16_t* Y = (bf16_t*)(ws + WS_Y);
    const int gw = F.bid * NWAVES + F.wave, NGW = F.G * NWAVES, lane = F.lane; LAS unsigned char* tl = F.lds + RING_OFF + F.wave * 16384;
    __syncthreads();
    for (int it = gw; it < 8 * 8 * 32; it += NGW) { const int cg = it & 7, b = (it >> 3) & 7, tt = it >> 6; const int c = cg * 64 + lane, t0 = tt * 64;
        const bf16_t* hp = HT + ((size_t)c * NB + b) * SEQ + t0; bf16_t* yp = Y + ((size_t)b * RPB + CTX + t0) * DM + cg * 64;
        v4u q[8];
#pragma unroll
        for (int j8 = 0; j8 < 8; ++j8) q[j8] = *(const v4u*)(hp + j8 * 8);
#pragma unroll
        for (int j8 = 0; j8 < 8; ++j8)
#pragma unroll
            for (int jj = 0; jj < 4; ++jj) { *(LAS bf16_t*)(tl + (j8 * 8 + 2 * jj) * 144 + lane * 2) = (bf16_t)(q[j8][jj] & 0xffffu); *(LAS bf16_t*)(tl + (j8 * 8 + 2 * jj + 1) * 144 + lane * 2) = (bf16_t)(q[j8][jj] >> 16); }
        LDS_WAIT(); asm volatile("" ::: "memory");
#pragma unroll
        for (int k = 0; k < 8; ++k) { const int p = lane + 64 * k, row = p >> 3, c8 = p & 7; *(v4u*)(yp + (size_t)row * DM + c8 * 8) = *(const LAS v4u*)(tl + row * 144 + c8 * 16); }
        LDS_WAIT(); asm volatile("" ::: "memory"); }
}
}
namespace lru {
using f32x16 = __attribute__((ext_vector_type(16))) float;
typedef float f32x2 __attribute__((ext_vector_type(2)));
constexpr int T = 32, NCH = RPB / T;
constexpr int UPITCH = 1040;
constexpr int L_UT = 0, L_GL = 34816, L_END = L_GL + 2 * T * 512 * 2;
static_assert(L_END <= RING_BYTES, "lru LDS");
__device__ __forceinline__ float fsigmoid(float x) { return __builtin_amdgcn_rcpf(1.f + __builtin_amdgcn_exp2f(-LOG2E * x)); }
__device__ __forceinline__ float gelu_fast(float x) { const float y = 0.7978845608028654f * (x + 0.044715f * x * x * x); const float e = __builtin_amdgcn_exp2f(2.f * LOG2E * y); const float th = 1.f - 2.f * __builtin_amdgcn_rcpf(1.f + e); return 0.5f * x * (1.f + th); }
__device__ __forceinline__ int chunk_of_order(int d, int q) { return d == 0 ? q : (q < 8 ? 7 - q : 79 - q); }
__device__ __forceinline__ int order_of_chunk(int d, int j) { return d == 0 ? j : (j < 8 ? 7 - j : 79 - j); }

__device__ __forceinline__ void unit0(const Frame& F, const Params& P, int b, int j) {
    char* ws = F.ws; const bf16_t* Z = (const bf16_t*)(ws + WS_Z); float* AGG = (float*)(ws + WS_AGG); const bf16_t* WL = (const bf16_t*)(ws + WS_WLRU);
    bf16_t* LAB = (bf16_t*)P.out; bf16_t* BTB = (bf16_t*)(ws + WS_H);
    LAS unsigned char* lds = F.lds + RING_OFF; const int ch = F.tid, lane = F.lane, wave = F.wave;
    const int s0 = j * T, seg_lo = s0 < CTX ? 0 : CTX, seg_hi = s0 < CTX ? CTX : RPB; const size_t row0 = (size_t)b * RPB + s0;
    LDS_WAIT(); asm volatile("" ::: "memory");
    float u[T];
    { const float w0 = PIN(10)[ch], w1 = PIN(10)[512 + ch], w2 = PIN(10)[1024 + ch], w3 = PIN(10)[1536 + ch], cb = PIN(11)[ch];
      float xw[T + 3];
#pragma unroll
      for (int i = 0; i < T + 3; ++i) { const int s = s0 + i - 2; xw[i] = (s >= seg_lo && s < seg_hi) ? bf2f(Z[((size_t)b * RPB + s) * AB_IN + ch]) : 0.f; }
#pragma unroll
      for (int t = 0; t < T; ++t) { u[t] = cb + w0 * xw[t] + w1 * xw[t + 1] + w2 * xw[t + 2] + w3 * xw[t + 3]; *(LAS bf16_t*)(lds + L_UT + t * UPITCH + ch * 2) = f2bf(u[t]); } }
#pragma unroll
    for (int d = 0; d < 2; ++d) {
        LDS_WAIT(); asm volatile("" ::: "memory");
        { const int n = wave, r32 = lane & 31, h = lane >> 5; bf16x8 af[4];
#pragma unroll
          for (int ks = 0; ks < 4; ++ks) af[ks] = *(const LAS bf16x8*)(lds + L_UT + r32 * UPITCH + (64 * n + 16 * ks + 8 * h) * 2);
#pragma unroll
          for (int g = 0; g < 2; ++g)
#pragma unroll
              for (int cb = 0; cb < 2; ++cb) { f32x16 acc = f32x16{}; const bf16_t* wp = WL + ((size_t)((d * 8 + n) * 2 + g) * 64 + 32 * cb + r32) * 64 + 8 * h;
#pragma unroll
                  for (int ks = 0; ks < 4; ++ks) { const bf16x8 bfr = *(const bf16x8*)(wp + 16 * ks); acc = __builtin_amdgcn_mfma_f32_32x32x16_bf16(af[ks], bfr, acc, 0, 0, 0); }
                  const float bias = (g == 0 ? PIN(13) : PIN(15))[(d * 8 + n) * 64 + 32 * cb + r32];
#pragma unroll
                  for (int r = 0; r < 16; ++r) *(LAS bf16_t*)(lds + L_GL + ((g * T + att::crow(r, h)) * 512 + 64 * n + 32 * cb + r32) * 2) = f2bf(fsigmoid(acc[r] + bias)); } }
        LDS_WAIT(); asm volatile("" ::: "memory");
        const float cl = -8.f * softplus_f(-PIN(16)[d * 512 + ch]);
        float h = 0.f, sumlog = 0.f; bf16_t* lap = LAB + ((size_t)d * MROWS + row0) * 512 + ch; bf16_t* btp = BTB + ((size_t)d * MROWS + row0) * 512 + ch;
#pragma unroll
        for (int st = 0; st < T; ++st) { const int t = d == 0 ? st : T - 1 - st;
            const float rg = bf2f(*(const LAS bf16_t*)(lds + L_GL + (t * 512 + ch) * 2)), ig = bf2f(*(const LAS bf16_t*)(lds + L_GL + ((T + t) * 512 + ch) * 2));
            const bf16_t lab = f2bf(cl * rg); const float la = bf2f(lab); const float a = __builtin_amdgcn_exp2f(LOG2E * la);
            const bf16_t btb = f2bf(__builtin_amdgcn_sqrtf(fmaf(-a, a, 1.f)) * (ig * u[t])); const float bt = bf2f(btb);
            lap[(size_t)t * 512] = lab; btp[(size_t)t * 512] = btb;
            h = a * h + bt; sumlog += la; }
        { f32x2* ag = (f32x2*)AGG + ((size_t)(d * 8 + b) * NCH + j) * 512 + ch; *ag = (f32x2){sumlog, h}; }
    }
}
__device__ __forceinline__ void unit1(const Frame& F, const Params& P, int b, int j) {
    char* ws = F.ws; const bf16_t* Z = (const bf16_t*)(ws + WS_Z); bf16_t* Y = (bf16_t*)(ws + WS_Y); const float* AGG = (const float*)(ws + WS_AGG);
    const bf16_t* LAB = (const bf16_t*)P.out; const bf16_t* BTB = (const bf16_t*)(ws + WS_H);
    const int ch = F.tid; const size_t row0 = (size_t)b * RPB + j * T;
    float hf[T];
#pragma unroll
    for (int d = 0; d < 2; ++d) {
        const bf16_t* lap = LAB + ((size_t)d * MROWS + row0) * 512 + ch; const bf16_t* btp = BTB + ((size_t)d * MROWS + row0) * 512 + ch;
        bf16_t lav[T], btv[T]; bf16_t gv[T];
#pragma unroll
        for (int t = 0; t < T; ++t) { lav[t] = lap[(size_t)t * 512]; btv[t] = btp[(size_t)t * 512]; if (d == 1) gv[t] = Z[(row0 + t) * AB_IN + 512 + ch]; }
        float h = 0.f;
        { const int q = order_of_chunk(d, j); const f32x2* ag = (const f32x2*)AGG + (size_t)(d * 8 + b) * NCH * 512 + ch;
#pragma unroll 24
          for (int qq = 0; qq < q; ++qq) { const int jj = chunk_of_order(d, qq); const f32x2 av = ag[(size_t)jj * 512]; h = __builtin_amdgcn_exp2f(LOG2E * av[0]) * h + av[1]; } }
#pragma unroll
        for (int st = 0; st < T; ++st) { const int t = d == 0 ? st : T - 1 - st;
            h = __builtin_amdgcn_exp2f(LOG2E * bf2f(lav[t])) * h + bf2f(btv[t]);
            if (d == 0) hf[t] = h; else Y[(row0 + t) * DM + ch] = f2bf((hf[t] + h) * gelu_fast(bf2f(gv[t]))); }
    }
}
template <int MODE>
__device__ __forceinline__ void phase(const Frame& F, const Params& P) {
    const int first = MODE == 0 ? F.bid : (F.bid + 192) % F.G;
    for (int L = first; L < NB * NCH; L += F.G) { if (MODE == 0) unit0(F, P, L & 7, L >> 3); else unit1(F, P, L & 7, L >> 3); }
}
}
namespace el {
__device__ __forceinline__ void mod_phase(const Frame& F, const Params& P) {
    char* ws = F.ws; float* MOD = (float*)(ws + WS_MOD); const float* c = PIN(1); const float* cctx = PIN(3); const float* mw = PIN(4); const float* mb = PIN(5);
    LAS float* sc = (LAS float*)(F.lds + RING_OFF); LAS float* part = sc + 9 * DM;
    if (F.bid >= 192) return;
    for (int i = F.tid; i < 9 * DM; i += NTHREADS) { const int j = i >> 10, k = i & 1023; const float v = j < 8 ? c[j * DM + k] : cctx[k]; sc[i] = v / (1.f + expf(-v)); }
    __syncthreads();
    const int cg = F.lane & 15, kr = F.lane >> 4; const int col = F.bid * 64 + 4 * cg, l = col / MODLD, n = col % MODLD; const float* w = mw + (size_t)l * DM * MODLD + n; const int k0 = F.wave * 128 + kr;
    f32x4 acc[9];
#pragma unroll
    for (int j = 0; j < 9; ++j) acc[j] = (f32x4){0.f, 0.f, 0.f, 0.f};
#pragma unroll 8
    for (int i = 0; i < 32; ++i) { const int k = k0 + 4 * i; const f32x4 wv = __builtin_nontemporal_load((const f32x4*)(w + (size_t)k * MODLD));
#pragma unroll
        for (int j = 0; j < 9; ++j) acc[j] += wv * sc[j * DM + k]; }
#pragma unroll
    for (int j = 0; j < 9; ++j) {
#pragma unroll
        for (int c = 0; c < 4; ++c) { float v = acc[j][c]; v += __shfl_xor(v, 16); v += __shfl_xor(v, 32); acc[j][c] = v; }
        if (kr == 0) *(LAS f32x4*)(part + (F.wave * 9 + j) * 64 + 4 * cg) = acc[j]; }
    __syncthreads();
    for (int i = F.tid; i < 9 * 64; i += NTHREADS) { const int j = i >> 6, ln = i & 63; float s = 0.f;
#pragma unroll
        for (int wv = 0; wv < 8; ++wv) s += part[(wv * 9 + j) * 64 + ln];
        const int cc = F.bid * 64 + ln; MOD[((size_t)(cc / MODLD) * 9 + j) * MODLD + cc % MODLD] = s + mb[cc]; }
    __syncthreads();
}
__device__ __forceinline__ void bias_phase(const Frame& F, const Params& P) {
    char* ws = F.ws; const float* MOD = (const float*)(ws + WS_MOD);
    LAS float* sc = (LAS float*)(F.lds + RING_OFF); LAS float* part = sc + 9 * DM;
    if (F.bid >= 120) return;
    const bool f1 = F.bid < 88; const float* shb = f1 ? MOD + 3 * DM : MOD + 9 * MODLD;
    __syncthreads();
    for (int i = F.tid; i < 9 * DM; i += NTHREADS) sc[i] = shb[(size_t)(i >> 10) * MODLD + (i & 1023)];
    __syncthreads();
    const int cg = F.lane & 15, kr = F.lane >> 4; const int cc = (f1 ? F.bid : F.bid - 88) * 64 + 4 * cg; const float* w; int ldw; bool valid = true;
    if (f1) { const int pn = cc >> 8, c = cc & 255; w = (c < 128 ? PIN(19) : PIN(20)) + pn * 128 + (c & 127); ldw = DFF; } else { valid = cc < CD_IN; w = PIN(22) + (valid ? cc : 0); ldw = CD_IN; }
    const int k0 = F.wave * 128 + kr; f32x4 acc[9];
#pragma unroll
    for (int j = 0; j < 9; ++j) acc[j] = (f32x4){0.f, 0.f, 0.f, 0.f};
#pragma unroll 8
    for (int i = 0; i < 32; ++i) { const int k = k0 + 4 * i; const f32x4 wv = *(const f32x4*)(w + (size_t)k * ldw);
#pragma unroll
        for (int j = 0; j < 9; ++j) acc[j] += wv * sc[j * DM + k]; }
#pragma unroll
    for (int j = 0; j < 9; ++j) {
#pragma unroll
        for (int c = 0; c < 4; ++c) { float v = acc[j][c]; v += __shfl_xor(v, 16); v += __shfl_xor(v, 32); acc[j][c] = valid ? v : 0.f; }
        if (kr == 0) *(LAS f32x4*)(part + (F.wave * 9 + j) * 64 + 4 * cg) = acc[j]; }
    __syncthreads();
    for (int i = F.tid; i < 9 * 64; i += NTHREADS) { const int j = i >> 6, ln = i & 63; float s = 0.f;
#pragma unroll
        for (int wv = 0; wv < 8; ++wv) s += part[(wv * 9 + j) * 64 + ln];
        if (f1) ((float*)(ws + WS_CBF1))[(size_t)j * 5632 + F.bid * 64 + ln] = s; else ((float*)(ws + WS_CBIN1))[(size_t)j * 2048 + (F.bid - 88) * 64 + ln] = s; }
    __syncthreads();
}
template <int SRC>
__device__ __forceinline__ void norm_phase(const Frame& F, const Params& P, const float* g, const float* MODL, int ish, int isc) {
    char* ws = F.ws; bf16_t* H = (bf16_t*)(ws + WS_H); const int gw = F.bid * NWAVES + F.wave, lane = F.lane; const int rb = gw * 9;
    f32x4 gg[4], gs[4], sh[4]; int cur = -1;
#pragma unroll
    for (int j = 0; j < 4; ++j) gg[j] = *(const f32x4*)(g + 4 * lane + 256 * j);
#pragma unroll 1
    for (int r0 = rb; r0 < rb + 9; r0 += 3) {
        f32x4 v[3][4];
#pragma unroll
        for (int q = 0; q < 3; ++q) { const int r = r0 + q, b = r / RPB, s = r - b * RPB;
            const float* xr = s < CTX ? PIN(2) + ((size_t)b * CTX + s) * DM : PIN(0) + ((size_t)b * SEQ + (s - CTX)) * DM;
#pragma unroll
            for (int j = 0; j < 4; ++j) v[q][j] = *(const f32x4*)(xr + 4 * lane + 256 * j); }
#pragma unroll
        for (int q = 0; q < 3; ++q) { const int r = r0 + q, b = r / RPB, s = r - b * RPB; const int mrow = s < CTX ? 8 : b;
            if (mrow != cur) { cur = mrow; const float* md = MODL + (size_t)mrow * MODLD;
#pragma unroll
                for (int j = 0; j < 4; ++j) { const int k = 4 * lane + 256 * j; gs[j] = gg[j] * (*(const f32x4*)(md + isc * DM + k) + 1.f); sh[j] = *(const f32x4*)(md + ish * DM + k); } }
            float ss = 0.f;
#pragma unroll
            for (int j = 0; j < 4; ++j) ss += (v[q][j][0] * v[q][j][0] + v[q][j][1] * v[q][j][1]) + (v[q][j][2] * v[q][j][2] + v[q][j][3] * v[q][j][3]);
            const float rstd = rsqrtf(wave_sum(ss) / DM + EPS);
#pragma unroll
            for (int j = 0; j < 4; ++j) { const int k = 4 * lane + 256 * j; const f32x4 hv = v[q][j] * rstd * gs[j] + sh[j];
                u32x2 w; w.x = pk2(hv[0], hv[1]); w.y = pk2(hv[2], hv[3]); *(u32x2*)(H + (size_t)r * DM + k) = w; } }
    }
}
__device__ __forceinline__ void rope_tables(const Frame& F) {
    float* R0 = (float*)(F.ws + WS_ROPE0); float* R1 = (float*)(F.ws + WS_ROPE1); const int gt = F.bid * NTHREADS + F.tid, NGT = F.G * NTHREADS;
    for (int i = gt; i < SEQ * 48; i += NGT) { const int t = i / 48, k = i % 48; const float row = (float)(t >> 6), col = (float)(t & 63);
        const bool l0 = k < 32; const int kk = l0 ? k : k - 32; const int half = l0 ? 16 : 8;
        const float invf = exp2f(-(float)(kk & (half - 1)) * (13.287712379549449f / (float)half)); const float ang = (kk < half ? row : col) * invf; const float cv = cosf(ang), sv = sinf(ang);
        if (l0) { R0[t * 64 + kk] = cv; R0[t * 64 + 32 + kk] = sv; } else { R1[t * 32 + kk] = cv; R1[t * 32 + 16 + kk] = sv; } }
}
__device__ __forceinline__ void gqa_prep(const Frame& F, const Params& P) {
    char* ws = F.ws; const bf16_t* Z = (const bf16_t*)(ws + WS_Z); bf16_t* Q = (bf16_t*)(ws + WS_QB); bf16_t* K = (bf16_t*)(ws + WS_KB); bf16_t* V = (bf16_t*)(ws + WS_VB); const float* R0 = (const float*)(ws + WS_ROPE0);
    const int gw = F.bid * NWAVES + F.wave, NGW = F.G * NWAVES, lane = F.lane; const int d0 = 8 * (lane & 7), i0 = d0 & 31;
    float qn[8], kn[8];
#pragma unroll
    for (int e = 0; e < 8; ++e) { qn[e] = PIN(17)[d0 + e] * QSCALE0; kn[e] = PIN(18)[d0 + e]; }
    constexpr int R1 = 6912; const int nb2 = F.G - 64; const int gw2 = (F.bid - 64) * NWAVES + F.wave, NGW2 = nb2 * NWAVES;
    for (int pass = 0; pass < 2; ++pass) { const int base = pass == 0 ? 0 : R1, lim = pass == 0 ? R1 : MROWS, g0 = pass == 0 ? gw : gw2, ng = pass == 0 ? NGW : NGW2; if (pass == 1 && F.bid < 64) break;
    for (int r0 = base + g0; r0 < lim; r0 += 2 * ng) {
        v4u qv[2], kv[2]; f32x4 cs[2][2], sn[2][2];
#pragma unroll
        for (int q = 0; q < 2; ++q) { const int r = r0 + q * ng; if (r < lim) { const bf16_t* z = Z + (size_t)r * AB_IN + 1024; const int s = r % RPB;
            qv[q] = *(const v4u*)(z + 8 * lane); kv[q] = lane < 32 ? *(const v4u*)(z + 512 + 8 * lane) : (v4u){0u, 0u, 0u, 0u};
            if (s >= CTX) { const float* rp = R0 + (size_t)(s - CTX) * 64 + i0; cs[q][0] = *(const f32x4*)rp; cs[q][1] = *(const f32x4*)(rp + 4); sn[q][0] = *(const f32x4*)(rp + 32); sn[q][1] = *(const f32x4*)(rp + 36); } } }
#pragma unroll
        for (int q = 0; q < 2; ++q) { const int r = r0 + q * ng; if (r < lim) { const bool lat = (r % RPB) >= CTX;
#pragma unroll
            for (int ps = 0; ps < 2; ++ps) { const v4u raw = ps == 0 ? qv[q] : kv[q]; float x[8];
#pragma unroll
                for (int e = 0; e < 4; ++e) { x[2 * e] = __uint_as_float(raw[e] << 16); x[2 * e + 1] = __uint_as_float(raw[e] & 0xffff0000u); }
                float ss = 0.f;
#pragma unroll
                for (int e = 0; e < 8; ++e) ss += x[e] * x[e];
                ss += __shfl_xor(ss, 1); ss += __shfl_xor(ss, 2); ss += __shfl_xor(ss, 4);
                const float rs = rsqrtf(ss * (1.f / 64.f) + EPS); float y[8];
#pragma unroll
                for (int e = 0; e < 8; ++e) y[e] = x[e] * rs * (ps == 0 ? qn[e] : kn[e]);
                if (lat) {
#pragma unroll
                    for (int e = 0; e < 8; ++e) { const float other = __shfl_xor(y[e], 4); const float c = cs[q][e >> 2][e & 3], s_ = sn[q][e >> 2][e & 3]; y[e] = (lane & 4) ? (other * s_ + y[e] * c) : (y[e] * c - other * s_); } }
                v4u o; o.x = pk2(y[0], y[1]); o.y = pk2(y[2], y[3]); o.z = pk2(y[4], y[5]); o.w = pk2(y[6], y[7]);
                if (ps == 0) *(v4u*)(Q + (size_t)r * 512 + 8 * lane) = o;
                else if (lane < 16) *(v4u*)(K + (size_t)r * 128 + 8 * lane) = o;
                else if (lane < 32) *(v4u*)(V + (size_t)r * 128 + 8 * (lane - 16)) = raw; } } }
    } }
}
__device__ __forceinline__ void mla_prep1(const Frame& F, const Params& P) {
    char* ws = F.ws; const bf16_t* Z = (const bf16_t*)(ws + WS_Z); bf16_t* QA = (bf16_t*)(ws + WS_QA); bf16_t* KVA = (bf16_t*)(ws + WS_KVA); bf16_t* KR = (bf16_t*)(ws + WS_KR);
    const int gw = F.bid * NWAVES + F.wave, NGW = F.G * NWAVES, lane = F.lane; const float* gq = PIN(33); const float* gkv = PIN(35);
    const f32x4 g4 = *(const f32x4*)(gq + 4 * lane); const float gk0 = gkv[2 * lane], gk1 = gkv[2 * lane + 1];
    for (int r0 = gw; r0 < MROWS; r0 += 3 * NGW) {
        u32x2 qw[3]; unsigned kw[3], krw[3];
#pragma unroll
        for (int q = 0; q < 3; ++q) { const int r = r0 + q * NGW; if (r < MROWS) { const bf16_t* z = Z + (size_t)r * CD_LD; qw[q] = *(const u32x2*)(z + 1536 + 4 * lane); kw[q] = *(const unsigned*)(z + 1792 + 2 * lane); krw[q] = lane < 16 ? *(const unsigned*)(z + 1920 + 2 * lane) : 0u; } }
#pragma unroll
        for (int q = 0; q < 3; ++q) { const int r = r0 + q * NGW; if (r < MROWS) {
            const float q0 = __uint_as_float(qw[q].x << 16), q1 = __uint_as_float(qw[q].x & 0xffff0000u), q2 = __uint_as_float(qw[q].y << 16), q3 = __uint_as_float(qw[q].y & 0xffff0000u);
            const float k0 = __uint_as_float(kw[q] << 16), k1 = __uint_as_float(kw[q] & 0xffff0000u);
            const float rq = rsqrtf(wave_sum((q0 * q0 + q1 * q1) + (q2 * q2 + q3 * q3)) * (1.f / 256.f) + EPS), rk = rsqrtf(wave_sum(k0 * k0 + k1 * k1) * (1.f / 128.f) + EPS);
            u32x2 o; o.x = pk2(q0 * rq * g4[0], q1 * rq * g4[1]); o.y = pk2(q2 * rq * g4[2], q3 * rq * g4[3]); *(u32x2*)(QA + (size_t)r * 256 + 4 * lane) = o;
            *(unsigned*)(KVA + (size_t)r * 256 + 2 * lane) = pk2(k0 * rk * gk0, k1 * rk * gk1); *(unsigned*)(KVA + (size_t)r * 256 + 128 + 2 * lane) = 0u;
            if (lane < 16) *(unsigned*)(KR + (size_t)r * 32 + 2 * lane) = krw[q]; } }
    }
}
__device__ __forceinline__ void mla_prep2(const Frame& F, const Params& P) {
    char* ws = F.ws; char* dob = (char*)P.out; const bf16_t* QR = (const bf16_t*)(ws + WS_QR); const bf16_t* KVR = (const bf16_t*)(ws + WS_KVR); const bf16_t* KR = (const bf16_t*)(ws + WS_KR);
    bf16_t* QM = (bf16_t*)(ws + WS_QM); bf16_t* KM = (bf16_t*)(dob + DO_KM); bf16_t* VM = (bf16_t*)(dob + DO_VM); const float* R1 = (const float*)(ws + WS_ROPE1);
    const int gw = F.bid * NWAVES + F.wave, NGW = F.G * NWAVES, lane = F.lane; const int h = lane >> 3, sub = lane & 7; const bool rl = sub < 4; const int rs8 = 8 * (sub & 3), ti = rs8 & 15;
    float qn0[8], qn1[8], kn0[8], kn1[8];
#pragma unroll
    for (int e = 0; e < 8; ++e) { qn0[e] = PIN(37)[8 * sub + e] * QSCALE1; qn1[e] = PIN(37)[64 + rs8 + e] * QSCALE1; kn0[e] = PIN(38)[8 * sub + e]; kn1[e] = PIN(38)[64 + rs8 + e]; }
#define MP2_UNPK(raw, x) _Pragma("unroll") for (int e_ = 0; e_ < 4; ++e_) { x[2 * e_] = __uint_as_float(raw[e_] << 16); x[2 * e_ + 1] = __uint_as_float(raw[e_] & 0xffff0000u); }
#define MP2_PK(y) (v4u){pk2(y[0], y[1]), pk2(y[2], y[3]), pk2(y[4], y[5]), pk2(y[6], y[7])}
    for (int r = gw; r < MROWS; r += NGW) { const int s = r % RPB; const bool lat = s >= CTX;
        const v4u kraw = *(const v4u*)(KVR + (size_t)r * 1024 + h * 128 + 8 * sub), vraw = *(const v4u*)(KVR + (size_t)r * 1024 + h * 128 + 64 + 8 * sub);
        const v4u rraw = *(const v4u*)(KR + (size_t)r * 32 + rs8);
        v4u qraw = {0u, 0u, 0u, 0u}, qrr = {0u, 0u, 0u, 0u}; f32x4 cs[2], sn[2];
        if (lat) { qraw = *(const v4u*)(QR + (size_t)r * 768 + h * 96 + 8 * sub); qrr = *(const v4u*)(QR + (size_t)r * 768 + h * 96 + 64 + rs8);
            const float* rp = R1 + (size_t)(s - CTX) * 32 + ti; cs[0] = *(const f32x4*)rp; cs[1] = *(const f32x4*)(rp + 4); sn[0] = *(const f32x4*)(rp + 16); sn[1] = *(const f32x4*)(rp + 20); }
        *(v4u*)(VM + (size_t)r * 512 + h * 64 + 8 * sub) = vraw;
#pragma unroll
        for (int which = 0; which < 2; ++which) {
            if (which == 1 && !lat) break;
            float a[8], bq[8]; { const v4u ra = which == 0 ? kraw : qraw, rb = which == 0 ? rraw : qrr; MP2_UNPK(ra, a) MP2_UNPK(rb, bq) }
            float ss = 0.f;
#pragma unroll
            for (int e = 0; e < 8; ++e) ss += a[e] * a[e] + (rl ? bq[e] * bq[e] : 0.f);
            ss += __shfl_xor(ss, 1); ss += __shfl_xor(ss, 2); ss += __shfl_xor(ss, 4);
            const float rsd = rsqrtf(ss * (1.f / 96.f) + EPS);
#pragma unroll
            for (int e = 0; e < 8; ++e) { a[e] = a[e] * rsd * (which == 0 ? kn0[e] : qn0[e]); bq[e] = bq[e] * rsd * (which == 0 ? kn1[e] : qn1[e]); }
            if (lat) {
#pragma unroll
                for (int e = 0; e < 8; ++e) { const float other = __shfl_xor(bq[e], 2); const float c = cs[e >> 2][e & 3], sv = sn[e >> 2][e & 3]; bq[e] = (sub & 2) ? (other * sv + bq[e] * c) : (bq[e] * c - other * sv); } }
            bf16_t* o = (which == 0 ? KM : QM) + (size_t)r * 768 + h * 96;
            *(v4u*)(o + 8 * sub) = MP2_PK(a); if (rl) *(v4u*)(o + 64 + rs8) = MP2_PK(bq); }
    }
#undef MP2_UNPK
#undef MP2_PK
}
}
__global__ void __launch_bounds__(NTHREADS, 2) mk_kernel(Params prm) {
    extern __shared__ __attribute__((aligned(16))) unsigned char lds_raw[];
    Frame F; F.lds = (LAS unsigned char*)lds_raw; F.tid = threadIdx.x; F.lane = F.tid & 63; F.wave = __builtin_amdgcn_readfirstlane(F.tid >> 6);
    F.G = gridDim.x; F.bid = blockIdx.x; F.even = 0; F.ws = prm.ws;
    const Params& P = prm;
    const float* MOD0 = (const float*)(prm.ws + WS_MOD);
    const int lo = prm.ph_lo, hi = prm.ph_hi;
    volatile LAS unsigned* MISCW = (volatile LAS unsigned*)(F.lds + MISC_OFF + 8192);
    if (F.tid < 64) MISCW[F.tid] = 0u;
    __syncthreads();
    if (prm.ph_lo == 123456) cooperative_groups::this_grid().sync();
    XcdBarrier bar = xcd_barrier_post((unsigned*)(prm.ws + WS_CTL + CT_BAR), MISCW + 8);
#define RUN(k, body) if (lo <= (k) && (k) < hi) { body; if ((k) + 1 < hi) xcd_barrier(bar); }
#define RUN_GEMMS(PH0, NPH, G0) { _Pragma("unroll 1") for (int i_ = 0; i_ < (NPH); ++i_) { const int k_ = (PH0) + i_; if (lo <= k_ && k_ < hi) { run_gemm(F, prm, (G0) + i_); if (k_ + 1 < hi) xcd_barrier(bar); } } }
    RUN(PH_P0, { el::rope_tables(F); el::mod_phase(F, prm); phase_conv(F, prm, false); hy::filt(F, prm); moe_conv_all(F, prm); })
    if (MISCW[8 + 3] != 0u) { F.bid = __builtin_amdgcn_readfirstlane((int)(MISCW[8 + 2] * 8u + bar.x)); F.even = 1; }
    RUN(PH_NORM0, { el::norm_phase<0>(F, prm, PIN(6), MOD0, 0, 1); el::bias_phase(F, prm); })
    RUN(PH_G_IN0, run_gemm(F, prm, G_IN0))
    RUN(PH_LRUPREP, { lru::phase<0>(F, prm); el::gqa_prep(F, prm); })
    RUN(PH_MIX0, { phase_attn0(F); lru::phase<1>(F, prm); })
    RUN(PH_G_OUT0, { run_gemm(F, prm, G_OUT0); run_gemm(F, prm, G_F1); run_gemm(F, prm, G_F2); })
    RUN(PH_G_IN1, run_gemm(F, prm, G_IN1))
    RUN(PH_PREP1, { hy::prep(F, prm); el::mla_prep1(F, prm); })
    RUN(PH_G_QKVB, { run_gemm(F, prm, G_QB); run_gemm(F, prm, G_KVB); })
    RUN(PH_PREP2, { el::mla_prep2(F, prm); hy::main_phase(F, prm); })
    RUN(PH_MIX1, { phase_attn1(F, prm); hy::untranspose(F); })
    RUN(PH_G_OUT1, run_gemm(F, prm, G_OUT1))
    RUN(PH_ROUTE, phase_route(F, prm))
    RUN(PH_SLOT, phase_slot(F, prm))
    RUN(PH_MOE1, { run_gemm(F, prm, G_MOE1); run_gemm(F, prm, G_MOE2); })
    RUN(PH_COMBINE, phase_combine(F, prm))
#undef RUN
#undef RUN_GEMMS
}
#ifndef SPLIT_LAUNCH
#define SPLIT_LAUNCH 0
#endif
extern "C" void kernel_launch(void* const* d_in, const int* in_sizes, int n_in, void* d_out, int out_size, void* d_ws, size_t ws_size, hipStream_t st) {
    static int grid = 0;
    if (grid == 0) {
        if (n_in != 43 || out_size != NLAT * DM || ws_size < WS_END) { fprintf(stderr, "kernel_launch: unexpected problem (n_in %d, out %d, ws %zu < %zu)\n", n_in, out_size, ws_size, (size_t)WS_END); grid = -1; return; }
        int dev = 0, cus = 0, per_cu = 0;
        (void)hipGetDevice(&dev); (void)hipDeviceGetAttribute(&cus, hipDeviceAttributeMultiprocessorCount, dev);
        (void)hipFuncSetAttribute((const void*)mk_kernel, hipFuncAttributeMaxDynamicSharedMemorySize, LDS_BYTES);
        (void)hipOccupancyMaxActiveBlocksPerMultiprocessor(&per_cu, (const void*)mk_kernel, NTHREADS, LDS_BYTES);
        grid = cus;
        if (grid != 256 || per_cu < 1) { fprintf(stderr, "kernel_launch: grid %d (CUs %d, occupancy query %d): this kernel is written for 256 resident workgroups; nothing launched\n", grid, cus, per_cu); grid = -1; return; }
    }
    if (grid < 0) return;
    (void)hipMemsetAsync((char*)d_ws + WS_CTL, 0, CTL_BYTES, st);
    Params prm{}; prm.i0 = (const float*)d_in[0]; prm.i1 = (const float*)d_in[1]; prm.i2 = (const float*)d_in[2]; prm.i3 = (const float*)d_in[3]; prm.i4 = (const float*)d_in[4]; prm.i5 = (const float*)d_in[5]; prm.i6 = (const float*)d_in[6]; prm.i7 = (const float*)d_in[7]; prm.i8 = (const float*)d_in[8]; prm.i9 = (const float*)d_in[9]; prm.i10 = (const float*)d_in[10]; prm.i11 = (const float*)d_in[11]; prm.i12 = (const float*)d_in[12]; prm.i13 = (const float*)d_in[13]; prm.i14 = (const float*)d_in[14]; prm.i15 = (const float*)d_in[15]; prm.i16 = (const float*)d_in[16]; prm.i17 = (const float*)d_in[17]; prm.i18 = (const float*)d_in[18]; prm.i19 = (const float*)d_in[19]; prm.i20 = (const float*)d_in[20]; prm.i21 = (const float*)d_in[21]; prm.i22 = (const float*)d_in[22]; prm.i23 = (const float*)d_in[23]; prm.i24 = (const float*)d_in[24]; prm.i25 = (const float*)d_in[25]; prm.i26 = (const float*)d_in[26]; prm.i27 = (const float*)d_in[27]; prm.i28 = (const float*)d_in[28]; prm.i29 = (const float*)d_in[29]; prm.i30 = (const float*)d_in[30]; prm.i31 = (const float*)d_in[31]; prm.i32 = (const float*)d_in[32]; prm.i33 = (const float*)d_in[33]; prm.i34 = (const float*)d_in[34]; prm.i35 = (const float*)d_in[35]; prm.i36 = (const float*)d_in[36]; prm.i37 = (const float*)d_in[37]; prm.i38 = (const float*)d_in[38]; prm.i39 = (const float*)d_in[39]; prm.i40 = (const float*)d_in[40]; prm.i41 = (const float*)d_in[41]; prm.i42 = (const float*)d_in[42]; prm.out = (float*)d_out; prm.ws = (char*)d_ws;
#if SPLIT_LAUNCH
    for (int ph = 0; ph < PH_COUNT; ++ph) { prm.ph_lo = ph; prm.ph_hi = ph + 1; hipLaunchKernelGGL(mk_kernel, dim3(grid), dim3(NTHREADS), LDS_BYTES, st, prm); }
#else
    prm.ph_lo = 0; prm.ph_hi = PH_COUNT;
    void* args[] = {&prm};
    hipError_t e = hipLaunchCooperativeKernel((const void*)mk_kernel, dim3(grid), dim3(NTHREADS), args, LDS_BYTES, st);
    if (e != hipSuccess) fprintf(stderr, "kernel_launch: cooperative launch failed: %s (grid %d)\n", hipGetErrorString(e), grid);
#endif
}
```

```cpp
#include <hip/hip_runtime.h>
#include <hip/hip_cooperative_groups.h>
#include <cstdio>
#include <cstdint>
#include <cmath>

constexpr int NB = 8, SEQ = 2048, CTX = 256, RPB = SEQ + CTX, MROWS = NB * RPB, DM = 1024, NLAT = NB * SEQ;
constexpr int NMOD = 6, MODLD = NMOD * DM;
constexpr int AB_IN = 1792, CD_IN = 1952, CD_LD = 2048, DFF = 2816, NEXP = 8, DFE = 3584;
constexpr float EPS = 1e-6f;
constexpr float LOG2E = 1.4426950408889634f;
constexpr float QSCALE0 = 0.125f * LOG2E;
constexpr float QSCALE1 = 0.10206207261596577f * LOG2E;

typedef unsigned short bf16_t;
typedef float f32x4 __attribute__((ext_vector_type(4)));
typedef unsigned u32x4 __attribute__((ext_vector_type(4)));
typedef unsigned u32x2 __attribute__((ext_vector_type(2)));

__device__ __forceinline__ int mod_row(int r) { int b = r / RPB, s = r % RPB; return s < CTX ? 8 : b; }
__device__ __forceinline__ int latent_row(int m) { return (m / SEQ) * RPB + CTX + (m % SEQ); }

__device__ __forceinline__ float bf2f(bf16_t v) { return __uint_as_float((unsigned)v << 16); }
typedef float hd_f32x2 __attribute__((ext_vector_type(2))); typedef __bf16 hd_bf16x2 __attribute__((ext_vector_type(2)));
__device__ __forceinline__ unsigned pk2(float lo, float hi) { hd_f32x2 v = {lo, hi}; hd_bf16x2 b = __builtin_convertvector(v, hd_bf16x2); return __builtin_bit_cast(unsigned, b); }
__device__ __forceinline__ bf16_t f2bf(float f) { return (bf16_t)(pk2(f, 0.f) & 0xffffu); }
__device__ __forceinline__ float ldf(const float* p) { return *p; }
__device__ __forceinline__ float ldf(const bf16_t* p) { return bf2f(*p); }
__device__ __forceinline__ void stf(float* p, float v) { *p = v; }
__device__ __forceinline__ void stf(bf16_t* p, float v) { *p = f2bf(v); }

__device__ __forceinline__ float silu_f(float x) { return x / (1.f + expf(-x)); }
__device__ __forceinline__ float sigmoid_f(float x) { return 1.f / (1.f + expf(-x)); }
__device__ __forceinline__ float gelu_tanh(float x) { return 0.5f * x * (1.f + tanhf(0.7978845608028654f * (x + 0.044715f * x * x * x))); }
__device__ __forceinline__ float softplus_f(float x) { return fmaxf(x, 0.f) + log1pf(expf(-fabsf(x))); }

__device__ __forceinline__ float wave_sum(float v) {
#pragma unroll
    for (int o = 1; o < 64; o <<= 1) v += __shfl_xor(v, o);
    return v;
}
__device__ __forceinline__ float wave_max(float v) {
#pragma unroll
    for (int o = 1; o < 64; o <<= 1) v = fmaxf(v, __shfl_xor(v, o));
    return v;
}

constexpr size_t MiB = 1ull << 20;
constexpr size_t WS_CTL = 0, CTL_BYTES = 256 * 1024;
constexpr size_t WS_MOD = 1 * MiB;
constexpr size_t WS_SC = WS_MOD + 512 * 1024;
constexpr size_t WS_W13M = 4 * MiB;
constexpr size_t WS_W2M = 116 * MiB;
constexpr size_t WS_WIN0 = 172 * MiB;
constexpr size_t WS_WOUT0 = WS_WIN0 + (size_t)1792 * 1024 * 2;
constexpr size_t WS_WF13 = WS_WOUT0 + (size_t)1024 * 1024 * 2;
constexpr size_t WS_WF2 = WS_WF13 + (size_t)5632 * 1024 * 2;
constexpr size_t WS_WIN1 = WS_WF2 + (size_t)1024 * 2816 * 2;
constexpr size_t WS_WOUT1 = WS_WIN1 + (size_t)2048 * 1024 * 2;
constexpr size_t WS_WQB = WS_WOUT1 + (size_t)1024 * 1024 * 2;
constexpr size_t WS_WKVB = WS_WQB + (size_t)768 * 256 * 2;
constexpr size_t WS_WLRU = WS_WKVB + (size_t)1024 * 256 * 2;
constexpr size_t WS_WEND = WS_WLRU + (size_t)2 * 8 * 2 * 64 * 64 * 2;
static_assert(WS_WEND <= 202 * MiB, "weights region");
constexpr size_t WS_X = 202 * MiB;
constexpr size_t WS_H = 274 * MiB;
constexpr size_t WS_Z = 310 * MiB;
constexpr size_t WS_Y = 382 * MiB;
constexpr size_t WS_ACT = WS_Z;
constexpr size_t WS_R2 = 418 * MiB;
constexpr size_t WS_END = 502 * MiB;
static_assert(WS_ACT + (size_t)MROWS * DFF * 2 <= WS_R2, "ACT overlay");
constexpr size_t WS_QB = WS_R2;
constexpr size_t WS_KB = WS_QB + (size_t)MROWS * 512 * 2;
constexpr size_t WS_VB = WS_KB + (size_t)MROWS * 128 * 2;
constexpr size_t WS_AGG = WS_VB + (size_t)MROWS * 128 * 2;
constexpr size_t WS_R2L0END = WS_AGG + (size_t)2 * 8 * 72 * 2 * 512 * 4;
constexpr size_t WS_ZT = WS_R2;
constexpr size_t WS_HT = WS_ZT + (size_t)1536 * NLAT * 2;
constexpr size_t WS_GT = WS_HT + (size_t)512 * NLAT * 2;
constexpr int GT_LD = 4224;
constexpr size_t WS_R2L1END = WS_GT + (size_t)2 * 512 * GT_LD * 2;
static_assert(WS_R2L0END <= WS_END && WS_R2L1END <= WS_END, "R2");
constexpr size_t WS_QA = WS_Y;
constexpr size_t WS_KVA = WS_QA + (size_t)MROWS * 256 * 2;
constexpr size_t WS_KR = WS_KVA + (size_t)MROWS * 256 * 2;
constexpr size_t WS_QR = WS_Z;
constexpr size_t WS_KVR = WS_QR + (size_t)MROWS * 768 * 2;
static_assert(WS_KVR + (size_t)MROWS * 1024 * 2 <= WS_Y && WS_KR + (size_t)MROWS * 32 * 2 <= WS_R2, "layer-1 overlays");
constexpr size_t WS_QM = WS_H;
static_assert((size_t)MROWS * 768 * 2 <= 36 * MiB, "QM in H");
constexpr size_t DO_KM = 0;
constexpr size_t DO_VM = (size_t)MROWS * 768 * 2;
static_assert(DO_VM + (size_t)MROWS * 512 * 2 <= (size_t)NLAT * DM * 4, "d_out scratch");
constexpr int MAXSLOT = 34816;
constexpr size_t WS_XG = WS_WIN0;
constexpr size_t WS_ACT2 = WS_XG + (size_t)MAXSLOT * 1024 * 2;
constexpr size_t WS_H2 = WS_ACT2 + (size_t)MAXSLOT * 3584 * 2 - (size_t)NLAT * 1024 * 2;
static_assert(WS_ACT2 + (size_t)MAXSLOT * 3584 * 2 <= WS_END, "MoE overlay");
constexpr size_t CT_BAR = 0;
constexpr size_t CT_PCNT = 16 * 1024;
constexpr size_t CT_MCNT = 48 * 1024;
constexpr size_t CT_HIST = 32 * 1024;
constexpr size_t CT_CNT = 48 * 1024;
constexpr size_t CT_CURSOR = 80 * 1024;
constexpr size_t CT_DONE = 80 * 1024 + 256;
constexpr size_t CT_SSQA = 96 * 1024;
constexpr size_t CT_SSQB = CT_SSQA + (size_t)MROWS * 4;
static_assert(CT_SSQB + (size_t)MROWS * 4 <= CTL_BYTES, "ssq in the zeroed control region");
constexpr size_t WS_SLOTTOK = 2 * MiB;
constexpr size_t WS_SLOTGATE = WS_SLOTTOK + (size_t)MAXSLOT * 4;
constexpr size_t WS_SEL = WS_SLOTGATE + (size_t)MAXSLOT * 4;
constexpr size_t WS_TOKSLOT = WS_SEL + (size_t)NLAT * 16;
static_assert(WS_TOKSLOT + (size_t)NLAT * 8 <= WS_W13M, "small tables");
constexpr size_t WS_ROPE0 = 3 * MiB;
constexpr size_t WS_ROPE1 = 3 * MiB + 512 * 1024;
static_assert(WS_TOKSLOT + (size_t)NLAT * 8 <= WS_ROPE0 && WS_ROPE1 + 256 * 1024 <= WS_W13M, "rope tables");
constexpr size_t WS_CBF1 = WS_SC + 64 * 1024;
constexpr size_t WS_CBIN1 = WS_CBF1 + 9 * 5632 * 4;
static_assert(WS_CBIN1 + 9 * 2048 * 4 <= WS_SLOTTOK, "bias vectors");
constexpr size_t WS_Y2 = WS_XG;
namespace pg8 {
#define PG8_LAS __attribute__((address_space(3)))
typedef unsigned short bf16_t;
typedef short bf16x8 __attribute__((ext_vector_type(8)));
typedef float f32x4 __attribute__((ext_vector_type(4)));
typedef unsigned u32x4 __attribute__((ext_vector_type(4)));
constexpr int BM = 256, BK = 64, HALF = 128, HTB = HALF * BK * 2  , STAGE_BYTES = 8 * HTB, NXCD = 8, WGM = 8;

__host__ __device__ __forceinline__ int lds_byte(int r, int c) { const int st = (r >> 4) * 2 + (c >> 5), rr = r & 15, cc = c & 31, ob = rr * 64 + cc * 2; return st * 1024 + (ob ^ (((ob >> 9) & 1) << 5)); }
__host__ __device__ __forceinline__ void stage_rc(int b, int& R, int& C) { const int st = b / 1024, sb = b % 1024, swz = sb ^ (((sb >> 9) & 1) << 5); R = (st >> 1) * 16 + swz / 64; C = (st & 1) * 32 + (swz % 64) / 2; }
__host__ __device__ __forceinline__ int perm32(int rho) { const int n = rho >> 4, i = rho & 15; return 8 * (i >> 2) + 4 * n + (i & 3); }

struct Unit { int pm, pn; };
struct Gemm { const bf16_t* A; const bf16_t* Bt; int M, N, K; };

struct StaticOrder {
    int nM, nN, nwg, G, c;
    __host__ __device__ void init(int M, int N, int G_, int c_) { nM = M / BM; nN = N / BM; nwg = nM * nN; G = G_; c = c_; }
    __host__ __device__ bool next(int i, Unit& u) const {
        const long L = (long)i * G + c; if (L >= nwg) return false;
        int wgid = (int)L; { const int q = nwg / NXCD, r = nwg % NXCD, xcd = wgid % NXCD, off = wgid / NXCD; wgid = (xcd < r ? xcd * (q + 1) : r * (q + 1) + (xcd - r) * q) + off; }
        const int nig = WGM * nN, gid = wgid / nig, fm = gid * WGM, gsz = (nM - fm) < WGM ? (nM - fm) : WGM;
        u.pm = fm + ((wgid % nig) % gsz); u.pn = (wgid % nig) / gsz; return true;
    }
    __device__ __forceinline__ void a_ready(const Unit&) const {}
    __device__ __forceinline__ void done(const Unit&) const {}
};

__device__ __forceinline__ unsigned cvt_pk_bf16(float lo, float hi) { unsigned r; asm volatile("v_cvt_pk_bf16_f32 %0, %1, %2" : "=v"(r) : "v"(lo), "v"(hi)); return r; }
typedef float f32x2 __attribute__((ext_vector_type(2)));
__device__ __forceinline__ f32x2 gelu_pk(f32x2 v) {
    const f32x2 av = __builtin_elementwise_abs(v), d = av * 0.2316418882f + 1.0f;
    f32x2 t; t.x = __builtin_amdgcn_rcpf(d.x); t.y = __builtin_amdgcn_rcpf(d.y);
    f32x2 q = t * 0.5307027145f + (-0.7265760135f); q = q * t + 0.7107068705f; q = q * t + (-0.142248368f); q = q * t + 0.127414796f; q = q * t;
    const f32x2 s = (v * v) * (-0.72134752044f);
    f32x2 e; e.x = __builtin_amdgcn_exp2f(s.x); e.y = __builtin_amdgcn_exp2f(s.y);
    const f32x2 m = v * (q * e), r = v - m;
    f32x2 o; o.x = v.x < 0.f ? m.x : r.x; o.y = v.y < 0.f ? m.y : r.y; return o;
}

template <int ACT  > struct EpiBf16 {
    static constexpr bool PERM = true, AFTER_DRAIN = false; static_assert(ACT == 0 || ACT == 1, "EpiBf16: ACT is 0 (none) or 1 (gelu_pk)");
    bf16_t* O; int ldc; const float* bias; int split_cols; size_t split_stride; float scale0;
    __device__ __forceinline__ void operator()(const f32x4 (&acc)[2][2][4][2], const Unit& u, int wr, int wc, int fr, int fq) const {
        const int row0 = u.pm * BM + wr * 64 + fr; int colt = u.pn * BM; bf16_t* base = O;
        float sc = 1.f; if (split_cols) { const int t = colt / split_cols; base += (size_t)t * split_stride; colt -= t * split_cols; if (t == 0) sc = scale0; }
        const int col0 = colt + wc * 32 + 8 * fq, bcol0 = u.pn * BM + wc * 32 + 8 * fq;
        f32x4 bv[2][2];
#pragma unroll
        for (int bj = 0; bj < 2; ++bj)
#pragma unroll
            for (int n = 0; n < 2; ++n) bv[bj][n] = bias ? *(const f32x4*)(bias + bcol0 + bj * HALF + 4 * n) : (f32x4){0.f, 0.f, 0.f, 0.f};
#pragma unroll
        for (int ai = 0; ai < 2; ++ai)
#pragma unroll
            for (int m = 0; m < 4; ++m) { bf16_t* rowp = base + (size_t)(row0 + ai * HALF + m * 16) * ldc + col0;
#pragma unroll
                for (int bj = 0; bj < 2; ++bj) { f32x4 v0 = acc[ai][bj][m][0] + bv[bj][0], v1 = acc[ai][bj][m][1] + bv[bj][1];
                    if (ACT == 1) { f32x2 a = gelu_pk((f32x2){v0[0], v0[1]}), b = gelu_pk((f32x2){v0[2], v0[3]}), c = gelu_pk((f32x2){v1[0], v1[1]}), d = gelu_pk((f32x2){v1[2], v1[3]});
                        v0 = (f32x4){a.x, a.y, b.x, b.y}; v1 = (f32x4){c.x, c.y, d.x, d.y}; }
                    v0 = v0 * sc; v1 = v1 * sc; u32x4 w; w.x = cvt_pk_bf16(v0[0], v0[1]); w.y = cvt_pk_bf16(v0[2], v0[3]); w.z = cvt_pk_bf16(v1[0], v1[1]); w.w = cvt_pk_bf16(v1[2], v1[3]);
                    *(u32x4*)(rowp + bj * HALF) = w; } }
    }
};

template <class Epi, class Sched, bool ALIGN_EPI = false, bool SP2 = false>
__device__ __forceinline__ void gemm_phase(PG8_LAS unsigned char* lds, const Gemm g, const Sched& S, const Epi& E) {
    int tid_ = threadIdx.x; asm volatile("" : "+v"(tid_));
    const int tid = tid_, wid = __builtin_amdgcn_readfirstlane(tid >> 6), lane = tid & 63, wr = wid >> 2, wc = wid & 3, fr = lane & 15, fq = lane >> 4;
    const int K = g.K, nt = K / BK;
    unsigned voffA[2], voffB[2];
#pragma unroll
    for (int i = 0; i < 2; ++i) { int R, C; stage_rc(tid * 16 + i * 8192, R, C); const int Rb = Epi::PERM ? ((R & ~31) + perm32(R & 31)) : R;
        voffA[i] = (unsigned)(R * K + C) * 2u; voffB[i] = (unsigned)(Rb * K + C) * 2u; }
    const size_t kstep = (size_t)(BK * 2);
    const size_t hstep = (size_t)HALF * K * 2;
    const size_t tstep = 2 * hstep;
    const unsigned ldsw = (unsigned)wid * 1024u;
    const int aoff = lds_byte(wr * 64 + fr, fq * 8), boff = lds_byte(wc * 32 + fr, fq * 8);
#define PG8_SA(b, h) (((b) * 2 + (h)) * HTB)
#define PG8_SB(b, h) ((4 + (b) * 2 + (h)) * HTB)
#define PG8_STAGE(bufoff, gbase, voff) do { _Pragma("unroll") for (int _i = 0; _i < 2; ++_i) \
        __builtin_amdgcn_global_load_lds((const unsigned*)((const char*)(gbase) + (voff)[_i]), (PG8_LAS unsigned*)(lds + (bufoff) + ldsw + _i * 8192), 16, 0, 0); } while (0)
#define PG8_LDA(dst, b, h) do { _Pragma("unroll") for (int m = 0; m < 4; ++m) _Pragma("unroll") for (int k = 0; k < 2; ++k) dst[m][k] = *(const PG8_LAS bf16x8*)(lds + PG8_SA(b, h) + aoff + m * 2048 + k * 1024); } while (0)
#define PG8_LDB(dst, b, h) do { _Pragma("unroll") for (int n = 0; n < 2; ++n) _Pragma("unroll") for (int k = 0; k < 2; ++k) dst[n][k] = *(const PG8_LAS bf16x8*)(lds + PG8_SB(b, h) + boff + n * 2048 + k * 1024); } while (0)
#define PG8_MMA(ai, bj, At, Bt) do { __builtin_amdgcn_s_setprio(1); _Pragma("unroll") for (int m = 0; m < 4; ++m) _Pragma("unroll") for (int n = 0; n < 2; ++n) _Pragma("unroll") for (int k = 0; k < 2; ++k) \
        acc[ai][bj][m][n] = __builtin_amdgcn_mfma_f32_16x16x32_bf16(Bt[n][k], At[m][k], acc[ai][bj][m][n], 0, 0, 0); __builtin_amdgcn_s_setprio(0); } while (0)
#define PG8_WAIT_V(n) asm volatile("s_waitcnt vmcnt(" #n ")" ::: "memory")
#define PG8_WAIT_L(n) asm volatile("s_waitcnt lgkmcnt(" #n ")" ::: "memory")
#define PG8_BAR __builtin_amdgcn_s_barrier()
#define PG8_SCHED __builtin_amdgcn_sched_barrier(0)
    Unit cur, nxt; int ui = 0;
    if (!S.next(0, cur)) return;
    f32x4 acc[2][2][4][2];
#pragma unroll
    for (int a = 0; a < 2; ++a)
#pragma unroll
        for (int b = 0; b < 2; ++b)
#pragma unroll
            for (int m = 0; m < 4; ++m)
#pragma unroll
                for (int n = 0; n < 2; ++n) acc[a][b][m][n] = (f32x4){0.f, 0.f, 0.f, 0.f};
    bf16x8 At[4][2], B0[2][2], B1[2][2];
    const char* cA = (const char*)g.A + (size_t)cur.pm * tstep; const char* cB = (const char*)g.Bt + (size_t)cur.pn * tstep;
    S.a_ready(cur);
    if constexpr (SP2) {
        PG8_STAGE(PG8_SB(0, 0), cB, voffB); PG8_STAGE(PG8_SB(0, 1), cB + hstep, voffB); PG8_STAGE(PG8_SA(0, 0), cA, voffA); PG8_STAGE(PG8_SA(0, 1), cA + hstep, voffA);
        if (wr == 1) PG8_BAR;
        PG8_WAIT_V(2); PG8_BAR;
        PG8_STAGE(PG8_SB(1, 0), cB + kstep, voffB); PG8_STAGE(PG8_SA(1, 0), cA + kstep, voffA); PG8_STAGE(PG8_SB(1, 1), cB + hstep + kstep, voffB);
        PG8_WAIT_V(6); PG8_BAR;
    } else {
        PG8_STAGE(PG8_SB(0, 0), cB, voffB); PG8_STAGE(PG8_SA(0, 0), cA, voffA); PG8_STAGE(PG8_SB(0, 1), cB + hstep, voffB); PG8_STAGE(PG8_SA(0, 1), cA + hstep, voffA);
        if (wr == 1) PG8_BAR;
        PG8_WAIT_V(4); PG8_BAR;
        PG8_STAGE(PG8_SB(1, 0), cB + kstep, voffB); PG8_STAGE(PG8_SA(1, 0), cA + kstep, voffA); PG8_STAGE(PG8_SB(1, 1), cB + hstep + kstep, voffB);
        PG8_WAIT_V(6); PG8_BAR;
    }
    for (;;) {
        const bool has_next = S.next(ui + 1, nxt);
        const char* nA = has_next ? (const char*)g.A + (size_t)nxt.pm * tstep : cA; const char* nB = has_next ? (const char*)g.Bt + (size_t)nxt.pn * tstep : cB;
        for (int t = 0; t < nt; t += 2) {
            const bool last = (t == nt - 2);
            const char* a1 = cA + (size_t)(t + 1) * kstep;
            const char* a2 = last ? nA : cA + (size_t)(t + 2) * kstep; const char* b2 = last ? nB : cB + (size_t)(t + 2) * kstep;
            const char* a3 = a2 + kstep; const char* b3 = b2 + kstep;
            if (last && has_next) S.a_ready(nxt);
            if constexpr (SP2) {
            PG8_LDB(B0, 0, 0); PG8_LDB(B1, 0, 1); PG8_SCHED; PG8_LDA(At, 0, 0); PG8_STAGE(PG8_SA(1, 1), a1 + hstep, voffA);
            PG8_WAIT_V(8); PG8_WAIT_L(0); PG8_BAR; PG8_MMA(0, 0, At, B0); PG8_MMA(0, 1, At, B1); PG8_BAR; PG8_SCHED;
            PG8_LDA(At, 0, 1); PG8_STAGE(PG8_SB(0, 0), b2, voffB); PG8_STAGE(PG8_SB(0, 1), b2 + hstep, voffB); PG8_STAGE(PG8_SA(0, 0), a2, voffA);
            PG8_WAIT_V(8); PG8_WAIT_L(0); PG8_BAR; PG8_MMA(1, 0, At, B0); PG8_MMA(1, 1, At, B1); PG8_BAR; PG8_SCHED;
            PG8_LDB(B0, 1, 0); PG8_LDB(B1, 1, 1); PG8_SCHED; PG8_LDA(At, 1, 0); PG8_STAGE(PG8_SA(0, 1), a2 + hstep, voffA);
            PG8_WAIT_V(8); PG8_WAIT_L(0); PG8_BAR; PG8_MMA(0, 0, At, B0); PG8_MMA(0, 1, At, B1); PG8_BAR; PG8_SCHED;
            PG8_LDA(At, 1, 1); PG8_STAGE(PG8_SB(1, 0), b3, voffB); PG8_STAGE(PG8_SB(1, 1), b3 + hstep, voffB); PG8_STAGE(PG8_SA(1, 0), a3, voffA);
            PG8_WAIT_V(8); PG8_WAIT_L(0); PG8_BAR; PG8_MMA(1, 0, At, B0); PG8_MMA(1, 1, At, B1); PG8_BAR; PG8_SCHED;
            } else {
            PG8_LDB(B0, 0, 0); PG8_SCHED; PG8_LDA(At, 0, 0); PG8_STAGE(PG8_SA(1, 1), a1 + hstep, voffA);
            PG8_WAIT_L(8); PG8_BAR; PG8_WAIT_L(0); PG8_MMA(0, 0, At, B0); PG8_BAR; PG8_SCHED;
            PG8_LDB(B1, 0, 1); PG8_STAGE(PG8_SB(0, 0), b2, voffB);
            PG8_BAR; PG8_WAIT_L(0); PG8_MMA(0, 1, At, B1); PG8_BAR;
            PG8_LDA(At, 0, 1); PG8_STAGE(PG8_SA(0, 0), a2, voffA);
            PG8_BAR; PG8_WAIT_L(0); PG8_MMA(1, 0, At, B0); PG8_BAR; PG8_SCHED;
            PG8_STAGE(PG8_SB(0, 1), b2 + hstep, voffB);
            PG8_WAIT_V(6); PG8_BAR; PG8_MMA(1, 1, At, B1); PG8_BAR;
            PG8_LDB(B0, 1, 0); PG8_SCHED; PG8_LDA(At, 1, 0); PG8_STAGE(PG8_SA(0, 1), a2 + hstep, voffA);
            PG8_WAIT_L(8); PG8_BAR; PG8_WAIT_L(0); PG8_MMA(0, 0, At, B0); PG8_BAR; PG8_SCHED;
            PG8_LDB(B1, 1, 1); PG8_STAGE(PG8_SB(1, 0), b3, voffB);
            PG8_BAR; PG8_WAIT_L(0); PG8_MMA(0, 1, At, B1); PG8_BAR;
            PG8_LDA(At, 1, 1); PG8_STAGE(PG8_SA(1, 0), a3, voffA);
            PG8_BAR; PG8_WAIT_L(0); PG8_MMA(1, 0, At, B0); PG8_BAR; PG8_SCHED;
            PG8_STAGE(PG8_SB(1, 1), b3 + hstep, voffB);
            PG8_WAIT_V(6); PG8_BAR; PG8_MMA(1, 1, At, B1); PG8_BAR;
            }
        }
        if constexpr (ALIGN_EPI) { if (wr == 0) PG8_BAR; }
        if constexpr (!Epi::AFTER_DRAIN) { E(acc, cur, wr, wc, fr, fq); S.done(cur); }
        if (!has_next) break;
#pragma unroll
        for (int a = 0; a < 2; ++a)
#pragma unroll
            for (int b = 0; b < 2; ++b)
#pragma unroll
                for (int m = 0; m < 4; ++m)
#pragma unroll
                    for (int n = 0; n < 2; ++n) acc[a][b][m][n] = (f32x4){0.f, 0.f, 0.f, 0.f};
        cur = nxt; cA = nA; cB = nB; ++ui;
        if constexpr (ALIGN_EPI) { if (wr == 1) PG8_BAR; }
    }
    PG8_WAIT_V(0);
    if constexpr (!ALIGN_EPI) { if (wr == 0) PG8_BAR; }
    PG8_BAR;
    if constexpr (Epi::AFTER_DRAIN) { E.fused(acc, cur, wr, wc, fr, fq, lds, wid, lane); S.done(cur); }
#undef PG8_SA
#undef PG8_SB
#undef PG8_STAGE
#undef PG8_LDA
#undef PG8_LDB
#undef PG8_MMA
#undef PG8_WAIT_V
#undef PG8_WAIT_L
#undef PG8_BAR
#undef PG8_SCHED
}
}
namespace pg8 {
__device__ __forceinline__ float fast_silu(float v) { return v * __builtin_amdgcn_rcpf(1.f + __builtin_amdgcn_exp2f(-1.4426950408889634f * v)); }

struct DenseOrder {
    int nM, nN, nreg, nwg, G, c, mode, wgm;
    __device__ __forceinline__ void init(int nM_, int nN_, int G_, int c_, int mode_) { nM = nM_; nN = nN_; G = G_; c = c_; mode = mode_; nreg = nM * nN; nwg = nreg + (mode == 2 ? 8 : 0); wgm = WGM; }
    __device__ __forceinline__ bool next(int i, Unit& u) const {
        const long L = (long)i * G + c; if (L >= nwg) return false;
        if (mode == 2 && L >= nreg) { u.pm = 9 * (int)(L - nreg); u.pn = nN - 1; return true; }
        int wgid = (int)L; { const int q = nreg / NXCD, r = nreg % NXCD, xcd = wgid % NXCD, off = wgid / NXCD; wgid = (xcd < r ? xcd * (q + 1) : r * (q + 1) + (xcd - r) * q) + off; }
        const int nig = wgm * nN, gid = wgid / nig, fm = gid * wgm, gsz = (nM - fm) < wgm ? (nM - fm) : wgm;
        int pm = fm + ((wgid % nig) % gsz); u.pn = (wgid % nig) / gsz;
        if (mode != 0) pm = 9 * (pm >> 3) + 1 + (pm & 7);
        u.pm = pm; return true;
    }
    __device__ __forceinline__ void a_ready(const Unit&) const {}
    __device__ __forceinline__ void done(const Unit&) const {}
};
struct MoeOrder {
    const PG8_LAS int* tb; int nN, G, c;
    __device__ __forceinline__ bool next(int i, Unit& u) const {
        const int nwg = tb[8] * nN; long L = (long)i * G + c; if (L >= nwg) return false;
        { const int wg = (int)L, q = nwg / NXCD, r = nwg % NXCD, xcd = wg % NXCD, off = wg / NXCD; L = (xcd < r ? xcd * (q + 1) : r * (q + 1) + (xcd - r) * q) + off; }
        int e = 0;
#pragma unroll
        for (int k = 1; k < 8; ++k) if (L >= (long)tb[k] * nN) e = k;
        const int Le = (int)(L - (long)tb[e] * nN), mt = tb[e + 1] - tb[e];
        const int nig = WGM * nN, gid = Le / nig, fm = gid * WGM, gsz = (mt - fm) < WGM ? (mt - fm) : WGM;
        u.pm = tb[e] + fm + ((Le % nig) % gsz); u.pn = e * nN + (Le % nig) / gsz; return true;
    }
    __device__ __forceinline__ void a_ready(const Unit&) const {}
    __device__ __forceinline__ void done(const Unit&) const {}
};

template <bool SRCIN, bool FUSE> struct EpiResGate {
    static constexpr bool PERM = true, AFTER_DRAIN = false;
    const float* xin; float* xout; const float* modbase; int compact;
    const float* xsrc_lat; const float* xsrc_ctx; bf16_t* hraw; const float* gnext; const float* nscale; float* ssq;
    __device__ __forceinline__ void operator()(const f32x4 (&acc)[2][2][4][2], const Unit& u, int wr, int wc, int fr, int fq) const {
        const int b = u.pm / 9, pj = u.pm - 9 * b; const int mrow = (pj == 0) ? 8 : b;
        const float* g = modbase + (size_t)mrow * 6144;
        const int col0 = u.pn * BM + wc * 32 + 8 * fq;
        f32x4 gv[2][2];
#pragma unroll
        for (int bj = 0; bj < 2; ++bj)
#pragma unroll
            for (int n = 0; n < 2; ++n) gv[bj][n] = *(const f32x4*)(g + col0 + bj * HALF + n * 4);
        const int row0 = u.pm * BM + wr * 64 + fr; const int oshift = compact ? 256 * (b + 1) : 0;
        const float* xbase = SRCIN ? (pj == 0 ? xsrc_ctx + (size_t)b * 256 * 1024 : xsrc_lat + ((size_t)b * 2048 + (pj - 1) * 256) * 1024) - (size_t)u.pm * BM * 1024 : xin;
        const float* ns = nscale + (size_t)mrow * 6144;
#pragma unroll
        for (int am = 0; am < 4; ++am) { const int ai = am >> 1;
            f32x4 xv[2][2][2];
#pragma unroll
            for (int mm = 0; mm < 2; ++mm) { const int m = (am & 1) * 2 + mm; const float* xi = xbase + (size_t)(row0 + ai * HALF + m * 16) * 1024 + col0;
#pragma unroll
                for (int bj = 0; bj < 2; ++bj)
#pragma unroll
                    for (int n = 0; n < 2; ++n) xv[mm][bj][n] = *(const f32x4*)(xi + bj * HALF + n * 4); }
#pragma unroll
            for (int mm = 0; mm < 2; ++mm) { const int m = (am & 1) * 2 + mm; const int row = row0 + ai * HALF + m * 16; float* xo = xout + (size_t)(row - oshift) * 1024 + col0; float ss = 0.f;
#pragma unroll
                for (int bj = 0; bj < 2; ++bj)
#pragma unroll
                    for (int n = 0; n < 2; ++n) { const f32x4 v = xv[mm][bj][n] + gv[bj][n] * acc[ai][bj][m][n]; *(f32x4*)(xo + bj * HALF + n * 4) = v;
                        if (FUSE) { const int c = col0 + bj * HALF + n * 4; const f32x4 hv = v * (*(const f32x4*)(gnext + c) * (*(const f32x4*)(ns + c) + 1.f));
                            ss += (v[0] * v[0] + v[1] * v[1]) + (v[2] * v[2] + v[3] * v[3]);
                            u32x2 w; w.x = cvt_pk_bf16(hv[0], hv[1]); w.y = cvt_pk_bf16(hv[2], hv[3]); *(u32x2*)(hraw + (size_t)row * 1024 + c) = w; } }
                if (FUSE) { ss += __shfl_xor(ss, 16); ss += __shfl_xor(ss, 32); if (fq == 0) unsafeAtomicAdd(ssq + row, ss); } }
            asm volatile("" ::: "memory"); }
    }
};
struct EpiSwiGLU {
    static constexpr bool PERM = true, AFTER_DRAIN = false;
    bf16_t* O; int ldc; int npn; const float* ssq; const float* cbias; int cbld;
    __device__ __forceinline__ void operator()(const f32x4 (&acc)[2][2][4][2], const Unit& u, int wr, int wc, int fr, int fq) const {
        const int row0 = u.pm * BM + wr * 64 + fr; const int col0 = (u.pn % npn) * HALF + wc * 32 + 8 * fq;
        f32x4 cb[2][2];
        if (ssq) { const int b = u.pm / 9; const int mrow = (u.pm - 9 * b == 0) ? 8 : b; const float* cp = cbias + (size_t)mrow * cbld + u.pn * BM + wc * 32 + 8 * fq;
#pragma unroll
            for (int bj = 0; bj < 2; ++bj)
#pragma unroll
                for (int n = 0; n < 2; ++n) cb[bj][n] = *(const f32x4*)(cp + bj * HALF + 4 * n); }
        float rsv[2][4];
        if (ssq) {
#pragma unroll
            for (int ai = 0; ai < 2; ++ai)
#pragma unroll
                for (int m = 0; m < 4; ++m) rsv[ai][m] = ssq[row0 + ai * HALF + m * 16];
#pragma unroll
            for (int ai = 0; ai < 2; ++ai)
#pragma unroll
                for (int m = 0; m < 4; ++m) rsv[ai][m] = rsqrtf(rsv[ai][m] * (1.f / 1024.f) + 1e-6f); }
#pragma unroll
        for (int ai = 0; ai < 2; ++ai)
#pragma unroll
            for (int m = 0; m < 4; ++m) { const int row = row0 + ai * HALF + m * 16; bf16_t* rowp = O + (size_t)row * ldc + col0;
                f32x4 a0 = acc[ai][0][m][0], a1 = acc[ai][0][m][1], g0 = acc[ai][1][m][0], g1 = acc[ai][1][m][1];
                if (ssq) { const float rs = rsv[ai][m]; a0 = a0 * rs + cb[0][0]; a1 = a1 * rs + cb[0][1]; g0 = g0 * rs + cb[1][0]; g1 = g1 * rs + cb[1][1]; }
                u32x4 w; w.x = cvt_pk_bf16(fast_silu(a0[0]) * g0[0], fast_silu(a0[1]) * g0[1]); w.y = cvt_pk_bf16(fast_silu(a0[2]) * g0[2], fast_silu(a0[3]) * g0[3]);
                w.z = cvt_pk_bf16(fast_silu(a1[0]) * g1[0], fast_silu(a1[1]) * g1[1]); w.w = cvt_pk_bf16(fast_silu(a1[2]) * g1[2], fast_silu(a1[3]) * g1[3]);
                *(u32x4*)rowp = w; }
    }
};
struct EpiBf16Norm {
    static constexpr bool PERM = true, AFTER_DRAIN = false;
    bf16_t* O; int ldc; const float* ssq; const float* cbias; int cbld;
    __device__ __forceinline__ void operator()(const f32x4 (&acc)[2][2][4][2], const Unit& u, int wr, int wc, int fr, int fq) const {
        const int row0 = u.pm * BM + wr * 64 + fr; const int col0 = u.pn * BM + wc * 32 + 8 * fq;
        const int b = u.pm / 9; const int mrow = (u.pm - 9 * b == 0) ? 8 : b; const float* cp = cbias + (size_t)mrow * cbld + col0;
        f32x4 cb[2][2];
#pragma unroll
        for (int bj = 0; bj < 2; ++bj)
#pragma unroll
            for (int n = 0; n < 2; ++n) cb[bj][n] = *(const f32x4*)(cp + bj * HALF + 4 * n);
        float rsv[2][4];
#pragma unroll
        for (int ai = 0; ai < 2; ++ai)
#pragma unroll
            for (int m = 0; m < 4; ++m) rsv[ai][m] = ssq[row0 + ai * HALF + m * 16];
#pragma unroll
        for (int ai = 0; ai < 2; ++ai)
#pragma unroll
            for (int m = 0; m < 4; ++m) { const int row = row0 + ai * HALF + m * 16; bf16_t* rowp = O + (size_t)row * ldc + col0; const float rs = rsqrtf(rsv[ai][m] * (1.f / 1024.f) + 1e-6f);
#pragma unroll
                for (int bj = 0; bj < 2; ++bj) { const f32x4 v0 = acc[ai][bj][m][0] * rs + cb[bj][0], v1 = acc[ai][bj][m][1] * rs + cb[bj][1];
                    u32x4 w; w.x = cvt_pk_bf16(v0[0], v0[1]); w.y = cvt_pk_bf16(v0[2], v0[3]); w.z = cvt_pk_bf16(v1[0], v1[1]); w.w = cvt_pk_bf16(v1[2], v1[3]); *(u32x4*)(rowp + bj * HALF) = w; } }
    }
};
struct EpiMoeY2 {
    static constexpr bool PERM = true, AFTER_DRAIN = false;
    const float* slot_gate; bf16_t* Y2;
    __device__ __forceinline__ void operator()(const f32x4 (&acc)[2][2][4][2], const Unit& u, int wr, int wc, int fr, int fq) const {
        const int col0 = (u.pn & 3) * BM + wc * 32 + 8 * fq; const int slot0 = u.pm * BM + wr * 64 + fr;
#pragma unroll
        for (int ai = 0; ai < 2; ++ai)
#pragma unroll
            for (int m = 0; m < 4; ++m) { const int slot = slot0 + ai * HALF + m * 16; const float g = slot_gate[slot]; bf16_t* rowp = Y2 + (size_t)slot * 1024 + col0;
#pragma unroll
                for (int bj = 0; bj < 2; ++bj) { const f32x4 v0 = acc[ai][bj][m][0] * g, v1 = acc[ai][bj][m][1] * g;
                    u32x4 w; w.x = cvt_pk_bf16(v0[0], v0[1]); w.y = cvt_pk_bf16(v0[2], v0[3]); w.z = cvt_pk_bf16(v1[0], v1[1]); w.w = cvt_pk_bf16(v1[2], v1[3]);
                    *(u32x4*)(rowp + bj * HALF) = w; } }
    }
};
enum EpiMode { E_BF16 = 0, E_BF16NORM, E_RES, E_SWIGLU, E_MOEY2 };
struct EpiAny {
    static constexpr bool PERM = true, AFTER_DRAIN = false;
    int mode;
    bf16_t* O; int ldc, npn; const float* ssq; const float* cbias; int cbld;
    const float* xin; float* xout; const float* modbase; int compact, srcin, fuse; const float* xsrc_lat; const float* xsrc_ctx; const float* gnext; const float* nscale; float* ssqw;
    const float* slot_gate;
    __device__ __forceinline__ void res(const f32x4 (&acc)[2][2][4][2], const Unit& u, int wr, int wc, int fr, int fq) const {
        const int b = u.pm / 9, pj = u.pm - 9 * b; const int mrow = (pj == 0) ? 8 : b;
        const float* g = modbase + (size_t)mrow * 6144;
        const int col0 = u.pn * BM + wc * 32 + 8 * fq;
        f32x4 gv[2][2];
#pragma unroll
        for (int bj = 0; bj < 2; ++bj)
#pragma unroll
            for (int n = 0; n < 2; ++n) gv[bj][n] = *(const f32x4*)(g + col0 + bj * HALF + n * 4);
        const int row0 = u.pm * BM + wr * 64 + fr; const int oshift = compact ? 256 * (b + 1) : 0;
        const float* xbase = srcin ? (pj == 0 ? xsrc_ctx + (size_t)b * 256 * 1024 : xsrc_lat + ((size_t)b * 2048 + (pj - 1) * 256) * 1024) - (size_t)u.pm * BM * 1024 : xin;
        const float* ns = nscale + (size_t)mrow * 6144; bf16_t* hraw = O;
#pragma unroll
        for (int ai = 0; ai < 2; ++ai)
#pragma unroll
            for (int m = 0; m < 4; ++m) { const int row = row0 + ai * HALF + m * 16; const float* xi = xbase + (size_t)row * 1024 + col0; float* xo = xout + (size_t)(row - oshift) * 1024 + col0; float ss = 0.f;
#pragma unroll
                for (int bj = 0; bj < 2; ++bj)
#pragma unroll
                    for (int n = 0; n < 2; ++n) { const f32x4 v = *(const f32x4*)(xi + bj * HALF + n * 4) + gv[bj][n] * acc[ai][bj][m][n]; *(f32x4*)(xo + bj * HALF + n * 4) = v;
                        if (fuse) { const int c = col0 + bj * HALF + n * 4; const f32x4 hv = v * (*(const f32x4*)(gnext + c) * (*(const f32x4*)(ns + c) + 1.f));
                            ss += (v[0] * v[0] + v[1] * v[1]) + (v[2] * v[2] + v[3] * v[3]);
                            u32x2 w; w.x = cvt_pk_bf16(hv[0], hv[1]); w.y = cvt_pk_bf16(hv[2], hv[3]); *(u32x2*)(hraw + (size_t)row * 1024 + c) = w; } }
                if (fuse) { ss += __shfl_xor(ss, 16); ss += __shfl_xor(ss, 32); if (fq == 0) unsafeAtomicAdd(ssqw + row, ss); }
                if (m & 1) asm volatile("" ::: "memory"); }
    }
    __device__ __forceinline__ void operator()(const f32x4 (&acc)[2][2][4][2], const Unit& u, int wr, int wc, int fr, int fq) const {
        if (mode == E_BF16) { EpiBf16<0> e{O, ldc, nullptr, 0, 0, 1.f}; e(acc, u, wr, wc, fr, fq); }
        else if (mode == E_BF16NORM) { EpiBf16Norm e{O, ldc, ssq, cbias, cbld}; e(acc, u, wr, wc, fr, fq); }
        else if (mode == E_SWIGLU) { EpiSwiGLU e{O, ldc, npn, ssq, cbias, cbld}; e(acc, u, wr, wc, fr, fq); }
        else if (mode == E_MOEY2) { EpiMoeY2 e{slot_gate, O}; e(acc, u, wr, wc, fr, fq); }
        else res(acc, u, wr, wc, fr, fq);
    }
};
struct ChainOrder {
    int stage, c;
    __device__ __forceinline__ bool next(int i, Unit& u) const {
        const int x = c & 7, r = c >> 3; int lu = -1, nN = 4;
        if (stage == 0) { if (i == 0) lu = r; else if (i == 1 && r >= 16 && r < 20) lu = 16 + r; }
        else if (stage == 1) { nN = 22;
            if (i < 3) lu = 32 * i + r; else if (i == 3) { if (r < 30) lu = 96 + r; }
            else if (r < 28) { if (i < 6) lu = 126 + 28 * (i - 4) + r; else if (i == 6 && r < 16) lu = 182 + r; } }
        else if (stage == 2) { if (r >= 28) { if (i == 0) lu = r - 28; else if (i == 1) lu = r - 16; }
               else if (i == 0) { if (r < 16) lu = 20 + r; else { const int k = r - 16; lu = k < 8 ? 4 + k : 8 + k; } } }
        else {
            if (i < 2) lu = 32 * i + r; else if (i == 2 && r == 31) lu = 64;
            if (lu < 0) return false;
            if (lu == 64) { u.pm = 9 * x; u.pn = 7; } else { u.pm = 9 * x + 1 + (lu & 7); u.pn = lu >> 3; }
            return true; }
        if (lu < 0) return false;
        const unsigned long long perm = x == 6 ? 0x874310652ull : x == 7 ? 0x875421630ull : 0x876543210ull;
        const int g = lu / (3 * nN), w = lu - g * 3 * nN; u.pm = 9 * x + (int)((perm >> (4 * (3 * g + w % 3))) & 15ull); u.pn = w / 3; return true;
    }
};
struct MoeChainOrder {
    const PG8_LAS int* tb; int stage, c;
    __device__ __forceinline__ bool next(int i, Unit& u) const {
        const int x = c & 7, r = c >> 3, T = tb[8];
        const int t0 = (T * x) >> 3, n = ((T * (x + 1)) >> 3) - t0, j = r & 7, cc = r >> 3;
        int tile, col, nN;
        if (stage == 1) { nN = 4; tile = 8 * i + j; col = cc; if (tile >= n) return false; }
        else { nN = 28;
            const int kb = ((n & 7) == 1) ? 1 : 0, H = 4 * kb, tot = 28 * n + 12 * kb, A0 = tot >> 5, rem = tot & 31, ah = A0 - 3 * kb;
            const bool heavy = kb && j == 0;
            const int nr = r - (kb ? cc + (j > 0 ? 1 : 0) : 0);
            int m;
            if (i < ah) m = 32 * i + r;
            else { if (heavy) return false;
                   if (i < A0) m = 32 * ah + (32 - H) * (i - ah) + nr;
                   else if (i == A0 && nr < rem) m = 32 * ah + (32 - H) * (A0 - ah) + nr;
                   else return false; }
            if (m >= 28 * n) return false;
            const int g = m / 112, w = m - g * 112, gs = (n - 4 * g) < 4 ? (n - 4 * g) : 4; tile = 4 * g + w % gs; col = w / gs; }
        const int t = t0 + tile; int e = 0;
#pragma unroll
        for (int k = 1; k < 8; ++k) if (t >= tb[k]) e = k;
        u.pm = t; u.pn = e * nN + col; return true;
    }
};
struct OrderAny {
    int omode;
    DenseOrder d; MoeOrder m; ChainOrder ch; MoeChainOrder mch;
    mutable unsigned early, ew0, ew1, ew2, ew3;
    __device__ __forceinline__ bool next(int i, Unit& u) const {
        const bool ok = omode == 3 ? m.next(i, u) : omode == 4 ? ch.next(i, u) : omode == 5 ? mch.next(i, u) : d.next(i, u);
        if (ok && wcnt != nullptr) {
            early = __hip_atomic_load(wcnt + u.pm * 16, __ATOMIC_RELAXED, __HIP_MEMORY_SCOPE_AGENT);
            if (w2kind != 0) { int lo, hi; war_range(u, lo, hi);
                ew0 = __hip_atomic_load(w2cnt + (lo     <= hi ? lo     : u.pm) * 16, __ATOMIC_RELAXED, __HIP_MEMORY_SCOPE_AGENT);
                ew1 = __hip_atomic_load(w2cnt + (lo + 1 <= hi ? lo + 1 : u.pm) * 16, __ATOMIC_RELAXED, __HIP_MEMORY_SCOPE_AGENT);
                ew2 = __hip_atomic_load(w2cnt + (lo + 2 <= hi ? lo + 2 : u.pm) * 16, __ATOMIC_RELAXED, __HIP_MEMORY_SCOPE_AGENT);
                ew3 = __hip_atomic_load(w2cnt + (lo + 3 <= hi ? lo + 3 : u.pm) * 16, __ATOMIC_RELAXED, __HIP_MEMORY_SCOPE_AGENT); }
        }
        return ok;
    }
    unsigned* wcnt; unsigned wtarget; unsigned* dcnt; int rel_agent;
    unsigned* w2cnt; int w2kind;
    __device__ __forceinline__ void war_range(const Unit& u, int& lo, int& hi) const {
        if (w2kind == 1) { const int a0 = u.pm * 1441792 - 75497472, a1 = a0 + 1441791; lo = (a0 > 0 ? a0 : 0) >> 19; hi = a1 < 0 ? -1 : (a1 >> 19); }
        else { const int b0 = u.pm << 20; lo = b0 / 1441792; hi = (b0 + 1048575) / 1441792; }
    }
    __device__ __forceinline__ void a_ready(const Unit& u) const {
        if (wcnt != nullptr) {
            unsigned* p = wcnt + u.pm * 16; unsigned sp = 0u;
            unsigned mn = early;
            if (w2kind != 0) { const unsigned a = ew0 < ew1 ? ew0 : ew1, b = ew2 < ew3 ? ew2 : ew3, c2 = a < b ? a : b; mn = c2 < mn ? c2 : mn; }
            if (mn < wtarget) {
                while (__hip_atomic_load(p, __ATOMIC_RELAXED, __HIP_MEMORY_SCOPE_AGENT) < wtarget) { __builtin_amdgcn_s_sleep(1); if (++sp > (1u << 22)) break; }
                if (w2kind != 0) { int lo, hi; war_range(u, lo, hi);
                    for (int q = lo; q <= hi; ++q) while (__hip_atomic_load(w2cnt + q * 16, __ATOMIC_RELAXED, __HIP_MEMORY_SCOPE_AGENT) < wtarget) { __builtin_amdgcn_s_sleep(1); if (++sp > (1u << 22)) break; } }
            }
            if (rel_agent) __builtin_amdgcn_fence(__ATOMIC_ACQUIRE, "agent");
            asm volatile("" ::: "memory");
        }
    }
    __device__ __forceinline__ void done(const Unit& u) const {
        if (dcnt != nullptr) {
            if (rel_agent) __builtin_amdgcn_fence(__ATOMIC_RELEASE, "agent");
            asm volatile("s_waitcnt vmcnt(0)" ::: "memory");
            if ((threadIdx.x & 63) == 0) (void)__hip_atomic_fetch_add(dcnt + u.pm * 16, 1u, __ATOMIC_RELAXED, __HIP_MEMORY_SCOPE_AGENT);
        }
    }
};
}
#define GAS __attribute__((address_space(1)))
#define LAS __attribute__((address_space(3)))
typedef unsigned v4u __attribute__((ext_vector_type(4)));
typedef short bf16x8 __attribute__((ext_vector_type(8)));
namespace att {
using f32x16 = __attribute__((ext_vector_type(16))) float;
using s16x4 = __attribute__((ext_vector_type(4))) short;
typedef float f32x2_t __attribute__((ext_vector_type(2))); typedef __bf16 bf16x2_t __attribute__((ext_vector_type(2)));
__device__ __forceinline__ int crow(int r, int hi) { return (r & 3) + 8 * (r >> 2) + 4 * hi; }
__device__ __forceinline__ void glds16(const void* gsrc, unsigned lds_dst) { unsigned keep;
    asm volatile("s_mov_b32 %0, m0\n\ts_mov_b32 m0, %2\n\ts_nop 0\n\tglobal_load_lds_dwordx4 %1, off\n\ts_mov_b32 m0, %0" : "=&s"(keep) : "v"(gsrc), "s"(lds_dst) : "memory"); }
__device__ __forceinline__ unsigned cvtpk_s(float lo, float hi) { f32x2_t v = {lo, hi}; bf16x2_t b = __builtin_convertvector(v, bf16x2_t); return __builtin_bit_cast(unsigned, b); }
#define ATT_MX3(a, b, c) __builtin_fmaxf(__builtin_fmaxf((a), (b)), (c))
__device__ __forceinline__ float rowmax32(const f32x16& p0, const f32x16& p1) {
    float a = ATT_MX3(p0[0], p0[1], p1[0]), b = ATT_MX3(p0[2], p0[3], p1[1]); a = ATT_MX3(a, p1[2], p1[3]);
#pragma unroll
    for (int r = 4; r < 16; r += 4) { a = ATT_MX3(a, p0[r], p0[r + 1]); b = ATT_MX3(b, p0[r + 2], p0[r + 3]); a = ATT_MX3(a, p1[r], p1[r + 1]); b = ATT_MX3(b, p1[r + 2], p1[r + 3]); }
    a = __builtin_fmaxf(a, b);
    auto rr = __builtin_amdgcn_permlane32_swap(__float_as_uint(a), __float_as_uint(a), false, false);
    return fmaxf(__uint_as_float(rr[0]), __uint_as_float(rr[1]));
}
__device__ __forceinline__ void pv(f32x16* o, int vb, bf16x8 pa0, bf16x8 pa1, bf16x8 pa2, bf16x8 pa3) {
    s16x4 lo[2][4], hi[2][4];
#pragma unroll
    for (int d0 = 0; d0 < 2; ++d0)
#pragma unroll
        for (int ks = 0; ks < 4; ++ks) {
            asm volatile("ds_read_b64_tr_b16 %0,%1 offset:%c2" : "=&v"(lo[d0][ks]) : "v"(vb), "i"(d0 * 4096 + ks * 1024) : "memory");
            asm volatile("ds_read_b64_tr_b16 %0,%1 offset:%c2" : "=&v"(hi[d0][ks]) : "v"(vb), "i"(d0 * 4096 + ks * 1024 + 512) : "memory"); }
    asm volatile("s_waitcnt lgkmcnt(0)" ::: "memory"); __builtin_amdgcn_sched_barrier(0);
#define ATT_PK(d, k) (bf16x8){lo[d][k][0], lo[d][k][1], lo[d][k][2], lo[d][k][3], hi[d][k][0], hi[d][k][1], hi[d][k][2], hi[d][k][3]}
    o[0] = __builtin_amdgcn_mfma_f32_32x32x16_bf16(pa0, ATT_PK(0, 0), o[0], 0, 0, 0); o[1] = __builtin_amdgcn_mfma_f32_32x32x16_bf16(pa0, ATT_PK(1, 0), o[1], 0, 0, 0);
    o[0] = __builtin_amdgcn_mfma_f32_32x32x16_bf16(pa1, ATT_PK(0, 1), o[0], 0, 0, 0); o[1] = __builtin_amdgcn_mfma_f32_32x32x16_bf16(pa1, ATT_PK(1, 1), o[1], 0, 0, 0);
    o[0] = __builtin_amdgcn_mfma_f32_32x32x16_bf16(pa2, ATT_PK(0, 2), o[0], 0, 0, 0); o[1] = __builtin_amdgcn_mfma_f32_32x32x16_bf16(pa2, ATT_PK(1, 2), o[1], 0, 0, 0);
    o[0] = __builtin_amdgcn_mfma_f32_32x32x16_bf16(pa3, ATT_PK(0, 3), o[0], 0, 0, 0); o[1] = __builtin_amdgcn_mfma_f32_32x32x16_bf16(pa3, ATT_PK(1, 3), o[1], 0, 0, 0);
#undef ATT_PK
}
template <int DQ> struct Geo {
    static constexpr int NCH = DQ / 8, KSLOT = NCH * 1024, VSLOT = 8192;
    static constexpr int LDS_K = 0, LDS_V = 2 * KSLOT, LDS_WS = LDS_V + 2 * VSLOT, LDS_OST = LDS_WS + 8 * 256, LDS_BYTES = LDS_OST + 8 * 4096;
};
template <int DQ>
__device__ __forceinline__ void unit(int b, int hq, int hk, int qb, int NT, const bf16_t* __restrict__ Q, int ldq, const bf16_t* __restrict__ K, int ldk, const bf16_t* __restrict__ V, int ldv,
                                     bf16_t* __restrict__ O, int ldo, LAS unsigned char* shm) {
    typedef Geo<DQ> G; constexpr int ND0 = DQ / 16;
    const int tid = threadIdx.x, lane = tid & 63, r32 = lane & 31, hi = lane >> 5; const int wid = __builtin_amdgcn_readfirstlane(tid >> 6);
    const long rowbase = (long)b * RPB; const int q0 = qb * 256;
    const bf16_t* Qw = Q + (rowbase + q0 + wid * 32) * ldq + hq * DQ;
    const bf16_t* Kh = K + rowbase * ldk + hk * DQ; const bf16_t* Vh = V + rowbase * ldv + hk * 64;
    const unsigned lds0 = (unsigned)(uintptr_t)shm;
    LAS float* wsf = (LAS float*)(shm + G::LDS_WS) + wid * 64;
    const bf16_t* ksrc = Kh + (long)lane * ldk + wid * 8;
    const bf16_t* vsrc = Vh + (long)(16 * (wid & 3) + (lane >> 2)) * ldv + (wid >> 2) * 32 + (lane & 3) * 8;
    const unsigned kdst = lds0 + G::LDS_K + wid * 1024, vdst = lds0 + G::LDS_V + wid * 1024;
    const int vb0 = (int)(lds0 + G::LDS_V) + ((lane >> 4) & 1) * 32 + (lane & 3) * 8 + (4 * hi + ((lane & 15) >> 2)) * 64;
#define ATT_DMA(t, s) do { const bf16_t* kp_ = ksrc + (long)(t) * 64 * ldk; glds16(kp_, (unsigned)__builtin_amdgcn_readfirstlane(kdst + (s) * G::KSLOT)); \
        if (DQ == 96 && wid < 4) glds16(kp_ + 64, (unsigned)__builtin_amdgcn_readfirstlane(kdst + (s) * G::KSLOT + 8192)); \
        glds16(vsrc + (long)(t) * 64 * ldv, (unsigned)__builtin_amdgcn_readfirstlane(vdst + (s) * G::VSLOT)); } while (0)
    ATT_DMA(0, 0);
    bf16x8 qr[ND0];
#pragma unroll
    for (int d0 = 0; d0 < ND0; ++d0) qr[d0] = *reinterpret_cast<const bf16x8*>(&Qw[(long)r32 * ldq + d0 * 16 + hi * 8]);
    constexpr float THR = 8.f;
    float mref = 0.f, l_reg = 0.f; f32x16 o[2]; o[0] = f32x16{}; o[1] = f32x16{}; f32x16 negm = f32x16{};
    for (int t = 0; t < NT; ++t) {
        const int s = t & 1;
        asm volatile("s_waitcnt vmcnt(0) lgkmcnt(0)\n\ts_barrier" ::: "memory");
        if (t + 1 < NT) ATT_DMA(t + 1, s ^ 1);
        f32x16 p0, p1;
        { const LAS unsigned char* kb = shm + G::LDS_K + s * G::KSLOT + hi * 1024 + r32 * 16;
#pragma unroll
          for (int d0 = 0; d0 < ND0; ++d0) { const bf16x8 b0 = *(const LAS bf16x8*)(kb + d0 * 2048); const bf16x8 b1 = *(const LAS bf16x8*)(kb + d0 * 2048 + 512);
              p0 = __builtin_amdgcn_mfma_f32_32x32x16_bf16(b0, qr[d0], d0 == 0 ? negm : p0, 0, 0, 0); p1 = __builtin_amdgcn_mfma_f32_32x32x16_bf16(b1, qr[d0], d0 == 0 ? negm : p1, 0, 0, 0); } }
        const float rm = rowmax32(p0, p1);
        if (__builtin_expect(t == 0 || __any(rm > THR), 0)) {
            const float dl = t == 0 ? rm : __builtin_fmaxf(rm, 0.f); mref += dl;
#pragma unroll
            for (int r = 0; r < 16; ++r) { p0[r] -= dl; p1[r] -= dl; negm[r] = -mref; }
            const float alpha = t == 0 ? 1.f : __builtin_amdgcn_exp2f(-dl); l_reg *= alpha;
            if (hi == 0) wsf[r32] = alpha;
            asm volatile("s_waitcnt lgkmcnt(0)" ::: "memory");
#pragma unroll
            for (int r = 0; r < 16; ++r) { const float a = wsf[crow(r, hi)]; o[0][r] *= a; o[1][r] *= a; }
        }
        f32x2_t sacc = {0.f, 0.f};
#pragma unroll
        for (int r = 0; r < 16; r += 2) { p0[r] = __builtin_amdgcn_exp2f(p0[r]); p0[r + 1] = __builtin_amdgcn_exp2f(p0[r + 1]); p1[r] = __builtin_amdgcn_exp2f(p1[r]); p1[r + 1] = __builtin_amdgcn_exp2f(p1[r + 1]);
            sacc += (f32x2_t){p0[r], p0[r + 1]}; sacc += (f32x2_t){p1[r], p1[r + 1]}; }
        l_reg += sacc[0] + sacc[1];
        u32x4 pw0, pw1, pw2, pw3;
        pw0 = (u32x4){cvtpk_s(p0[0], p0[1]), cvtpk_s(p0[2], p0[3]), cvtpk_s(p0[4], p0[5]), cvtpk_s(p0[6], p0[7])};
        pw1 = (u32x4){cvtpk_s(p0[8], p0[9]), cvtpk_s(p0[10], p0[11]), cvtpk_s(p0[12], p0[13]), cvtpk_s(p0[14], p0[15])};
        pw2 = (u32x4){cvtpk_s(p1[0], p1[1]), cvtpk_s(p1[2], p1[3]), cvtpk_s(p1[4], p1[5]), cvtpk_s(p1[6], p1[7])};
        pw3 = (u32x4){cvtpk_s(p1[8], p1[9]), cvtpk_s(p1[10], p1[11]), cvtpk_s(p1[12], p1[13]), cvtpk_s(p1[14], p1[15])};
        pv(o, vb0 + s * G::VSLOT, __builtin_bit_cast(bf16x8, pw0), __builtin_bit_cast(bf16x8, pw1), __builtin_bit_cast(bf16x8, pw2), __builtin_bit_cast(bf16x8, pw3));
    }
#undef ATT_DMA
    { auto rr = __builtin_amdgcn_permlane32_swap(__float_as_uint(l_reg), __float_as_uint(l_reg), false, false); l_reg = __uint_as_float(rr[0]) + __uint_as_float(rr[1]); }
    if (hi == 0) wsf[32 + r32] = l_reg;
    asm volatile("s_waitcnt lgkmcnt(0)" ::: "memory");
    float rli[16];
#pragma unroll
    for (int r = 0; r < 16; ++r) rli[r] = __builtin_amdgcn_rcpf(wsf[32 + crow(r, hi)]);
    bf16_t* Ow = O + (rowbase + q0 + wid * 32) * ldo + hq * 64;
    { LAS bf16_t* stg = (LAS bf16_t*)(shm + G::LDS_OST) + wid * 2048;
#pragma unroll
      for (int r = 0; r < 16; ++r) { const int orow = crow(r, hi);
#pragma unroll
          for (int d0 = 0; d0 < 2; ++d0) stg[orow * 64 + d0 * 32 + r32] = f2bf(o[d0][r] * rli[r]); }
      asm volatile("s_waitcnt lgkmcnt(0)" ::: "memory");
#pragma unroll
      for (int i = 0; i < 4; ++i) { const int row = i * 8 + (lane >> 3), ch = lane & 7; const u32x4 v = *(const LAS u32x4*)(stg + row * 64 + ch * 8); *(u32x4*)(Ow + (long)row * ldo + ch * 8) = v; } }
    asm volatile("s_waitcnt lgkmcnt(0)\n\ts_barrier" ::: "memory");
}
}
#define LDS_WAIT() asm volatile("s_waitcnt lgkmcnt(0)" ::: "memory")
#define VM_WAIT() asm volatile("s_waitcnt vmcnt(0)" ::: "memory")
constexpr int NWAVES = 8, NTHREADS = 512;
constexpr int RING_OFF = 0, RING_BYTES = 131072;
constexpr int MISC_OFF = RING_BYTES;
constexpr int LDS_BYTES = 147456;

enum Phase { PH_P0 = 0, PH_NORM0, PH_G_IN0, PH_LRUPREP, PH_MIX0, PH_G_OUT0, PH_G_F1, PH_G_F2, PH_G_IN1, PH_PREP1, PH_G_QKVB, PH_PREP2, PH_MIX1, PH_G_OUT1,
             PH_ROUTE, PH_SLOT, PH_MOE1, PH_MOE2, PH_COMBINE, PH_COUNT,
             PH_G_QB = 100, PH_G_KVB = 101 };

struct Params { const float* i0; const float* i1; const float* i2; const float* i3; const float* i4; const float* i5; const float* i6; const float* i7; const float* i8; const float* i9; const float* i10; const float* i11; const float* i12; const float* i13; const float* i14; const float* i15; const float* i16; const float* i17; const float* i18; const float* i19; const float* i20; const float* i21; const float* i22; const float* i23; const float* i24; const float* i25; const float* i26; const float* i27; const float* i28; const float* i29; const float* i30; const float* i31; const float* i32; const float* i33; const float* i34; const float* i35; const float* i36; const float* i37; const float* i38; const float* i39; const float* i40; const float* i41; const float* i42; float* out; char* ws; int ph_lo, ph_hi; };
#define PIN(k) (P.i##k)
static_assert(sizeof(Params) == 43 * 8 + 8 + 8 + 8, "Params has no padding");

struct Frame { LAS unsigned char* lds; int tid, lane, wave, G, bid, even; char* ws; };

__device__ __forceinline__ void tr_item(const float* __restrict__ W, int N, bf16_t* __restrict__ WT, int ldk, int kb, int nb, int dst_row0, LAS float* scr, int lane) {
    const int k0 = 64 * kb, n0 = 32 * nb;
    f32x4 v[8]; const float* wp = W + (size_t)(k0 + (lane >> 3)) * N + n0 + 4 * (lane & 7);
#pragma unroll
    for (int i = 0; i < 8; ++i) v[i] = __builtin_nontemporal_load((const f32x4*)(wp + (size_t)(8 * i) * N));
#pragma unroll
    for (int i = 0; i < 8; ++i) { LAS float* sp = scr + (8 * i + (lane >> 3)) * 33 + 4 * (lane & 7); sp[0] = v[i][0]; sp[1] = v[i][1]; sp[2] = v[i][2]; sp[3] = v[i][3]; }
    LDS_WAIT(); asm volatile("" ::: "memory");
    const int c = lane & 7;
#pragma unroll
    for (int j = 0; j < 4; ++j) { const int n = (lane >> 3) + 8 * j; const LAS float* s = scr + (8 * c) * 33 + n;
        v4u o; o.x = pk2(s[0 * 33], s[1 * 33]); o.y = pk2(s[2 * 33], s[3 * 33]); o.z = pk2(s[4 * 33], s[5 * 33]); o.w = pk2(s[6 * 33], s[7 * 33]);
        *(v4u*)(WT + (size_t)(dst_row0 + n) * ldk + k0 + 8 * c) = o; }
    LDS_WAIT(); asm volatile("" ::: "memory");
}
constexpr int MOE_ITEMS = 8 * 3 * 1792, MOE_CHUNK = 32, MOE_NCHUNK = MOE_ITEMS / MOE_CHUNK;
__device__ __forceinline__ void moe_conv_item(const Frame& F, const Params& P, int it, LAS float* scr) {
    const int e = it / 5376, r = it % 5376, which = r / 1792, q = r % 1792; char* ws = F.ws;
    const float* src; bf16_t* dst; int N, ldk, kb, nb, dr;
    if (which < 2) { kb = q / 112; nb = q % 112; const int n0 = nb * 32; dr = (n0 >> 7) * 256 + (n0 & 127) + (which == 1 ? 128 : 0);
        src = (which == 0 ? PIN(40) : PIN(41)) + (size_t)e * 1024 * 3584; N = 3584; dst = (bf16_t*)(ws + WS_W13M) + (size_t)e * 7168 * 1024; ldk = 1024; }
    else { kb = q / 32; nb = q % 32; dr = nb * 32; src = PIN(42) + (size_t)e * 3584 * 1024; N = 1024; dst = (bf16_t*)(ws + WS_W2M) + (size_t)e * 1024 * 3584; ldk = 3584; }
    tr_item(src, N, dst, ldk, kb, nb, dr, scr, F.lane);
}
__device__ __forceinline__ void moe_conv_all(const Frame& F, const Params& P) {
    LAS float* scr = (LAS float*)(F.lds + RING_OFF + F.wave * 16384); const int gw = F.bid * NWAVES + F.wave, NGW = F.G * NWAVES;
    __syncthreads();
#pragma unroll 1
    for (int it = gw; it < MOE_ITEMS; it += NGW) moe_conv_item(F, P, it, scr);
    __syncthreads();
}
struct ConvDesc { const float* src; bf16_t* dst; int N, ldk, nblk, start, il, pad; };
__device__ __forceinline__ void phase_conv(const Frame& F, const Params& P, bool moe) {
    LAS float* scr = (LAS float*)(F.lds + RING_OFF + F.wave * 16384); char* ws = F.ws;
    LAS ConvDesc* tab = (LAS ConvDesc*)(F.lds + MISC_OFF);
    if (F.tid < 41) { const int t = F.tid; ConvDesc d; d.il = 0; d.pad = 0;
        if (t == 0) { d.src = PIN(8); d.dst = (bf16_t*)(ws + WS_WIN0); d.N = 1792; d.ldk = 1024; d.start = 16 * 56; }
        else if (t == 1) { d.src = PIN(9); d.dst = (bf16_t*)(ws + WS_WOUT0); d.N = 1024; d.ldk = 1024; d.start = 16 * 32; }
        else if (t == 2) { d.src = PIN(19); d.dst = (bf16_t*)(ws + WS_WF13); d.N = 2816; d.ldk = 1024; d.start = 16 * 88; d.il = 1; }
        else if (t == 3) { d.src = PIN(20); d.dst = (bf16_t*)(ws + WS_WF13); d.N = 2816; d.ldk = 1024; d.start = 16 * 88; d.il = 2; }
        else if (t == 4) { d.src = PIN(21); d.dst = (bf16_t*)(ws + WS_WF2); d.N = 1024; d.ldk = 2816; d.start = 44 * 32; }
        else if (t == 5) { d.src = PIN(22); d.dst = (bf16_t*)(ws + WS_WIN1); d.N = 1952; d.ldk = 1024; d.start = 16 * 61; }
        else if (t == 6) { d.src = PIN(23); d.dst = (bf16_t*)(ws + WS_WOUT1); d.N = 1024; d.ldk = 1024; d.start = 16 * 32; }
        else if (t == 7) { d.src = PIN(34); d.dst = (bf16_t*)(ws + WS_WQB); d.N = 768; d.ldk = 256; d.start = 4 * 24; }
        else if (t == 8) { d.src = PIN(36); d.dst = (bf16_t*)(ws + WS_WKVB); d.N = 1024; d.ldk = 256; d.start = 2 * 32; }
        else { const int q = t - 9, dn = q >> 1, g = q & 1; d.src = (g ? PIN(14) : PIN(12)) + (size_t)dn * 4096; d.dst = (bf16_t*)(ws + WS_WLRU) + (size_t)(dn * 2 + g) * 4096; d.N = 64; d.ldk = 64; d.start = 2; }
        d.nblk = d.N / 32;
        tab[t].src = d.src; tab[t].dst = d.dst; tab[t].N = d.N; tab[t].ldk = d.ldk; tab[t].nblk = d.nblk; tab[t].start = d.start; tab[t].il = d.il; tab[t].pad = 0; }
    __syncthreads();
    if (F.tid == 0) { int s = 0; for (int t = 0; t < 41; ++t) { const int c = tab[t].start; tab[t].start = s; s += c; } tab[0].pad = s; }
    __syncthreads();
    const int total = tab[0].pad; const int gw = F.bid * NWAVES + F.wave, NGW = F.G * NWAVES;
#pragma unroll 1
    for (int it = gw; it < total; it += NGW) { int e = 0;
#pragma unroll 1
        for (int t = 1; t < 41; ++t) if (it >= tab[t].start) e = t;
        ConvDesc d; d.src = tab[e].src; d.dst = tab[e].dst; d.N = tab[e].N; d.ldk = tab[e].ldk; d.nblk = tab[e].nblk; d.start = tab[e].start; d.il = tab[e].il;
        const int loc = it - d.start, kb = loc / d.nblk, nb = loc % d.nblk, n0 = nb * 32;
        const int dr = d.il == 0 ? n0 : ((n0 >> 7) * 256 + (n0 & 127) + (d.il == 2 ? 128 : 0));
        tr_item(d.src, d.N, d.dst, d.ldk, kb, nb, dr, scr, F.lane); }
    const int gt = F.bid * NTHREADS + F.tid, NGT = F.G * NTHREADS;
    { v4u* z = (v4u*)((bf16_t*)(ws + WS_WIN1) + (size_t)1952 * 1024); for (int i = gt; i < 96 * 1024 / 8; i += NGT) z[i] = (v4u){0u, 0u, 0u, 0u}; }
    { bf16_t* wk = (bf16_t*)(ws + WS_WKVB); for (int i = gt; i < 1024 * 16; i += NGT) { const int r = i >> 4, cc = i & 15; *(v4u*)(wk + (size_t)r * 256 + 128 + cc * 8) = (v4u){0u, 0u, 0u, 0u}; } }
    __syncthreads();
}

constexpr size_t CT_TB = 64 * 1024;
enum GemmId { G_IN0 = 0, G_OUT0, G_F1, G_F2, G_IN1, G_QB, G_KVB, G_OUT1, G_MOE1, G_MOE2 };
__device__ __forceinline__ void run_gemm(const Frame& F, const Params& P, int gid) {
    char* ws = F.ws; float* MOD = (float*)(ws + WS_MOD); const float* MOD1 = MOD + 9 * MODLD; LAS unsigned char* lds = F.lds + RING_OFF;
    float* X = (float*)(ws + WS_X); bf16_t* H = (bf16_t*)(ws + WS_H); LAS int* tb = (LAS int*)(F.lds + MISC_OFF);
    pg8::Gemm g; pg8::OrderAny S; pg8::EpiAny E;
    E.mode = pg8::E_BF16; E.O = nullptr; E.ldc = 0; E.npn = 1; E.ssq = nullptr; E.cbias = nullptr; E.cbld = 0; E.xin = X; E.xout = X; E.modbase = MOD; E.compact = 0; E.srcin = 0; E.fuse = 0;
    E.xsrc_lat = PIN(0); E.xsrc_ctx = PIN(2); E.gnext = PIN(7); E.nscale = MOD; E.ssqw = (float*)(ws + WS_CTL + CT_SSQA); E.slot_gate = (const float*)(ws + WS_SLOTGATE);
    S.wcnt = nullptr; S.dcnt = nullptr; S.wtarget = 0u; S.w2cnt = nullptr; S.w2kind = 0; S.rel_agent = F.even ? 0 : 1; unsigned* PCNT = (unsigned*)(ws + WS_CTL + CT_PCNT);
    S.omode = 0; S.m.tb = tb; S.m.nN = 28; S.m.G = F.G; S.m.c = F.bid; g.M = MROWS; g.N = 0;
    if (gid == G_IN0) { g.A = H; g.Bt = (const bf16_t*)(ws + WS_WIN0); g.K = 1024; S.d.init(72, 7, F.G, F.bid, 0); E.O = (bf16_t*)(ws + WS_Z); E.ldc = 1792; }
    else if (gid == G_OUT0) { g.A = (const bf16_t*)(ws + WS_Y); g.Bt = (const bf16_t*)(ws + WS_WOUT0); g.K = 1024; S.d.init(72, 4, F.G, F.bid, 0); S.omode = 4; S.ch.stage = 0; S.ch.c = F.bid; S.dcnt = PCNT;
        E.mode = pg8::E_RES; E.modbase = MOD + 2 * DM; E.srcin = 1; E.fuse = 1; E.O = H; E.gnext = PIN(7); E.nscale = MOD + 4 * DM; E.ssqw = (float*)(ws + WS_CTL + CT_SSQA); }
    else if (gid == G_F1) { g.A = H; g.Bt = (const bf16_t*)(ws + WS_WF13); g.K = 1024; S.d.init(72, 22, F.G, F.bid, 0); S.omode = 4; S.ch.stage = 1; S.ch.c = F.bid; S.wcnt = PCNT; S.wtarget = 32u; S.dcnt = PCNT + 72 * 16; S.w2cnt = PCNT; S.w2kind = 1;
        E.mode = pg8::E_SWIGLU; E.O = (bf16_t*)(ws + WS_ACT); E.ldc = DFF; E.npn = 22; E.ssq = (const float*)(ws + WS_CTL + CT_SSQA); E.cbias = (const float*)(ws + WS_CBF1); E.cbld = 5632; }
    else if (gid == G_F2) { g.A = (const bf16_t*)(ws + WS_ACT); g.Bt = (const bf16_t*)(ws + WS_WF2); g.K = 2816; S.d.init(72, 4, F.G, F.bid, 0); S.omode = 4; S.ch.stage = 2; S.ch.c = F.bid; S.wcnt = PCNT + 72 * 16; S.wtarget = 176u; S.dcnt = PCNT + 144 * 16;
        E.mode = pg8::E_RES; E.modbase = MOD + 5 * DM; E.fuse = 1; E.O = H; E.gnext = PIN(6) + DM; E.nscale = MOD1 + 1 * DM; E.ssqw = (float*)(ws + WS_CTL + CT_SSQB); }
    else if (gid == G_IN1) { g.A = H; g.Bt = (const bf16_t*)(ws + WS_WIN1); g.K = 1024; S.d.init(64, 8, F.G, F.bid, 2); S.omode = 4; S.ch.stage = 3; S.ch.c = F.bid; S.wcnt = PCNT + 144 * 16; S.wtarget = 32u; S.w2cnt = PCNT + 144 * 16; S.w2kind = 2;
        E.mode = pg8::E_BF16NORM; E.O = (bf16_t*)(ws + WS_Z); E.ldc = 2048; E.ssq = (const float*)(ws + WS_CTL + CT_SSQB); E.cbias = (const float*)(ws + WS_CBIN1); E.cbld = 2048; }
    else if (gid == G_QB) { g.A = (const bf16_t*)(ws + WS_QA); g.Bt = (const bf16_t*)(ws + WS_WQB); g.K = 256; S.d.init(64, 3, F.G, F.bid, 1); S.omode = 1; E.O = (bf16_t*)(ws + WS_QR); E.ldc = 768; }
    else if (gid == G_KVB) { g.A = (const bf16_t*)(ws + WS_KVA); g.Bt = (const bf16_t*)(ws + WS_WKVB); g.K = 256; S.d.init(72, 4, F.G, F.bid, 0); E.O = (bf16_t*)(ws + WS_KVR); E.ldc = 1024; }
    else if (gid == G_OUT1) { g.A = (const bf16_t*)(ws + WS_Y); g.Bt = (const bf16_t*)(ws + WS_WOUT1); g.K = 1024; S.d.init(64, 4, F.G, F.bid, 1); S.omode = 1;
        E.mode = pg8::E_RES; E.xout = P.out; E.modbase = MOD1 + 2 * DM; E.compact = 1; }
    else { if (F.tid < 9) tb[F.tid] = ((const int*)(ws + WS_CTL + CT_TB))[F.tid];
        __syncthreads();
        S.omode = 5; S.d.init(1, 1, F.G, F.bid, 0); S.mch.tb = tb; S.mch.c = F.bid; unsigned* MCNT = (unsigned*)(ws + WS_CTL + CT_MCNT);
        if (gid == G_MOE1) { g.A = (const bf16_t*)(ws + WS_XG); g.Bt = (const bf16_t*)(ws + WS_W13M); g.K = 1024; S.m.nN = 28; S.mch.stage = 0; S.dcnt = MCNT; E.mode = pg8::E_SWIGLU; E.O = (bf16_t*)(ws + WS_ACT2); E.ldc = DFE; E.npn = 28; }
        else { g.A = (const bf16_t*)(ws + WS_ACT2); g.Bt = (const bf16_t*)(ws + WS_W2M); g.K = 3584; S.m.nN = 4; S.mch.stage = 1; S.wcnt = MCNT; S.wtarget = 224u; E.mode = pg8::E_MOEY2; E.O = (bf16_t*)(ws + WS_Y2); } }
    if (S.wcnt != nullptr) __builtin_amdgcn_fence(__ATOMIC_ACQUIRE, "agent");
    pg8::gemm_phase<pg8::EpiAny, pg8::OrderAny, true, true>(lds, g, S, E);
    __syncthreads();
}

__device__ __forceinline__ void phase_attn0(const Frame& F) {
    char* ws = F.ws; LAS unsigned char* lds = F.lds + RING_OFF;
    for (int i = 0;; ++i) { const int L = i * F.G + F.bid; if (L >= 576) break; const int b = L & 7, idx = L >> 3;
        const int h = idx < 64 ? (idx >> 3) : idx - 64, qb = idx < 64 ? 1 + (idx & 7) : 0, NT = idx < 64 ? 36 : 4;
        att::unit<64>(b, h, h >> 2, qb, NT, (const bf16_t*)(ws + WS_QB), 512, (const bf16_t*)(ws + WS_KB), 128, (const bf16_t*)(ws + WS_VB), 128, (bf16_t*)(ws + WS_Y) + 512, DM, lds); }
}
__device__ __forceinline__ void phase_attn1(const Frame& F, const Params& P) {
    char* ws = F.ws; char* dob = (char*)P.out; LAS unsigned char* lds = F.lds + RING_OFF;
    for (int i = 0;; ++i) { const int L = i * F.G + F.bid; if (L >= 512) break; const int b = L & 7, idx = L >> 3; const int h = idx >> 3, qb = 1 + (idx & 7);
        att::unit<96>(b, h, h, qb, 36, (const bf16_t*)(ws + WS_QM), 768, (const bf16_t*)(dob + DO_KM), 768, (const bf16_t*)(dob + DO_VM), 512, (bf16_t*)(ws + WS_Y) + 512, DM, lds); }
}

__device__ __forceinline__ void phase_route(const Frame& F, const Params& P) {
    char* ws = F.ws; const float* X = P.out; const float* g = PIN(7) + DM; const float* MODL = (const float*)(ws + WS_MOD) + 9 * MODLD; const float* router = PIN(39);
    bf16_t* H2 = (bf16_t*)(ws + WS_H2); int* SEL = (int*)(ws + WS_SEL); int* HIST = (int*)(ws + WS_CTL + CT_HIST);
    LAS int* hist = (LAS int*)(F.lds + MISC_OFF);
    if (F.tid < 8) hist[F.tid] = 0;
    __syncthreads();
    const int rpb = NLAT / F.G, rpw = rpb / NWAVES;
    const int lane = F.lane;
    f32x4 rw[4][4][2], gsc[4], shv[4];
    { const float* md = MODL + (size_t)((F.bid * rpb) / SEQ) * MODLD;
#pragma unroll
      for (int j4 = 0; j4 < 4; ++j4) { const int k = 4 * lane + 256 * j4; gsc[j4] = *(const f32x4*)(g + k) * (*(const f32x4*)(md + 4 * DM + k) + 1.f); shv[j4] = *(const f32x4*)(md + 3 * DM + k);
#pragma unroll
          for (int c = 0; c < 4; ++c) { rw[j4][c][0] = *(const f32x4*)(router + (size_t)(k + c) * 8); rw[j4][c][1] = *(const f32x4*)(router + (size_t)(k + c) * 8 + 4); } } }
#pragma unroll 1
    for (int q0 = 0; q0 < rpw; q0 += 2) {
      f32x4 vv[2][4];
#pragma unroll
      for (int qq = 0; qq < 2; ++qq) { const float* xr = X + (size_t)(F.bid * rpb + F.wave * rpw + q0 + qq) * DM;
#pragma unroll
          for (int j4 = 0; j4 < 4; ++j4) vv[qq][j4] = *(const f32x4*)(xr + 4 * lane + 256 * j4); }
#pragma unroll
      for (int qq = 0; qq < 2; ++qq) {
        const int m = F.bid * rpb + F.wave * rpw + q0 + qq;
        f32x4 (&v)[4] = vv[qq]; float ss = 0.f;
#pragma unroll
        for (int j4 = 0; j4 < 4; ++j4) ss += (v[j4][0] * v[j4][0] + v[j4][1] * v[j4][1]) + (v[j4][2] * v[j4][2] + v[j4][3] * v[j4][3]);
        const float rstd = rsqrtf(wave_sum(ss) / DM + EPS);
        f32x4 a03 = {0.f, 0.f, 0.f, 0.f}, a47 = {0.f, 0.f, 0.f, 0.f};
#pragma unroll
        for (int j4 = 0; j4 < 4; ++j4) { const int k = 4 * lane + 256 * j4; const f32x4 hv = v[j4] * rstd * gsc[j4] + shv[j4];
#pragma unroll
            for (int c = 0; c < 4; ++c) { a03 += rw[j4][c][0] * hv[c]; a47 += rw[j4][c][1] * hv[c]; }
            u32x2 w; w.x = pk2(hv[0], hv[1]); w.y = pk2(hv[2], hv[3]); *(u32x2*)(H2 + (size_t)m * DM + k) = w; }
        float acc[8] = {a03[0], a03[1], a03[2], a03[3], a47[0], a47[1], a47[2], a47[3]};
#pragma unroll
        for (int e = 0; e < 8; ++e) acc[e] = wave_sum(acc[e]);
        if (lane == 0) {
            int e0 = 0; float b0 = acc[0];
#pragma unroll
            for (int e = 1; e < 8; ++e) if (acc[e] > b0) { b0 = acc[e]; e0 = e; }
            int e1 = -1; float b1 = -INFINITY;
#pragma unroll
            for (int e = 0; e < 8; ++e) if (e != e0 && acc[e] > b1) { b1 = acc[e]; e1 = e; }
            const float ex = expf(b1 - b0); const float g0 = 1.f / (1.f + ex), g1 = ex / (1.f + ex);
            SEL[4 * m + 0] = e0; SEL[4 * m + 1] = e1; SEL[4 * m + 2] = __float_as_int(g0); SEL[4 * m + 3] = __float_as_int(g1);
            atomicAdd((int*)&hist[e0], 1); atomicAdd((int*)&hist[e1], 1);
        }
      }
    }
    __syncthreads();
    if (F.tid < 8) HIST[F.bid * 8 + F.tid] = hist[F.tid];
}
__device__ __forceinline__ void phase_slot(const Frame& F, const Params& P) {
    char* ws = F.ws; const int* HIST = (const int*)(ws + WS_CTL + CT_HIST); const int* SEL = (const int*)(ws + WS_SEL); int* TB = (int*)(ws + WS_CTL + CT_TB);
    const bf16_t* H2 = (const bf16_t*)(ws + WS_H2); bf16_t* XG = (bf16_t*)(ws + WS_XG); int* slot_tok = (int*)(ws + WS_SLOTTOK); float* slot_gate = (float*)(ws + WS_SLOTGATE);
    LAS int* sm = (LAS int*)(F.lds + MISC_OFF);
    if (F.tid < 16) sm[F.tid] = 0;
    { const int rpb0 = NLAT / F.G; for (int i = F.tid; i < 4 * rpb0; i += NTHREADS) sm[512 + i] = SEL[4 * F.bid * rpb0 + i]; }
    __syncthreads();
    for (int t = F.tid; t < 2 * F.G; t += NTHREADS) {
        const int j = t % F.G, hf = t / F.G; const int4 c = *(const int4*)(HIST + j * 8 + 4 * hf); const int mk = j < F.bid ? 1 : 0;
        int v[8] = {c.x, c.y, c.z, c.w, c.x * mk, c.y * mk, c.z * mk, c.w * mk};
#pragma unroll
        for (int q = 0; q < 8; ++q) {
#pragma unroll
            for (int o = 1; o < 64; o <<= 1) v[q] += __shfl_xor(v[q], o); }
        if (F.lane == 0) {
#pragma unroll
            for (int q = 0; q < 4; ++q) { atomicAdd((int*)&sm[4 * hf + q], v[q]); atomicAdd((int*)&sm[8 + 4 * hf + q], v[4 + q]); } }
    }
    __syncthreads();
    if (F.tid == 0) { int s = 0; for (int e = 0; e < 8; ++e) { sm[16 + e] = s; s += (sm[e] + 255) & ~255; } sm[24] = s; }
    __syncthreads();
    const int rpb = NLAT / F.G, na = 2 * rpb;
    if (F.tid == 0) { int run[8];
#pragma unroll
        for (int e = 0; e < 8; ++e) run[e] = sm[16 + e] + sm[8 + e];
        for (int a = 0; a < na; ++a) { const int e = sm[512 + 4 * (a >> 1) + (a & 1)]; int sl = 0;
#pragma unroll
            for (int q = 0; q < 8; ++q) if (q == e) { sl = run[q]; run[q] = sl + 1; }
            sm[32 + a] = sl; } }
    __syncthreads();
    for (int a0 = F.wave * 4; a0 < na; a0 += NWAVES * 4) { v4u va[4][2];
#pragma unroll
        for (int q = 0; q < 4; ++q) { const int a = a0 + q; const int m = F.bid * rpb + (a >> 1); const v4u* src = (const v4u*)(H2 + (size_t)m * DM); va[q][0] = src[F.lane]; va[q][1] = src[64 + F.lane]; }
#pragma unroll
        for (int q = 0; q < 4; ++q) { const int a = a0 + q; const int m = F.bid * rpb + (a >> 1), sl = sm[32 + a]; v4u* dst = (v4u*)(XG + (size_t)sl * DM); dst[F.lane] = va[q][0]; dst[64 + F.lane] = va[q][1];
            if (F.lane == 0) { slot_tok[sl] = m; ((int*)(ws + WS_TOKSLOT))[2 * m + (a & 1)] = sl; slot_gate[sl] = __int_as_float(sm[512 + 4 * (a >> 1) + 2 + (a & 1)]); } } }
    if (F.bid < 8) { const int e = F.bid; for (int sl = sm[16 + e] + sm[e] + F.tid; sl < sm[16 + e + 1]; sl += NTHREADS) slot_tok[sl] = -1; }
    if (F.bid == 0 && F.tid < 9) TB[F.tid] = sm[16 + F.tid] >> 8;
}
__device__ __forceinline__ void phase_combine(const Frame& F, const Params& P) {
    char* ws = F.ws; float* out = P.out; const bf16_t* Y2 = (const bf16_t*)(ws + WS_Y2); const int* TS = (const int*)(ws + WS_TOKSLOT); const float* mod5 = (const float*)(ws + WS_MOD) + 9 * MODLD + 5 * DM;
    const int gw = F.bid * NWAVES + F.wave, lane = F.lane; const int mb = gw * 8;
    f32x4 mv[2][2];
    { const float* md = mod5 + (size_t)(mb >> 11) * MODLD;
#pragma unroll
      for (int jj = 0; jj < 2; ++jj)
#pragma unroll
          for (int hlf = 0; hlf < 2; ++hlf) mv[jj][hlf] = *(const f32x4*)(md + 8 * lane + 512 * jj + 4 * hlf); }
#pragma unroll 1
    for (int q0 = 0; q0 < 8; q0 += 2) {
        f32x4 xv[2][4]; v4u ya[2][2], yb[2][2];
#pragma unroll
        for (int q = 0; q < 2; ++q) { const int m = mb + q0 + q; const int sa = TS[2 * m], sb = TS[2 * m + 1];
#pragma unroll
            for (int jj = 0; jj < 4; ++jj) xv[q][jj] = *(const f32x4*)(out + (size_t)m * DM + 8 * lane + 512 * (jj >> 1) + 4 * (jj & 1));
#pragma unroll
            for (int jj = 0; jj < 2; ++jj) { ya[q][jj] = *(const v4u*)(Y2 + (size_t)sa * DM + 8 * lane + 512 * jj); yb[q][jj] = *(const v4u*)(Y2 + (size_t)sb * DM + 8 * lane + 512 * jj); } }
#pragma unroll
        for (int q = 0; q < 2; ++q) { const int m = mb + q0 + q;
#pragma unroll
            for (int jj = 0; jj < 2; ++jj) { const int k = 8 * lane + 512 * jj;
#pragma unroll
                for (int hlf = 0; hlf < 2; ++hlf) { f32x4 o = xv[q][2 * jj + hlf]; const f32x4 mm = mv[jj][hlf];
                    const unsigned a0 = ya[q][jj][2 * hlf], a1 = ya[q][jj][2 * hlf + 1], b0 = yb[q][jj][2 * hlf], b1 = yb[q][jj][2 * hlf + 1];
                    o[0] += mm[0] * (__uint_as_float(a0 << 16) + __uint_as_float(b0 << 16)); o[1] += mm[1] * (__uint_as_float(a0 & 0xffff0000u) + __uint_as_float(b0 & 0xffff0000u));
                    o[2] += mm[2] * (__uint_as_float(a1 << 16) + __uint_as_float(b1 << 16)); o[3] += mm[3] * (__uint_as_float(a1 & 0xffff0000u) + __uint_as_float(b1 & 0xffff0000u));
                    *(f32x4*)(out + (size_t)m * DM + k + 4 * hlf) = o; } } }
    }
}

#define XB_TMO      128
#define XB_XCNT(j)  (256  + 64 * (j))
#define XB_XSUB(j)  (1280 + 64 * (j))
#define XB_XGEN(j)  (2304 + 64 * (j))
#define XB_TOP      3328
#define XB_TOPGEN   3392
#define XCD_BAR_WORDS 3456
#define XB_SPIN_CAP (1u << 18)

__device__ __forceinline__ unsigned xb_ld(unsigned* p)              { return __hip_atomic_load(p, __ATOMIC_RELAXED, __HIP_MEMORY_SCOPE_AGENT); }
__device__ __forceinline__ unsigned xb_add(unsigned* p, unsigned v) { return __hip_atomic_fetch_add(p, v, __ATOMIC_RELAXED, __HIP_MEMORY_SCOPE_AGENT); }
__device__ __forceinline__ unsigned xb_xcc_id() { return (unsigned)__builtin_amdgcn_s_getreg((3 << 11) | 20) & 0xFu; }
#define XB_SPIN(cond, bar) do { unsigned _sp = 0; while (cond) { __builtin_amdgcn_s_sleep(1); \
    if ((++_sp & 255u) == 0u) { if (xb_ld(&(bar)[XB_TMO])) break; if (_sp > XB_SPIN_CAP) { atomicAdd(&(bar)[XB_TMO], 1u); break; } } } } while (0)

struct XcdBarrier {
    unsigned* bar; unsigned x;
    volatile LAS unsigned* st;
};

__device__ __forceinline__ XcdBarrier xcd_barrier_post(unsigned* bar, volatile LAS unsigned* st) {
    XcdBarrier b; b.bar = bar; b.x = xb_xcc_id(); b.st = st;
    if (threadIdx.x == 0) st[2] = xb_add(&bar[XB_XCNT(b.x)], 1u);
    return b;
}
__device__ __forceinline__ void xcd_barrier_complete(unsigned* bar, unsigned x, unsigned& nloc, unsigned& nx, unsigned& even) {
    const unsigned G = gridDim.x * gridDim.y * gridDim.z;
    unsigned sum, cnt, mine, bal, sp = 0u;
    for (;;) {
        sum = 0u; cnt = 0u; mine = 0u; bal = 1u;
#pragma unroll
        for (unsigned j = 0; j < 16; ++j) { const unsigned c = xb_ld(&bar[XB_XCNT(j)]); sum += c; cnt += (c > 0u) ? 1u : 0u; mine = (j == x) ? c : mine; bal = (j < 8u && c * 8u != G) ? 0u : bal; }
        if (sum == G) break;
        __builtin_amdgcn_s_sleep(1);
        if ((++sp & 255u) == 0u) { if (xb_ld(&bar[XB_TMO])) break; if (sp > XB_SPIN_CAP) { atomicAdd(&bar[XB_TMO], 1u); break; } }
    }
    nloc = mine > 0u ? mine : 1u; nx = cnt > 0u ? cnt : 1u; even = (sum == G) ? bal : 0u;
}

__device__ __forceinline__ void xcd_barrier(const XcdBarrier& b) {
    asm volatile("s_waitcnt vmcnt(0)" ::: "memory");
    __syncthreads();
    if (threadIdx.x == 0) {
        unsigned* bar = b.bar;
        __builtin_amdgcn_s_waitcnt(0);
        unsigned nloc = b.st[0], nx = b.st[1];
        if (nloc == 0u) { unsigned ev; xcd_barrier_complete(bar, b.x, nloc, nx, ev); b.st[0] = nloc; b.st[1] = nx; b.st[3] = ev; }
        const unsigned old = xb_add(&bar[XB_XSUB(b.x)], 1u);
        const unsigned gen = old / nloc;
        if (old + 1u == (gen + 1u) * nloc) {
            __builtin_amdgcn_fence(__ATOMIC_RELEASE, "agent");
            asm volatile("s_waitcnt vmcnt(0)" ::: "memory");
            const unsigned og = xb_add(&bar[XB_TOP], 1u);
            const unsigned tg = og / nx;
            if (og + 1u == (tg + 1u) * nx) xb_add(&bar[XB_TOPGEN], 1u);
            else XB_SPIN(xb_ld(&bar[XB_TOPGEN]) == tg, bar);
            __builtin_amdgcn_fence(__ATOMIC_ACQUIRE, "agent");
            xb_add(&bar[XB_XGEN(b.x)], 1u);
            asm volatile("s_waitcnt vmcnt(0)" ::: "memory");
        } else {
            XB_SPIN(xb_ld(&bar[XB_XGEN(b.x)]) == gen, bar);
            __builtin_amdgcn_fence(__ATOMIC_ACQUIRE, "agent");
            asm volatile("s_waitcnt vmcnt(0)" ::: "memory");
        }
    }
    __syncthreads();
}
namespace hy {
using f32x16 = __attribute__((ext_vector_type(16))) float;
constexpr int UL = 2088, ULB = UL * 2;
constexpr int GOFF = 2064;
constexpr int L_U = 0, L_U2 = 8 * ULB, L_X = 2 * 8 * ULB, L_G0 = L_X + 8 * 2048 * 2, L_G1 = L_G0 + GT_LD * 2, L_END = L_G1 + GT_LD * 2;
static_assert(L_END <= RING_BYTES, "hyena LDS");
__device__ __forceinline__ void prep(const Frame& F, const Params& P) {
    char* ws = F.ws; const bf16_t* Z = (const bf16_t*)(ws + WS_Z); bf16_t* ZT = (bf16_t*)(ws + WS_ZT); const float* cw = PIN(24); const float* cb = PIN(25);
    const int gw = F.bid * NWAVES + F.wave, NGW = F.G * NWAVES, lane = F.lane; LAS unsigned char* tl = F.lds + RING_OFF + F.wave * 8192;
    for (int it = gw; it < 24 * 8 * 64; it += NGW) { const int cg = it % 24, b = (it / 24) & 7, tt = it / 192; const int c = cg * 64 + lane, t0 = tt * 32;
        const float w0 = cw[c], w1 = cw[1536 + c], w2 = cw[3072 + c], bias = cb[c];
        const bf16_t* zp = Z + ((size_t)b * RPB + CTX) * CD_LD + cg * 64;
        v4u pc[5];
#pragma unroll
        for (int k = 0; k < 5; ++k) { const int p = lane + 64 * k, row = p >> 3, c8 = p & 7, t = t0 - 1 + row; pc[k] = (p < 272 && t >= 0 && t < SEQ) ? *(const v4u*)(zp + (size_t)t * CD_LD + c8 * 8) : (v4u){0u, 0u, 0u, 0u}; }
#pragma unroll
        for (int k = 0; k < 5; ++k) { const int p = lane + 64 * k, row = p >> 3, c8 = p & 7; if (p < 272) *(LAS v4u*)(tl + row * 144 + c8 * 16) = pc[k]; }
        LDS_WAIT(); asm volatile("" ::: "memory");
        float xr[34];
#pragma unroll
        for (int i = 0; i < 34; ++i) xr[i] = bf2f(*(const LAS bf16_t*)(tl + i * 144 + lane * 2));
        LDS_WAIT(); asm volatile("" ::: "memory");
        bf16_t* op = ZT + ((size_t)c * NB + b) * SEQ + t0;
#pragma unroll
        for (int j8 = 0; j8 < 4; ++j8) { float y[8];
#pragma unroll
            for (int jj = 0; jj < 8; ++jj) { const int i = j8 * 8 + jj; y[jj] = bias + w0 * xr[i] + w1 * xr[i + 1] + w2 * xr[i + 2]; }
            v4u o; o.x = pk2(y[0], y[1]); o.y = pk2(y[2], y[3]); o.z = pk2(y[4], y[5]); o.w = pk2(y[6], y[7]); *(v4u*)(op + j8 * 8) = o; } }
}
__device__ __forceinline__ void filt(const Frame& F, const Params& P) {
    char* ws = F.ws; bf16_t* GT = (bf16_t*)(ws + WS_GT);
    const float *w1 = PIN(26), *b1 = PIN(27), *w2 = PIN(28), *b2 = PIN(29), *w3 = PIN(30), *freq = PIN(31);
    LAS float* z = (LAS float*)(F.lds + RING_OFF); LAS float* h1 = z + 9 * 64; LAS float* h2 = h1 + 9 * 64;
    const int tid = F.tid;
    for (int tb = F.bid; tb < SEQ / 8; tb += F.G) {
        const int t0 = tb * 8;
        __syncthreads();
        if (tid < 9 * 33) { const int tt = tid / 33, k = tid % 33, t = t0 + tt; float zv = (float)t / (float)(SEQ - 1);
            if (k > 0) { const int bi = (k - 1) & 15; const double band = 1e-4 + (15.0 - 1e-4) * (double)bi / 15.0; const double rev = (double)t * band * (1.0 / (double)SEQ);
                const float fr = (float)(rev - floor(rev)); zv = k <= 16 ? __builtin_amdgcn_cosf(fr) : -__builtin_amdgcn_sinf(fr); }
            z[tt * 64 + k] = zv; }
        __syncthreads();
        for (int idx = tid; idx < 9 * 64; idx += NTHREADS) { const int tt = idx >> 6, j = idx & 63; float a = b1[j];
#pragma unroll
            for (int i = 0; i < 33; ++i) a += z[tt * 64 + i] * w1[i * 64 + j];
            h1[idx] = __sinf(freq[j] * a); }
        __syncthreads();
        for (int idx = tid; idx < 9 * 64; idx += NTHREADS) { const int tt = idx >> 6, j = idx & 63; float a = b2[j];
#pragma unroll 16
            for (int i = 0; i < 64; ++i) a += h1[tt * 64 + i] * w2[i * 64 + j];
            h2[idx] = __sinf(freq[j] * a); }
        __syncthreads();
        float acc[4][9];
#pragma unroll
        for (int q = 0; q < 4; ++q)
#pragma unroll
            for (int tt = 0; tt < 9; ++tt) acc[q][tt] = 0.f;
#pragma unroll 16
        for (int i = 0; i < 64; ++i) { float wv[4];
#pragma unroll
            for (int q = 0; q < 4; ++q) wv[q] = w3[(size_t)i * 2048 + tid + 512 * q];
#pragma unroll
            for (int tt = 0; tt < 9; ++tt) { const float hv = h2[tt * 64 + i];
#pragma unroll
                for (int q = 0; q < 4; ++q) acc[q][tt] += hv * wv[q]; } }
        const double mind = log(1e-2) / 1.5, maxd = log(1e-2) / 0.3; const int ch = tid; const float delta = fabsf((float)(mind + (maxd - mind) * (double)ch / 511.0));
        float win[9];
#pragma unroll
        for (int tt = 0; tt < 9; ++tt) { const int t = t0 + tt; win[tt] = t < SEQ ? __expf(-((float)t / (float)(SEQ - 1)) * delta) + 0.05f : 0.f; }
#pragma unroll
        for (int ord = 0; ord < 2; ++ord) { bf16_t* gp = GT + ((size_t)ord * 512 + ch) * GT_LD + GOFF; float fw[9], bw[9];
#pragma unroll
            for (int tt = 0; tt < 9; ++tt) { fw[tt] = acc[2 * ord][tt] * win[tt]; bw[tt] = acc[2 * ord + 1][tt] * win[tt]; }
            if (t0 == 0) bw[0] = fw[0];
            v4u ob; ob.x = pk2(bw[0], bw[1]); ob.y = pk2(bw[2], bw[3]); ob.z = pk2(bw[4], bw[5]); ob.w = pk2(bw[6], bw[7]); *(v4u*)(gp + t0) = ob;
            v4u of; of.x = pk2(fw[8], fw[7]); of.y = pk2(fw[6], fw[5]); of.z = pk2(fw[4], fw[3]); of.w = pk2(fw[2], fw[1]); *(v4u*)(gp - t0 - 8) = of; }
    }
    const int gt = F.bid * NTHREADS + F.tid, NGT = F.G * NTHREADS; constexpr int NZ = 16 + (GT_LD - GOFF - 2048);
    for (int i = gt; i < 1024 * NZ; i += NGT) { const int oc = i / NZ, k = i % NZ; GT[(size_t)oc * GT_LD + (k < 16 ? k : GOFF + 2048 + (k - 16))] = 0; }
}
__device__ __forceinline__ void conv_mfma(f32x16 (&acc)[2], LAS unsigned char* Ub, LAS unsigned char* Gb, int wave, int lane) {
    const int n = lane & 31, h = lane >> 5, b = n >> 2, dl = n & 3;
    const LAS unsigned char* up = Ub + b * ULB + 16 * h;
    const int i = lane & 31;
    const LAS unsigned char* gp0 = Gb + 2 * (GOFF + 8 * h - 4 * i - 16 * (8 * (2 * wave) + 1));
    const LAS unsigned char* gp1 = gp0 - 2 * 16 * 8;
    acc[0] = f32x16{}; acc[1] = f32x16{};
    const bool sh2 = dl >= 2; const unsigned sb = (dl & 1) * 2;
    const LAS unsigned char* upq = up + 8 * (dl < 3 ? dl : 2);
    u32x4 ring[8];
#pragma unroll
    for (int b8 = 0; b8 < 8; ++b8) { const u32x2 a0 = *(const LAS u32x2*)(gp1 + 32 * b8), a1 = *(const LAS u32x2*)(gp1 + 32 * b8 + 8); ring[b8] = (u32x4){a0[0], a0[1], a1[0], a1[1]}; }
#define HY_STEP(J, b8) do { \
          \
        const u32x2 qx = *(const LAS u32x2*)(upq + 32 * (J)); \
        unsigned q[6]; \
        q[0] = __builtin_amdgcn_mov_dpp((int)qx[0], 0x00, 0xF, 0xF, false); q[1] = __builtin_amdgcn_mov_dpp((int)qx[1], 0x00, 0xF, 0xF, false); \
        q[2] = __builtin_amdgcn_mov_dpp((int)qx[0], 0x55, 0xF, 0xF, false); q[3] = __builtin_amdgcn_mov_dpp((int)qx[1], 0x55, 0xF, 0xF, false); \
        q[4] = __builtin_amdgcn_mov_dpp((int)qx[0], 0xAA, 0xF, 0xF, false); q[5] = __builtin_amdgcn_mov_dpp((int)qx[1], 0xAA, 0xF, 0xF, false); \
        u32x4 bw; \
        _Pragma("unroll") for (int w = 0; w < 4; ++w) { const unsigned lo = sh2 ? q[w + 1] : q[w], hi_ = sh2 ? q[w + 2] : q[w + 1]; bw[w] = __builtin_amdgcn_alignbyte(hi_, lo, sb); } \
        const u32x2 a00 = *(const LAS u32x2*)(gp0 + 32 * (J)), a01 = *(const LAS u32x2*)(gp0 + 32 * (J) + 8); \
        const u32x4 A1 = ring[b8]; const u32x4 A0 = {a00[0], a00[1], a01[0], a01[1]}; ring[b8] = A0; \
        acc[0] = __builtin_amdgcn_mfma_f32_32x32x16_bf16(__builtin_bit_cast(bf16x8, A0), __builtin_bit_cast(bf16x8, bw), acc[0], 0, 0, 0); \
        acc[1] = __builtin_amdgcn_mfma_f32_32x32x16_bf16(__builtin_bit_cast(bf16x8, A1), __builtin_bit_cast(bf16x8, bw), acc[1], 0, 0, 0); } while (0)
#pragma unroll 1
    for (int J8 = 0; J8 < 128; J8 += 8) {
#pragma unroll
        for (int b8 = 0; b8 < 8; ++b8) HY_STEP(J8 + b8, b8); }
    HY_STEP(128, 0);
#undef HY_STEP
}
__device__ __forceinline__ void main_phase(const Frame& F, const Params& P) {
    char* ws = F.ws; const bf16_t* ZT = (const bf16_t*)(ws + WS_ZT); const bf16_t* GT = (const bf16_t*)(ws + WS_GT); bf16_t* HT = (bf16_t*)(ws + WS_HT); const float* skip = PIN(32);
    LAS unsigned char* lds = F.lds + RING_OFF; const int tid = F.tid, lane = F.lane, wave = F.wave;
    const int n = lane & 31, h = lane >> 5, b = n >> 2, dl = n & 3;
    for (int c = F.bid; c < 512; c += F.G) {
        __syncthreads();
        for (int i = tid; i < 8 * 256; i += NTHREADS) { const int bb = i >> 8, k = i & 255; *(LAS v4u*)(lds + L_U + bb * ULB + 32 + k * 16) = *(const v4u*)(ZT + ((size_t)c * NB + bb) * SEQ + k * 8);
            *(LAS v4u*)(lds + L_X + (bb * 2048 + k * 8) * 2) = *(const v4u*)(ZT + ((size_t)(512 + c) * NB + bb) * SEQ + k * 8); }
        for (int i = tid; i < GT_LD / 8; i += NTHREADS) { *(LAS v4u*)(lds + L_G0 + i * 16) = *(const v4u*)(GT + (size_t)c * GT_LD + i * 8); *(LAS v4u*)(lds + L_G1 + i * 16) = *(const v4u*)(GT + (size_t)(512 + c) * GT_LD + i * 8); }
        if (tid < 80) { const int bb = tid / 10, k = tid % 10, which = k / 5, part = k % 5; const int off = bb * ULB + (part < 2 ? part * 16 : (16 + 2048) * 2 + (part - 2) * 16);
            *(LAS v4u*)(lds + (which ? L_U2 : L_U) + off) = (v4u){0u, 0u, 0u, 0u}; }
        __syncthreads();
        const float sk0 = skip[c], sk1 = skip[512 + c];
        f32x16 acc[2];
        conv_mfma(acc, lds + L_U, lds + L_G0, wave, lane);
#pragma unroll
        for (int ip = 0; ip < 2; ++ip)
#pragma unroll
            for (int r = 0; r < 16; ++r) { const int t = 128 * (2 * wave + ip) + 4 * att::crow(r, h) + dl;
                const float v = bf2f(*(const LAS bf16_t*)(lds + L_U + b * ULB + (16 + t) * 2)), x1 = bf2f(*(const LAS bf16_t*)(lds + L_X + (b * 2048 + t) * 2));
                *(LAS bf16_t*)(lds + L_U2 + b * ULB + (16 + t) * 2) = f2bf(x1 * (acc[ip][r] + sk0 * v)); }
        __syncthreads();
        for (int i = tid; i < 8 * 256; i += NTHREADS) { const int bb = i >> 8, k = i & 255; *(LAS v4u*)(lds + L_X + (bb * 2048 + k * 8) * 2) = *(const v4u*)(ZT + ((size_t)(1024 + c) * NB + bb) * SEQ + k * 8); }
        conv_mfma(acc, lds + L_U2, lds + L_G1, wave, lane);
        __syncthreads();
#pragma unroll
        for (int ip = 0; ip < 2; ++ip)
#pragma unroll
            for (int r = 0; r < 16; ++r) { const int t = 128 * (2 * wave + ip) + 4 * att::crow(r, h) + dl;
                const float y1 = bf2f(*(const LAS bf16_t*)(lds + L_U2 + b * ULB + (16 + t) * 2)), x2 = bf2f(*(const LAS bf16_t*)(lds + L_X + (b * 2048 + t) * 2));
                *(LAS bf16_t*)(lds + L_U + (b * 2048 + t) * 2) = f2bf(x2 * (acc[ip][r] + sk1 * y1)); }
        __syncthreads();
        for (int i = tid; i < 8 * 256; i += NTHREADS) *(v4u*)(HT + (size_t)c * NLAT + i * 8) = *(const LAS v4u*)(lds + L_U + i * 16);
    }
}
__device__ __forceinline__ void untranspose(const Frame& F) {
    char* ws = F.ws; const bf16_t* HT = (const bf16_t*)(ws + WS_HT); bf16_t* Y = (bf16_t*)(ws + WS_Y);
    const int gw = F.bid * NWAVES + F.wave, NGW = F.G * NWAVES, lane = F.lane; LAS unsigned char* tl = F.lds + RING_OFF + F.wave * 16384;
    __syncthreads();
    for (int it = gw; it < 8 * 8 * 32; it += NGW) { const int cg = it & 7, b = (it >> 3) & 7, tt = it >> 6; const int c = cg * 64 + lane, t0 = tt * 64;
        const bf16_t* hp = HT + ((size_t)c * NB + b) * SEQ + t0; bf16_t* yp = Y + ((size_t)b * RPB + CTX + t0) * DM + cg * 64;
        v4u q[8];
#pragma unroll
        for (int j8 = 0; j8 < 8; ++j8) q[j8] = *(const v4u*)(hp + j8 * 8);
#pragma unroll
        for (int j8 = 0; j8 < 8; ++j8)
#pragma unroll
            for (int jj = 0; jj < 4; ++jj) { *(LAS bf16_t*)(tl + (j8 * 8 + 2 * jj) * 144 + lane * 2) = (bf16_t)(q[j8][jj] & 0xffffu); *(LAS bf16_t*)(tl + (j8 * 8 + 2 * jj + 1) * 144 + lane * 2) = (bf16_t)(q[j8][jj] >> 16); }
        LDS_WAIT(); asm volatile("" ::: "memory");
#pragma unroll
        for (int k = 0; k < 8; ++k) { const int p = lane + 64 * k, row = p >> 3, c8 = p & 7; *(v4u*)(yp + (size_t)row * DM + c8 * 8) = *(const LAS v4u*)(tl + row * 144 + c8 * 16); }
        LDS_WAIT(); asm volatile("" ::: "memory"); }
}
}
namespace lru {
using f32x16 = __attribute__((ext_vector_type(16))) float;
typedef float f32x2 __attribute__((ext_vector_type(2)));
constexpr int T = 32, NCH = RPB / T;
constexpr int UPITCH = 1040;
constexpr int L_UT = 0, L_GL = 34816, L_END = L_GL + 2 * T * 512 * 2;
static_assert(L_END <= RING_BYTES, "lru LDS");
__device__ __forceinline__ float fsigmoid(float x) { return __builtin_amdgcn_rcpf(1.f + __builtin_amdgcn_exp2f(-LOG2E * x)); }
__device__ __forceinline__ float gelu_fast(float x) { const float y = 0.7978845608028654f * (x + 0.044715f * x * x * x); const float e = __builtin_amdgcn_exp2f(2.f * LOG2E * y); const float th = 1.f - 2.f * __builtin_amdgcn_rcpf(1.f + e); return 0.5f * x * (1.f + th); }
__device__ __forceinline__ int chunk_of_order(int d, int q) { return d == 0 ? q : (q < 8 ? 7 - q : 79 - q); }
__device__ __forceinline__ int order_of_chunk(int d, int j) { return d == 0 ? j : (j < 8 ? 7 - j : 79 - j); }

__device__ __forceinline__ void unit0(const Frame& F, const Params& P, int b, int j) {
    char* ws = F.ws; const bf16_t* Z = (const bf16_t*)(ws + WS_Z); float* AGG = (float*)(ws + WS_AGG); const bf16_t* WL = (const bf16_t*)(ws + WS_WLRU);
    bf16_t* LAB = (bf16_t*)P.out; bf16_t* BTB = (bf16_t*)(ws + WS_H);
    LAS unsigned char* lds = F.lds + RING_OFF; const int ch = F.tid, lane = F.lane, wave = F.wave;
    const int s0 = j * T, seg_lo = s0 < CTX ? 0 : CTX, seg_hi = s0 < CTX ? CTX : RPB; const size_t row0 = (size_t)b * RPB + s0;
    LDS_WAIT(); asm volatile("" ::: "memory");
    float u[T];
    { const float w0 = PIN(10)[ch], w1 = PIN(10)[512 + ch], w2 = PIN(10)[1024 + ch], w3 = PIN(10)[1536 + ch], cb = PIN(11)[ch];
      float xw[T + 3];
#pragma unroll
      for (int i = 0; i < T + 3; ++i) { const int s = s0 + i - 2; xw[i] = (s >= seg_lo && s < seg_hi) ? bf2f(Z[((size_t)b * RPB + s) * AB_IN + ch]) : 0.f; }
#pragma unroll
      for (int t = 0; t < T; ++t) { u[t] = cb + w0 * xw[t] + w1 * xw[t + 1] + w2 * xw[t + 2] + w3 * xw[t + 3]; *(LAS bf16_t*)(lds + L_UT + t * UPITCH + ch * 2) = f2bf(u[t]); } }
#pragma unroll
    for (int d = 0; d < 2; ++d) {
        LDS_WAIT(); asm volatile("" ::: "memory");
        { const int n = wave, r32 = lane & 31, h = lane >> 5; bf16x8 af[4];
#pragma unroll
          for (int ks = 0; ks < 4; ++ks) af[ks] = *(const LAS bf16x8*)(lds + L_UT + r32 * UPITCH + (64 * n + 16 * ks + 8 * h) * 2);
#pragma unroll
          for (int g = 0; g < 2; ++g)
#pragma unroll
              for (int cb = 0; cb < 2; ++cb) { f32x16 acc = f32x16{}; const bf16_t* wp = WL + ((size_t)((d * 8 + n) * 2 + g) * 64 + 32 * cb + r32) * 64 + 8 * h;
#pragma unroll
                  for (int ks = 0; ks < 4; ++ks) { const bf16x8 bfr = *(const bf16x8*)(wp + 16 * ks); acc = __builtin_amdgcn_mfma_f32_32x32x16_bf16(af[ks], bfr, acc, 0, 0, 0); }
                  const float bias = (g == 0 ? PIN(13) : PIN(15))[(d * 8 + n) * 64 + 32 * cb + r32];
#pragma unroll
                  for (int r = 0; r < 16; ++r) *(LAS bf16_t*)(lds + L_GL + ((g * T + att::crow(r, h)) * 512 + 64 * n + 32 * cb + r32) * 2) = f2bf(fsigmoid(acc[r] + bias)); } }
        LDS_WAIT(); asm volatile("" ::: "memory");
        const float cl = -8.f * softplus_f(-PIN(16)[d * 512 + ch]);
        float h = 0.f, sumlog = 0.f; bf16_t* lap = LAB + ((size_t)d * MROWS + row0) * 512 + ch; bf16_t* btp = BTB + ((size_t)d * MROWS + row0) * 512 + ch;
#pragma unroll
        for (int st = 0; st < T; ++st) { const int t = d == 0 ? st : T - 1 - st;
            const float rg = bf2f(*(const LAS bf16_t*)(lds + L_GL + (t * 512 + ch) * 2)), ig = bf2f(*(const LAS bf16_t*)(lds + L_GL + ((T + t) * 512 + ch) * 2));
            const bf16_t lab = f2bf(cl * rg); const float la = bf2f(lab); const float a = __builtin_amdgcn_exp2f(LOG2E * la);
            const bf16_t btb = f2bf(__builtin_amdgcn_sqrtf(fmaf(-a, a, 1.f)) * (ig * u[t])); const float bt = bf2f(btb);
            lap[(size_t)t * 512] = lab; btp[(size_t)t * 512] = btb;
            h = a * h + bt; sumlog += la; }
        { f32x2* ag = (f32x2*)AGG + ((size_t)(d * 8 + b) * NCH + j) * 512 + ch; *ag = (f32x2){sumlog, h}; }
    }
}
__device__ __forceinline__ void unit1(const Frame& F, const Params& P, int b, int j) {
    char* ws = F.ws; const bf16_t* Z = (const bf16_t*)(ws + WS_Z); bf16_t* Y = (bf16_t*)(ws + WS_Y); const float* AGG = (const float*)(ws + WS_AGG);
    const bf16_t* LAB = (const bf16_t*)P.out; const bf16_t* BTB = (const bf16_t*)(ws + WS_H);
    const int ch = F.tid; const size_t row0 = (size_t)b * RPB + j * T;
    float hf[T];
#pragma unroll
    for (int d = 0; d < 2; ++d) {
        const bf16_t* lap = LAB + ((size_t)d * MROWS + row0) * 512 + ch; const bf16_t* btp = BTB + ((size_t)d * MROWS + row0) * 512 + ch;
        bf16_t lav[T], btv[T]; bf16_t gv[T];
#pragma unroll
        for (int t = 0; t < T; ++t) { lav[t] = lap[(size_t)t * 512]; btv[t] = btp[(size_t)t * 512]; if (d == 1) gv[t] = Z[(row0 + t) * AB_IN + 512 + ch]; }
        float h = 0.f;
        { const int q = order_of_chunk(d, j); const f32x2* ag = (const f32x2*)AGG + (size_t)(d * 8 + b) * NCH * 512 + ch;
#pragma unroll 24
          for (int qq = 0; qq < q; ++qq) { const int jj = chunk_of_order(d, qq); const f32x2 av = ag[(size_t)jj * 512]; h = __builtin_amdgcn_exp2f(LOG2E * av[0]) * h + av[1]; } }
#pragma unroll
        for (int st = 0; st < T; ++st) { const int t = d == 0 ? st : T - 1 - st;
            h = __builtin_amdgcn_exp2f(LOG2E * bf2f(lav[t])) * h + bf2f(btv[t]);
            if (d == 0) hf[t] = h; else Y[(row0 + t) * DM + ch] = f2bf((hf[t] + h) * gelu_fast(bf2f(gv[t]))); }
    }
}
template <int MODE>
__device__ __forceinline__ void phase(const Frame& F, const Params& P) {
    const int first = MODE == 0 ? F.bid : (F.bid + 192) % F.G;
    for (int L = first; L < NB * NCH; L += F.G) { if (MODE == 0) unit0(F, P, L & 7, L >> 3); else unit1(F, P, L & 7, L >> 3); }
}
}
namespace el {
__device__ __forceinline__ void mod_phase(const Frame& F, const Params& P) {
    char* ws = F.ws; float* MOD = (float*)(ws + WS_MOD); const float* c = PIN(1); const float* cctx = PIN(3); const float* mw = PIN(4); const float* mb = PIN(5);
    LAS float* sc = (LAS float*)(F.lds + RING_OFF); LAS float* part = sc + 9 * DM;
    if (F.bid >= 192) return;
    for (int i = F.tid; i < 9 * DM; i += NTHREADS) { const int j = i >> 10, k = i & 1023; const float v = j < 8 ? c[j * DM + k] : cctx[k]; sc[i] = v / (1.f + expf(-v)); }
    __syncthreads();
    const int cg = F.lane & 15, kr = F.lane >> 4; const int col = F.bid * 64 + 4 * cg, l = col / MODLD, n = col % MODLD; const float* w = mw + (size_t)l * DM * MODLD + n; const int k0 = F.wave * 128 + kr;
    f32x4 acc[9];
#pragma unroll
    for (int j = 0; j < 9; ++j) acc[j] = (f32x4){0.f, 0.f, 0.f, 0.f};
#pragma unroll 8
    for (int i = 0; i < 32; ++i) { const int k = k0 + 4 * i; const f32x4 wv = __builtin_nontemporal_load((const f32x4*)(w + (size_t)k * MODLD));
#pragma unroll
        for (int j = 0; j < 9; ++j) acc[j] += wv * sc[j * DM + k]; }
#pragma unroll
    for (int j = 0; j < 9; ++j) {
#pragma unroll
        for (int c = 0; c < 4; ++c) { float v = acc[j][c]; v += __shfl_xor(v, 16); v += __shfl_xor(v, 32); acc[j][c] = v; }
        if (kr == 0) *(LAS f32x4*)(part + (F.wave * 9 + j) * 64 + 4 * cg) = acc[j]; }
    __syncthreads();
    for (int i = F.tid; i < 9 * 64; i += NTHREADS) { const int j = i >> 6, ln = i & 63; float s = 0.f;
#pragma unroll
        for (int wv = 0; wv < 8; ++wv) s += part[(wv * 9 + j) * 64 + ln];
        const int cc = F.bid * 64 + ln; MOD[((size_t)(cc / MODLD) * 9 + j) * MODLD + cc % MODLD] = s + mb[cc]; }
    __syncthreads();
}
__device__ __forceinline__ void bias_phase(const Frame& F, const Params& P) {
    char* ws = F.ws; const float* MOD = (const float*)(ws + WS_MOD);
    LAS float* sc = (LAS float*)(F.lds + RING_OFF); LAS float* part = sc + 9 * DM;
    if (F.bid >= 120) return;
    const bool f1 = F.bid < 88; const float* shb = f1 ? MOD + 3 * DM : MOD + 9 * MODLD;
    __syncthreads();
    for (int i = F.tid; i < 9 * DM; i += NTHREADS) sc[i] = shb[(size_t)(i >> 10) * MODLD + (i & 1023)];
    __syncthreads();
    const int cg = F.lane & 15, kr = F.lane >> 4; const int cc = (f1 ? F.bid : F.bid - 88) * 64 + 4 * cg; const float* w; int ldw; bool valid = true;
    if (f1) { const int pn = cc >> 8, c = cc & 255; w = (c < 128 ? PIN(19) : PIN(20)) + pn * 128 + (c & 127); ldw = DFF; } else { valid = cc < CD_IN; w = PIN(22) + (valid ? cc : 0); ldw = CD_IN; }
    const int k0 = F.wave * 128 + kr; f32x4 acc[9];
#pragma unroll
    for (int j = 0; j < 9; ++j) acc[j] = (f32x4){0.f, 0.f, 0.f, 0.f};
#pragma unroll 8
    for (int i = 0; i < 32; ++i) { const int k = k0 + 4 * i; const f32x4 wv = *(const f32x4*)(w + (size_t)k * ldw);
#pragma unroll
        for (int j = 0; j < 9; ++j) acc[j] += wv * sc[j * DM + k]; }
#pragma unroll
    for (int j = 0; j < 9; ++j) {
#pragma unroll
        for (int c = 0; c < 4; ++c) { float v = acc[j][c]; v += __shfl_xor(v, 16); v += __shfl_xor(v, 32); acc[j][c] = valid ? v : 0.f; }
        if (kr == 0) *(LAS f32x4*)(part + (F.wave * 9 + j) * 64 + 4 * cg) = acc[j]; }
    __syncthreads();
    for (int i = F.tid; i < 9 * 64; i += NTHREADS) { const int j = i >> 6, ln = i & 63; float s = 0.f;
#pragma unroll
        for (int wv = 0; wv < 8; ++wv) s += part[(wv * 9 + j) * 64 + ln];
        if (f1) ((float*)(ws + WS_CBF1))[(size_t)j * 5632 + F.bid * 64 + ln] = s; else ((float*)(ws + WS_CBIN1))[(size_t)j * 2048 + (F.bid - 88) * 64 + ln] = s; }
    __syncthreads();
}
template <int SRC>
__device__ __forceinline__ void norm_phase(const Frame& F, const Params& P, const float* g, const float* MODL, int ish, int isc) {
    char* ws = F.ws; bf16_t* H = (bf16_t*)(ws + WS_H); const int gw = F.bid * NWAVES + F.wave, lane = F.lane; const int rb = gw * 9;
    f32x4 gg[4], gs[4], sh[4]; int cur = -1;
#pragma unroll
    for (int j = 0; j < 4; ++j) gg[j] = *(const f32x4*)(g + 4 * lane + 256 * j);
#pragma unroll 1
    for (int r0 = rb; r0 < rb + 9; r0 += 3) {
        f32x4 v[3][4];
#pragma unroll
        for (int q = 0; q < 3; ++q) { const int r = r0 + q, b = r / RPB, s = r - b * RPB;
            const float* xr = s < CTX ? PIN(2) + ((size_t)b * CTX + s) * DM : PIN(0) + ((size_t)b * SEQ + (s - CTX)) * DM;
#pragma unroll
            for (int j = 0; j < 4; ++j) v[q][j] = *(const f32x4*)(xr + 4 * lane + 256 * j); }
#pragma unroll
        for (int q = 0; q < 3; ++q) { const int r = r0 + q, b = r / RPB, s = r - b * RPB; const int mrow = s < CTX ? 8 : b;
            if (mrow != cur) { cur = mrow; const float* md = MODL + (size_t)mrow * MODLD;
#pragma unroll
                for (int j = 0; j < 4; ++j) { const int k = 4 * lane + 256 * j; gs[j] = gg[j] * (*(const f32x4*)(md + isc * DM + k) + 1.f); sh[j] = *(const f32x4*)(md + ish * DM + k); } }
            float ss = 0.f;
#pragma unroll
            for (int j = 0; j < 4; ++j) ss += (v[q][j][0] * v[q][j][0] + v[q][j][1] * v[q][j][1]) + (v[q][j][2] * v[q][j][2] + v[q][j][3] * v[q][j][3]);
            const float rstd = rsqrtf(wave_sum(ss) / DM + EPS);
#pragma unroll
            for (int j = 0; j < 4; ++j) { const int k = 4 * lane + 256 * j; const f32x4 hv = v[q][j] * rstd * gs[j] + sh[j];
                u32x2 w; w.x = pk2(hv[0], hv[1]); w.y = pk2(hv[2], hv[3]); *(u32x2*)(H + (size_t)r * DM + k) = w; } }
    }
}
__device__ __forceinline__ void rope_tables(const Frame& F) {
    float* R0 = (float*)(F.ws + WS_ROPE0); float* R1 = (float*)(F.ws + WS_ROPE1); const int gt = F.bid * NTHREADS + F.tid, NGT = F.G * NTHREADS;
    for (int i = gt; i < SEQ * 48; i += NGT) { const int t = i / 48, k = i % 48; const float row = (float)(t >> 6), col = (float)(t & 63);
        const bool l0 = k < 32; const int kk = l0 ? k : k - 32; const int half = l0 ? 16 : 8;
        const float invf = exp2f(-(float)(kk & (half - 1)) * (13.287712379549449f / (float)half)); const float ang = (kk < half ? row : col) * invf; const float cv = cosf(ang), sv = sinf(ang);
        if (l0) { R0[t * 64 + kk] = cv; R0[t * 64 + 32 + kk] = sv; } else { R1[t * 32 + kk] = cv; R1[t * 32 + 16 + kk] = sv; } }
}
__device__ __forceinline__ void gqa_prep(const Frame& F, const Params& P) {
    char* ws = F.ws; const bf16_t* Z = (const bf16_t*)(ws + WS_Z); bf16_t* Q = (bf16_t*)(ws + WS_QB); bf16_t* K = (bf16_t*)(ws + WS_KB); bf16_t* V = (bf16_t*)(ws + WS_VB); const float* R0 = (const float*)(ws + WS_ROPE0);
    const int gw = F.bid * NWAVES + F.wave, NGW = F.G * NWAVES, lane = F.lane; const int d0 = 8 * (lane & 7), i0 = d0 & 31;
    float qn[8], kn[8];
#pragma unroll
    for (int e = 0; e < 8; ++e) { qn[e] = PIN(17)[d0 + e] * QSCALE0; kn[e] = PIN(18)[d0 + e]; }
    constexpr int R1 = 6912; const int nb2 = F.G - 64; const int gw2 = (F.bid - 64) * NWAVES + F.wave, NGW2 = nb2 * NWAVES;
    for (int pass = 0; pass < 2; ++pass) { const int base = pass == 0 ? 0 : R1, lim = pass == 0 ? R1 : MROWS, g0 = pass == 0 ? gw : gw2, ng = pass == 0 ? NGW : NGW2; if (pass == 1 && F.bid < 64) break;
    for (int r0 = base + g0; r0 < lim; r0 += 2 * ng) {
        v4u qv[2], kv[2]; f32x4 cs[2][2], sn[2][2];
#pragma unroll
        for (int q = 0; q < 2; ++q) { const int r = r0 + q * ng; if (r < lim) { const bf16_t* z = Z + (size_t)r * AB_IN + 1024; const int s = r % RPB;
            qv[q] = *(const v4u*)(z + 8 * lane); kv[q] = lane < 32 ? *(const v4u*)(z + 512 + 8 * lane) : (v4u){0u, 0u, 0u, 0u};
            if (s >= CTX) { const float* rp = R0 + (size_t)(s - CTX) * 64 + i0; cs[q][0] = *(const f32x4*)rp; cs[q][1] = *(const f32x4*)(rp + 4); sn[q][0] = *(const f32x4*)(rp + 32); sn[q][1] = *(const f32x4*)(rp + 36); } } }
#pragma unroll
        for (int q = 0; q < 2; ++q) { const int r = r0 + q * ng; if (r < lim) { const bool lat = (r % RPB) >= CTX;
#pragma unroll
            for (int ps = 0; ps < 2; ++ps) { const v4u raw = ps == 0 ? qv[q] : kv[q]; float x[8];
#pragma unroll
                for (int e = 0; e < 4; ++e) { x[2 * e] = __uint_as_float(raw[e] << 16); x[2 * e + 1] = __uint_as_float(raw[e] & 0xffff0000u); }
                float ss = 0.f;
#pragma unroll
                for (int e = 0; e < 8; ++e) ss += x[e] * x[e];
                ss += __shfl_xor(ss, 1); ss += __shfl_xor(ss, 2); ss += __shfl_xor(ss, 4);
                const float rs = rsqrtf(ss * (1.f / 64.f) + EPS); float y[8];
#pragma unroll
                for (int e = 0; e < 8; ++e) y[e] = x[e] * rs * (ps == 0 ? qn[e] : kn[e]);
                if (lat) {
#pragma unroll
                    for (int e = 0; e < 8; ++e) { const float other = __shfl_xor(y[e], 4); const float c = cs[q][e >> 2][e & 3], s_ = sn[q][e >> 2][e & 3]; y[e] = (lane & 4) ? (other * s_ + y[e] * c) : (y[e] * c - other * s_); } }
                v4u o; o.x = pk2(y[0], y[1]); o.y = pk2(y[2], y[3]); o.z = pk2(y[4], y[5]); o.w = pk2(y[6], y[7]);
                if (ps == 0) *(v4u*)(Q + (size_t)r * 512 + 8 * lane) = o;
                else if (lane < 16) *(v4u*)(K + (size_t)r * 128 + 8 * lane) = o;
                else if (lane < 32) *(v4u*)(V + (size_t)r * 128 + 8 * (lane - 16)) = raw; } } }
    } }
}
__device__ __forceinline__ void mla_prep1(const Frame& F, const Params& P) {
    char* ws = F.ws; const bf16_t* Z = (const bf16_t*)(ws + WS_Z); bf16_t* QA = (bf16_t*)(ws + WS_QA); bf16_t* KVA = (bf16_t*)(ws + WS_KVA); bf16_t* KR = (bf16_t*)(ws + WS_KR);
    const int gw = F.bid * NWAVES + F.wave, NGW = F.G * NWAVES, lane = F.lane; const float* gq = PIN(33); const float* gkv = PIN(35);
    const f32x4 g4 = *(const f32x4*)(gq + 4 * lane); const float gk0 = gkv[2 * lane], gk1 = gkv[2 * lane + 1];
    for (int r0 = gw; r0 < MROWS; r0 += 3 * NGW) {
        u32x2 qw[3]; unsigned kw[3], krw[3];
#pragma unroll
        for (int q = 0; q < 3; ++q) { const int r = r0 + q * NGW; if (r < MROWS) { const bf16_t* z = Z + (size_t)r * CD_LD; qw[q] = *(const u32x2*)(z + 1536 + 4 * lane); kw[q] = *(const unsigned*)(z + 1792 + 2 * lane); krw[q] = lane < 16 ? *(const unsigned*)(z + 1920 + 2 * lane) : 0u; } }
#pragma unroll
        for (int q = 0; q < 3; ++q) { const int r = r0 + q * NGW; if (r < MROWS) {
            const float q0 = __uint_as_float(qw[q].x << 16), q1 = __uint_as_float(qw[q].x & 0xffff0000u), q2 = __uint_as_float(qw[q].y << 16), q3 = __uint_as_float(qw[q].y & 0xffff0000u);
            const float k0 = __uint_as_float(kw[q] << 16), k1 = __uint_as_float(kw[q] & 0xffff0000u);
            const float rq = rsqrtf(wave_sum((q0 * q0 + q1 * q1) + (q2 * q2 + q3 * q3)) * (1.f / 256.f) + EPS), rk = rsqrtf(wave_sum(k0 * k0 + k1 * k1) * (1.f / 128.f) + EPS);
            u32x2 o; o.x = pk2(q0 * rq * g4[0], q1 * rq * g4[1]); o.y = pk2(q2 * rq * g4[2], q3 * rq * g4[3]); *(u32x2*)(QA + (size_t)r * 256 + 4 * lane) = o;
            *(unsigned*)(KVA + (size_t)r * 256 + 2 * lane) = pk2(k0 * rk * gk0, k1 * rk * gk1); *(unsigned*)(KVA + (size_t)r * 256 + 128 + 2 * lane) = 0u;
            if (lane < 16) *(unsigned*)(KR + (size_t)r * 32 + 2 * lane) = krw[q]; } }
    }
}
__device__ __forceinline__ void mla_prep2(const Frame& F, const Params& P) {
    char* ws = F.ws; char* dob = (char*)P.out; const bf16_t* QR = (const bf16_t*)(ws + WS_QR); const bf16_t* KVR = (const bf16_t*)(ws + WS_KVR); const bf16_t* KR = (const bf16_t*)(ws + WS_KR);
    bf16_t* QM = (bf16_t*)(ws + WS_QM); bf16_t* KM = (bf16_t*)(dob + DO_KM); bf16_t* VM = (bf16_t*)(dob + DO_VM); const float* R1 = (const float*)(ws + WS_ROPE1);
    const int gw = F.bid * NWAVES + F.wave, NGW = F.G * NWAVES, lane = F.lane; const int h = lane >> 3, sub = lane & 7; const bool rl = sub < 4; const int rs8 = 8 * (sub & 3), ti = rs8 & 15;
    float qn0[8], qn1[8], kn0[8], kn1[8];
#pragma unroll
    for (int e = 0; e < 8; ++e) { qn0[e] = PIN(37)[8 * sub + e] * QSCALE1; qn1[e] = PIN(37)[64 + rs8 + e] * QSCALE1; kn0[e] = PIN(38)[8 * sub + e]; kn1[e] = PIN(38)[64 + rs8 + e]; }
#define MP2_UNPK(raw, x) _Pragma("unroll") for (int e_ = 0; e_ < 4; ++e_) { x[2 * e_] = __uint_as_float(raw[e_] << 16); x[2 * e_ + 1] = __uint_as_float(raw[e_] & 0xffff0000u); }
#define MP2_PK(y) (v4u){pk2(y[0], y[1]), pk2(y[2], y[3]), pk2(y[4], y[5]), pk2(y[6], y[7])}
    for (int r = gw; r < MROWS; r += NGW) { const int s = r % RPB; const bool lat = s >= CTX;
        const v4u kraw = *(const v4u*)(KVR + (size_t)r * 1024 + h * 128 + 8 * sub), vraw = *(const v4u*)(KVR + (size_t)r * 1024 + h * 128 + 64 + 8 * sub);
        const v4u rraw = *(const v4u*)(KR + (size_t)r * 32 + rs8);
        v4u qraw = {0u, 0u, 0u, 0u}, qrr = {0u, 0u, 0u, 0u}; f32x4 cs[2], sn[2];
        if (lat) { qraw = *(const v4u*)(QR + (size_t)r * 768 + h * 96 + 8 * sub); qrr = *(const v4u*)(QR + (size_t)r * 768 + h * 96 + 64 + rs8);
            const float* rp = R1 + (size_t)(s - CTX) * 32 + ti; cs[0] = *(const f32x4*)rp; cs[1] = *(const f32x4*)(rp + 4); sn[0] = *(const f32x4*)(rp + 16); sn[1] = *(const f32x4*)(rp + 20); }
        *(v4u*)(VM + (size_t)r * 512 + h * 64 + 8 * sub) = vraw;
#pragma unroll
        for (int which = 0; which < 2; ++which) {
            if (which == 1 && !lat) break;
            float a[8], bq[8]; { const v4u ra = which == 0 ? kraw : qraw, rb = which == 0 ? rraw : qrr; MP2_UNPK(ra, a) MP2_UNPK(rb, bq) }
            float ss = 0.f;
#pragma unroll
            for (int e = 0; e < 8; ++e) ss += a[e] * a[e] + (rl ? bq[e] * bq[e] : 0.f);
            ss += __shfl_xor(ss, 1); ss += __shfl_xor(ss, 2); ss += __shfl_xor(ss, 4);
            const float rsd = rsqrtf(ss * (1.f / 96.f) + EPS);
#pragma unroll
            for (int e = 0; e < 8; ++e) { a[e] = a[e] * rsd * (which == 0 ? kn0[e] : qn0[e]); bq[e] = bq[e] * rsd * (which == 0 ? kn1[e] : qn1[e]); }
            if (lat) {
#pragma unroll
                for (int e = 0; e < 8; ++e) { const float other = __shfl_xor(bq[e], 2); const float c = cs[e >> 2][e & 3], sv = sn[e >> 2][e & 3]; bq[e] = (sub & 2) ? (other * sv + bq[e] * c) : (bq[e] * c - other * sv); } }
            bf16_t* o = (which == 0 ? KM : QM) + (size_t)r * 768 + h * 96;
            *(v4u*)(o + 8 * sub) = MP2_PK(a); if (rl) *(v4u*)(o + 64 + rs8) = MP2_PK(bq); }
    }
#undef MP2_UNPK
#undef MP2_PK
}
}
__global__ void __launch_bounds__(NTHREADS, 2) mk_kernel(Params prm) {
    extern __shared__ __attribute__((aligned(16))) unsigned char lds_raw[];
    Frame F; F.lds = (LAS unsigned char*)lds_raw; F.tid = threadIdx.x; F.lane = F.tid & 63; F.wave = __builtin_amdgcn_readfirstlane(F.tid >> 6);
    F.G = gridDim.x; F.bid = blockIdx.x; F.even = 0; F.ws = prm.ws;
    const Params& P = prm;
    const float* MOD0 = (const float*)(prm.ws + WS_MOD);
    const int lo = prm.ph_lo, hi = prm.ph_hi;
    volatile LAS unsigned* MISCW = (volatile LAS unsigned*)(F.lds + MISC_OFF + 8192);
    if (F.tid < 64) MISCW[F.tid] = 0u;
    __syncthreads();
    if (prm.ph_lo == 123456) cooperative_groups::this_grid().sync();
    XcdBarrier bar = xcd_barrier_post((unsigned*)(prm.ws + WS_CTL + CT_BAR), MISCW + 8);
#define RUN(k, body) if (lo <= (k) && (k) < hi) { body; if ((k) + 1 < hi) xcd_barrier(bar); }
#define RUN_GEMMS(PH0, NPH, G0) { _Pragma("unroll 1") for (int i_ = 0; i_ < (NPH); ++i_) { const int k_ = (PH0) + i_; if (lo <= k_ && k_ < hi) { run_gemm(F, prm, (G0) + i_); if (k_ + 1 < hi) xcd_barrier(bar); } } }
    RUN(PH_P0, { el::rope_tables(F); el::mod_phase(F, prm); phase_conv(F, prm, false); hy::filt(F, prm); moe_conv_all(F, prm); })
    if (MISCW[8 + 3] != 0u) { F.bid = __builtin_amdgcn_readfirstlane((int)(MISCW[8 + 2] * 8u + bar.x)); F.even = 1; }
    RUN(PH_NORM0, { el::norm_phase<0>(F, prm, PIN(6), MOD0, 0, 1); el::bias_phase(F, prm); })
    RUN(PH_G_IN0, run_gemm(F, prm, G_IN0))
    RUN(PH_LRUPREP, { lru::phase<0>(F, prm); el::gqa_prep(F, prm); })
    RUN(PH_MIX0, { phase_attn0(F); lru::phase<1>(F, prm); })
    RUN(PH_G_OUT0, { run_gemm(F, prm, G_OUT0); run_gemm(F, prm, G_F1); run_gemm(F, prm, G_F2); run_gemm(F, prm, G_IN1); })
    RUN(PH_PREP1, { hy::prep(F, prm); el::mla_prep1(F, prm); })
    RUN(PH_G_QKVB, { run_gemm(F, prm, G_QB); run_gemm(F, prm, G_KVB); })
    RUN(PH_PREP2, { el::mla_prep2(F, prm); hy::main_phase(F, prm); })
    RUN(PH_MIX1, { phase_attn1(F, prm); hy::untranspose(F); })
    RUN(PH_G_OUT1, run_gemm(F, prm, G_OUT1))
    RUN(PH_ROUTE, phase_route(F, prm))
    RUN(PH_SLOT, phase_slot(F, prm))
    RUN(PH_MOE1, { run_gemm(F, prm, G_MOE1); run_gemm(F, prm, G_MOE2); })
    RUN(PH_COMBINE, phase_combine(F, prm))
#undef RUN
#undef RUN_GEMMS
}
#ifndef SPLIT_LAUNCH
#define SPLIT_LAUNCH 0
#endif
extern "C" void kernel_launch(void* const* d_in, const int* in_sizes, int n_in, void* d_out, int out_size, void* d_ws, size_t ws_size, hipStream_t st) {
    static int grid = 0;
    if (grid == 0) {
        if (n_in != 43 || out_size != NLAT * DM || ws_size < WS_END) { fprintf(stderr, "kernel_launch: unexpected problem (n_in %d, out %d, ws %zu < %zu)\n", n_in, out_size, ws_size, (size_t)WS_END); grid = -1; return; }
        int dev = 0, cus = 0, per_cu = 0;
        (void)hipGetDevice(&dev); (void)hipDeviceGetAttribute(&cus, hipDeviceAttributeMultiprocessorCount, dev);
        (void)hipFuncSetAttribute((const void*)mk_kernel, hipFuncAttributeMaxDynamicSharedMemorySize, LDS_BYTES);
        (void)hipOccupancyMaxActiveBlocksPerMultiprocessor(&per_cu, (const void*)mk_kernel, NTHREADS, LDS_BYTES);
        grid = cus;
        if (grid != 256 || per_cu < 1) { fprintf(stderr, "kernel_launch: grid %d (CUs %d, occupancy query %d): this kernel is written for 256 resident workgroups; nothing launched\n", grid, cus, per_cu); grid = -1; return; }
    }
    if (grid < 0) return;
    (void)hipMemsetAsync((char*)d_ws + WS_CTL, 0, CTL_BYTES, st);
    Params prm{}; prm.i0 = (const float*)d_in[0]; prm.i1 = (const float*)d_in[1]; prm.i2 = (const float*)d_in[2]; prm.i3 = (const float*)d_in[3]; prm.i4 = (const float*)d_in[4]; prm.i5 = (const float*)d_in[5]; prm.i6 = (const float*)d_in[6]; prm.i7 = (const float*)d_in[7]; prm.i8 = (const float*)d_in[8]; prm.i9 = (const float*)d_in[9]; prm.i10 = (const float*)d_in[10]; prm.i11 = (const float*)d_in[11]; prm.i12 = (const float*)d_in[12]; prm.i13 = (const float*)d_in[13]; prm.i14 = (const float*)d_in[14]; prm.i15 = (const float*)d_in[15]; prm.i16 = (const float*)d_in[16]; prm.i17 = (const float*)d_in[17]; prm.i18 = (const float*)d_in[18]; prm.i19 = (const float*)d_in[19]; prm.i20 = (const float*)d_in[20]; prm.i21 = (const float*)d_in[21]; prm.i22 = (const float*)d_in[22]; prm.i23 = (const float*)d_in[23]; prm.i24 = (const float*)d_in[24]; prm.i25 = (const float*)d_in[25]; prm.i26 = (const float*)d_in[26]; prm.i27 = (const float*)d_in[27]; prm.i28 = (const float*)d_in[28]; prm.i29 = (const float*)d_in[29]; prm.i30 = (const float*)d_in[30]; prm.i31 = (const float*)d_in[31]; prm.i32 = (const float*)d_in[32]; prm.i33 = (const float*)d_in[33]; prm.i34 = (const float*)d_in[34]; prm.i35 = (const float*)d_in[35]; prm.i36 = (const float*)d_in[36]; prm.i37 = (const float*)d_in[37]; prm.i38 = (const float*)d_in[38]; prm.i39 = (const float*)d_in[39]; prm.i40 = (const float*)d_in[40]; prm.i41 = (const float*)d_in[41]; prm.i42 = (const float*)d_in[42]; prm.out = (float*)d_out; prm.ws = (char*)d_ws;
#if SPLIT_LAUNCH
    for (int ph = 0; ph < PH_COUNT; ++ph) { prm.ph_lo = ph; prm.ph_hi = ph + 1; hipLaunchKernelGGL(mk_kernel, dim3(grid), dim3(NTHREADS), LDS_BYTES, st, prm); }
#else
    prm.ph_lo = 0; prm.ph_hi = PH_COUNT;
    void* args[] = {&prm};
    hipError_t e = hipLaunchCooperativeKernel((const void*)mk_kernel, dim3(grid), dim3(NTHREADS), args, LDS_BYTES, st);
    if (e != hipSuccess) fprintf(stderr, "kernel_launch: cooperative launch failed: %s (grid %d)\n", hipGetErrorString(e), grid);
#endif
}
```

```cpp
#include <hip/hip_runtime.h>
#include <hip/hip_cooperative_groups.h>
#include <cstdio>
#include <cstdint>
#include <cmath>

constexpr int NB = 8, SEQ = 2048, CTX = 256, RPB = SEQ + CTX, MROWS = NB * RPB, DM = 1024, NLAT = NB * SEQ;
constexpr int NMOD = 6, MODLD = NMOD * DM;
constexpr int AB_IN = 1792, CD_IN = 1952, CD_LD = 2048, DFF = 2816, NEXP = 8, DFE = 3584;
constexpr float EPS = 1e-6f;
constexpr float LOG2E = 1.4426950408889634f;
constexpr float QSCALE0 = 0.125f * LOG2E;
constexpr float QSCALE1 = 0.10206207261596577f * LOG2E;

typedef unsigned short bf16_t;
typedef float f32x4 __attribute__((ext_vector_type(4)));
typedef unsigned u32x4 __attribute__((ext_vector_type(4)));
typedef unsigned u32x2 __attribute__((ext_vector_type(2)));

__device__ __forceinline__ int mod_row(int r) { int b = r / RPB, s = r % RPB; return s < CTX ? 8 : b; }
__device__ __forceinline__ int latent_row(int m) { return (m / SEQ) * RPB + CTX + (m % SEQ); }

__device__ __forceinline__ float bf2f(bf16_t v) { return __uint_as_float((unsigned)v << 16); }
typedef float hd_f32x2 __attribute__((ext_vector_type(2))); typedef __bf16 hd_bf16x2 __attribute__((ext_vector_type(2)));
__device__ __forceinline__ unsigned pk2(float lo, float hi) { hd_f32x2 v = {lo, hi}; hd_bf16x2 b = __builtin_convertvector(v, hd_bf16x2); return __builtin_bit_cast(unsigned, b); }
__device__ __forceinline__ bf16_t f2bf(float f) { return (bf16_t)(pk2(f, 0.f) & 0xffffu); }
__device__ __forceinline__ float ldf(const float* p) { return *p; }
__device__ __forceinline__ float ldf(const bf16_t* p) { return bf2f(*p); }
__device__ __forceinline__ void stf(float* p, float v) { *p = v; }
__device__ __forceinline__ void stf(bf16_t* p, float v) { *p = f2bf(v); }

__device__ __forceinline__ float silu_f(float x) { return x / (1.f + expf(-x)); }
__device__ __forceinline__ float sigmoid_f(float x) { return 1.f / (1.f + expf(-x)); }
__device__ __forceinline__ float gelu_tanh(float x) { return 0.5f * x * (1.f + tanhf(0.7978845608028654f * (x + 0.044715f * x * x * x))); }
__device__ __forceinline__ float softplus_f(float x) { return fmaxf(x, 0.f) + log1pf(expf(-fabsf(x))); }

__device__ __forceinline__ float wave_sum(float v) {
#pragma unroll
    for (int o = 1; o < 64; o <<= 1) v += __shfl_xor(v, o);
    return v;
}
__device__ __forceinline__ float wave_max(float v) {
#pragma unroll
    for (int o = 1; o < 64; o <<= 1) v = fmaxf(v, __shfl_xor(v, o));
    return v;
}

constexpr size_t MiB = 1ull << 20;
constexpr size_t WS_CTL = 0, CTL_BYTES = 256 * 1024;
constexpr size_t WS_MOD = 1 * MiB;
constexpr size_t WS_SC = WS_MOD + 512 * 1024;
constexpr size_t WS_W13M = 4 * MiB;
constexpr size_t WS_W2M = 116 * MiB;
constexpr size_t WS_WIN0 = 172 * MiB;
constexpr size_t WS_WOUT0 = WS_WIN0 + (size_t)1792 * 1024 * 2;
constexpr size_t WS_WF13 = WS_WOUT0 + (size_t)1024 * 1024 * 2;
constexpr size_t WS_WF2 = WS_WF13 + (size_t)5632 * 1024 * 2;
constexpr size_t WS_WIN1 = WS_WF2 + (size_t)1024 * 2816 * 2;
constexpr size_t WS_WOUT1 = WS_WIN1 + (size_t)2048 * 1024 * 2;
constexpr size_t WS_WQB = WS_WOUT1 + (size_t)1024 * 1024 * 2;
constexpr size_t WS_WKVB = WS_WQB + (size_t)768 * 256 * 2;
constexpr size_t WS_WLRU = WS_WKVB + (size_t)1024 * 256 * 2;
constexpr size_t WS_WEND = WS_WLRU + (size_t)2 * 8 * 2 * 64 * 64 * 2;
static_assert(WS_WEND <= 202 * MiB, "weights region");
constexpr size_t WS_X = 202 * MiB;
constexpr size_t WS_H = 274 * MiB;
constexpr size_t WS_Z = 310 * MiB;
constexpr size_t WS_Y = 382 * MiB;
constexpr size_t WS_ACT = WS_Z;
constexpr size_t WS_R2 = 418 * MiB;
constexpr size_t WS_END = 502 * MiB;
static_assert(WS_ACT + (size_t)MROWS * DFF * 2 <= WS_R2, "ACT overlay");
constexpr size_t WS_QB = WS_R2;
constexpr size_t WS_KB = WS_QB + (size_t)MROWS * 512 * 2;
constexpr size_t WS_VB = WS_KB + (size_t)MROWS * 128 * 2;
constexpr size_t WS_AGG = WS_VB + (size_t)MROWS * 128 * 2;
constexpr size_t WS_R2L0END = WS_AGG + (size_t)2 * 8 * 72 * 2 * 512 * 4;
constexpr size_t WS_ZT = WS_R2;
constexpr size_t WS_HT = WS_ZT + (size_t)1536 * NLAT * 2;
constexpr size_t WS_GT = WS_HT + (size_t)512 * NLAT * 2;
constexpr int GT_LD = 4224;
constexpr size_t WS_R2L1END = WS_GT + (size_t)2 * 512 * GT_LD * 2;
static_assert(WS_R2L0END <= WS_END && WS_R2L1END <= WS_END, "R2");
constexpr size_t WS_QA = WS_Y;
constexpr size_t WS_KVA = WS_QA + (size_t)MROWS * 256 * 2;
constexpr size_t WS_KR = WS_KVA + (size_t)MROWS * 256 * 2;
constexpr size_t WS_QR = WS_Z;
constexpr size_t WS_KVR = WS_QR + (size_t)MROWS * 768 * 2;
static_assert(WS_KVR + (size_t)MROWS * 1024 * 2 <= WS_Y && WS_KR + (size_t)MROWS * 32 * 2 <= WS_R2, "layer-1 overlays");
constexpr size_t WS_QM = WS_H;
static_assert((size_t)MROWS * 768 * 2 <= 36 * MiB, "QM in H");
constexpr size_t DO_KM = 0;
constexpr size_t DO_VM = (size_t)MROWS * 768 * 2;
static_assert(DO_VM + (size_t)MROWS * 512 * 2 <= (size_t)NLAT * DM * 4, "d_out scratch");
constexpr int MAXSLOT = 34816;
constexpr size_t WS_XG = WS_WIN0;
constexpr size_t WS_ACT2 = WS_XG + (size_t)MAXSLOT * 1024 * 2;
constexpr size_t WS_H2 = WS_ACT2 + (size_t)MAXSLOT * 3584 * 2 - (size_t)NLAT * 1024 * 2;
static_assert(WS_ACT2 + (size_t)MAXSLOT * 3584 * 2 <= WS_END, "MoE overlay");
constexpr size_t CT_BAR = 0;
constexpr size_t CT_PCNT = 16 * 1024;
constexpr size_t CT_MCNT = 48 * 1024;
constexpr size_t CT_HIST = 32 * 1024;
constexpr size_t CT_CNT = 48 * 1024;
constexpr size_t CT_CURSOR = 80 * 1024;
constexpr size_t CT_DONE = 80 * 1024 + 256;
constexpr size_t CT_SSQA = 96 * 1024;
constexpr size_t CT_SSQB = CT_SSQA + (size_t)MROWS * 4;
static_assert(CT_SSQB + (size_t)MROWS * 4 <= CTL_BYTES, "ssq in the zeroed control region");
constexpr size_t WS_SLOTTOK = 2 * MiB;
constexpr size_t WS_SLOTGATE = WS_SLOTTOK + (size_t)MAXSLOT * 4;
constexpr size_t WS_SEL = WS_SLOTGATE + (size_t)MAXSLOT * 4;
constexpr size_t WS_TOKSLOT = WS_SEL + (size_t)NLAT * 16;
static_assert(WS_TOKSLOT + (size_t)NLAT * 8 <= WS_W13M, "small tables");
constexpr size_t WS_ROPE0 = 3 * MiB;
constexpr size_t WS_ROPE1 = 3 * MiB + 512 * 1024;
static_assert(WS_TOKSLOT + (size_t)NLAT * 8 <= WS_ROPE0 && WS_ROPE1 + 256 * 1024 <= WS_W13M, "rope tables");
constexpr size_t WS_CBF1 = WS_SC + 64 * 1024;
constexpr size_t WS_CBIN1 = WS_CBF1 + 9 * 5632 * 4;
static_assert(WS_CBIN1 + 9 * 2048 * 4 <= WS_SLOTTOK, "bias vectors");
constexpr size_t WS_Y2 = WS_XG;
namespace pg8 {
#define PG8_LAS __attribute__((address_space(3)))
typedef unsigned short bf16_t;
typedef short bf16x8 __attribute__((ext_vector_type(8)));
typedef float f32x4 __attribute__((ext_vector_type(4)));
typedef unsigned u32x4 __attribute__((ext_vector_type(4)));
constexpr int BM = 256, BK = 64, HALF = 128, HTB = HALF * BK * 2  , STAGE_BYTES = 8 * HTB, NXCD = 8, WGM = 8;

__host__ __device__ __forceinline__ int lds_byte(int r, int c) { const int st = (r >> 4) * 2 + (c >> 5), rr = r & 15, cc = c & 31, ob = rr * 64 + cc * 2; return st * 1024 + (ob ^ (((ob >> 9) & 1) << 5)); }
__host__ __device__ __forceinline__ void stage_rc(int b, int& R, int& C) { const int st = b / 1024, sb = b % 1024, swz = sb ^ (((sb >> 9) & 1) << 5); R = (st >> 1) * 16 + swz / 64; C = (st & 1) * 32 + (swz % 64) / 2; }
__host__ __device__ __forceinline__ int perm32(int rho) { const int n = rho >> 4, i = rho & 15; return 8 * (i >> 2) + 4 * n + (i & 3); }

struct Unit { int pm, pn; };
struct Gemm { const bf16_t* A; const bf16_t* Bt; int M, N, K; };

struct StaticOrder {
    int nM, nN, nwg, G, c;
    __host__ __device__ void init(int M, int N, int G_, int c_) { nM = M / BM; nN = N / BM; nwg = nM * nN; G = G_; c = c_; }
    __host__ __device__ bool next(int i, Unit& u) const {
        const long L = (long)i * G + c; if (L >= nwg) return false;
        int wgid = (int)L; { const int q = nwg / NXCD, r = nwg % NXCD, xcd = wgid % NXCD, off = wgid / NXCD; wgid = (xcd < r ? xcd * (q + 1) : r * (q + 1) + (xcd - r) * q) + off; }
        const int nig = WGM * nN, gid = wgid / nig, fm = gid * WGM, gsz = (nM - fm) < WGM ? (nM - fm) : WGM;
        u.pm = fm + ((wgid % nig) % gsz); u.pn = (wgid % nig) / gsz; return true;
    }
    __device__ __forceinline__ void a_ready(const Unit&) const {}
    __device__ __forceinline__ void done(const Unit&) const {}
};

__device__ __forceinline__ unsigned cvt_pk_bf16(float lo, float hi) { unsigned r; asm volatile("v_cvt_pk_bf16_f32 %0, %1, %2" : "=v"(r) : "v"(lo), "v"(hi)); return r; }
typedef float f32x2 __attribute__((ext_vector_type(2)));
__device__ __forceinline__ f32x2 gelu_pk(f32x2 v) {
    const f32x2 av = __builtin_elementwise_abs(v), d = av * 0.2316418882f + 1.0f;
    f32x2 t; t.x = __builtin_amdgcn_rcpf(d.x); t.y = __builtin_amdgcn_rcpf(d.y);
    f32x2 q = t * 0.5307027145f + (-0.7265760135f); q = q * t + 0.7107068705f; q = q * t + (-0.142248368f); q = q * t + 0.127414796f; q = q * t;
    const f32x2 s = (v * v) * (-0.72134752044f);
    f32x2 e; e.x = __builtin_amdgcn_exp2f(s.x); e.y = __builtin_amdgcn_exp2f(s.y);
    const f32x2 m = v * (q * e), r = v - m;
    f32x2 o; o.x = v.x < 0.f ? m.x : r.x; o.y = v.y < 0.f ? m.y : r.y; return o;
}

template <int ACT  > struct EpiBf16 {
    static constexpr bool PERM = true, AFTER_DRAIN = false; static_assert(ACT == 0 || ACT == 1, "EpiBf16: ACT is 0 (none) or 1 (gelu_pk)");
    bf16_t* O; int ldc; const float* bias; int split_cols; size_t split_stride; float scale0;
    __device__ __forceinline__ void operator()(const f32x4 (&acc)[2][2][4][2], const Unit& u, int wr, int wc, int fr, int fq) const {
        const int row0 = u.pm * BM + wr * 64 + fr; int colt = u.pn * BM; bf16_t* base = O;
        float sc = 1.f; if (split_cols) { const int t = colt / split_cols; base += (size_t)t * split_stride; colt -= t * split_cols; if (t == 0) sc = scale0; }
        const int col0 = colt + wc * 32 + 8 * fq, bcol0 = u.pn * BM + wc * 32 + 8 * fq;
        f32x4 bv[2][2];
#pragma unroll
        for (int bj = 0; bj < 2; ++bj)
#pragma unroll
            for (int n = 0; n < 2; ++n) bv[bj][n] = bias ? *(const f32x4*)(bias + bcol0 + bj * HALF + 4 * n) : (f32x4){0.f, 0.f, 0.f, 0.f};
#pragma unroll
        for (int ai = 0; ai < 2; ++ai)
#pragma unroll
            for (int m = 0; m < 4; ++m) { bf16_t* rowp = base + (size_t)(row0 + ai * HALF + m * 16) * ldc + col0;
#pragma unroll
                for (int bj = 0; bj < 2; ++bj) { f32x4 v0 = acc[ai][bj][m][0] + bv[bj][0], v1 = acc[ai][bj][m][1] + bv[bj][1];
                    if (ACT == 1) { f32x2 a = gelu_pk((f32x2){v0[0], v0[1]}), b = gelu_pk((f32x2){v0[2], v0[3]}), c = gelu_pk((f32x2){v1[0], v1[1]}), d = gelu_pk((f32x2){v1[2], v1[3]});
                        v0 = (f32x4){a.x, a.y, b.x, b.y}; v1 = (f32x4){c.x, c.y, d.x, d.y}; }
                    v0 = v0 * sc; v1 = v1 * sc; u32x4 w; w.x = cvt_pk_bf16(v0[0], v0[1]); w.y = cvt_pk_bf16(v0[2], v0[3]); w.z = cvt_pk_bf16(v1[0], v1[1]); w.w = cvt_pk_bf16(v1[2], v1[3]);
                    *(u32x4*)(rowp + bj * HALF) = w; } }
    }
};

template <class Epi, class Sched, bool ALIGN_EPI = false, bool SP2 = false>
__device__ __forceinline__ void gemm_phase(PG8_LAS unsigned char* lds, const Gemm g, const Sched& S, const Epi& E) {
    int tid_ = threadIdx.x; asm volatile("" : "+v"(tid_));
    const int tid = tid_, wid = __builtin_amdgcn_readfirstlane(tid >> 6), lane = tid & 63, wr = wid >> 2, wc = wid & 3, fr = lane & 15, fq = lane >> 4;
    const int K = g.K, nt = K / BK;
    unsigned voffA[2], voffB[2];
#pragma unroll
    for (int i = 0; i < 2; ++i) { int R, C; stage_rc(tid * 16 + i * 8192, R, C); const int Rb = Epi::PERM ? ((R & ~31) + perm32(R & 31)) : R;
        voffA[i] = (unsigned)(R * K + C) * 2u; voffB[i] = (unsigned)(Rb * K + C) * 2u; }
    const size_t kstep = (size_t)(BK * 2);
    const size_t hstep = (size_t)HALF * K * 2;
    const size_t tstep = 2 * hstep;
    const unsigned ldsw = (unsigned)wid * 1024u;
    const int aoff = lds_byte(wr * 64 + fr, fq * 8), boff = lds_byte(wc * 32 + fr, fq * 8);
#define PG8_SA(b, h) (((b) * 2 + (h)) * HTB)
#define PG8_SB(b, h) ((4 + (b) * 2 + (h)) * HTB)
#define PG8_STAGE(bufoff, gbase, voff) do { _Pragma("unroll") for (int _i = 0; _i < 2; ++_i) \
        __builtin_amdgcn_global_load_lds((const unsigned*)((const char*)(gbase) + (voff)[_i]), (PG8_LAS unsigned*)(lds + (bufoff) + ldsw + _i * 8192), 16, 0, 0); } while (0)
#define PG8_LDA(dst, b, h) do { _Pragma("unroll") for (int m = 0; m < 4; ++m) _Pragma("unroll") for (int k = 0; k < 2; ++k) dst[m][k] = *(const PG8_LAS bf16x8*)(lds + PG8_SA(b, h) + aoff + m * 2048 + k * 1024); } while (0)
#define PG8_LDB(dst, b, h) do { _Pragma("unroll") for (int n = 0; n < 2; ++n) _Pragma("unroll") for (int k = 0; k < 2; ++k) dst[n][k] = *(const PG8_LAS bf16x8*)(lds + PG8_SB(b, h) + boff + n * 2048 + k * 1024); } while (0)
#define PG8_MMA(ai, bj, At, Bt) do { __builtin_amdgcn_s_setprio(1); _Pragma("unroll") for (int m = 0; m < 4; ++m) _Pragma("unroll") for (int n = 0; n < 2; ++n) _Pragma("unroll") for (int k = 0; k < 2; ++k) \
        acc[ai][bj][m][n] = __builtin_amdgcn_mfma_f32_16x16x32_bf16(Bt[n][k], At[m][k], acc[ai][bj][m][n], 0, 0, 0); __builtin_amdgcn_s_setprio(0); } while (0)
#define PG8_WAIT_V(n) asm volatile("s_waitcnt vmcnt(" #n ")" ::: "memory")
#define PG8_WAIT_L(n) asm volatile("s_waitcnt lgkmcnt(" #n ")" ::: "memory")
#define PG8_BAR __builtin_amdgcn_s_barrier()
#define PG8_SCHED __builtin_amdgcn_sched_barrier(0)
    Unit cur, nxt; int ui = 0;
    if (!S.next(0, cur)) return;
    f32x4 acc[2][2][4][2];
#pragma unroll
    for (int a = 0; a < 2; ++a)
#pragma unroll
        for (int b = 0; b < 2; ++b)
#pragma unroll
            for (int m = 0; m < 4; ++m)
#pragma unroll
                for (int n = 0; n < 2; ++n) acc[a][b][m][n] = (f32x4){0.f, 0.f, 0.f, 0.f};
    bf16x8 At[4][2], B0[2][2], B1[2][2];
    const char* cA = (const char*)g.A + (size_t)cur.pm * tstep; const char* cB = (const char*)g.Bt + (size_t)cur.pn * tstep;
    S.a_ready(cur);
    if constexpr (SP2) {
        PG8_STAGE(PG8_SB(0, 0), cB, voffB); PG8_STAGE(PG8_SB(0, 1), cB + hstep, voffB); PG8_STAGE(PG8_SA(0, 0), cA, voffA); PG8_STAGE(PG8_SA(0, 1), cA + hstep, voffA);
        if (wr == 1) PG8_BAR;
        PG8_WAIT_V(2); PG8_BAR;
        PG8_STAGE(PG8_SB(1, 0), cB + kstep, voffB); PG8_STAGE(PG8_SA(1, 0), cA + kstep, voffA); PG8_STAGE(PG8_SB(1, 1), cB + hstep + kstep, voffB);
        PG8_WAIT_V(6); PG8_BAR;
    } else {
        PG8_STAGE(PG8_SB(0, 0), cB, voffB); PG8_STAGE(PG8_SA(0, 0), cA, voffA); PG8_STAGE(PG8_SB(0, 1), cB + hstep, voffB); PG8_STAGE(PG8_SA(0, 1), cA + hstep, voffA);
        if (wr == 1) PG8_BAR;
        PG8_WAIT_V(4); PG8_BAR;
        PG8_STAGE(PG8_SB(1, 0), cB + kstep, voffB); PG8_STAGE(PG8_SA(1, 0), cA + kstep, voffA); PG8_STAGE(PG8_SB(1, 1), cB + hstep + kstep, voffB);
        PG8_WAIT_V(6); PG8_BAR;
    }
    for (;;) {
        const bool has_next = S.next(ui + 1, nxt);
        const char* nA = has_next ? (const char*)g.A + (size_t)nxt.pm * tstep : cA; const char* nB = has_next ? (const char*)g.Bt + (size_t)nxt.pn * tstep : cB;
        for (int t = 0; t < nt; t += 2) {
            const bool last = (t == nt - 2);
            const char* a1 = cA + (size_t)(t + 1) * kstep;
            const char* a2 = last ? nA : cA + (size_t)(t + 2) * kstep; const char* b2 = last ? nB : cB + (size_t)(t + 2) * kstep;
            const char* a3 = a2 + kstep; const char* b3 = b2 + kstep;
            if (last && has_next) S.a_ready(nxt);
            if constexpr (SP2) {
            PG8_LDB(B0, 0, 0); PG8_LDB(B1, 0, 1); PG8_SCHED; PG8_LDA(At, 0, 0); PG8_STAGE(PG8_SA(1, 1), a1 + hstep, voffA);
            PG8_WAIT_V(8); PG8_WAIT_L(0); PG8_BAR; PG8_MMA(0, 0, At, B0); PG8_MMA(0, 1, At, B1); PG8_BAR; PG8_SCHED;
            PG8_LDA(At, 0, 1); PG8_STAGE(PG8_SB(0, 0), b2, voffB); PG8_STAGE(PG8_SB(0, 1), b2 + hstep, voffB); PG8_STAGE(PG8_SA(0, 0), a2, voffA);
            PG8_WAIT_V(8); PG8_WAIT_L(0); PG8_BAR; PG8_MMA(1, 0, At, B0); PG8_MMA(1, 1, At, B1); PG8_BAR; PG8_SCHED;
            PG8_LDB(B0, 1, 0); PG8_LDB(B1, 1, 1); PG8_SCHED; PG8_LDA(At, 1, 0); PG8_STAGE(PG8_SA(0, 1), a2 + hstep, voffA);
            PG8_WAIT_V(8); PG8_WAIT_L(0); PG8_BAR; PG8_MMA(0, 0, At, B0); PG8_MMA(0, 1, At, B1); PG8_BAR; PG8_SCHED;
            PG8_LDA(At, 1, 1); PG8_STAGE(PG8_SB(1, 0), b3, voffB); PG8_STAGE(PG8_SB(1, 1), b3 + hstep, voffB); PG8_STAGE(PG8_SA(1, 0), a3, voffA);
            PG8_WAIT_V(8); PG8_WAIT_L(0); PG8_BAR; PG8_MMA(1, 0, At, B0); PG8_MMA(1, 1, At, B1); PG8_BAR; PG8_SCHED;
            } else {
            PG8_LDB(B0, 0, 0); PG8_SCHED; PG8_LDA(At, 0, 0); PG8_STAGE(PG8_SA(1, 1), a1 + hstep, voffA);
            PG8_WAIT_L(8); PG8_BAR; PG8_WAIT_L(0); PG8_MMA(0, 0, At, B0); PG8_BAR; PG8_SCHED;
            PG8_LDB(B1, 0, 1); PG8_STAGE(PG8_SB(0, 0), b2, voffB);
            PG8_BAR; PG8_WAIT_L(0); PG8_MMA(0, 1, At, B1); PG8_BAR;
            PG8_LDA(At, 0, 1); PG8_STAGE(PG8_SA(0, 0), a2, voffA);
            PG8_BAR; PG8_WAIT_L(0); PG8_MMA(1, 0, At, B0); PG8_BAR; PG8_SCHED;
            PG8_STAGE(PG8_SB(0, 1), b2 + hstep, voffB);
            PG8_WAIT_V(6); PG8_BAR; PG8_MMA(1, 1, At, B1); PG8_BAR;
            PG8_LDB(B0, 1, 0); PG8_SCHED; PG8_LDA(At, 1, 0); PG8_STAGE(PG8_SA(0, 1), a2 + hstep, voffA);
            PG8_WAIT_L(8); PG8_BAR; PG8_WAIT_L(0); PG8_MMA(0, 0, At, B0); PG8_BAR; PG8_SCHED;
            PG8_LDB(B1, 1, 1); PG8_STAGE(PG8_SB(1, 0), b3, voffB);
            PG8_BAR; PG8_WAIT_L(0); PG8_MMA(0, 1, At, B1); PG8_BAR;
            PG8_LDA(At, 1, 1); PG8_STAGE(PG8_SA(1, 0), a3, voffA);
            PG8_BAR; PG8_WAIT_L(0); PG8_MMA(1, 0, At, B0); PG8_BAR; PG8_SCHED;
            PG8_STAGE(PG8_SB(1, 1), b3 + hstep, voffB);
            PG8_WAIT_V(6); PG8_BAR; PG8_MMA(1, 1, At, B1); PG8_BAR;
            }
        }
        if constexpr (ALIGN_EPI) { if (wr == 0) PG8_BAR; }
        if constexpr (!Epi::AFTER_DRAIN) { E(acc, cur, wr, wc, fr, fq); S.done(cur); }
        if (!has_next) break;
#pragma unroll
        for (int a = 0; a < 2; ++a)
#pragma unroll
            for (int b = 0; b < 2; ++b)
#pragma unroll
                for (int m = 0; m < 4; ++m)
#pragma unroll
                    for (int n = 0; n < 2; ++n) acc[a][b][m][n] = (f32x4){0.f, 0.f, 0.f, 0.f};
        cur = nxt; cA = nA; cB = nB; ++ui;
        if constexpr (ALIGN_EPI) { if (wr == 1) PG8_BAR; }
    }
    PG8_WAIT_V(0);
    if constexpr (!ALIGN_EPI) { if (wr == 0) PG8_BAR; }
    PG8_BAR;
    if constexpr (Epi::AFTER_DRAIN) { E.fused(acc, cur, wr, wc, fr, fq, lds, wid, lane); S.done(cur); }
#undef PG8_SA
#undef PG8_SB
#undef PG8_STAGE
#undef PG8_LDA
#undef PG8_LDB
#undef PG8_MMA
#undef PG8_WAIT_V
#undef PG8_WAIT_L
#undef PG8_BAR
#undef PG8_SCHED
}
}
namespace pg8 {
__device__ __forceinline__ float fast_silu(float v) { return v * __builtin_amdgcn_rcpf(1.f + __builtin_amdgcn_exp2f(-1.4426950408889634f * v)); }

struct DenseOrder {
    int nM, nN, nreg, nwg, G, c, mode, wgm;
    __device__ __forceinline__ void init(int nM_, int nN_, int G_, int c_, int mode_) { nM = nM_; nN = nN_; G = G_; c = c_; mode = mode_; nreg = nM * nN; nwg = nreg + (mode == 2 ? 8 : 0); wgm = WGM; }
    __device__ __forceinline__ bool next(int i, Unit& u) const {
        const long L = (long)i * G + c; if (L >= nwg) return false;
        if (mode == 2 && L >= nreg) { u.pm = 9 * (int)(L - nreg); u.pn = nN - 1; return true; }
        int wgid = (int)L; { const int q = nreg / NXCD, r = nreg % NXCD, xcd = wgid % NXCD, off = wgid / NXCD; wgid = (xcd < r ? xcd * (q + 1) : r * (q + 1) + (xcd - r) * q) + off; }
        const int nig = wgm * nN, gid = wgid / nig, fm = gid * wgm, gsz = (nM - fm) < wgm ? (nM - fm) : wgm;
        int pm = fm + ((wgid % nig) % gsz); u.pn = (wgid % nig) / gsz;
        if (mode != 0) pm = 9 * (pm >> 3) + 1 + (pm & 7);
        u.pm = pm; return true;
    }
    __device__ __forceinline__ void a_ready(const Unit&) const {}
    __device__ __forceinline__ void done(const Unit&) const {}
};
struct MoeOrder {
    const PG8_LAS int* tb; int nN, G, c;
    __device__ __forceinline__ bool next(int i, Unit& u) const {
        const int nwg = tb[8] * nN; long L = (long)i * G + c; if (L >= nwg) return false;
        { const int wg = (int)L, q = nwg / NXCD, r = nwg % NXCD, xcd = wg % NXCD, off = wg / NXCD; L = (xcd < r ? xcd * (q + 1) : r * (q + 1) + (xcd - r) * q) + off; }
        int e = 0;
#pragma unroll
        for (int k = 1; k < 8; ++k) if (L >= (long)tb[k] * nN) e = k;
        const int Le = (int)(L - (long)tb[e] * nN), mt = tb[e + 1] - tb[e];
        const int nig = WGM * nN, gid = Le / nig, fm = gid * WGM, gsz = (mt - fm) < WGM ? (mt - fm) : WGM;
        u.pm = tb[e] + fm + ((Le % nig) % gsz); u.pn = e * nN + (Le % nig) / gsz; return true;
    }
    __device__ __forceinline__ void a_ready(const Unit&) const {}
    __device__ __forceinline__ void done(const Unit&) const {}
};

template <bool SRCIN, bool FUSE> struct EpiResGate {
    static constexpr bool PERM = true, AFTER_DRAIN = false;
    const float* xin; float* xout; const float* modbase; int compact;
    const float* xsrc_lat; const float* xsrc_ctx; bf16_t* hraw; const float* gnext; const float* nscale; float* ssq;
    __device__ __forceinline__ void operator()(const f32x4 (&acc)[2][2][4][2], const Unit& u, int wr, int wc, int fr, int fq) const {
        const int b = u.pm / 9, pj = u.pm - 9 * b; const int mrow = (pj == 0) ? 8 : b;
        const float* g = modbase + (size_t)mrow * 6144;
        const int col0 = u.pn * BM + wc * 32 + 8 * fq;
        f32x4 gv[2][2];
#pragma unroll
        for (int bj = 0; bj < 2; ++bj)
#pragma unroll
            for (int n = 0; n < 2; ++n) gv[bj][n] = *(const f32x4*)(g + col0 + bj * HALF + n * 4);
        const int row0 = u.pm * BM + wr * 64 + fr; const int oshift = compact ? 256 * (b + 1) : 0;
        const float* xbase = SRCIN ? (pj == 0 ? xsrc_ctx + (size_t)b * 256 * 1024 : xsrc_lat + ((size_t)b * 2048 + (pj - 1) * 256) * 1024) - (size_t)u.pm * BM * 1024 : xin;
        const float* ns = nscale + (size_t)mrow * 6144;
#pragma unroll
        for (int am = 0; am < 4; ++am) { const int ai = am >> 1;
            f32x4 xv[2][2][2];
#pragma unroll
            for (int mm = 0; mm < 2; ++mm) { const int m = (am & 1) * 2 + mm; const float* xi = xbase + (size_t)(row0 + ai * HALF + m * 16) * 1024 + col0;
#pragma unroll
                for (int bj = 0; bj < 2; ++bj)
#pragma unroll
                    for (int n = 0; n < 2; ++n) xv[mm][bj][n] = *(const f32x4*)(xi + bj * HALF + n * 4); }
#pragma unroll
            for (int mm = 0; mm < 2; ++mm) { const int m = (am & 1) * 2 + mm; const int row = row0 + ai * HALF + m * 16; float* xo = xout + (size_t)(row - oshift) * 1024 + col0; float ss = 0.f;
#pragma unroll
                for (int bj = 0; bj < 2; ++bj)
#pragma unroll
                    for (int n = 0; n < 2; ++n) { const f32x4 v = xv[mm][bj][n] + gv[bj][n] * acc[ai][bj][m][n]; *(f32x4*)(xo + bj * HALF + n * 4) = v;
                        if (FUSE) { const int c = col0 + bj * HALF + n * 4; const f32x4 hv = v * (*(const f32x4*)(gnext + c) * (*(const f32x4*)(ns + c) + 1.f));
                            ss += (v[0] * v[0] + v[1] * v[1]) + (v[2] * v[2] + v[3] * v[3]);
                            u32x2 w; w.x = cvt_pk_bf16(hv[0], hv[1]); w.y = cvt_pk_bf16(hv[2], hv[3]); *(u32x2*)(hraw + (size_t)row * 1024 + c) = w; } }
                if (FUSE) { ss += __shfl_xor(ss, 16); ss += __shfl_xor(ss, 32); if (fq == 0) unsafeAtomicAdd(ssq + row, ss); } }
            asm volatile("" ::: "memory"); }
    }
};
struct EpiSwiGLU {
    static constexpr bool PERM = true, AFTER_DRAIN = false;
    bf16_t* O; int ldc; int npn; const float* ssq; const float* cbias; int cbld;
    __device__ __forceinline__ void operator()(const f32x4 (&acc)[2][2][4][2], const Unit& u, int wr, int wc, int fr, int fq) const {
        const int row0 = u.pm * BM + wr * 64 + fr; const int col0 = (u.pn % npn) * HALF + wc * 32 + 8 * fq;
        f32x4 cb[2][2];
        if (ssq) { const int b = u.pm / 9; const int mrow = (u.pm - 9 * b == 0) ? 8 : b; const float* cp = cbias + (size_t)mrow * cbld + u.pn * BM + wc * 32 + 8 * fq;
#pragma unroll
            for (int bj = 0; bj < 2; ++bj)
#pragma unroll
                for (int n = 0; n < 2; ++n) cb[bj][n] = *(const f32x4*)(cp + bj * HALF + 4 * n); }
        float rsv[2][4];
        if (ssq) {
#pragma unroll
            for (int ai = 0; ai < 2; ++ai)
#pragma unroll
                for (int m = 0; m < 4; ++m) rsv[ai][m] = ssq[row0 + ai * HALF + m * 16];
#pragma unroll
            for (int ai = 0; ai < 2; ++ai)
#pragma unroll
                for (int m = 0; m < 4; ++m) rsv[ai][m] = rsqrtf(rsv[ai][m] * (1.f / 1024.f) + 1e-6f); }
#pragma unroll
        for (int ai = 0; ai < 2; ++ai)
#pragma unroll
            for (int m = 0; m < 4; ++m) { const int row = row0 + ai * HALF + m * 16; bf16_t* rowp = O + (size_t)row * ldc + col0;
                f32x4 a0 = acc[ai][0][m][0], a1 = acc[ai][0][m][1], g0 = acc[ai][1][m][0], g1 = acc[ai][1][m][1];
                if (ssq) { const float rs = rsv[ai][m]; a0 = a0 * rs + cb[0][0]; a1 = a1 * rs + cb[0][1]; g0 = g0 * rs + cb[1][0]; g1 = g1 * rs + cb[1][1]; }
                u32x4 w; w.x = cvt_pk_bf16(fast_silu(a0[0]) * g0[0], fast_silu(a0[1]) * g0[1]); w.y = cvt_pk_bf16(fast_silu(a0[2]) * g0[2], fast_silu(a0[3]) * g0[3]);
                w.z = cvt_pk_bf16(fast_silu(a1[0]) * g1[0], fast_silu(a1[1]) * g1[1]); w.w = cvt_pk_bf16(fast_silu(a1[2]) * g1[2], fast_silu(a1[3]) * g1[3]);
                *(u32x4*)rowp = w; }
    }
};
struct EpiBf16Norm {
    static constexpr bool PERM = true, AFTER_DRAIN = false;
    bf16_t* O; int ldc; const float* ssq; const float* cbias; int cbld;
    __device__ __forceinline__ void operator()(const f32x4 (&acc)[2][2][4][2], const Unit& u, int wr, int wc, int fr, int fq) const {
        const int row0 = u.pm * BM + wr * 64 + fr; const int col0 = u.pn * BM + wc * 32 + 8 * fq;
        const int b = u.pm / 9; const int mrow = (u.pm - 9 * b == 0) ? 8 : b; const float* cp = cbias + (size_t)mrow * cbld + col0;
        f32x4 cb[2][2];
#pragma unroll
        for (int bj = 0; bj < 2; ++bj)
#pragma unroll
            for (int n = 0; n < 2; ++n) cb[bj][n] = *(const f32x4*)(cp + bj * HALF + 4 * n);
        float rsv[2][4];
#pragma unroll
        for (int ai = 0; ai < 2; ++ai)
#pragma unroll
            for (int m = 0; m < 4; ++m) rsv[ai][m] = ssq[row0 + ai * HALF + m * 16];
#pragma unroll
        for (int ai = 0; ai < 2; ++ai)
#pragma unroll
            for (int m = 0; m < 4; ++m) { const int row = row0 + ai * HALF + m * 16; bf16_t* rowp = O + (size_t)row * ldc + col0; const float rs = rsqrtf(rsv[ai][m] * (1.f / 1024.f) + 1e-6f);
#pragma unroll
                for (int bj = 0; bj < 2; ++bj) { const f32x4 v0 = acc[ai][bj][m][0] * rs + cb[bj][0], v1 = acc[ai][bj][m][1] * rs + cb[bj][1];
                    u32x4 w; w.x = cvt_pk_bf16(v0[0], v0[1]); w.y = cvt_pk_bf16(v0[2], v0[3]); w.z = cvt_pk_bf16(v1[0], v1[1]); w.w = cvt_pk_bf16(v1[2], v1[3]); *(u32x4*)(rowp + bj * HALF) = w; } }
    }
};
struct EpiMoeY2 {
    static constexpr bool PERM = true, AFTER_DRAIN = false;
    const float* slot_gate; bf16_t* Y2;
    __device__ __forceinline__ void operator()(const f32x4 (&acc)[2][2][4][2], const Unit& u, int wr, int wc, int fr, int fq) const {
        const int col0 = (u.pn & 3) * BM + wc * 32 + 8 * fq; const int slot0 = u.pm * BM + wr * 64 + fr;
#pragma unroll
        for (int ai = 0; ai < 2; ++ai)
#pragma unroll
            for (int m = 0; m < 4; ++m) { const int slot = slot0 + ai * HALF + m * 16; const float g = slot_gate[slot]; bf16_t* rowp = Y2 + (size_t)slot * 1024 + col0;
#pragma unroll
                for (int bj = 0; bj < 2; ++bj) { const f32x4 v0 = acc[ai][bj][m][0] * g, v1 = acc[ai][bj][m][1] * g;
                    u32x4 w; w.x = cvt_pk_bf16(v0[0], v0[1]); w.y = cvt_pk_bf16(v0[2], v0[3]); w.z = cvt_pk_bf16(v1[0], v1[1]); w.w = cvt_pk_bf16(v1[2], v1[3]);
                    *(u32x4*)(rowp + bj * HALF) = w; } }
    }
};
enum EpiMode { E_BF16 = 0, E_BF16NORM, E_RES, E_SWIGLU, E_MOEY2 };
struct EpiAny {
    static constexpr bool PERM = true, AFTER_DRAIN = false;
    int mode;
    bf16_t* O; int ldc, npn; const float* ssq; const float* cbias; int cbld;
    const float* xin; float* xout; const float* modbase; int compact, srcin, fuse; const float* xsrc_lat; const float* xsrc_ctx; const float* gnext; const float* nscale; float* ssqw;
    const float* slot_gate;
    __device__ __forceinline__ void res(const f32x4 (&acc)[2][2][4][2], const Unit& u, int wr, int wc, int fr, int fq) const {
        const int b = u.pm / 9, pj = u.pm - 9 * b; const int mrow = (pj == 0) ? 8 : b;
        const float* g = modbase + (size_t)mrow * 6144;
        const int col0 = u.pn * BM + wc * 32 + 8 * fq;
        f32x4 gv[2][2];
#pragma unroll
        for (int bj = 0; bj < 2; ++bj)
#pragma unroll
            for (int n = 0; n < 2; ++n) gv[bj][n] = *(const f32x4*)(g + col0 + bj * HALF + n * 4);
        const int row0 = u.pm * BM + wr * 64 + fr; const int oshift = compact ? 256 * (b + 1) : 0;
        const float* xbase = srcin ? (pj == 0 ? xsrc_ctx + (size_t)b * 256 * 1024 : xsrc_lat + ((size_t)b * 2048 + (pj - 1) * 256) * 1024) - (size_t)u.pm * BM * 1024 : xin;
        const float* ns = nscale + (size_t)mrow * 6144; bf16_t* hraw = O;
#pragma unroll
        for (int ai = 0; ai < 2; ++ai)
#pragma unroll
            for (int m = 0; m < 4; ++m) { const int row = row0 + ai * HALF + m * 16; const float* xi = xbase + (size_t)row * 1024 + col0; float* xo = xout + (size_t)(row - oshift) * 1024 + col0; float ss = 0.f;
#pragma unroll
                for (int bj = 0; bj < 2; ++bj)
#pragma unroll
                    for (int n = 0; n < 2; ++n) { const f32x4 v = *(const f32x4*)(xi + bj * HALF + n * 4) + gv[bj][n] * acc[ai][bj][m][n]; *(f32x4*)(xo + bj * HALF + n * 4) = v;
                        if (fuse) { const int c = col0 + bj * HALF + n * 4; const f32x4 hv = v * (*(const f32x4*)(gnext + c) * (*(const f32x4*)(ns + c) + 1.f));
                            ss += (v[0] * v[0] + v[1] * v[1]) + (v[2] * v[2] + v[3] * v[3]);
                            u32x2 w; w.x = cvt_pk_bf16(hv[0], hv[1]); w.y = cvt_pk_bf16(hv[2], hv[3]); *(u32x2*)(hraw + (size_t)row * 1024 + c) = w; } }
                if (fuse) { ss += __shfl_xor(ss, 16); ss += __shfl_xor(ss, 32); if (fq == 0) unsafeAtomicAdd(ssqw + row, ss); }
                if (m & 1) asm volatile("" ::: "memory"); }
    }
    __device__ __forceinline__ void operator()(const f32x4 (&acc)[2][2][4][2], const Unit& u, int wr, int wc, int fr, int fq) const {
        if (mode == E_BF16) { EpiBf16<0> e{O, ldc, nullptr, 0, 0, 1.f}; e(acc, u, wr, wc, fr, fq); }
        else if (mode == E_BF16NORM) { EpiBf16Norm e{O, ldc, ssq, cbias, cbld}; e(acc, u, wr, wc, fr, fq); }
        else if (mode == E_SWIGLU) { EpiSwiGLU e{O, ldc, npn, ssq, cbias, cbld}; e(acc, u, wr, wc, fr, fq); }
        else if (mode == E_MOEY2) { EpiMoeY2 e{slot_gate, O}; e(acc, u, wr, wc, fr, fq); }
        else res(acc, u, wr, wc, fr, fq);
    }
};
struct ChainOrder {
    int stage, c;
    __device__ __forceinline__ bool next(int i, Unit& u) const {
        const int x = c & 7, r = c >> 3; int lu = -1, nN = 4;
        if (stage == 0) { if (i == 0) lu = r; else if (i == 1 && r >= 16 && r < 20) lu = 16 + r; }
        else if (stage == 1) { nN = 22;
            if (i < 3) lu = 32 * i + r; else if (i == 3) { if (r < 30) lu = 96 + r; }
            else if (r < 28) { if (i < 6) lu = 126 + 28 * (i - 4) + r; else if (i == 6 && r < 16) lu = 182 + r; } }
        else if (stage == 2) { if (r >= 28) { if (i == 0) lu = r - 28; else if (i == 1) lu = r - 16; }
               else if (i == 0) { if (r < 16) lu = 20 + r; else { const int k = r - 16; lu = k < 8 ? 4 + k : 8 + k; } } }
        else {
            if (i < 2) lu = 32 * i + r; else if (i == 2 && r == 31) lu = 64;
            if (lu < 0) return false;
            if (lu == 64) { u.pm = 9 * x; u.pn = 7; } else { u.pm = 9 * x + 1 + (lu & 7); u.pn = lu >> 3; }
            return true; }
        if (lu < 0) return false;
        const unsigned long long perm = x == 6 ? 0x874310652ull : x == 7 ? 0x875421630ull : 0x876543210ull;
        const int g = lu / (3 * nN), w = lu - g * 3 * nN; u.pm = 9 * x + (int)((perm >> (4 * (3 * g + w % 3))) & 15ull); u.pn = w / 3; return true;
    }
};
struct MoeChainOrder {
    const PG8_LAS int* tb; int stage, c;
    __device__ __forceinline__ bool next(int i, Unit& u) const {
        const int x = c & 7, r = c >> 3, T = tb[8];
        const int t0 = (T * x) >> 3, n = ((T * (x + 1)) >> 3) - t0, j = r & 7, cc = r >> 3;
        int tile, col, nN;
        if (stage == 1) { nN = 4; tile = 8 * i + j; col = cc; if (tile >= n) return false; }
        else { nN = 28;
            const int kb = ((n & 7) == 1) ? 1 : 0, H = 4 * kb, tot = 28 * n + 12 * kb, A0 = tot >> 5, rem = tot & 31, ah = A0 - 3 * kb;
            const bool heavy = kb && j == 0;
            const int nr = r - (kb ? cc + (j > 0 ? 1 : 0) : 0);
            int m;
            if (i < ah) m = 32 * i + r;
            else { if (heavy) return false;
                   if (i < A0) m = 32 * ah + (32 - H) * (i - ah) + nr;
                   else if (i == A0 && nr < rem) m = 32 * ah + (32 - H) * (A0 - ah) + nr;
                   else return false; }
            if (m >= 28 * n) return false;
            const int g = m / 112, w = m - g * 112, gs = (n - 4 * g) < 4 ? (n - 4 * g) : 4; tile = 4 * g + w % gs; col = w / gs; }
        const int t = t0 + tile; int e = 0;
#pragma unroll
        for (int k = 1; k < 8; ++k) if (t >= tb[k]) e = k;
        u.pm = t; u.pn = e * nN + col; return true;
    }
};
struct OrderAny {
    int omode;
    DenseOrder d; MoeOrder m; ChainOrder ch; MoeChainOrder mch;
    mutable unsigned early, ew0, ew1, ew2, ew3;
    __device__ __forceinline__ bool next(int i, Unit& u) const {
        const bool ok = omode == 3 ? m.next(i, u) : omode == 4 ? ch.next(i, u) : omode == 5 ? mch.next(i, u) : d.next(i, u);
        if (ok && wcnt != nullptr) {
            early = __hip_atomic_load(wcnt + u.pm * 16, __ATOMIC_RELAXED, __HIP_MEMORY_SCOPE_AGENT);
            if (w2kind != 0) { int lo, hi; war_range(u, lo, hi);
                ew0 = __hip_atomic_load(w2cnt + (lo     <= hi ? lo     : u.pm) * 16, __ATOMIC_RELAXED, __HIP_MEMORY_SCOPE_AGENT);
                ew1 = __hip_atomic_load(w2cnt + (lo + 1 <= hi ? lo + 1 : u.pm) * 16, __ATOMIC_RELAXED, __HIP_MEMORY_SCOPE_AGENT);
                ew2 = __hip_atomic_load(w2cnt + (lo + 2 <= hi ? lo + 2 : u.pm) * 16, __ATOMIC_RELAXED, __HIP_MEMORY_SCOPE_AGENT);
                ew3 = __hip_atomic_load(w2cnt + (lo + 3 <= hi ? lo + 3 : u.pm) * 16, __ATOMIC_RELAXED, __HIP_MEMORY_SCOPE_AGENT); }
        }
        return ok;
    }
    unsigned* wcnt; unsigned wtarget; unsigned* dcnt; int rel_agent;
    unsigned* w2cnt; int w2kind;
    __device__ __forceinline__ void war_range(const Unit& u, int& lo, int& hi) const {
        if (w2kind == 1) { const int a0 = u.pm * 1441792 - 75497472, a1 = a0 + 1441791; lo = (a0 > 0 ? a0 : 0) >> 19; hi = a1 < 0 ? -1 : (a1 >> 19); }
        else { const int b0 = u.pm << 20; lo = b0 / 1441792; hi = (b0 + 1048575) / 1441792; }
    }
    __device__ __forceinline__ void a_ready(const Unit& u) const {
        if (wcnt != nullptr) {
            unsigned* p = wcnt + u.pm * 16; unsigned sp = 0u;
            unsigned mn = early;
            if (w2kind != 0) { const unsigned a = ew0 < ew1 ? ew0 : ew1, b = ew2 < ew3 ? ew2 : ew3, c2 = a < b ? a : b; mn = c2 < mn ? c2 : mn; }
            if (mn < wtarget) {
                while (__hip_atomic_load(p, __ATOMIC_RELAXED, __HIP_MEMORY_SCOPE_AGENT) < wtarget) { __builtin_amdgcn_s_sleep(1); if (++sp > (1u << 22)) break; }
                if (w2kind != 0) { int lo, hi; war_range(u, lo, hi);
                    for (int q = lo; q <= hi; ++q) while (__hip_atomic_load(w2cnt + q * 16, __ATOMIC_RELAXED, __HIP_MEMORY_SCOPE_AGENT) < wtarget) { __builtin_amdgcn_s_sleep(1); if (++sp > (1u << 22)) break; } }
            }
            if (rel_agent) __builtin_amdgcn_fence(__ATOMIC_ACQUIRE, "agent");
            asm volatile("" ::: "memory");
        }
    }
    __device__ __forceinline__ void done(const Unit& u) const {
        if (dcnt != nullptr) {
            if (rel_agent) __builtin_amdgcn_fence(__ATOMIC_RELEASE, "agent");
            asm volatile("s_waitcnt vmcnt(0)" ::: "memory");
            if ((threadIdx.x & 63) == 0) (void)__hip_atomic_fetch_add(dcnt + u.pm * 16, 1u, __ATOMIC_RELAXED, __HIP_MEMORY_SCOPE_AGENT);
        }
    }
};
}
#define GAS __attribute__((address_space(1)))
#define LAS __attribute__((address_space(3)))
typedef unsigned v4u __attribute__((ext_vector_type(4)));
typedef short bf16x8 __attribute__((ext_vector_type(8)));
namespace att {
using f32x16 = __attribute__((ext_vector_type(16))) float;
using s16x4 = __attribute__((ext_vector_type(4))) short;
typedef float f32x2_t __attribute__((ext_vector_type(2))); typedef __bf16 bf16x2_t __attribute__((ext_vector_type(2)));
__device__ __forceinline__ int crow(int r, int hi) { return (r & 3) + 8 * (r >> 2) + 4 * hi; }
__device__ __forceinline__ void glds16(const void* gsrc, unsigned lds_dst) { unsigned keep;
    asm volatile("s_mov_b32 %0, m0\n\ts_mov_b32 m0, %2\n\ts_nop 0\n\tglobal_load_lds_dwordx4 %1, off\n\ts_mov_b32 m0, %0" : "=&s"(keep) : "v"(gsrc), "s"(lds_dst) : "memory"); }
__device__ __forceinline__ unsigned cvtpk_s(float lo, float hi) { f32x2_t v = {lo, hi}; bf16x2_t b = __builtin_convertvector(v, bf16x2_t); return __builtin_bit_cast(unsigned, b); }
#define ATT_MX3(a, b, c) __builtin_fmaxf(__builtin_fmaxf((a), (b)), (c))
__device__ __forceinline__ float rowmax32(const f32x16& p0, const f32x16& p1) {
    float a = ATT_MX3(p0[0], p0[1], p1[0]), b = ATT_MX3(p0[2], p0[3], p1[1]); a = ATT_MX3(a, p1[2], p1[3]);
#pragma unroll
    for (int r = 4; r < 16; r += 4) { a = ATT_MX3(a, p0[r], p0[r + 1]); b = ATT_MX3(b, p0[r + 2], p0[r + 3]); a = ATT_MX3(a, p1[r], p1[r + 1]); b = ATT_MX3(b, p1[r + 2], p1[r + 3]); }
    a = __builtin_fmaxf(a, b);
    auto rr = __builtin_amdgcn_permlane32_swap(__float_as_uint(a), __float_as_uint(a), false, false);
    return fmaxf(__uint_as_float(rr[0]), __uint_as_float(rr[1]));
}
__device__ __forceinline__ void pv(f32x16* o, int vb, bf16x8 pa0, bf16x8 pa1, bf16x8 pa2, bf16x8 pa3) {
    s16x4 lo[2][4], hi[2][4];
#pragma unroll
    for (int d0 = 0; d0 < 2; ++d0)
#pragma unroll
        for (int ks = 0; ks < 4; ++ks) {
            asm volatile("ds_read_b64_tr_b16 %0,%1 offset:%c2" : "=&v"(lo[d0][ks]) : "v"(vb), "i"(d0 * 4096 + ks * 1024) : "memory");
            asm volatile("ds_read_b64_tr_b16 %0,%1 offset:%c2" : "=&v"(hi[d0][ks]) : "v"(vb), "i"(d0 * 4096 + ks * 1024 + 512) : "memory"); }
    asm volatile("s_waitcnt lgkmcnt(0)" ::: "memory"); __builtin_amdgcn_sched_barrier(0);
#define ATT_PK(d, k) (bf16x8){lo[d][k][0], lo[d][k][1], lo[d][k][2], lo[d][k][3], hi[d][k][0], hi[d][k][1], hi[d][k][2], hi[d][k][3]}
    o[0] = __builtin_amdgcn_mfma_f32_32x32x16_bf16(pa0, ATT_PK(0, 0), o[0], 0, 0, 0); o[1] = __builtin_amdgcn_mfma_f32_32x32x16_bf16(pa0, ATT_PK(1, 0), o[1], 0, 0, 0);
    o[0] = __builtin_amdgcn_mfma_f32_32x32x16_bf16(pa1, ATT_PK(0, 1), o[0], 0, 0, 0); o[1] = __builtin_amdgcn_mfma_f32_32x32x16_bf16(pa1, ATT_PK(1, 1), o[1], 0, 0, 0);
    o[0] = __builtin_amdgcn_mfma_f32_32x32x16_bf16(pa2, ATT_PK(0, 2), o[0], 0, 0, 0); o[1] = __builtin_amdgcn_mfma_f32_32x32x16_bf16(pa2, ATT_PK(1, 2), o[1], 0, 0, 0);
    o[0] = __builtin_amdgcn_mfma_f32_32x32x16_bf16(pa3, ATT_PK(0, 3), o[0], 0, 0, 0); o[1] = __builtin_amdgcn_mfma_f32_32x32x16_bf16(pa3, ATT_PK(1, 3), o[1], 0, 0, 0);
#undef ATT_PK
}
template <int DQ> struct Geo {
    static constexpr int NCH = DQ / 8, KSLOT = NCH * 1024, VSLOT = 8192;
    static constexpr int LDS_K = 0, LDS_V = 2 * KSLOT, LDS_WS = LDS_V + 2 * VSLOT, LDS_OST = LDS_WS + 8 * 256, LDS_BYTES = LDS_OST + 8 * 4096;
};
template <int DQ>
__device__ __forceinline__ void unit(int b, int hq, int hk, int qb, int NT, const bf16_t* __restrict__ Q, int ldq, const bf16_t* __restrict__ K, int ldk, const bf16_t* __restrict__ V, int ldv,
                                     bf16_t* __restrict__ O, int ldo, LAS unsigned char* shm) {
    typedef Geo<DQ> G; constexpr int ND0 = DQ / 16;
    const int tid = threadIdx.x, lane = tid & 63, r32 = lane & 31, hi = lane >> 5; const int wid = __builtin_amdgcn_readfirstlane(tid >> 6);
    const long rowbase = (long)b * RPB; const int q0 = qb * 256;
    const bf16_t* Qw = Q + (rowbase + q0 + wid * 32) * ldq + hq * DQ;
    const bf16_t* Kh = K + rowbase * ldk + hk * DQ; const bf16_t* Vh = V + rowbase * ldv + hk * 64;
    const unsigned lds0 = (unsigned)(uintptr_t)shm;
    LAS float* wsf = (LAS float*)(shm + G::LDS_WS) + wid * 64;
    const bf16_t* ksrc = Kh + (long)lane * ldk + wid * 8;
    const bf16_t* vsrc = Vh + (long)(16 * (wid & 3) + (lane >> 2)) * ldv + (wid >> 2) * 32 + (lane & 3) * 8;
    const unsigned kdst = lds0 + G::LDS_K + wid * 1024, vdst = lds0 + G::LDS_V + wid * 1024;
    const int vb0 = (int)(lds0 + G::LDS_V) + ((lane >> 4) & 1) * 32 + (lane & 3) * 8 + (4 * hi + ((lane & 15) >> 2)) * 64;
#define ATT_DMA(t, s) do { const bf16_t* kp_ = ksrc + (long)(t) * 64 * ldk; glds16(kp_, (unsigned)__builtin_amdgcn_readfirstlane(kdst + (s) * G::KSLOT)); \
        if (DQ == 96 && wid < 4) glds16(kp_ + 64, (unsigned)__builtin_amdgcn_readfirstlane(kdst + (s) * G::KSLOT + 8192)); \
        glds16(vsrc + (long)(t) * 64 * ldv, (unsigned)__builtin_amdgcn_readfirstlane(vdst + (s) * G::VSLOT)); } while (0)
    ATT_DMA(0, 0);
    bf16x8 qr[ND0];
#pragma unroll
    for (int d0 = 0; d0 < ND0; ++d0) qr[d0] = *reinterpret_cast<const bf16x8*>(&Qw[(long)r32 * ldq + d0 * 16 + hi * 8]);
    constexpr float THR = 8.f;
    float mref = 0.f, l_reg = 0.f; f32x16 o[2]; o[0] = f32x16{}; o[1] = f32x16{}; f32x16 negm = f32x16{};
    for (int t = 0; t < NT; ++t) {
        const int s = t & 1;
        asm volatile("s_waitcnt vmcnt(0) lgkmcnt(0)\n\ts_barrier" ::: "memory");
        if (t + 1 < NT) ATT_DMA(t + 1, s ^ 1);
        f32x16 p0, p1;
        { const LAS unsigned char* kb = shm + G::LDS_K + s * G::KSLOT + hi * 1024 + r32 * 16;
#pragma unroll
          for (int d0 = 0; d0 < ND0; ++d0) { const bf16x8 b0 = *(const LAS bf16x8*)(kb + d0 * 2048); const bf16x8 b1 = *(const LAS bf16x8*)(kb + d0 * 2048 + 512);
              p0 = __builtin_amdgcn_mfma_f32_32x32x16_bf16(b0, qr[d0], d0 == 0 ? negm : p0, 0, 0, 0); p1 = __builtin_amdgcn_mfma_f32_32x32x16_bf16(b1, qr[d0], d0 == 0 ? negm : p1, 0, 0, 0); } }
        const float rm = rowmax32(p0, p1);
        if (__builtin_expect(t == 0 || __any(rm > THR), 0)) {
            const float dl = t == 0 ? rm : __builtin_fmaxf(rm, 0.f); mref += dl;
#pragma unroll
            for (int r = 0; r < 16; ++r) { p0[r] -= dl; p1[r] -= dl; negm[r] = -mref; }
            const float alpha = t == 0 ? 1.f : __builtin_amdgcn_exp2f(-dl); l_reg *= alpha;
            if (hi == 0) wsf[r32] = alpha;
            asm volatile("s_waitcnt lgkmcnt(0)" ::: "memory");
#pragma unroll
            for (int r = 0; r < 16; ++r) { const float a = wsf[crow(r, hi)]; o[0][r] *= a; o[1][r] *= a; }
        }
        f32x2_t sacc = {0.f, 0.f};
#pragma unroll
        for (int r = 0; r < 16; r += 2) { p0[r] = __builtin_amdgcn_exp2f(p0[r]); p0[r + 1] = __builtin_amdgcn_exp2f(p0[r + 1]); p1[r] = __builtin_amdgcn_exp2f(p1[r]); p1[r + 1] = __builtin_amdgcn_exp2f(p1[r + 1]);
            sacc += (f32x2_t){p0[r], p0[r + 1]}; sacc += (f32x2_t){p1[r], p1[r + 1]}; }
        l_reg += sacc[0] + sacc[1];
        u32x4 pw0, pw1, pw2, pw3;
        pw0 = (u32x4){cvtpk_s(p0[0], p0[1]), cvtpk_s(p0[2], p0[3]), cvtpk_s(p0[4], p0[5]), cvtpk_s(p0[6], p0[7])};
        pw1 = (u32x4){cvtpk_s(p0[8], p0[9]), cvtpk_s(p0[10], p0[11]), cvtpk_s(p0[12], p0[13]), cvtpk_s(p0[14], p0[15])};
        pw2 = (u32x4){cvtpk_s(p1[0], p1[1]), cvtpk_s(p1[2], p1[3]), cvtpk_s(p1[4], p1[5]), cvtpk_s(p1[6], p1[7])};
        pw3 = (u32x4){cvtpk_s(p1[8], p1[9]), cvtpk_s(p1[10], p1[11]), cvtpk_s(p1[12], p1[13]), cvtpk_s(p1[14], p1[15])};
        pv(o, vb0 + s * G::VSLOT, __builtin_bit_cast(bf16x8, pw0), __builtin_bit_cast(bf16x8, pw1), __builtin_bit_cast(bf16x8, pw2), __builtin_bit_cast(bf16x8, pw3));
    }
#undef ATT_DMA
    { auto rr = __builtin_amdgcn_permlane32_swap(__float_as_uint(l_reg), __float_as_uint(l_reg), false, false); l_reg = __uint_as_float(rr[0]) + __uint_as_float(rr[1]); }
    if (hi == 0) wsf[32 + r32] = l_reg;
    asm volatile("s_waitcnt lgkmcnt(0)" ::: "memory");
    float rli[16];
#pragma unroll
    for (int r = 0; r < 16; ++r) rli[r] = __builtin_amdgcn_rcpf(wsf[32 + crow(r, hi)]);
    bf16_t* Ow = O + (rowbase + q0 + wid * 32) * ldo + hq * 64;
    { LAS bf16_t* stg = (LAS bf16_t*)(shm + G::LDS_OST) + wid * 2048;
#pragma unroll
      for (int r = 0; r < 16; ++r) { const int orow = crow(r, hi);
#pragma unroll
          for (int d0 = 0; d0 < 2; ++d0) stg[orow * 64 + d0 * 32 + r32] = f2bf(o[d0][r] * rli[r]); }
      asm volatile("s_waitcnt lgkmcnt(0)" ::: "memory");
#pragma unroll
      for (int i = 0; i < 4; ++i) { const int row = i * 8 + (lane >> 3), ch = lane & 7; const u32x4 v = *(const LAS u32x4*)(stg + row * 64 + ch * 8); *(u32x4*)(Ow + (long)row * ldo + ch * 8) = v; } }
    asm volatile("s_waitcnt lgkmcnt(0)\n\ts_barrier" ::: "memory");
}
}
#define LDS_WAIT() asm volatile("s_waitcnt lgkmcnt(0)" ::: "memory")
#define VM_WAIT() asm volatile("s_waitcnt vmcnt(0)" ::: "memory")
constexpr int NWAVES = 8, NTHREADS = 512;
constexpr int RING_OFF = 0, RING_BYTES = 131072;
constexpr int MISC_OFF = RING_BYTES;
constexpr int LDS_BYTES = 147456;

enum Phase { PH_P0 = 0, PH_NORM0, PH_G_IN0, PH_LRUPREP, PH_MIX0, PH_G_OUT0, PH_G_F1, PH_G_F2, PH_G_IN1, PH_PREP1, PH_G_QKVB, PH_PREP2, PH_MIX1, PH_G_OUT1,
             PH_ROUTE, PH_SLOT, PH_MOE1, PH_MOE2, PH_COMBINE, PH_COUNT,
             PH_G_QB = 100, PH_G_KVB = 101 };

struct Params { const float* i0; const float* i1; const float* i2; const float* i3; const float* i4; const float* i5; const float* i6; const float* i7; const float* i8; const float* i9; const float* i10; const float* i11; const float* i12; const float* i13; const float* i14; const float* i15; const float* i16; const float* i17; const float* i18; const float* i19; const float* i20; const float* i21; const float* i22; const float* i23; const float* i24; const float* i25; const float* i26; const float* i27; const float* i28; const float* i29; const float* i30; const float* i31; const float* i32; const float* i33; const float* i34; const float* i35; const float* i36; const float* i37; const float* i38; const float* i39; const float* i40; const float* i41; const float* i42; float* out; char* ws; int ph_lo, ph_hi; };
#define PIN(k) (P.i##k)
static_assert(sizeof(Params) == 43 * 8 + 8 + 8 + 8, "Params has no padding");

struct Frame { LAS unsigned char* lds; int tid, lane, wave, G, bid, even; char* ws; };

__device__ __forceinline__ void tr_item(const float* __restrict__ W, int N, bf16_t* __restrict__ WT, int ldk, int kb, int nb, int dst_row0, LAS float* scr, int lane) {
    const int k0 = 64 * kb, n0 = 32 * nb;
    f32x4 v[8]; const float* wp = W + (size_t)(k0 + (lane >> 3)) * N + n0 + 4 * (lane & 7);
#pragma unroll
    for (int i = 0; i < 8; ++i) v[i] = __builtin_nontemporal_load((const f32x4*)(wp + (size_t)(8 * i) * N));
#pragma unroll
    for (int i = 0; i < 8; ++i) { LAS float* sp = scr + (8 * i + (lane >> 3)) * 33 + 4 * (lane & 7); sp[0] = v[i][0]; sp[1] = v[i][1]; sp[2] = v[i][2]; sp[3] = v[i][3]; }
    LDS_WAIT(); asm volatile("" ::: "memory");
    const int c = lane & 7;
#pragma unroll
    for (int j = 0; j < 4; ++j) { const int n = (lane >> 3) + 8 * j; const LAS float* s = scr + (8 * c) * 33 + n;
        v4u o; o.x = pk2(s[0 * 33], s[1 * 33]); o.y = pk2(s[2 * 33], s[3 * 33]); o.z = pk2(s[4 * 33], s[5 * 33]); o.w = pk2(s[6 * 33], s[7 * 33]);
        *(v4u*)(WT + (size_t)(dst_row0 + n) * ldk + k0 + 8 * c) = o; }
    LDS_WAIT(); asm volatile("" ::: "memory");
}
constexpr int MOE_ITEMS = 8 * 3 * 1792, MOE_CHUNK = 32, MOE_NCHUNK = MOE_ITEMS / MOE_CHUNK;
__device__ __forceinline__ void moe_conv_item(const Frame& F, const Params& P, int it, LAS float* scr) {
    const int e = it / 5376, r = it % 5376, which = r / 1792, q = r % 1792; char* ws = F.ws;
    const float* src; bf16_t* dst; int N, ldk, kb, nb, dr;
    if (which < 2) { kb = q / 112; nb = q % 112; const int n0 = nb * 32; dr = (n0 >> 7) * 256 + (n0 & 127) + (which == 1 ? 128 : 0);
        src = (which == 0 ? PIN(40) : PIN(41)) + (size_t)e * 1024 * 3584; N = 3584; dst = (bf16_t*)(ws + WS_W13M) + (size_t)e * 7168 * 1024; ldk = 1024; }
    else { kb = q / 32; nb = q % 32; dr = nb * 32; src = PIN(42) + (size_t)e * 3584 * 1024; N = 1024; dst = (bf16_t*)(ws + WS_W2M) + (size_t)e * 1024 * 3584; ldk = 3584; }
    tr_item(src, N, dst, ldk, kb, nb, dr, scr, F.lane);
}
__device__ __forceinline__ void moe_conv_all(const Frame& F, const Params& P) {
    LAS float* scr = (LAS float*)(F.lds + RING_OFF + F.wave * 16384); const int gw = F.bid * NWAVES + F.wave, NGW = F.G * NWAVES;
    __syncthreads();
#pragma unroll 1
    for (int it = gw; it < MOE_ITEMS; it += NGW) moe_conv_item(F, P, it, scr);
    __syncthreads();
}
struct ConvDesc { const float* src; bf16_t* dst; int N, ldk, nblk, start, il, pad; };
__device__ __forceinline__ void phase_conv(const Frame& F, const Params& P, bool moe) {
    LAS float* scr = (LAS float*)(F.lds + RING_OFF + F.wave * 16384); char* ws = F.ws;
    LAS ConvDesc* tab = (LAS ConvDesc*)(F.lds + MISC_OFF);
    if (F.tid < 41) { const int t = F.tid; ConvDesc d; d.il = 0; d.pad = 0;
        if (t == 0) { d.src = PIN(8); d.dst = (bf16_t*)(ws + WS_WIN0); d.N = 1792; d.ldk = 1024; d.start = 16 * 56; }
        else if (t == 1) { d.src = PIN(9); d.dst = (bf16_t*)(ws + WS_WOUT0); d.N = 1024; d.ldk = 1024; d.start = 16 * 32; }
        else if (t == 2) { d.src = PIN(19); d.dst = (bf16_t*)(ws + WS_WF13); d.N = 2816; d.ldk = 1024; d.start = 16 * 88; d.il = 1; }
        else if (t == 3) { d.src = PIN(20); d.dst = (bf16_t*)(ws + WS_WF13); d.N = 2816; d.ldk = 1024; d.start = 16 * 88; d.il = 2; }
        else if (t == 4) { d.src = PIN(21); d.dst = (bf16_t*)(ws + WS_WF2); d.N = 1024; d.ldk = 2816; d.start = 44 * 32; }
        else if (t == 5) { d.src = PIN(22); d.dst = (bf16_t*)(ws + WS_WIN1); d.N = 1952; d.ldk = 1024; d.start = 16 * 61; }
        else if (t == 6) { d.src = PIN(23); d.dst = (bf16_t*)(ws + WS_WOUT1); d.N = 1024; d.ldk = 1024; d.start = 16 * 32; }
        else if (t == 7) { d.src = PIN(34); d.dst = (bf16_t*)(ws + WS_WQB); d.N = 768; d.ldk = 256; d.start = 4 * 24; }
        else if (t == 8) { d.src = PIN(36); d.dst = (bf16_t*)(ws + WS_WKVB); d.N = 1024; d.ldk = 256; d.start = 2 * 32; }
        else { const int q = t - 9, dn = q >> 1, g = q & 1; d.src = (g ? PIN(14) : PIN(12)) + (size_t)dn * 4096; d.dst = (bf16_t*)(ws + WS_WLRU) + (size_t)(dn * 2 + g) * 4096; d.N = 64; d.ldk = 64; d.start = 2; }
        d.nblk = d.N / 32;
        tab[t].src = d.src; tab[t].dst = d.dst; tab[t].N = d.N; tab[t].ldk = d.ldk; tab[t].nblk = d.nblk; tab[t].start = d.start; tab[t].il = d.il; tab[t].pad = 0; }
    __syncthreads();
    if (F.tid == 0) { int s = 0; for (int t = 0; t < 41; ++t) { const int c = tab[t].start; tab[t].start = s; s += c; } tab[0].pad = s; }
    __syncthreads();
    const int total = tab[0].pad; const int gw = F.bid * NWAVES + F.wave, NGW = F.G * NWAVES;
#pragma unroll 1
    for (int it = gw; it < total; it += NGW) { int e = 0;
#pragma unroll 1
        for (int t = 1; t < 41; ++t) if (it >= tab[t].start) e = t;
        ConvDesc d; d.src = tab[e].src; d.dst = tab[e].dst; d.N = tab[e].N; d.ldk = tab[e].ldk; d.nblk = tab[e].nblk; d.start = tab[e].start; d.il = tab[e].il;
        const int loc = it - d.start, kb = loc / d.nblk, nb = loc % d.nblk, n0 = nb * 32;
        const int dr = d.il == 0 ? n0 : ((n0 >> 7) * 256 + (n0 & 127) + (d.il == 2 ? 128 : 0));
        tr_item(d.src, d.N, d.dst, d.ldk, kb, nb, dr, scr, F.lane); }
    const int gt = F.bid * NTHREADS + F.tid, NGT = F.G * NTHREADS;
    { v4u* z = (v4u*)((bf16_t*)(ws + WS_WIN1) + (size_t)1952 * 1024); for (int i = gt; i < 96 * 1024 / 8; i += NGT) z[i] = (v4u){0u, 0u, 0u, 0u}; }
    { bf16_t* wk = (bf16_t*)(ws + WS_WKVB); for (int i = gt; i < 1024 * 16; i += NGT) { const int r = i >> 4, cc = i & 15; *(v4u*)(wk + (size_t)r * 256 + 128 + cc * 8) = (v4u){0u, 0u, 0u, 0u}; } }
    __syncthreads();
}

constexpr size_t CT_TB = 64 * 1024;
enum GemmId { G_IN0 = 0, G_OUT0, G_F1, G_F2, G_IN1, G_QB, G_KVB, G_OUT1, G_MOE1, G_MOE2 };
__device__ __forceinline__ void run_gemm(const Frame& F, const Params& P, int gid) {
    char* ws = F.ws; float* MOD = (float*)(ws + WS_MOD); const float* MOD1 = MOD + 9 * MODLD; LAS unsigned char* lds = F.lds + RING_OFF;
    float* X = (float*)(ws + WS_X); bf16_t* H = (bf16_t*)(ws + WS_H); LAS int* tb = (LAS int*)(F.lds + MISC_OFF);
    pg8::Gemm g; pg8::OrderAny S; pg8::EpiAny E;
    E.mode = pg8::E_BF16; E.O = nullptr; E.ldc = 0; E.npn = 1; E.ssq = nullptr; E.cbias = nullptr; E.cbld = 0; E.xin = X; E.xout = X; E.modbase = MOD; E.compact = 0; E.srcin = 0; E.fuse = 0;
    E.xsrc_lat = PIN(0); E.xsrc_ctx = PIN(2); E.gnext = PIN(7); E.nscale = MOD; E.ssqw = (float*)(ws + WS_CTL + CT_SSQA); E.slot_gate = (const float*)(ws + WS_SLOTGATE);
    S.wcnt = nullptr; S.dcnt = nullptr; S.wtarget = 0u; S.w2cnt = nullptr; S.w2kind = 0; S.rel_agent = F.even ? 0 : 1; unsigned* PCNT = (unsigned*)(ws + WS_CTL + CT_PCNT);
    S.omode = 0; S.m.tb = tb; S.m.nN = 28; S.m.G = F.G; S.m.c = F.bid; g.M = MROWS; g.N = 0;
    if (gid == G_IN0) { g.A = H; g.Bt = (const bf16_t*)(ws + WS_WIN0); g.K = 1024; S.d.init(72, 7, F.G, F.bid, 0); E.O = (bf16_t*)(ws + WS_Z); E.ldc = 1792; }
    else if (gid == G_OUT0) { g.A = (const bf16_t*)(ws + WS_Y); g.Bt = (const bf16_t*)(ws + WS_WOUT0); g.K = 1024; S.d.init(72, 4, F.G, F.bid, 0); S.omode = 4; S.ch.stage = 0; S.ch.c = F.bid; S.dcnt = PCNT;
        E.mode = pg8::E_RES; E.modbase = MOD + 2 * DM; E.srcin = 1; E.fuse = 1; E.O = H; E.gnext = PIN(7); E.nscale = MOD + 4 * DM; E.ssqw = (float*)(ws + WS_CTL + CT_SSQA); }
    else if (gid == G_F1) { g.A = H; g.Bt = (const bf16_t*)(ws + WS_WF13); g.K = 1024; S.d.init(72, 22, F.G, F.bid, 0); S.omode = 4; S.ch.stage = 1; S.ch.c = F.bid; S.wcnt = PCNT; S.wtarget = 32u; S.dcnt = PCNT + 72 * 16; S.w2cnt = PCNT; S.w2kind = 1;
        E.mode = pg8::E_SWIGLU; E.O = (bf16_t*)(ws + WS_ACT); E.ldc = DFF; E.npn = 22; E.ssq = (const float*)(ws + WS_CTL + CT_SSQA); E.cbias = (const float*)(ws + WS_CBF1); E.cbld = 5632; }
    else if (gid == G_F2) { g.A = (const bf16_t*)(ws + WS_ACT); g.Bt = (const bf16_t*)(ws + WS_WF2); g.K = 2816; S.d.init(72, 4, F.G, F.bid, 0); S.omode = 4; S.ch.stage = 2; S.ch.c = F.bid; S.wcnt = PCNT + 72 * 16; S.wtarget = 176u; S.dcnt = PCNT + 144 * 16;
        E.mode = pg8::E_RES; E.modbase = MOD + 5 * DM; E.fuse = 1; E.O = H; E.gnext = PIN(6) + DM; E.nscale = MOD1 + 1 * DM; E.ssqw = (float*)(ws + WS_CTL + CT_SSQB); }
    else if (gid == G_IN1) { g.A = H; g.Bt = (const bf16_t*)(ws + WS_WIN1); g.K = 1024; S.d.init(64, 8, F.G, F.bid, 2); S.omode = 4; S.ch.stage = 3; S.ch.c = F.bid; S.wcnt = PCNT + 144 * 16; S.wtarget = 32u; S.w2cnt = PCNT + 144 * 16; S.w2kind = 2;
        E.mode = pg8::E_BF16NORM; E.O = (bf16_t*)(ws + WS_Z); E.ldc = 2048; E.ssq = (const float*)(ws + WS_CTL + CT_SSQB); E.cbias = (const float*)(ws + WS_CBIN1); E.cbld = 2048; }
    else if (gid == G_QB) { g.A = (const bf16_t*)(ws + WS_QA); g.Bt = (const bf16_t*)(ws + WS_WQB); g.K = 256; S.d.init(64, 3, F.G, F.bid, 1); S.omode = 1; E.O = (bf16_t*)(ws + WS_QR); E.ldc = 768; }
    else if (gid == G_KVB) { g.A = (const bf16_t*)(ws + WS_KVA); g.Bt = (const bf16_t*)(ws + WS_WKVB); g.K = 256; S.d.init(72, 4, F.G, F.bid, 0); E.O = (bf16_t*)(ws + WS_KVR); E.ldc = 1024; }
    else if (gid == G_OUT1) { g.A = (const bf16_t*)(ws + WS_Y); g.Bt = (const bf16_t*)(ws + WS_WOUT1); g.K = 1024; S.d.init(64, 4, F.G, F.bid, 1); S.omode = 1;
        E.mode = pg8::E_RES; E.xout = P.out; E.modbase = MOD1 + 2 * DM; E.compact = 1; }
    else { if (F.tid < 9) tb[F.tid] = ((const int*)(ws + WS_CTL + CT_TB))[F.tid];
        __syncthreads();
        S.omode = 5; S.d.init(1, 1, F.G, F.bid, 0); S.mch.tb = tb; S.mch.c = F.bid; unsigned* MCNT = (unsigned*)(ws + WS_CTL + CT_MCNT);
        if (gid == G_MOE1) { g.A = (const bf16_t*)(ws + WS_XG); g.Bt = (const bf16_t*)(ws + WS_W13M); g.K = 1024; S.m.nN = 28; S.mch.stage = 0; S.dcnt = MCNT; E.mode = pg8::E_SWIGLU; E.O = (bf16_t*)(ws + WS_ACT2); E.ldc = DFE; E.npn = 28; }
        else { g.A = (const bf16_t*)(ws + WS_ACT2); g.Bt = (const bf16_t*)(ws + WS_W2M); g.K = 3584; S.m.nN = 4; S.mch.stage = 1; S.wcnt = MCNT; S.wtarget = 224u; E.mode = pg8::E_MOEY2; E.O = (bf16_t*)(ws + WS_Y2); } }
    if (S.wcnt != nullptr) __builtin_amdgcn_fence(__ATOMIC_ACQUIRE, "agent");
    pg8::gemm_phase<pg8::EpiAny, pg8::OrderAny, true, true>(lds, g, S, E);
    __syncthreads();
}

__device__ __forceinline__ void phase_attn0(const Frame& F) {
    char* ws = F.ws; LAS unsigned char* lds = F.lds + RING_OFF;
    for (int i = 0;; ++i) { const int L = i * F.G + F.bid; if (L >= 576) break; const int b = L & 7, idx = L >> 3;
        const int h = idx < 64 ? (idx >> 3) : idx - 64, qb = idx < 64 ? 1 + (idx & 7) : 0, NT = idx < 64 ? 36 : 4;
        att::unit<64>(b, h, h >> 2, qb, NT, (const bf16_t*)(ws + WS_QB), 512, (const bf16_t*)(ws + WS_KB), 128, (const bf16_t*)(ws + WS_VB), 128, (bf16_t*)(ws + WS_Y) + 512, DM, lds); }
}
__device__ __forceinline__ void phase_attn1(const Frame& F, const Params& P) {
    char* ws = F.ws; char* dob = (char*)P.out; LAS unsigned char* lds = F.lds + RING_OFF;
    for (int i = 0;; ++i) { const int L = i * F.G + F.bid; if (L >= 512) break; const int b = L & 7, idx = L >> 3; const int h = idx >> 3, qb = 1 + (idx & 7);
        att::unit<96>(b, h, h, qb, 36, (const bf16_t*)(ws + WS_QM), 768, (const bf16_t*)(dob + DO_KM), 768, (const bf16_t*)(dob + DO_VM), 512, (bf16_t*)(ws + WS_Y) + 512, DM, lds); }
}

__device__ __forceinline__ void phase_route(const Frame& F, const Params& P) {
    char* ws = F.ws; const float* X = P.out; const float* g = PIN(7) + DM; const float* MODL = (const float*)(ws + WS_MOD) + 9 * MODLD; const float* router = PIN(39);
    bf16_t* H2 = (bf16_t*)(ws + WS_H2); int* SEL = (int*)(ws + WS_SEL); int* HIST = (int*)(ws + WS_CTL + CT_HIST);
    LAS int* hist = (LAS int*)(F.lds + MISC_OFF);
    if (F.tid < 8) hist[F.tid] = 0;
    __syncthreads();
    const int rpb = NLAT / F.G, rpw = rpb / NWAVES;
    const int lane = F.lane;
    f32x4 rw[4][4][2], gsc[4], shv[4];
    { const float* md = MODL + (size_t)((F.bid * rpb) / SEQ) * MODLD;
#pragma unroll
      for (int j4 = 0; j4 < 4; ++j4) { const int k = 4 * lane + 256 * j4; gsc[j4] = *(const f32x4*)(g + k) * (*(const f32x4*)(md + 4 * DM + k) + 1.f); shv[j4] = *(const f32x4*)(md + 3 * DM + k);
#pragma unroll
          for (int c = 0; c < 4; ++c) { rw[j4][c][0] = *(const f32x4*)(router + (size_t)(k + c) * 8); rw[j4][c][1] = *(const f32x4*)(router + (size_t)(k + c) * 8 + 4); } } }
#pragma unroll 1
    for (int q0 = 0; q0 < rpw; q0 += 2) {
      f32x4 vv[2][4];
#pragma unroll
      for (int qq = 0; qq < 2; ++qq) { const float* xr = X + (size_t)(F.bid * rpb + F.wave * rpw + q0 + qq) * DM;
#pragma unroll
          for (int j4 = 0; j4 < 4; ++j4) vv[qq][j4] = *(const f32x4*)(xr + 4 * lane + 256 * j4); }
#pragma unroll
      for (int qq = 0; qq < 2; ++qq) {
        const int m = F.bid * rpb + F.wave * rpw + q0 + qq;
        f32x4 (&v)[4] = vv[qq]; float ss = 0.f;
#pragma unroll
        for (int j4 = 0; j4 < 4; ++j4) ss += (v[j4][0] * v[j4][0] + v[j4][1] * v[j4][1]) + (v[j4][2] * v[j4][2] + v[j4][3] * v[j4][3]);
        const float rstd = rsqrtf(wave_sum(ss) / DM + EPS);
        f32x4 a03 = {0.f, 0.f, 0.f, 0.f}, a47 = {0.f, 0.f, 0.f, 0.f};
#pragma unroll
        for (int j4 = 0; j4 < 4; ++j4) { const int k = 4 * lane + 256 * j4; const f32x4 hv = v[j4] * rstd * gsc[j4] + shv[j4];
#pragma unroll
            for (int c = 0; c < 4; ++c) { a03 += rw[j4][c][0] * hv[c]; a47 += rw[j4][c][1] * hv[c]; }
            u32x2 w; w.x = pk2(hv[0], hv[1]); w.y = pk2(hv[2], hv[3]); *(u32x2*)(H2 + (size_t)m * DM + k) = w; }
        float acc[8] = {a03[0], a03[1], a03[2], a03[3], a47[0], a47[1], a47[2], a47[3]};
#pragma unroll
        for (int e = 0; e < 8; ++e) acc[e] = wave_sum(acc[e]);
        if (lane == 0) {
            int e0 = 0; float b0 = acc[0];
#pragma unroll
            for (int e = 1; e < 8; ++e) if (acc[e] > b0) { b0 = acc[e]; e0 = e; }
            int e1 = -1; float b1 = -INFINITY;
#pragma unroll
            for (int e = 0; e < 8; ++e) if (e != e0 && acc[e] > b1) { b1 = acc[e]; e1 = e; }
            const float ex = expf(b1 - b0); const float g0 = 1.f / (1.f + ex), g1 = ex / (1.f + ex);
            SEL[4 * m + 0] = e0; SEL[4 * m + 1] = e1; SEL[4 * m + 2] = __float_as_int(g0); SEL[4 * m + 3] = __float_as_int(g1);
            atomicAdd((int*)&hist[e0], 1); atomicAdd((int*)&hist[e1], 1);
        }
      }
    }
    __syncthreads();
    if (F.tid < 8) HIST[F.bid * 8 + F.tid] = hist[F.tid];
}
__device__ __forceinline__ void phase_slot(const Frame& F, const Params& P) {
    char* ws = F.ws; const int* HIST = (const int*)(ws + WS_CTL + CT_HIST); const int* SEL = (const int*)(ws + WS_SEL); int* TB = (int*)(ws + WS_CTL + CT_TB);
    const bf16_t* H2 = (const bf16_t*)(ws + WS_H2); bf16_t* XG = (bf16_t*)(ws + WS_XG); int* slot_tok = (int*)(ws + WS_SLOTTOK); float* slot_gate = (float*)(ws + WS_SLOTGATE);
    LAS int* sm = (LAS int*)(F.lds + MISC_OFF);
    if (F.tid < 16) sm[F.tid] = 0;
    { const int rpb0 = NLAT / F.G; for (int i = F.tid; i < 4 * rpb0; i += NTHREADS) sm[512 + i] = SEL[4 * F.bid * rpb0 + i]; }
    __syncthreads();
    for (int t = F.tid; t < 2 * F.G; t += NTHREADS) {
        const int j = t % F.G, hf = t / F.G; const int4 c = *(const int4*)(HIST + j * 8 + 4 * hf); const int mk = j < F.bid ? 1 : 0;
        int v[8] = {c.x, c.y, c.z, c.w, c.x * mk, c.y * mk, c.z * mk, c.w * mk};
#pragma unroll
        for (int q = 0; q < 8; ++q) {
#pragma unroll
            for (int o = 1; o < 64; o <<= 1) v[q] += __shfl_xor(v[q], o); }
        if (F.lane == 0) {
#pragma unroll
            for (int q = 0; q < 4; ++q) { atomicAdd((int*)&sm[4 * hf + q], v[q]); atomicAdd((int*)&sm[8 + 4 * hf + q], v[4 + q]); } }
    }
    __syncthreads();
    if (F.tid == 0) { int s = 0; for (int e = 0; e < 8; ++e) { sm[16 + e] = s; s += (sm[e] + 255) & ~255; } sm[24] = s; }
    __syncthreads();
    const int rpb = NLAT / F.G, na = 2 * rpb;
    if (F.tid == 0) { int run[8];
#pragma unroll
        for (int e = 0; e < 8; ++e) run[e] = sm[16 + e] + sm[8 + e];
        for (int a = 0; a < na; ++a) { const int e = sm[512 + 4 * (a >> 1) + (a & 1)]; int sl = 0;
#pragma unroll
            for (int q = 0; q < 8; ++q) if (q == e) { sl = run[q]; run[q] = sl + 1; }
            sm[32 + a] = sl; } }
    __syncthreads();
    for (int a0 = F.wave * 4; a0 < na; a0 += NWAVES * 4) { v4u va[4][2];
#pragma unroll
        for (int q = 0; q < 4; ++q) { const int a = a0 + q; const int m = F.bid * rpb + (a >> 1); const v4u* src = (const v4u*)(H2 + (size_t)m * DM); va[q][0] = src[F.lane]; va[q][1] = src[64 + F.lane]; }
#pragma unroll
        for (int q = 0; q < 4; ++q) { const int a = a0 + q; const int m = F.bid * rpb + (a >> 1), sl = sm[32 + a]; v4u* dst = (v4u*)(XG + (size_t)sl * DM); dst[F.lane] = va[q][0]; dst[64 + F.lane] = va[q][1];
            if (F.lane == 0) { slot_tok[sl] = m; ((int*)(ws + WS_TOKSLOT))[2 * m + (a & 1)] = sl; slot_gate[sl] = __int_as_float(sm[512 + 4 * (a >> 1) + 2 + (a & 1)]); } } }
    if (F.bid < 8) { const int e = F.bid; for (int sl = sm[16 + e] + sm[e] + F.tid; sl < sm[16 + e + 1]; sl += NTHREADS) slot_tok[sl] = -1; }
    if (F.bid == 0 && F.tid < 9) TB[F.tid] = sm[16 + F.tid] >> 8;
}
__device__ __forceinline__ void phase_combine(const Frame& F, const Params& P) {
    char* ws = F.ws; float* out = P.out; const bf16_t* Y2 = (const bf16_t*)(ws + WS_Y2); const int* TS = (const int*)(ws + WS_TOKSLOT); const float* mod5 = (const float*)(ws + WS_MOD) + 9 * MODLD + 5 * DM;
    const int gw = F.bid * NWAVES + F.wave, lane = F.lane; const int mb = gw * 8;
    f32x4 mv[2][2];
    { const float* md = mod5 + (size_t)(mb >> 11) * MODLD;
#pragma unroll
      for (int jj = 0; jj < 2; ++jj)
#pragma unroll
          for (int hlf = 0; hlf < 2; ++hlf) mv[jj][hlf] = *(const f32x4*)(md + 8 * lane + 512 * jj + 4 * hlf); }
#pragma unroll 1
    for (int q0 = 0; q0 < 8; q0 += 2) {
        f32x4 xv[2][4]; v4u ya[2][2], yb[2][2];
#pragma unroll
        for (int q = 0; q < 2; ++q) { const int m = mb + q0 + q; const int sa = TS[2 * m], sb = TS[2 * m + 1];
#pragma unroll
            for (int jj = 0; jj < 4; ++jj) xv[q][jj] = *(const f32x4*)(out + (size_t)m * DM + 8 * lane + 512 * (jj >> 1) + 4 * (jj & 1));
#pragma unroll
            for (int jj = 0; jj < 2; ++jj) { ya[q][jj] = *(const v4u*)(Y2 + (size_t)sa * DM + 8 * lane + 512 * jj); yb[q][jj] = *(const v4u*)(Y2 + (size_t)sb * DM + 8 * lane + 512 * jj); } }
#pragma unroll
        for (int q = 0; q < 2; ++q) { const int m = mb + q0 + q;
#pragma unroll
            for (int jj = 0; jj < 2; ++jj) { const int k = 8 * lane + 512 * jj;
#pragma unroll
                for (int hlf = 0; hlf < 2; ++hlf) { f32x4 o = xv[q][2 * jj + hlf]; const f32x4 mm = mv[jj][hlf];
                    const unsigned a0 = ya[q][jj][2 * hlf], a1 = ya[q][jj][2 * hlf + 1], b0 = yb[q][jj][2 * hlf], b1 = yb[q][jj][2 * hlf + 1];
                    o[0] += mm[0] * (__uint_as_float(a0 << 16) + __uint_as_float(b0 << 16)); o[1] += mm[1] * (__uint_as_float(a0 & 0xffff0000u) + __uint_as_float(b0 & 0xffff0000u));
                    o[2] += mm[2] * (__uint_as_float(a1 << 16) + __uint_as_float(b1 << 16)); o[3] += mm[3] * (__uint_as_float(a1 & 0xffff0000u) + __uint_as_float(b1 & 0xffff0000u));
                    *(f32x4*)(out + (size_t)m * DM + k + 4 * hlf) = o; } } }
    }
}

#define XB_TMO      128
#define XB_XCNT(j)  (256  + 64 * (j))
#define XB_XSUB(j)  (1280 + 64 * (j))
#define XB_XGEN(j)  (2304 + 64 * (j))
#define XB_TOP      3328
#define XB_TOPGEN   3392
#define XCD_BAR_WORDS 3456
#define XB_SPIN_CAP (1u << 18)

__device__ __forceinline__ unsigned xb_ld(unsigned* p)              { return __hip_atomic_load(p, __ATOMIC_RELAXED, __HIP_MEMORY_SCOPE_AGENT); }
__device__ __forceinline__ unsigned xb_add(unsigned* p, unsigned v) { return __hip_atomic_fetch_add(p, v, __ATOMIC_RELAXED, __HIP_MEMORY_SCOPE_AGENT); }
__device__ __forceinline__ unsigned xb_xcc_id() { return (unsigned)__builtin_amdgcn_s_getreg((3 << 11) | 20) & 0xFu; }
#define XB_SPIN(cond, bar) do { unsigned _sp = 0; while (cond) { __builtin_amdgcn_s_sleep(1); \
    if ((++_sp & 255u) == 0u) { if (xb_ld(&(bar)[XB_TMO])) break; if (_sp > XB_SPIN_CAP) { atomicAdd(&(bar)[XB_TMO], 1u); break; } } } } while (0)

struct XcdBarrier {
    unsigned* bar; unsigned x;
    volatile LAS unsigned* st;
};

__device__ __forceinline__ XcdBarrier xcd_barrier_post(unsigned* bar, volatile LAS unsigned* st) {
    XcdBarrier b; b.bar = bar; b.x = xb_xcc_id(); b.st = st;
    if (threadIdx.x == 0) st[2] = xb_add(&bar[XB_XCNT(b.x)], 1u);
    return b;
}
__device__ __forceinline__ void xcd_barrier_complete(unsigned* bar, unsigned x, unsigned& nloc, unsigned& nx, unsigned& even) {
    const unsigned G = gridDim.x * gridDim.y * gridDim.z;
    unsigned sum, cnt, mine, bal, sp = 0u;
    for (;;) {
        sum = 0u; cnt = 0u; mine = 0u; bal = 1u;
#pragma unroll
        for (unsigned j = 0; j < 16; ++j) { const unsigned c = xb_ld(&bar[XB_XCNT(j)]); sum += c; cnt += (c > 0u) ? 1u : 0u; mine = (j == x) ? c : mine; bal = (j < 8u && c * 8u != G) ? 0u : bal; }
        if (sum == G) break;
        __builtin_amdgcn_s_sleep(1);
        if ((++sp & 255u) == 0u) { if (xb_ld(&bar[XB_TMO])) break; if (sp > XB_SPIN_CAP) { atomicAdd(&bar[XB_TMO], 1u); break; } }
    }
    nloc = mine > 0u ? mine : 1u; nx = cnt > 0u ? cnt : 1u; even = (sum == G) ? bal : 0u;
}

__device__ __forceinline__ void xcd_barrier(const XcdBarrier& b) {
    asm volatile("s_waitcnt vmcnt(0)" ::: "memory");
    __syncthreads();
    if (threadIdx.x == 0) {
        unsigned* bar = b.bar;
        __builtin_amdgcn_s_waitcnt(0);
        unsigned nloc = b.st[0], nx = b.st[1];
        if (nloc == 0u) { unsigned ev; xcd_barrier_complete(bar, b.x, nloc, nx, ev); b.st[0] = nloc; b.st[1] = nx; b.st[3] = ev; }
        const unsigned old = xb_add(&bar[XB_XSUB(b.x)], 1u);
        const unsigned gen = old / nloc;
        if (old + 1u == (gen + 1u) * nloc) {
            __builtin_amdgcn_fence(__ATOMIC_RELEASE, "agent");
            asm volatile("s_waitcnt vmcnt(0)" ::: "memory");
            const unsigned og = xb_add(&bar[XB_TOP], 1u);
            const unsigned tg = og / nx;
            if (og + 1u == (tg + 1u) * nx) xb_add(&bar[XB_TOPGEN], 1u);
            else XB_SPIN(xb_ld(&bar[XB_TOPGEN]) == tg, bar);
            __builtin_amdgcn_fence(__ATOMIC_ACQUIRE, "agent");
            xb_add(&bar[XB_XGEN(b.x)], 1u);
            asm volatile("s_waitcnt vmcnt(0)" ::: "memory");
        } else {
            XB_SPIN(xb_ld(&bar[XB_XGEN(b.x)]) == gen, bar);
            __builtin_amdgcn_fence(__ATOMIC_ACQUIRE, "agent");
            asm volatile("s_waitcnt vmcnt(0)" ::: "memory");
        }
    }
    __syncthreads();
}
namespace hy {
using f32x16 = __attribute__((ext_vector_type(16))) float;
constexpr int UL = 2088, ULB = UL * 2;
constexpr int GOFF = 2064;
constexpr int L_U = 0, L_U2 = 8 * ULB, L_X = 2 * 8 * ULB, L_G0 = L_X + 8 * 2048 * 2, L_G1 = L_G0 + GT_LD * 2, L_END = L_G1 + GT_LD * 2;
static_assert(L_END <= RING_BYTES, "hyena LDS");
__device__ __forceinline__ void prep(const Frame& F, const Params& P) {
    char* ws = F.ws; const bf16_t* Z = (const bf16_t*)(ws + WS_Z); bf16_t* ZT = (bf16_t*)(ws + WS_ZT); const float* cw = PIN(24); const float* cb = PIN(25);
    const int gw = F.bid * NWAVES + F.wave, NGW = F.G * NWAVES, lane = F.lane; LAS unsigned char* tl = F.lds + RING_OFF + F.wave * 8192;
    for (int it = gw; it < 24 * 8 * 64; it += NGW) { const int cg = it % 24, b = (it / 24) & 7, tt = it / 192; const int c = cg * 64 + lane, t0 = tt * 32;
        const float w0 = cw[c], w1 = cw[1536 + c], w2 = cw[3072 + c], bias = cb[c];
        const bf16_t* zp = Z + ((size_t)b * RPB + CTX) * CD_LD + cg * 64;
        v4u pc[5];
#pragma unroll
        for (int k = 0; k < 5; ++k) { const int p = lane + 64 * k, row = p >> 3, c8 = p & 7, t = t0 - 1 + row; pc[k] = (p < 272 && t >= 0 && t < SEQ) ? *(const v4u*)(zp + (size_t)t * CD_LD + c8 * 8) : (v4u){0u, 0u, 0u, 0u}; }
#pragma unroll
        for (int k = 0; k < 5; ++k) { const int p = lane + 64 * k, row = p >> 3, c8 = p & 7; if (p < 272) *(LAS v4u*)(tl + row * 144 + c8 * 16) = pc[k]; }
        LDS_WAIT(); asm volatile("" ::: "memory");
        float xr[34];
#pragma unroll
        for (int i = 0; i < 34; ++i) xr[i] = bf2f(*(const LAS bf16_t*)(tl + i * 144 + lane * 2));
        LDS_WAIT(); asm volatile("" ::: "memory");
        bf16_t* op = ZT + ((size_t)c * NB + b) * SEQ + t0;
#pragma unroll
        for (int j8 = 0; j8 < 4; ++j8) { float y[8];
#pragma unroll
            for (int jj = 0; jj < 8; ++jj) { const int i = j8 * 8 + jj; y[jj] = bias + w0 * xr[i] + w1 * xr[i + 1] + w2 * xr[i + 2]; }
            v4u o; o.x = pk2(y[0], y[1]); o.y = pk2(y[2], y[3]); o.z = pk2(y[4], y[5]); o.w = pk2(y[6], y[7]); *(v4u*)(op + j8 * 8) = o; } }
}
__device__ __forceinline__ void filt(const Frame& F, const Params& P) {
    char* ws = F.ws; bf16_t* GT = (bf16_t*)(ws + WS_GT);
    const float *w1 = PIN(26), *b1 = PIN(27), *w2 = PIN(28), *b2 = PIN(29), *w3 = PIN(30), *freq = PIN(31);
    LAS float* z = (LAS float*)(F.lds + RING_OFF); LAS float* h1 = z + 9 * 64; LAS float* h2 = h1 + 9 * 64;
    const int tid = F.tid;
    for (int tb = F.bid; tb < SEQ / 8; tb += F.G) {
        const int t0 = tb * 8;
        __syncthreads();
        if (tid < 9 * 33) { const int tt = tid / 33, k = tid % 33, t = t0 + tt; float zv = (float)t / (float)(SEQ - 1);
            if (k > 0) { const int bi = (k - 1) & 15; const double band = 1e-4 + (15.0 - 1e-4) * (double)bi / 15.0; const double rev = (double)t * band * (1.0 / (double)SEQ);
                const float fr = (float)(rev - floor(rev)); zv = k <= 16 ? __builtin_amdgcn_cosf(fr) : -__builtin_amdgcn_sinf(fr); }
            z[tt * 64 + k] = zv; }
        __syncthreads();
        for (int idx = tid; idx < 9 * 64; idx += NTHREADS) { const int tt = idx >> 6, j = idx & 63; float a = b1[j];
#pragma unroll
            for (int i = 0; i < 33; ++i) a += z[tt * 64 + i] * w1[i * 64 + j];
            h1[idx] = __sinf(freq[j] * a); }
        __syncthreads();
        for (int idx = tid; idx < 9 * 64; idx += NTHREADS) { const int tt = idx >> 6, j = idx & 63; float a = b2[j];
#pragma unroll 16
            for (int i = 0; i < 64; ++i) a += h1[tt * 64 + i] * w2[i * 64 + j];
            h2[idx] = __sinf(freq[j] * a); }
        __syncthreads();
        float acc[4][9];
#pragma unroll
        for (int q = 0; q < 4; ++q)
#pragma unroll
            for (int tt = 0; tt < 9; ++tt) acc[q][tt] = 0.f;
#pragma unroll 16
        for (int i = 0; i < 64; ++i) { float wv[4];
#pragma unroll
            for (int q = 0; q < 4; ++q) wv[q] = w3[(size_t)i * 2048 + tid + 512 * q];
#pragma unroll
            for (int tt = 0; tt < 9; ++tt) { const float hv = h2[tt * 64 + i];
#pragma unroll
                for (int q = 0; q < 4; ++q) acc[q][tt] += hv * wv[q]; } }
        const double mind = log(1e-2) / 1.5, maxd = log(1e-2) / 0.3; const int ch = tid; const float delta = fabsf((float)(mind + (maxd - mind) * (double)ch / 511.0));
        float win[9];
#pragma unroll
        for (int tt = 0; tt < 9; ++tt) { const int t = t0 + tt; win[tt] = t < SEQ ? __expf(-((float)t / (float)(SEQ - 1)) * delta) + 0.05f : 0.f; }
#pragma unroll
        for (int ord = 0; ord < 2; ++ord) { bf16_t* gp = GT + ((size_t)ord * 512 + ch) * GT_LD + GOFF; float fw[9], bw[9];
#pragma unroll
            for (int tt = 0; tt < 9; ++tt) { fw[tt] = acc[2 * ord][tt] * win[tt]; bw[tt] = acc[2 * ord + 1][tt] * win[tt]; }
            if (t0 == 0) bw[0] = fw[0];
            v4u ob; ob.x = pk2(bw[0], bw[1]); ob.y = pk2(bw[2], bw[3]); ob.z = pk2(bw[4], bw[5]); ob.w = pk2(bw[6], bw[7]); *(v4u*)(gp + t0) = ob;
            v4u of; of.x = pk2(fw[8], fw[7]); of.y = pk2(fw[6], fw[5]); of.z = pk2(fw[4], fw[3]); of.w = pk2(fw[2], fw[1]); *(v4u*)(gp - t0 - 8) = of; }
    }
    const int gt = F.bid * NTHREADS + F.tid, NGT = F.G * NTHREADS; constexpr int NZ = 16 + (GT_LD - GOFF - 2048);
    for (int i = gt; i < 1024 * NZ; i += NGT) { const int oc = i / NZ, k = i % NZ; GT[(size_t)oc * GT_LD + (k < 16 ? k : GOFF + 2048 + (k - 16))] = 0; }
}
__device__ __forceinline__ void conv_mfma(f32x16 (&acc)[2], LAS unsigned char* Ub, LAS unsigned char* Gb, int wave, int lane) {
    const int n = lane & 31, h = lane >> 5, b = n >> 2, dl = n & 3;
    const LAS unsigned char* up = Ub + b * ULB + 16 * h;
    const int i = lane & 31;
    const LAS unsigned char* gp0 = Gb + 2 * (GOFF + 8 * h - 4 * i - 16 * (8 * (2 * wave) + 1));
    const LAS unsigned char* gp1 = gp0 - 2 * 16 * 8;
    acc[0] = f32x16{}; acc[1] = f32x16{};
    const bool sh2 = dl >= 2; const unsigned sb = (dl & 1) * 2;
    const LAS unsigned char* upq = up + 8 * (dl < 3 ? dl : 2);
    u32x4 ring[8];
#pragma unroll
    for (int b8 = 0; b8 < 8; ++b8) { const u32x2 a0 = *(const LAS u32x2*)(gp1 + 32 * b8), a1 = *(const LAS u32x2*)(gp1 + 32 * b8 + 8); ring[b8] = (u32x4){a0[0], a0[1], a1[0], a1[1]}; }
#define HY_STEP(J, b8) do { \
          \
        const u32x2 qx = *(const LAS u32x2*)(upq + 32 * (J)); \
        unsigned q[6]; \
        q[0] = __builtin_amdgcn_mov_dpp((int)qx[0], 0x00, 0xF, 0xF, false); q[1] = __builtin_amdgcn_mov_dpp((int)qx[1], 0x00, 0xF, 0xF, false); \
        q[2] = __builtin_amdgcn_mov_dpp((int)qx[0], 0x55, 0xF, 0xF, false); q[3] = __builtin_amdgcn_mov_dpp((int)qx[1], 0x55, 0xF, 0xF, false); \
        q[4] = __builtin_amdgcn_mov_dpp((int)qx[0], 0xAA, 0xF, 0xF, false); q[5] = __builtin_amdgcn_mov_dpp((int)qx[1], 0xAA, 0xF, 0xF, false); \
        u32x4 bw; \
        _Pragma("unroll") for (int w = 0; w < 4; ++w) { const unsigned lo = sh2 ? q[w + 1] : q[w], hi_ = sh2 ? q[w + 2] : q[w + 1]; bw[w] = __builtin_amdgcn_alignbyte(hi_, lo, sb); } \
        const u32x2 a00 = *(const LAS u32x2*)(gp0 + 32 * (J)), a01 = *(const LAS u32x2*)(gp0 + 32 * (J) + 8); \
        const u32x4 A1 = ring[b8]; const u32x4 A0 = {a00[0], a00[1], a01[0], a01[1]}; ring[b8] = A0; \
        acc[0] = __builtin_amdgcn_mfma_f32_32x32x16_bf16(__builtin_bit_cast(bf16x8, A0), __builtin_bit_cast(bf16x8, bw), acc[0], 0, 0, 0); \
        acc[1] = __builtin_amdgcn_mfma_f32_32x32x16_bf16(__builtin_bit_cast(bf16x8, A1), __builtin_bit_cast(bf16x8, bw), acc[1], 0, 0, 0); } while (0)
#pragma unroll 1
    for (int J8 = 0; J8 < 128; J8 += 8) {
#pragma unroll
        for (int b8 = 0; b8 < 8; ++b8) HY_STEP(J8 + b8, b8); }
    HY_STEP(128, 0);
#undef HY_STEP
}
__device__ __forceinline__ void main_phase(const Frame& F, const Params& P) {
    char* ws = F.ws; const bf16_t* ZT = (const bf16_t*)(ws + WS_ZT); const bf16_t* GT = (const bf16_t*)(ws + WS_GT); bf16_t* HT = (bf16_t*)(ws + WS_HT); const float* skip = PIN(32);
    LAS unsigned char* lds = F.lds + RING_OFF; const int tid = F.tid, lane = F.lane, wave = F.wave;
    const int n = lane & 31, h = lane >> 5, b = n >> 2, dl = n & 3;
    for (int c = F.bid; c < 512; c += F.G) {
        __syncthreads();
        for (int i = tid; i < 8 * 256; i += NTHREADS) { const int bb = i >> 8, k = i & 255; *(LAS v4u*)(lds + L_U + bb * ULB + 32 + k * 16) = *(const v4u*)(ZT + ((size_t)c * NB + bb) * SEQ + k * 8);
            *(LAS v4u*)(lds + L_X + (bb * 2048 + k * 8) * 2) = *(const v4u*)(ZT + ((size_t)(512 + c) * NB + bb) * SEQ + k * 8); }
        for (int i = tid; i < GT_LD / 8; i += NTHREADS) { *(LAS v4u*)(lds + L_G0 + i * 16) = *(const v4u*)(GT + (size_t)c * GT_LD + i * 8); *(LAS v4u*)(lds + L_G1 + i * 16) = *(const v4u*)(GT + (size_t)(512 + c) * GT_LD + i * 8); }
        if (tid < 80) { const int bb = tid / 10, k = tid % 10, which = k / 5, part = k % 5; const int off = bb * ULB + (part < 2 ? part * 16 : (16 + 2048) * 2 + (part - 2) * 16);
            *(LAS v4u*)(lds + (which ? L_U2 : L_U) + off) = (v4u){0u, 0u, 0u, 0u}; }
        __syncthreads();
        const float sk0 = skip[c], sk1 = skip[512 + c];
        f32x16 acc[2];
        conv_mfma(acc, lds + L_U, lds + L_G0, wave, lane);
#pragma unroll
        for (int ip = 0; ip < 2; ++ip)
#pragma unroll
            for (int r = 0; r < 16; ++r) { const int t = 128 * (2 * wave + ip) + 4 * att::crow(r, h) + dl;
                const float v = bf2f(*(const LAS bf16_t*)(lds + L_U + b * ULB + (16 + t) * 2)), x1 = bf2f(*(const LAS bf16_t*)(lds + L_X + (b * 2048 + t) * 2));
                *(LAS bf16_t*)(lds + L_U2 + b * ULB + (16 + t) * 2) = f2bf(x1 * (acc[ip][r] + sk0 * v)); }
        __syncthreads();
        for (int i = tid; i < 8 * 256; i += NTHREADS) { const int bb = i >> 8, k = i & 255; *(LAS v4u*)(lds + L_X + (bb * 2048 + k * 8) * 2) = *(const v4u*)(ZT + ((size_t)(1024 + c) * NB + bb) * SEQ + k * 8); }
        conv_mfma(acc, lds + L_U2, lds + L_G1, wave, lane);
        __syncthreads();
#pragma unroll
        for (int ip = 0; ip < 2; ++ip)
#pragma unroll
            for (int r = 0; r < 16; ++r) { const int t = 128 * (2 * wave + ip) + 4 * att::crow(r, h) + dl;
                const float y1 = bf2f(*(const LAS bf16_t*)(lds + L_U2 + b * ULB + (16 + t) * 2)), x2 = bf2f(*(const LAS bf16_t*)(lds + L_X + (b * 2048 + t) * 2));
                *(LAS bf16_t*)(lds + L_U + (b * 2048 + t) * 2) = f2bf(x2 * (acc[ip][r] + sk1 * y1)); }
        __syncthreads();
        for (int i = tid; i < 8 * 256; i += NTHREADS) *(v4u*)(HT + (size_t)c * NLAT + i * 8) = *(const LAS v4u*)(lds + L_U + i * 16);
    }
}
__device__ __forceinline__ void untranspose(const Frame& F) {
    char* ws = F.ws; const bf16_t* HT = (const bf16_t*)(ws + WS_HT); bf16_t* Y = (bf16_t*)(ws + WS_Y);
    const int gw = F.bid * NWAVES + F.wave, NGW = F.G * NWAVES, lane = F.lane; LAS unsigned char* tl = F.lds + RING_OFF + F.wave * 16384;
    __syncthreads();
    for (int it = gw; it < 8 * 8 * 32; it += NGW) { const int cg = it & 7, b = (it >> 3) & 7, tt = it >> 6; const int c = cg * 64 + lane, t0 = tt * 64;
        const bf16_t* hp = HT + ((size_t)c * NB + b) * SEQ + t0; bf16_t* yp = Y + ((size_t)b * RPB + CTX + t0) * DM + cg * 64;
        v4u q[8];
#pragma unroll
        for (int j8 = 0; j8 < 8; ++j8) q[j8] = *(const v4u*)(hp + j8 * 8);
#pragma unroll
        for (int j8 = 0; j8 < 8; ++j8)
#pragma unroll
            for (int jj = 0; jj < 4; ++jj) { *(LAS bf16_t*)(tl + (j8 * 8 + 2 * jj) * 144 + lane * 2) = (bf16_t)(q[j8][jj] & 0xffffu); *(LAS bf16_t*)(tl + (j8 * 8 + 2 * jj + 1) * 144 + lane * 2) = (bf16_t)(q[j8][jj] >> 16); }
        LDS_WAIT(); asm volatile("" ::: "memory");
#pragma unroll
        for (int k = 0; k < 8; ++k) { const int p = lane + 64 * k, row = p >> 3, c8 = p & 7; *(v4u*)(yp + (size_t)row * DM + c8 * 8) = *(const LAS v4u*)(tl + row * 144 + c8 * 16); }
        LDS_WAIT(); asm volatile("" ::: "memory"); }
}
}
namespace lru {
using f32x16 = __attribute__((ext_vector_type(16))) float;
typedef float f32x2 __attribute__((ext_vector_type(2)));
constexpr int T = 32, NCH = RPB / T;
constexpr int UPITCH = 1040;
constexpr int L_UT = 0, L_GL = 34816, L_END = L_GL + 2 * T * 512 * 2;
static_assert(L_END <= RING_BYTES, "lru LDS");
__device__ __forceinline__ float fsigmoid(float x) { return __builtin_amdgcn_rcpf(1.f + __builtin_amdgcn_exp2f(-LOG2E * x)); }
__device__ __forceinline__ float gelu_fast(float x) { const float y = 0.7978845608028654f * (x + 0.044715f * x * x * x); const float e = __builtin_amdgcn_exp2f(2.f * LOG2E * y); const float th = 1.f - 2.f * __builtin_amdgcn_rcpf(1.f + e); return 0.5f * x * (1.f + th); }
__device__ __forceinline__ int chunk_of_order(int d, int q) { return d == 0 ? q : (q < 8 ? 7 - q : 79 - q); }
__device__ __forceinline__ int order_of_chunk(int d, int j) { return d == 0 ? j : (j < 8 ? 7 - j : 79 - j); }

__device__ __forceinline__ void unit0(const Frame& F, const Params& P, int b, int j) {
    char* ws = F.ws; const bf16_t* Z = (const bf16_t*)(ws + WS_Z); float* AGG = (float*)(ws + WS_AGG); const bf16_t* WL = (const bf16_t*)(ws + WS_WLRU);
    bf16_t* LAB = (bf16_t*)P.out; bf16_t* BTB = (bf16_t*)(ws + WS_H);
    LAS unsigned char* lds = F.lds + RING_OFF; const int ch = F.tid, lane = F.lane, wave = F.wave;
    const int s0 = j * T, seg_lo = s0 < CTX ? 0 : CTX, seg_hi = s0 < CTX ? CTX : RPB; const size_t row0 = (size_t)b * RPB + s0;
    LDS_WAIT(); asm volatile("" ::: "memory");
    float u[T];
    { const float w0 = PIN(10)[ch], w1 = PIN(10)[512 + ch], w2 = PIN(10)[1024 + ch], w3 = PIN(10)[1536 + ch], cb = PIN(11)[ch];
      float xw[T + 3];
#pragma unroll
      for (int i = 0; i < T + 3; ++i) { const int s = s0 + i - 2; xw[i] = (s >= seg_lo && s < seg_hi) ? bf2f(Z[((size_t)b * RPB + s) * AB_IN + ch]) : 0.f; }
#pragma unroll
      for (int t = 0; t < T; ++t) { u[t] = cb + w0 * xw[t] + w1 * xw[t + 1] + w2 * xw[t + 2] + w3 * xw[t + 3]; *(LAS bf16_t*)(lds + L_UT + t * UPITCH + ch * 2) = f2bf(u[t]); } }
#pragma unroll
    for (int d = 0; d < 2; ++d) {
        LDS_WAIT(); asm volatile("" ::: "memory");
        { const int n = wave, r32 = lane & 31, h = lane >> 5; bf16x8 af[4];
#pragma unroll
          for (int ks = 0; ks < 4; ++ks) af[ks] = *(const LAS bf16x8*)(lds + L_UT + r32 * UPITCH + (64 * n + 16 * ks + 8 * h) * 2);
#pragma unroll
          for (int g = 0; g < 2; ++g)
#pragma unroll
              for (int cb = 0; cb < 2; ++cb) { f32x16 acc = f32x16{}; const bf16_t* wp = WL + ((size_t)((d * 8 + n) * 2 + g) * 64 + 32 * cb + r32) * 64 + 8 * h;
#pragma unroll
                  for (int ks = 0; ks < 4; ++ks) { const bf16x8 bfr = *(const bf16x8*)(wp + 16 * ks); acc = __builtin_amdgcn_mfma_f32_32x32x16_bf16(af[ks], bfr, acc, 0, 0, 0); }
                  const float bias = (g == 0 ? PIN(13) : PIN(15))[(d * 8 + n) * 64 + 32 * cb + r32];
#pragma unroll
                  for (int r = 0; r < 16; ++r) *(LAS bf16_t*)(lds + L_GL + ((g * T + att::crow(r, h)) * 512 + 64 * n + 32 * cb + r32) * 2) = f2bf(fsigmoid(acc[r] + bias)); } }
        LDS_WAIT(); asm volatile("" ::: "memory");
        const float cl = -8.f * softplus_f(-PIN(16)[d * 512 + ch]);
        float h = 0.f, sumlog = 0.f; bf16_t* lap = LAB + ((size_t)d * MROWS + row0) * 512 + ch; bf16_t* btp = BTB + ((size_t)d * MROWS + row0) * 512 + ch;
#pragma unroll
        for (int st = 0; st < T; ++st) { const int t = d == 0 ? st : T - 1 - st;
            const float rg = bf2f(*(const LAS bf16_t*)(lds + L_GL + (t * 512 + ch) * 2)), ig = bf2f(*(const LAS bf16_t*)(lds + L_GL + ((T + t) * 512 + ch) * 2));
            const bf16_t lab = f2bf(cl * rg); const float la = bf2f(lab); const float a = __builtin_amdgcn_exp2f(LOG2E * la);
            const bf16_t btb = f2bf(__builtin_amdgcn_sqrtf(fmaf(-a, a, 1.f)) * (ig * u[t])); const float bt = bf2f(btb);
            lap[(size_t)t * 512] = lab; btp[(size_t)t * 512] = btb;
            h = a * h + bt; sumlog += la; }
        { f32x2* ag = (f32x2*)AGG + ((size_t)(d * 8 + b) * NCH + j) * 512 + ch; *ag = (f32x2){sumlog, h}; }
    }
}
__device__ __forceinline__ void unit1(const Frame& F, const Params& P, int b, int j) {
    char* ws = F.ws; const bf16_t* Z = (const bf16_t*)(ws + WS_Z); bf16_t* Y = (bf16_t*)(ws + WS_Y); const float* AGG = (const float*)(ws + WS_AGG);
    const bf16_t* LAB = (const bf16_t*)P.out; const bf16_t* BTB = (const bf16_t*)(ws + WS_H);
    const int ch = F.tid; const size_t row0 = (size_t)b * RPB + j * T;
    float hf[T];
#pragma unroll
    for (int d = 0; d < 2; ++d) {
        const bf16_t* lap = LAB + ((size_t)d * MROWS + row0) * 512 + ch; const bf16_t* btp = BTB + ((size_t)d * MROWS + row0) * 512 + ch;
        bf16_t lav[T], btv[T]; bf16_t gv[T];
#pragma unroll
        for (int t = 0; t < T; ++t) { lav[t] = lap[(size_t)t * 512]; btv[t] = btp[(size_t)t * 512]; if (d == 1) gv[t] = Z[(row0 + t) * AB_IN + 512 + ch]; }
        float h = 0.f;
        { const int q = order_of_chunk(d, j); const f32x2* ag = (const f32x2*)AGG + (size_t)(d * 8 + b) * NCH * 512 + ch;
#pragma unroll 24
          for (int qq = 0; qq < q; ++qq) { const int jj = chunk_of_order(d, qq); const f32x2 av = ag[(size_t)jj * 512]; h = __builtin_amdgcn_exp2f(LOG2E * av[0]) * h + av[1]; } }
#pragma unroll
        for (int st = 0; st < T; ++st) { const int t = d == 0 ? st : T - 1 - st;
            h = __builtin_amdgcn_exp2f(LOG2E * bf2f(lav[t])) * h + bf2f(btv[t]);
            if (d == 0) hf[t] = h; else Y[(row0 + t) * DM + ch] = f2bf((hf[t] + h) * gelu_fast(bf2f(gv[t]))); }
    }
}
template <int MODE>
__device__ __forceinline__ void phase(const Frame& F, const Params& P) {
    const int first = MODE == 0 ? F.bid : (F.bid + 192) % F.G;
    for (int L = first; L < NB * NCH; L += F.G) { if (MODE == 0) unit0(F, P, L & 7, L >> 3); else unit1(F, P, L & 7, L >> 3); }
}
}
namespace el {
__device__ __forceinline__ void mod_phase(const Frame& F, const Params& P) {
    char* ws = F.ws; float* MOD = (float*)(ws + WS_MOD); const float* c = PIN(1); const float* cctx = PIN(3); const float* mw = PIN(4); const float* mb = PIN(5);
    LAS float* sc = (LAS float*)(F.lds + RING_OFF); LAS float* part = sc + 9 * DM;
    if (F.bid >= 192) return;
    for (int i = F.tid; i < 9 * DM; i += NTHREADS) { const int j = i >> 10, k = i & 1023; const float v = j < 8 ? c[j * DM + k] : cctx[k]; sc[i] = v / (1.f + expf(-v)); }
    __syncthreads();
    const int cg = F.lane & 15, kr = F.lane >> 4; const int col = F.bid * 64 + 4 * cg, l = col / MODLD, n = col % MODLD; const float* w = mw + (size_t)l * DM * MODLD + n; const int k0 = F.wave * 128 + kr;
    f32x4 acc[9];
#pragma unroll
    for (int j = 0; j < 9; ++j) acc[j] = (f32x4){0.f, 0.f, 0.f, 0.f};
#pragma unroll 8
    for (int i = 0; i < 32; ++i) { const int k = k0 + 4 * i; const f32x4 wv = __builtin_nontemporal_load((const f32x4*)(w + (size_t)k * MODLD));
#pragma unroll
        for (int j = 0; j < 9; ++j) acc[j] += wv * sc[j * DM + k]; }
#pragma unroll
    for (int j = 0; j < 9; ++j) {
#pragma unroll
        for (int c = 0; c < 4; ++c) { float v = acc[j][c]; v += __shfl_xor(v, 16); v += __shfl_xor(v, 32); acc[j][c] = v; }
        if (kr == 0) *(LAS f32x4*)(part + (F.wave * 9 + j) * 64 + 4 * cg) = acc[j]; }
    __syncthreads();
    for (int i = F.tid; i < 9 * 64; i += NTHREADS) { const int j = i >> 6, ln = i & 63; float s = 0.f;
#pragma unroll
        for (int wv = 0; wv < 8; ++wv) s += part[(wv * 9 + j) * 64 + ln];
        const int cc = F.bid * 64 + ln; MOD[((size_t)(cc / MODLD) * 9 + j) * MODLD + cc % MODLD] = s + mb[cc]; }
    __syncthreads();
}
__device__ __forceinline__ void bias_phase(const Frame& F, const Params& P) {
    char* ws = F.ws; const float* MOD = (const float*)(ws + WS_MOD);
    LAS float* sc = (LAS float*)(F.lds + RING_OFF); LAS float* part = sc + 9 * DM;
    if (F.bid >= 120) return;
    const bool f1 = F.bid < 88; const float* shb = f1 ? MOD + 3 * DM : MOD + 9 * MODLD;
    __syncthreads();
    for (int i = F.tid; i < 9 * DM; i += NTHREADS) sc[i] = shb[(size_t)(i >> 10) * MODLD + (i & 1023)];
    __syncthreads();
    const int cg = F.lane & 15, kr = F.lane >> 4; const int cc = (f1 ? F.bid : F.bid - 88) * 64 + 4 * cg; const float* w; int ldw; bool valid = true;
    if (f1) { const int pn = cc >> 8, c = cc & 255; w = (c < 128 ? PIN(19) : PIN(20)) + pn * 128 + (c & 127); ldw = DFF; } else { valid = cc < CD_IN; w = PIN(22) + (valid ? cc : 0); ldw = CD_IN; }
    const int k0 = F.wave * 128 + kr; f32x4 acc[9];
#pragma unroll
    for (int j = 0; j < 9; ++j) acc[j] = (f32x4){0.f, 0.f, 0.f, 0.f};
#pragma unroll 8
    for (int i = 0; i < 32; ++i) { const int k = k0 + 4 * i; const f32x4 wv = *(const f32x4*)(w + (size_t)k * ldw);
#pragma unroll
        for (int j = 0; j < 9; ++j) acc[j] += wv * sc[j * DM + k]; }
#pragma unroll
    for (int j = 0; j < 9; ++j) {
#pragma unroll
        for (int c = 0; c < 4; ++c) { float v = acc[j][c]; v += __shfl_xor(v, 16); v += __shfl_xor(v, 32); acc[j][c] = valid ? v : 0.f; }
        if (kr == 0) *(LAS f32x4*)(part + (F.wave * 9 + j) * 64 + 4 * cg) = acc[j]; }
    __syncthreads();
    for (int i = F.tid; i < 9 * 64; i += NTHREADS) { const int j = i >> 6, ln = i & 63; float s = 0.f;
#pragma unroll
        for (int wv = 0; wv < 8; ++wv) s += part[(wv * 9 + j) * 64 + ln];
        if (f1) ((float*)(ws + WS_CBF1))[(size_t)j * 5632 + F.bid * 64 + ln] = s; else ((float*)(ws + WS_CBIN1))[(size_t)j * 2048 + (F.bid - 88) * 64 + ln] = s; }
    __syncthreads();
}
template <int SRC>
__device__ __forceinline__ void norm_phase(const Frame& F, const Params& P, const float* g, const float* MODL, int ish, int isc) {
    char* ws = F.ws; bf16_t* H = (bf16_t*)(ws + WS_H); const int gw = F.bid * NWAVES + F.wave, lane = F.lane; const int rb = gw * 9;
    f32x4 gg[4], gs[4], sh[4]; int cur = -1;
#pragma unroll
    for (int j = 0; j < 4; ++j) gg[j] = *(const f32x4*)(g + 4 * lane + 256 * j);
#pragma unroll 1
    for (int r0 = rb; r0 < rb + 9; r0 += 3) {
        f32x4 v[3][4];
#pragma unroll
        for (int q = 0; q < 3; ++q) { const int r = r0 + q, b = r / RPB, s = r - b * RPB;
            const float* xr = s < CTX ? PIN(2) + ((size_t)b * CTX + s) * DM : PIN(0) + ((size_t)b * SEQ + (s - CTX)) * DM;
#pragma unroll
            for (int j = 0; j < 4; ++j) v[q][j] = *(const f32x4*)(xr + 4 * lane + 256 * j); }
#pragma unroll
        for (int q = 0; q < 3; ++q) { const int r = r0 + q, b = r / RPB, s = r - b * RPB; const int mrow = s < CTX ? 8 : b;
            if (mrow != cur) { cur = mrow; const float* md = MODL + (size_t)mrow * MODLD;
#pragma unroll
                for (int j = 0; j < 4; ++j) { const int k = 4 * lane + 256 * j; gs[j] = gg[j] * (*(const f32x4*)(md + isc * DM + k) + 1.f); sh[j] = *(const f32x4*)(md + ish * DM + k); } }
            float ss = 0.f;
#pragma unroll
            for (int j = 0; j < 4; ++j) ss += (v[q][j][0] * v[q][j][0] + v[q][j][1] * v[q][j][1]) + (v[q][j][2] * v[q][j][2] + v[q][j][3] * v[q][j][3]);
            const float rstd = rsqrtf(wave_sum(ss) / DM + EPS);
#pragma unroll
            for (int j = 0; j < 4; ++j) { const int k = 4 * lane + 256 * j; const f32x4 hv = v[q][j] * rstd * gs[j] + sh[j];
                u32x2 w; w.x = pk2(hv[0], hv[1]); w.y = pk2(hv[2], hv[3]); *(u32x2*)(H + (size_t)r * DM + k) = w; } }
    }
}
__device__ __forceinline__ void rope_tables(const Frame& F) {
    float* R0 = (float*)(F.ws + WS_ROPE0); float* R1 = (float*)(F.ws + WS_ROPE1); const int gt = F.bid * NTHREADS + F.tid, NGT = F.G * NTHREADS;
    for (int i = gt; i < SEQ * 48; i += NGT) { const int t = i / 48, k = i % 48; const float row = (float)(t >> 6), col = (float)(t & 63);
        const bool l0 = k < 32; const int kk = l0 ? k : k - 32; const int half = l0 ? 16 : 8;
        const float invf = exp2f(-(float)(kk & (half - 1)) * (13.287712379549449f / (float)half)); const float ang = (kk < half ? row : col) * invf; const float cv = cosf(ang), sv = sinf(ang);
        if (l0) { R0[t * 64 + kk] = cv; R0[t * 64 + 32 + kk] = sv; } else { R1[t * 32 + kk] = cv; R1[t * 32 + 16 + kk] = sv; } }
}
__device__ __forceinline__ void gqa_prep(const Frame& F, const Params& P) {
    char* ws = F.ws; const bf16_t* Z = (const bf16_t*)(ws + WS_Z); bf16_t* Q = (bf16_t*)(ws + WS_QB); bf16_t* K = (bf16_t*)(ws + WS_KB); bf16_t* V = (bf16_t*)(ws + WS_VB); const float* R0 = (const float*)(ws + WS_ROPE0);
    const int gw = F.bid * NWAVES + F.wave, NGW = F.G * NWAVES, lane = F.lane; const int d0 = 8 * (lane & 7), i0 = d0 & 31;
    float qn[8], kn[8];
#pragma unroll
    for (int e = 0; e < 8; ++e) { qn[e] = PIN(17)[d0 + e] * QSCALE0; kn[e] = PIN(18)[d0 + e]; }
    constexpr int R1 = 6912; const int nb2 = F.G - 64; const int gw2 = (F.bid - 64) * NWAVES + F.wave, NGW2 = nb2 * NWAVES;
    for (int pass = 0; pass < 2; ++pass) { const int base = pass == 0 ? 0 : R1, lim = pass == 0 ? R1 : MROWS, g0 = pass == 0 ? gw : gw2, ng = pass == 0 ? NGW : NGW2; if (pass == 1 && F.bid < 64) break;
    for (int r0 = base + g0; r0 < lim; r0 += 2 * ng) {
        v4u qv[2], kv[2]; f32x4 cs[2][2], sn[2][2];
#pragma unroll
        for (int q = 0; q < 2; ++q) { const int r = r0 + q * ng; if (r < lim) { const bf16_t* z = Z + (size_t)r * AB_IN + 1024; const int s = r % RPB;
            qv[q] = *(const v4u*)(z + 8 * lane); kv[q] = lane < 32 ? *(const v4u*)(z + 512 + 8 * lane) : (v4u){0u, 0u, 0u, 0u};
            if (s >= CTX) { const float* rp = R0 + (size_t)(s - CTX) * 64 + i0; cs[q][0] = *(const f32x4*)rp; cs[q][1] = *(const f32x4*)(rp + 4); sn[q][0] = *(const f32x4*)(rp + 32); sn[q][1] = *(const f32x4*)(rp + 36); } } }
#pragma unroll
        for (int q = 0; q < 2; ++q) { const int r = r0 + q * ng; if (r < lim) { const bool lat = (r % RPB) >= CTX;
#pragma unroll
            for (int ps = 0; ps < 2; ++ps) { const v4u raw = ps == 0 ? qv[q] : kv[q]; float x[8];
#pragma unroll
                for (int e = 0; e < 4; ++e) { x[2 * e] = __uint_as_float(raw[e] << 16); x[2 * e + 1] = __uint_as_float(raw[e] & 0xffff0000u); }
                float ss = 0.f;
#pragma unroll
                for (int e = 0; e < 8; ++e) ss += x[e] * x[e];
                ss += __shfl_xor(ss, 1); ss += __shfl_xor(ss, 2); ss += __shfl_xor(ss, 4);
                const float rs = rsqrtf(ss * (1.f / 64.f) + EPS); float y[8];
#pragma unroll
                for (int e = 0; e < 8; ++e) y[e] = x[e] * rs * (ps == 0 ? qn[e] : kn[e]);
                if (lat) {
#pragma unroll
                    for (int e = 0; e < 8; ++e) { const float other = __shfl_xor(y[e], 4); const float c = cs[q][e >> 2][e & 3], s_ = sn[q][e >> 2][e & 3]; y[e] = (lane & 4) ? (other * s_ + y[e] * c) : (y[e] * c - other * s_); } }
                v4u o; o.x = pk2(y[0], y[1]); o.y = pk2(y[2], y[3]); o.z = pk2(y[4], y[5]); o.w = pk2(y[6], y[7]);
                if (ps == 0) *(v4u*)(Q + (size_t)r * 512 + 8 * lane) = o;
                else if (lane < 16) *(v4u*)(K + (size_t)r * 128 + 8 * lane) = o;
                else if (lane < 32) *(v4u*)(V + (size_t)r * 128 + 8 * (lane - 16)) = raw; } } }
    } }
}
__device__ __forceinline__ void mla_prep1(const Frame& F, const Params& P) {
    char* ws = F.ws; const bf16_t* Z = (const bf16_t*)(ws + WS_Z); bf16_t* QA = (bf16_t*)(ws + WS_QA); bf16_t* KVA = (bf16_t*)(ws + WS_KVA); bf16_t* KR = (bf16_t*)(ws + WS_KR);
    const int gw = F.bid * NWAVES + F.wave, NGW = F.G * NWAVES, lane = F.lane; const float* gq = PIN(33); const float* gkv = PIN(35);
    const f32x4 g4 = *(const f32x4*)(gq + 4 * lane); const float gk0 = gkv[2 * lane], gk1 = gkv[2 * lane + 1];
    for (int r0 = gw; r0 < MROWS; r0 += 3 * NGW) {
        u32x2 qw[3]; unsigned kw[3], krw[3];
#pragma unroll
        for (int q = 0; q < 3; ++q) { const int r = r0 + q * NGW; if (r < MROWS) { const bf16_t* z = Z + (size_t)r * CD_LD; qw[q] = *(const u32x2*)(z + 1536 + 4 * lane); kw[q] = *(const unsigned*)(z + 1792 + 2 * lane); krw[q] = lane < 16 ? *(const unsigned*)(z + 1920 + 2 * lane) : 0u; } }
#pragma unroll
        for (int q = 0; q < 3; ++q) { const int r = r0 + q * NGW; if (r < MROWS) {
            const float q0 = __uint_as_float(qw[q].x << 16), q1 = __uint_as_float(qw[q].x & 0xffff0000u), q2 = __uint_as_float(qw[q].y << 16), q3 = __uint_as_float(qw[q].y & 0xffff0000u);
            const float k0 = __uint_as_float(kw[q] << 16), k1 = __uint_as_float(kw[q] & 0xffff0000u);
            const float rq = rsqrtf(wave_sum((q0 * q0 + q1 * q1) + (q2 * q2 + q3 * q3)) * (1.f / 256.f) + EPS), rk = rsqrtf(wave_sum(k0 * k0 + k1 * k1) * (1.f / 128.f) + EPS);
            u32x2 o; o.x = pk2(q0 * rq * g4[0], q1 * rq * g4[1]); o.y = pk2(q2 * rq * g4[2], q3 * rq * g4[3]); *(u32x2*)(QA + (size_t)r * 256 + 4 * lane) = o;
            *(unsigned*)(KVA + (size_t)r * 256 + 2 * lane) = pk2(k0 * rk * gk0, k1 * rk * gk1); *(unsigned*)(KVA + (size_t)r * 256 + 128 + 2 * lane) = 0u;
            if (lane < 16) *(unsigned*)(KR + (size_t)r * 32 + 2 * lane) = krw[q]; } }
    }
}
__device__ __forceinline__ void mla_prep2(const Frame& F, const Params& P) {
    char* ws = F.ws; char* dob = (char*)P.out; const bf16_t* QR = (const bf16_t*)(ws + WS_QR); const bf16_t* KVR = (const bf16_t*)(ws + WS_KVR); const bf16_t* KR = (const bf16_t*)(ws + WS_KR);
    bf16_t* QM = (bf16_t*)(ws + WS_QM); bf16_t* KM = (bf16_t*)(dob + DO_KM); bf16_t* VM = (bf16_t*)(dob + DO_VM); const float* R1 = (const float*)(ws + WS_ROPE1);
    const int gw = F.bid * NWAVES + F.wave, NGW = F.G * NWAVES, lane = F.lane; const int h = lane >> 3, sub = lane & 7; const bool rl = sub < 4; const int rs8 = 8 * (sub & 3), ti = rs8 & 15;
    float qn0[8], qn1[8], kn0[8], kn1[8];
#pragma unroll
    for (int e = 0; e < 8; ++e) { qn0[e] = PIN(37)[8 * sub + e] * QSCALE1; qn1[e] = PIN(37)[64 + rs8 + e] * QSCALE1; kn0[e] = PIN(38)[8 * sub + e]; kn1[e] = PIN(38)[64 + rs8 + e]; }
#define MP2_UNPK(raw, x) _Pragma("unroll") for (int e_ = 0; e_ < 4; ++e_) { x[2 * e_] = __uint_as_float(raw[e_] << 16); x[2 * e_ + 1] = __uint_as_float(raw[e_] & 0xffff0000u); }
#define MP2_PK(y) (v4u){pk2(y[0], y[1]), pk2(y[2], y[3]), pk2(y[4], y[5]), pk2(y[6], y[7])}
    for (int r = gw; r < MROWS; r += NGW) { const int s = r % RPB; const bool lat = s >= CTX;
        const v4u kraw = *(const v4u*)(KVR + (size_t)r * 1024 + h * 128 + 8 * sub), vraw = *(const v4u*)(KVR + (size_t)r * 1024 + h * 128 + 64 + 8 * sub);
        const v4u rraw = *(const v4u*)(KR + (size_t)r * 32 + rs8);
        v4u qraw = {0u, 0u, 0u, 0u}, qrr = {0u, 0u, 0u, 0u}; f32x4 cs[2], sn[2];
        if (lat) { qraw = *(const v4u*)(QR + (size_t)r * 768 + h * 96 + 8 * sub); qrr = *(const v4u*)(QR + (size_t)r * 768 + h * 96 + 64 + rs8);
            const float* rp = R1 + (size_t)(s - CTX) * 32 + ti; cs[0] = *(const f32x4*)rp; cs[1] = *(const f32x4*)(rp + 4); sn[0] = *(const f32x4*)(rp + 16); sn[1] = *(const f32x4*)(rp + 20); }
        *(v4u*)(VM + (size_t)r * 512 + h * 64 + 8 * sub) = vraw;
#pragma unroll
        for (int which = 0; which < 2; ++which) {
            if (which == 1 && !lat) break;
            float a[8], bq[8]; { const v4u ra = which == 0 ? kraw : qraw, rb = which == 0 ? rraw : qrr; MP2_UNPK(ra, a) MP2_UNPK(rb, bq) }
            float ss = 0.f;
#pragma unroll
            for (int e = 0; e < 8; ++e) ss += a[e] * a[e] + (rl ? bq[e] * bq[e] : 0.f);
            ss += __shfl_xor(ss, 1); ss += __shfl_xor(ss, 2); ss += __shfl_xor(ss, 4);
            const float rsd = rsqrtf(ss * (1.f / 96.f) + EPS);
#pragma unroll
            for (int e = 0; e < 8; ++e) { a[e] = a[e] * rsd * (which == 0 ? kn0[e] : qn0[e]); bq[e] = bq[e] * rsd * (which == 0 ? kn1[e] : qn1[e]); }
            if (lat) {
#pragma unroll
                for (int e = 0; e < 8; ++e) { const float other = __shfl_xor(bq[e], 2); const float c = cs[e >> 2][e & 3], sv = sn[e >> 2][e & 3]; bq[e] = (sub & 2) ? (other * sv + bq[e] * c) : (bq[e] * c - other * sv); } }
            bf16_t* o = (which == 0 ? KM : QM) + (size_t)r * 768 + h * 96;
            *(v4u*)(o + 8 * sub) = MP2_PK(a); if (rl) *(v4u*)(o + 64 + rs8) = MP2_PK(bq); }
    }
#undef MP2_UNPK
#undef MP2_PK
}
}
__global__ void __launch_bounds__(NTHREADS, 2) mk_kernel(Params prm) {
    extern __shared__ __attribute__((aligned(16))) unsigned char lds_raw[];
    Frame F; F.lds = (LAS unsigned char*)lds_raw; F.tid = threadIdx.x; F.lane = F.tid & 63; F.wave = __builtin_amdgcn_readfirstlane(F.tid >> 6);
    F.G = gridDim.x; F.bid = blockIdx.x; F.even = 0; F.ws = prm.ws;
    const Params& P = prm;
    const float* MOD0 = (const float*)(prm.ws + WS_MOD);
    const int lo = prm.ph_lo, hi = prm.ph_hi;
    volatile LAS unsigned* MISCW = (volatile LAS unsigned*)(F.lds + MISC_OFF + 8192);
    if (F.tid < 64) MISCW[F.tid] = 0u;
    __syncthreads();
    if (prm.ph_lo == 123456) cooperative_groups::this_grid().sync();
    XcdBarrier bar = xcd_barrier_post((unsigned*)(prm.ws + WS_CTL + CT_BAR), MISCW + 8);
#define RUN(k, body) if (lo <= (k) && (k) < hi) { body; if ((k) + 1 < hi) xcd_barrier(bar); }
#define RUN_GEMMS(PH0, NPH, G0) { _Pragma("unroll 1") for (int i_ = 0; i_ < (NPH); ++i_) { const int k_ = (PH0) + i_; if (lo <= k_ && k_ < hi) { run_gemm(F, prm, (G0) + i_); if (k_ + 1 < hi) xcd_barrier(bar); } } }
    RUN(PH_P0, { el::rope_tables(F); el::mod_phase(F, prm); phase_conv(F, prm, false); hy::filt(F, prm); })
    if (MISCW[8 + 3] != 0u) { F.bid = __builtin_amdgcn_readfirstlane((int)(MISCW[8 + 2] * 8u + bar.x)); F.even = 1; }
    RUN(PH_NORM0, { el::norm_phase<0>(F, prm, PIN(6), MOD0, 0, 1); el::bias_phase(F, prm); })
    RUN(PH_G_IN0, run_gemm(F, prm, G_IN0))
    RUN(PH_LRUPREP, { lru::phase<0>(F, prm); el::gqa_prep(F, prm); })
    RUN(PH_MIX0, { phase_attn0(F); lru::phase<1>(F, prm); })
    RUN(PH_G_OUT0, { run_gemm(F, prm, G_OUT0); run_gemm(F, prm, G_F1); moe_conv_all(F, prm); run_gemm(F, prm, G_F2); run_gemm(F, prm, G_IN1); })
    RUN(PH_PREP1, { hy::prep(F, prm); el::mla_prep1(F, prm); })
    RUN(PH_G_QKVB, { run_gemm(F, prm, G_QB); run_gemm(F, prm, G_KVB); })
    RUN(PH_PREP2, { el::mla_prep2(F, prm); hy::main_phase(F, prm); })
    RUN(PH_MIX1, { phase_attn1(F, prm); hy::untranspose(F); })
    RUN(PH_G_OUT1, run_gemm(F, prm, G_OUT1))
    RUN(PH_ROUTE, phase_route(F, prm))
    RUN(PH_SLOT, phase_slot(F, prm))
    RUN(PH_MOE1, { run_gemm(F, prm, G_MOE1); run_gemm(F, prm, G_MOE2); })
    RUN(PH_COMBINE, phase_combine(F, prm))
#undef RUN
#undef RUN_GEMMS
}
#ifndef SPLIT_LAUNCH
#define SPLIT_LAUNCH 0
#endif
extern "C" void kernel_launch(void* const* d_in, const int* in_sizes, int n_in, void* d_out, int out_size, void* d_ws, size_t ws_size, hipStream_t st) {
    static int grid = 0;
    if (grid == 0) {
        if (n_in != 43 || out_size != NLAT * DM || ws_size < WS_END) { fprintf(stderr, "kernel_launch: unexpected problem (n_in %d, out %d, ws %zu < %zu)\n", n_in, out_size, ws_size, (size_t)WS_END); grid = -1; return; }
        int dev = 0, cus = 0, per_cu = 0;
        (void)hipGetDevice(&dev); (void)hipDeviceGetAttribute(&cus, hipDeviceAttributeMultiprocessorCount, dev);
        (void)hipFuncSetAttribute((const void*)mk_kernel, hipFuncAttributeMaxDynamicSharedMemorySize, LDS_BYTES);
        (void)hipOccupancyMaxActiveBlocksPerMultiprocessor(&per_cu, (const void*)mk_kernel, NTHREADS, LDS_BYTES);
        grid = cus;
        if (grid != 256 || per_cu < 1) { fprintf(stderr, "kernel_launch: grid %d (CUs %d, occupancy query %d): this kernel is written for 256 resident workgroups; nothing launched\n", grid, cus, per_cu); grid = -1; return; }
    }
    if (grid < 0) return;
    (void)hipMemsetAsync((char*)d_ws + WS_CTL, 0, CTL_BYTES, st);
    Params prm{}; prm.i0 = (const float*)d_in[0]; prm.i1 = (const float*)d_in[1]; prm.i2 = (const float*)d_in[2]; prm.i3 = (const float*)d_in[3]; prm.i4 = (const float*)d_in[4]; prm.i5 = (const float*)d_in[5]; prm.i6 = (const float*)d_in[6]; prm.i7 = (const float*)d_in[7]; prm.i8 = (const float*)d_in[8]; prm.i9 = (const float*)d_in[9]; prm.i10 = (const float*)d_in[10]; prm.i11 = (const float*)d_in[11]; prm.i12 = (const float*)d_in[12]; prm.i13 = (const float*)d_in[13]; prm.i14 = (const float*)d_in[14]; prm.i15 = (const float*)d_in[15]; prm.i16 = (const float*)d_in[16]; prm.i17 = (const float*)d_in[17]; prm.i18 = (const float*)d_in[18]; prm.i19 = (const float*)d_in[19]; prm.i20 = (const float*)d_in[20]; prm.i21 = (const float*)d_in[21]; prm.i22 = (const float*)d_in[22]; prm.i23 = (const float*)d_in[23]; prm.i24 = (const float*)d_in[24]; prm.i25 = (const float*)d_in[25]; prm.i26 = (const float*)d_in[26]; prm.i27 = (const float*)d_in[27]; prm.i28 = (const float*)d_in[28]; prm.i29 = (const float*)d_in[29]; prm.i30 = (const float*)d_in[30]; prm.i31 = (const float*)d_in[31]; prm.i32 = (const float*)d_in[32]; prm.i33 = (const float*)d_in[33]; prm.i34 = (const float*)d_in[34]; prm.i35 = (const float*)d_in[35]; prm.i36 = (const float*)d_in[36]; prm.i37 = (const float*)d_in[37]; prm.i38 = (const float*)d_in[38]; prm.i39 = (const float*)d_in[39]; prm.i40 = (const float*)d_in[40]; prm.i41 = (const float*)d_in[41]; prm.i42 = (const float*)d_in[42]; prm.out = (float*)d_out; prm.ws = (char*)d_ws;
#if SPLIT_LAUNCH
    for (int ph = 0; ph < PH_COUNT; ++ph) { prm.ph_lo = ph; prm.ph_hi = ph + 1; hipLaunchKernelGGL(mk_kernel, dim3(grid), dim3(NTHREADS), LDS_BYTES, st, prm); }
#else
    prm.ph_lo = 0; prm.ph_hi = PH_COUNT;
    void* args[] = {&prm};
    hipError_t e = hipLaunchCooperativeKernel((const void*)mk_kernel, dim3(grid), dim3(NTHREADS), args, LDS_BYTES, st);
    if (e != hipSuccess) fprintf(stderr, "kernel_launch: cooperative launch failed: %s (grid %d)\n", hipGetErrorString(e), grid);
#endif
}
```

```cpp
#include <hip/hip_runtime.h>
#include <hip/hip_cooperative_groups.h>
#include <cstdio>
#include <cstdint>
#include <cmath>

constexpr int NB = 8, SEQ = 2048, CTX = 256, RPB = SEQ + CTX, MROWS = NB * RPB, DM = 1024, NLAT = NB * SEQ;
constexpr int NMOD = 6, MODLD = NMOD * DM;
constexpr int AB_IN = 1792, CD_IN = 1952, CD_LD = 2048, DFF = 2816, NEXP = 8, DFE = 3584;
constexpr float EPS = 1e-6f;
constexpr float LOG2E = 1.4426950408889634f;
constexpr float QSCALE0 = 0.125f * LOG2E;
constexpr float QSCALE1 = 0.10206207261596577f * LOG2E;

typedef unsigned short bf16_t;
typedef float f32x4 __attribute__((ext_vector_type(4)));
typedef unsigned u32x4 __attribute__((ext_vector_type(4)));
typedef unsigned u32x2 __attribute__((ext_vector_type(2)));

__device__ __forceinline__ int mod_row(int r) { int b = r / RPB, s = r % RPB; return s < CTX ? 8 : b; }
__device__ __forceinline__ int latent_row(int m) { return (m / SEQ) * RPB + CTX + (m % SEQ); }

__device__ __forceinline__ float bf2f(bf16_t v) { return __uint_as_float((unsigned)v << 16); }
typedef float hd_f32x2 __attribute__((ext_vector_type(2))); typedef __bf16 hd_bf16x2 __attribute__((ext_vector_type(2)));
__device__ __forceinline__ unsigned pk2(float lo, float hi) { hd_f32x2 v = {lo, hi}; hd_bf16x2 b = __builtin_convertvector(v, hd_bf16x2); return __builtin_bit_cast(unsigned, b); }
__device__ __forceinline__ bf16_t f2bf(float f) { return (bf16_t)(pk2(f, 0.f) & 0xffffu); }
__device__ __forceinline__ float ldf(const float* p) { return *p; }
__device__ __forceinline__ float ldf(const bf16_t* p) { return bf2f(*p); }
__device__ __forceinline__ void stf(float* p, float v) { *p = v; }
__device__ __forceinline__ void stf(bf16_t* p, float v) { *p = f2bf(v); }

__device__ __forceinline__ float silu_f(float x) { return x / (1.f + expf(-x)); }
__device__ __forceinline__ float sigmoid_f(float x) { return 1.f / (1.f + expf(-x)); }
__device__ __forceinline__ float gelu_tanh(float x) { return 0.5f * x * (1.f + tanhf(0.7978845608028654f * (x + 0.044715f * x * x * x))); }
__device__ __forceinline__ float softplus_f(float x) { return fmaxf(x, 0.f) + log1pf(expf(-fabsf(x))); }

__device__ __forceinline__ float wave_sum(float v) {
#pragma unroll
    for (int o = 1; o < 64; o <<= 1) v += __shfl_xor(v, o);
    return v;
}
__device__ __forceinline__ float wave_max(float v) {
#pragma unroll
    for (int o = 1; o < 64; o <<= 1) v = fmaxf(v, __shfl_xor(v, o));
    return v;
}

constexpr size_t MiB = 1ull << 20;
constexpr size_t WS_CTL = 0, CTL_BYTES = 256 * 1024;
constexpr size_t WS_MOD = 1 * MiB;
constexpr size_t WS_SC = WS_MOD + 512 * 1024;
constexpr size_t WS_W13M = 4 * MiB;
constexpr size_t WS_W2M = 116 * MiB;
constexpr size_t WS_WIN0 = 172 * MiB;
constexpr size_t WS_WOUT0 = WS_WIN0 + (size_t)1792 * 1024 * 2;
constexpr size_t WS_WF13 = WS_WOUT0 + (size_t)1024 * 1024 * 2;
constexpr size_t WS_WF2 = WS_WF13 + (size_t)5632 * 1024 * 2;
constexpr size_t WS_WIN1 = WS_WF2 + (size_t)1024 * 2816 * 2;
constexpr size_t WS_WOUT1 = WS_WIN1 + (size_t)2048 * 1024 * 2;
constexpr size_t WS_WQB = WS_WOUT1 + (size_t)1024 * 1024 * 2;
constexpr size_t WS_WKVB = WS_WQB + (size_t)768 * 256 * 2;
constexpr size_t WS_WLRU = WS_WKVB + (size_t)1024 * 256 * 2;
constexpr size_t WS_WEND = WS_WLRU + (size_t)2 * 8 * 2 * 64 * 64 * 2;
static_assert(WS_WEND <= 202 * MiB, "weights region");
constexpr size_t WS_X = 202 * MiB;
constexpr size_t WS_H = 274 * MiB;
constexpr size_t WS_Z = 310 * MiB;
constexpr size_t WS_Y = 382 * MiB;
constexpr size_t WS_ACT = WS_Z;
constexpr size_t WS_R2 = 418 * MiB;
constexpr size_t WS_END = 502 * MiB;
static_assert(WS_ACT + (size_t)MROWS * DFF * 2 <= WS_R2, "ACT overlay");
constexpr size_t WS_QB = WS_R2;
constexpr size_t WS_KB = WS_QB + (size_t)MROWS * 512 * 2;
constexpr size_t WS_VB = WS_KB + (size_t)MROWS * 128 * 2;
constexpr size_t WS_AGG = WS_VB + (size_t)MROWS * 128 * 2;
constexpr size_t WS_R2L0END = WS_AGG + (size_t)2 * 8 * 72 * 2 * 512 * 4;
constexpr size_t WS_ZT = WS_R2;
constexpr size_t WS_HT = WS_ZT + (size_t)1536 * NLAT * 2;
constexpr size_t WS_GT = WS_HT + (size_t)512 * NLAT * 2;
constexpr int GT_LD = 4224;
constexpr size_t WS_R2L1END = WS_GT + (size_t)2 * 512 * GT_LD * 2;
static_assert(WS_R2L0END <= WS_END && WS_R2L1END <= WS_END, "R2");
constexpr size_t WS_QA = WS_Y;
constexpr size_t WS_KVA = WS_QA + (size_t)MROWS * 256 * 2;
constexpr size_t WS_KR = WS_KVA + (size_t)MROWS * 256 * 2;
constexpr size_t WS_QR = WS_Z;
constexpr size_t WS_KVR = WS_QR + (size_t)MROWS * 768 * 2;
static_assert(WS_KVR + (size_t)MROWS * 1024 * 2 <= WS_Y && WS_KR + (size_t)MROWS * 32 * 2 <= WS_R2, "layer-1 overlays");
constexpr size_t WS_QM = WS_H;
static_assert((size_t)MROWS * 768 * 2 <= 36 * MiB, "QM in H");
constexpr size_t DO_KM = 0;
constexpr size_t DO_VM = (size_t)MROWS * 768 * 2;
static_assert(DO_VM + (size_t)MROWS * 512 * 2 <= (size_t)NLAT * DM * 4, "d_out scratch");
constexpr int MAXSLOT = 34816;
constexpr size_t WS_XG = WS_WIN0;
constexpr size_t WS_ACT2 = WS_XG + (size_t)MAXSLOT * 1024 * 2;
constexpr size_t WS_H2 = WS_ACT2 + (size_t)MAXSLOT * 3584 * 2 - (size_t)NLAT * 1024 * 2;
static_assert(WS_ACT2 + (size_t)MAXSLOT * 3584 * 2 <= WS_END, "MoE overlay");
constexpr size_t CT_BAR = 0;
constexpr size_t CT_PCNT = 16 * 1024;
constexpr size_t CT_MCNT = 48 * 1024;
constexpr size_t CT_HIST = 32 * 1024;
constexpr size_t CT_CNT = 48 * 1024;
constexpr size_t CT_CURSOR = 80 * 1024;
constexpr size_t CT_DONE = 80 * 1024 + 256;
constexpr size_t CT_SSQA = 96 * 1024;
constexpr size_t CT_SSQB = CT_SSQA + (size_t)MROWS * 4;
static_assert(CT_SSQB + (size_t)MROWS * 4 <= CTL_BYTES, "ssq in the zeroed control region");
constexpr size_t WS_SLOTTOK = 2 * MiB;
constexpr size_t WS_SLOTGATE = WS_SLOTTOK + (size_t)MAXSLOT * 4;
constexpr size_t WS_SEL = WS_SLOTGATE + (size_t)MAXSLOT * 4;
constexpr size_t WS_TOKSLOT = WS_SEL + (size_t)NLAT * 16;
static_assert(WS_TOKSLOT + (size_t)NLAT * 8 <= WS_W13M, "small tables");
constexpr size_t WS_ROPE0 = 3 * MiB;
constexpr size_t WS_ROPE1 = 3 * MiB + 512 * 1024;
static_assert(WS_TOKSLOT + (size_t)NLAT * 8 <= WS_ROPE0 && WS_ROPE1 + 256 * 1024 <= WS_W13M, "rope tables");
constexpr size_t WS_CBF1 = WS_SC + 64 * 1024;
constexpr size_t WS_CBIN1 = WS_CBF1 + 9 * 5632 * 4;
static_assert(WS_CBIN1 + 9 * 2048 * 4 <= WS_SLOTTOK, "bias vectors");
constexpr size_t WS_Y2 = WS_XG;
namespace pg8 {
#define PG8_LAS __attribute__((address_space(3)))
typedef unsigned short bf16_t;
typedef short bf16x8 __attribute__((ext_vector_type(8)));
typedef float f32x4 __attribute__((ext_vector_type(4)));
typedef unsigned u32x4 __attribute__((ext_vector_type(4)));
constexpr int BM = 256, BK = 64, HALF = 128, HTB = HALF * BK * 2  , STAGE_BYTES = 8 * HTB, NXCD = 8, WGM = 8;

__host__ __device__ __forceinline__ int lds_byte(int r, int c) { const int st = (r >> 4) * 2 + (c >> 5), rr = r & 15, cc = c & 31, ob = rr * 64 + cc * 2; return st * 1024 + (ob ^ (((ob >> 9) & 1) << 5)); }
__host__ __device__ __forceinline__ void stage_rc(int b, int& R, int& C) { const int st = b / 1024, sb = b % 1024, swz = sb ^ (((sb >> 9) & 1) << 5); R = (st >> 1) * 16 + swz / 64; C = (st & 1) * 32 + (swz % 64) / 2; }
__host__ __device__ __forceinline__ int perm32(int rho) { const int n = rho >> 4, i = rho & 15; return 8 * (i >> 2) + 4 * n + (i & 3); }

struct Unit { int pm, pn; };
struct Gemm { const bf16_t* A; const bf16_t* Bt; int M, N, K; };

struct StaticOrder {
    int nM, nN, nwg, G, c;
    __host__ __device__ void init(int M, int N, int G_, int c_) { nM = M / BM; nN = N / BM; nwg = nM * nN; G = G_; c = c_; }
    __host__ __device__ bool next(int i, Unit& u) const {
        const long L = (long)i * G + c; if (L >= nwg) return false;
        int wgid = (int)L; { const int q = nwg / NXCD, r = nwg % NXCD, xcd = wgid % NXCD, off = wgid / NXCD; wgid = (xcd < r ? xcd * (q + 1) : r * (q + 1) + (xcd - r) * q) + off; }
        const int nig = WGM * nN, gid = wgid / nig, fm = gid * WGM, gsz = (nM - fm) < WGM ? (nM - fm) : WGM;
        u.pm = fm + ((wgid % nig) % gsz); u.pn = (wgid % nig) / gsz; return true;
    }
    __device__ __forceinline__ void a_ready(const Unit&) const {}
    __device__ __forceinline__ void done(const Unit&) const {}
};

__device__ __forceinline__ unsigned cvt_pk_bf16(float lo, float hi) { unsigned r; asm volatile("v_cvt_pk_bf16_f32 %0, %1, %2" : "=v"(r) : "v"(lo), "v"(hi)); return r; }
typedef float f32x2 __attribute__((ext_vector_type(2)));
__device__ __forceinline__ f32x2 gelu_pk(f32x2 v) {
    const f32x2 av = __builtin_elementwise_abs(v), d = av * 0.2316418882f + 1.0f;
    f32x2 t; t.x = __builtin_amdgcn_rcpf(d.x); t.y = __builtin_amdgcn_rcpf(d.y);
    f32x2 q = t * 0.5307027145f + (-0.7265760135f); q = q * t + 0.7107068705f; q = q * t + (-0.142248368f); q = q * t + 0.127414796f; q = q * t;
    const f32x2 s = (v * v) * (-0.72134752044f);
    f32x2 e; e.x = __builtin_amdgcn_exp2f(s.x); e.y = __builtin_amdgcn_exp2f(s.y);
    const f32x2 m = v * (q * e), r = v - m;
    f32x2 o; o.x = v.x < 0.f ? m.x : r.x; o.y = v.y < 0.f ? m.y : r.y; return o;
}

template <int ACT  > struct EpiBf16 {
    static constexpr bool PERM = true, AFTER_DRAIN = false; static_assert(ACT == 0 || ACT == 1, "EpiBf16: ACT is 0 (none) or 1 (gelu_pk)");
    bf16_t* O; int ldc; const float* bias; int split_cols; size_t split_stride; float scale0;
    __device__ __forceinline__ void operator()(const f32x4 (&acc)[2][2][4][2], const Unit& u, int wr, int wc, int fr, int fq) const {
        const int row0 = u.pm * BM + wr * 64 + fr; int colt = u.pn * BM; bf16_t* base = O;
        float sc = 1.f; if (split_cols) { const int t = colt / split_cols; base += (size_t)t * split_stride; colt -= t * split_cols; if (t == 0) sc = scale0; }
        const int col0 = colt + wc * 32 + 8 * fq, bcol0 = u.pn * BM + wc * 32 + 8 * fq;
        f32x4 bv[2][2];
#pragma unroll
        for (int bj = 0; bj < 2; ++bj)
#pragma unroll
            for (int n = 0; n < 2; ++n) bv[bj][n] = bias ? *(const f32x4*)(bias + bcol0 + bj * HALF + 4 * n) : (f32x4){0.f, 0.f, 0.f, 0.f};
#pragma unroll
        for (int ai = 0; ai < 2; ++ai)
#pragma unroll
            for (int m = 0; m < 4; ++m) { bf16_t* rowp = base + (size_t)(row0 + ai * HALF + m * 16) * ldc + col0;
#pragma unroll
                for (int bj = 0; bj < 2; ++bj) { f32x4 v0 = acc[ai][bj][m][0] + bv[bj][0], v1 = acc[ai][bj][m][1] + bv[bj][1];
                    if (ACT == 1) { f32x2 a = gelu_pk((f32x2){v0[0], v0[1]}), b = gelu_pk((f32x2){v0[2], v0[3]}), c = gelu_pk((f32x2){v1[0], v1[1]}), d = gelu_pk((f32x2){v1[2], v1[3]});
                        v0 = (f32x4){a.x, a.y, b.x, b.y}; v1 = (f32x4){c.x, c.y, d.x, d.y}; }
                    v0 = v0 * sc; v1 = v1 * sc; u32x4 w; w.x = cvt_pk_bf16(v0[0], v0[1]); w.y = cvt_pk_bf16(v0[2], v0[3]); w.z = cvt_pk_bf16(v1[0], v1[1]); w.w = cvt_pk_bf16(v1[2], v1[3]);
                    *(u32x4*)(rowp + bj * HALF) = w; } }
    }
};

template <class Epi, class Sched, bool ALIGN_EPI = false, bool SP2 = false>
__device__ __forceinline__ void gemm_phase(PG8_LAS unsigned char* lds, const Gemm g, const Sched& S, const Epi& E) {
    int tid_ = threadIdx.x; asm volatile("" : "+v"(tid_));
    const int tid = tid_, wid = __builtin_amdgcn_readfirstlane(tid >> 6), lane = tid & 63, wr = wid >> 2, wc = wid & 3, fr = lane & 15, fq = lane >> 4;
    const int K = g.K, nt = K / BK;
    unsigned voffA[2], voffB[2];
#pragma unroll
    for (int i = 0; i < 2; ++i) { int R, C; stage_rc(tid * 16 + i * 8192, R, C); const int Rb = Epi::PERM ? ((R & ~31) + perm32(R & 31)) : R;
        voffA[i] = (unsigned)(R * K + C) * 2u; voffB[i] = (unsigned)(Rb * K + C) * 2u; }
    const size_t kstep = (size_t)(BK * 2);
    const size_t hstep = (size_t)HALF * K * 2;
    const size_t tstep = 2 * hstep;
    const unsigned ldsw = (unsigned)wid * 1024u;
    const int aoff = lds_byte(wr * 64 + fr, fq * 8), boff = lds_byte(wc * 32 + fr, fq * 8);
#define PG8_SA(b, h) (((b) * 2 + (h)) * HTB)
#define PG8_SB(b, h) ((4 + (b) * 2 + (h)) * HTB)
#define PG8_STAGE(bufoff, gbase, voff) do { _Pragma("unroll") for (int _i = 0; _i < 2; ++_i) \
        __builtin_amdgcn_global_load_lds((const unsigned*)((const char*)(gbase) + (voff)[_i]), (PG8_LAS unsigned*)(lds + (bufoff) + ldsw + _i * 8192), 16, 0, 0); } while (0)
#define PG8_LDA(dst, b, h) do { _Pragma("unroll") for (int m = 0; m < 4; ++m) _Pragma("unroll") for (int k = 0; k < 2; ++k) dst[m][k] = *(const PG8_LAS bf16x8*)(lds + PG8_SA(b, h) + aoff + m * 2048 + k * 1024); } while (0)
#define PG8_LDB(dst, b, h) do { _Pragma("unroll") for (int n = 0; n < 2; ++n) _Pragma("unroll") for (int k = 0; k < 2; ++k) dst[n][k] = *(const PG8_LAS bf16x8*)(lds + PG8_SB(b, h) + boff + n * 2048 + k * 1024); } while (0)
#define PG8_MMA(ai, bj, At, Bt) do { __builtin_amdgcn_s_setprio(1); _Pragma("unroll") for (int m = 0; m < 4; ++m) _Pragma("unroll") for (int n = 0; n < 2; ++n) _Pragma("unroll") for (int k = 0; k < 2; ++k) \
        acc[ai][bj][m][n] = __builtin_amdgcn_mfma_f32_16x16x32_bf16(Bt[n][k], At[m][k], acc[ai][bj][m][n], 0, 0, 0); __builtin_amdgcn_s_setprio(0); } while (0)
#define PG8_WAIT_V(n) asm volatile("s_waitcnt vmcnt(" #n ")" ::: "memory")
#define PG8_WAIT_L(n) asm volatile("s_waitcnt lgkmcnt(" #n ")" ::: "memory")
#define PG8_BAR __builtin_amdgcn_s_barrier()
#define PG8_SCHED __builtin_amdgcn_sched_barrier(0)
    Unit cur, nxt; int ui = 0;
    if (!S.next(0, cur)) return;
    f32x4 acc[2][2][4][2];
#pragma unroll
    for (int a = 0; a < 2; ++a)
#pragma unroll
        for (int b = 0; b < 2; ++b)
#pragma unroll
            for (int m = 0; m < 4; ++m)
#pragma unroll
                for (int n = 0; n < 2; ++n) acc[a][b][m][n] = (f32x4){0.f, 0.f, 0.f, 0.f};
    bf16x8 At[4][2], B0[2][2], B1[2][2];
    const char* cA = (const char*)g.A + (size_t)cur.pm * tstep; const char* cB = (const char*)g.Bt + (size_t)cur.pn * tstep;
    S.a_ready(cur);
    if constexpr (SP2) {
        PG8_STAGE(PG8_SB(0, 0), cB, voffB); PG8_STAGE(PG8_SB(0, 1), cB + hstep, voffB); PG8_STAGE(PG8_SA(0, 0), cA, voffA); PG8_STAGE(PG8_SA(0, 1), cA + hstep, voffA);
        if (wr == 1) PG8_BAR;
        PG8_WAIT_V(2); PG8_BAR;
        PG8_STAGE(PG8_SB(1, 0), cB + kstep, voffB); PG8_STAGE(PG8_SA(1, 0), cA + kstep, voffA); PG8_STAGE(PG8_SB(1, 1), cB + hstep + kstep, voffB);
        PG8_WAIT_V(6); PG8_BAR;
    } else {
        PG8_STAGE(PG8_SB(0, 0), cB, voffB); PG8_STAGE(PG8_SA(0, 0), cA, voffA); PG8_STAGE(PG8_SB(0, 1), cB + hstep, voffB); PG8_STAGE(PG8_SA(0, 1), cA + hstep, voffA);
        if (wr == 1) PG8_BAR;
        PG8_WAIT_V(4); PG8_BAR;
        PG8_STAGE(PG8_SB(1, 0), cB + kstep, voffB); PG8_STAGE(PG8_SA(1, 0), cA + kstep, voffA); PG8_STAGE(PG8_SB(1, 1), cB + hstep + kstep, voffB);
        PG8_WAIT_V(6); PG8_BAR;
    }
    for (;;) {
        const bool has_next = S.next(ui + 1, nxt);
        const char* nA = has_next ? (const char*)g.A + (size_t)nxt.pm * tstep : cA; const char* nB = has_next ? (const char*)g.Bt + (size_t)nxt.pn * tstep : cB;
        for (int t = 0; t < nt; t += 2) {
            const bool last = (t == nt - 2);
            const char* a1 = cA + (size_t)(t + 1) * kstep;
            const char* a2 = last ? nA : cA + (size_t)(t + 2) * kstep; const char* b2 = last ? nB : cB + (size_t)(t + 2) * kstep;
            const char* a3 = a2 + kstep; const char* b3 = b2 + kstep;
            if (last && has_next) S.a_ready(nxt);
            if constexpr (SP2) {
            PG8_LDB(B0, 0, 0); PG8_LDB(B1, 0, 1); PG8_SCHED; PG8_LDA(At, 0, 0); PG8_STAGE(PG8_SA(1, 1), a1 + hstep, voffA);
            PG8_WAIT_V(8); PG8_WAIT_L(0); PG8_BAR; PG8_MMA(0, 0, At, B0); PG8_MMA(0, 1, At, B1); PG8_BAR; PG8_SCHED;
            PG8_LDA(At, 0, 1); PG8_STAGE(PG8_SB(0, 0), b2, voffB); PG8_STAGE(PG8_SB(0, 1), b2 + hstep, voffB); PG8_STAGE(PG8_SA(0, 0), a2, voffA);
            PG8_WAIT_V(8); PG8_WAIT_L(0); PG8_BAR; PG8_MMA(1, 0, At, B0); PG8_MMA(1, 1, At, B1); PG8_BAR; PG8_SCHED;
            PG8_LDB(B0, 1, 0); PG8_LDB(B1, 1, 1); PG8_SCHED; PG8_LDA(At, 1, 0); PG8_STAGE(PG8_SA(0, 1), a2 + hstep, voffA);
            PG8_WAIT_V(8); PG8_WAIT_L(0); PG8_BAR; PG8_MMA(0, 0, At, B0); PG8_MMA(0, 1, At, B1); PG8_BAR; PG8_SCHED;
            PG8_LDA(At, 1, 1); PG8_STAGE(PG8_SB(1, 0), b3, voffB); PG8_STAGE(PG8_SB(1, 1), b3 + hstep, voffB); PG8_STAGE(PG8_SA(1, 0), a3, voffA);
            PG8_WAIT_V(8); PG8_WAIT_L(0); PG8_BAR; PG8_MMA(1, 0, At, B0); PG8_MMA(1, 1, At, B1); PG8_BAR; PG8_SCHED;
            } else {
            PG8_LDB(B0, 0, 0); PG8_SCHED; PG8_LDA(At, 0, 0); PG8_STAGE(PG8_SA(1, 1), a1 + hstep, voffA);
            PG8_WAIT_L(8); PG8_BAR; PG8_WAIT_L(0); PG8_MMA(0, 0, At, B0); PG8_BAR; PG8_SCHED;
            PG8_LDB(B1, 0, 1); PG8_STAGE(PG8_SB(0, 0), b2, voffB);
            PG8_BAR; PG8_WAIT_L(0); PG8_MMA(0, 1, At, B1); PG8_BAR;
            PG8_LDA(At, 0, 1); PG8_STAGE(PG8_SA(0, 0), a2, voffA);
            PG8_BAR; PG8_WAIT_L(0); PG8_MMA(1, 0, At, B0); PG8_BAR; PG8_SCHED;
            PG8_STAGE(PG8_SB(0, 1), b2 + hstep, voffB);
            PG8_WAIT_V(6); PG8_BAR; PG8_MMA(1, 1, At, B1); PG8_BAR;
            PG8_LDB(B0, 1, 0); PG8_SCHED; PG8_LDA(At, 1, 0); PG8_STAGE(PG8_SA(0, 1), a2 + hstep, voffA);
            PG8_WAIT_L(8); PG8_BAR; PG8_WAIT_L(0); PG8_MMA(0, 0, At, B0); PG8_BAR; PG8_SCHED;
            PG8_LDB(B1, 1, 1); PG8_STAGE(PG8_SB(1, 0), b3, voffB);
            PG8_BAR; PG8_WAIT_L(0); PG8_MMA(0, 1, At, B1); PG8_BAR;
            PG8_LDA(At, 1, 1); PG8_STAGE(PG8_SA(1, 0), a3, voffA);
            PG8_BAR; PG8_WAIT_L(0); PG8_MMA(1, 0, At, B0); PG8_BAR; PG8_SCHED;
            PG8_STAGE(PG8_SB(1, 1), b3 + hstep, voffB);
            PG8_WAIT_V(6); PG8_BAR; PG8_MMA(1, 1, At, B1); PG8_BAR;
            }
        }
        if constexpr (ALIGN_EPI) { if (wr == 0) PG8_BAR; }
        if constexpr (!Epi::AFTER_DRAIN) { E(acc, cur, wr, wc, fr, fq); S.done(cur); }
        if (!has_next) break;
#pragma unroll
        for (int a = 0; a < 2; ++a)
#pragma unroll
            for (int b = 0; b < 2; ++b)
#pragma unroll
                for (int m = 0; m < 4; ++m)
#pragma unroll
                    for (int n = 0; n < 2; ++n) acc[a][b][m][n] = (f32x4){0.f, 0.f, 0.f, 0.f};
        cur = nxt; cA = nA; cB = nB; ++ui;
        if constexpr (ALIGN_EPI) { if (wr == 1) PG8_BAR; }
    }
    PG8_WAIT_V(0);
    if constexpr (!ALIGN_EPI) { if (wr == 0) PG8_BAR; }
    PG8_BAR;
    if constexpr (Epi::AFTER_DRAIN) { E.fused(acc, cur, wr, wc, fr, fq, lds, wid, lane); S.done(cur); }
#undef PG8_SA
#undef PG8_SB
#undef PG8_STAGE
#undef PG8_LDA
#undef PG8_LDB
#undef PG8_MMA
#undef PG8_WAIT_V
#undef PG8_WAIT_L
#undef PG8_BAR
#undef PG8_SCHED
}
}
namespace pg8 {
__device__ __forceinline__ float fast_silu(float v) { return v * __builtin_amdgcn_rcpf(1.f + __builtin_amdgcn_exp2f(-1.4426950408889634f * v)); }

struct DenseOrder {
    int nM, nN, nreg, nwg, G, c, mode, wgm;
    __device__ __forceinline__ void init(int nM_, int nN_, int G_, int c_, int mode_) { nM = nM_; nN = nN_; G = G_; c = c_; mode = mode_; nreg = nM * nN; nwg = nreg + (mode == 2 ? 8 : 0); wgm = WGM; }
    __device__ __forceinline__ bool next(int i, Unit& u) const {
        const long L = (long)i * G + c; if (L >= nwg) return false;
        if (mode == 2 && L >= nreg) { u.pm = 9 * (int)(L - nreg); u.pn = nN - 1; return true; }
        int wgid = (int)L; { const int q = nreg / NXCD, r = nreg % NXCD, xcd = wgid % NXCD, off = wgid / NXCD; wgid = (xcd < r ? xcd * (q + 1) : r * (q + 1) + (xcd - r) * q) + off; }
        const int nig = wgm * nN, gid = wgid / nig, fm = gid * wgm, gsz = (nM - fm) < wgm ? (nM - fm) : wgm;
        int pm = fm + ((wgid % nig) % gsz); u.pn = (wgid % nig) / gsz;
        if (mode != 0) pm = 9 * (pm >> 3) + 1 + (pm & 7);
        u.pm = pm; return true;
    }
    __device__ __forceinline__ void a_ready(const Unit&) const {}
    __device__ __forceinline__ void done(const Unit&) const {}
};
struct MoeOrder {
    const PG8_LAS int* tb; int nN, G, c;
    __device__ __forceinline__ bool next(int i, Unit& u) const {
        const int nwg = tb[8] * nN; long L = (long)i * G + c; if (L >= nwg) return false;
        { const int wg = (int)L, q = nwg / NXCD, r = nwg % NXCD, xcd = wg % NXCD, off = wg / NXCD; L = (xcd < r ? xcd * (q + 1) : r * (q + 1) + (xcd - r) * q) + off; }
        int e = 0;
#pragma unroll
        for (int k = 1; k < 8; ++k) if (L >= (long)tb[k] * nN) e = k;
        const int Le = (int)(L - (long)tb[e] * nN), mt = tb[e + 1] - tb[e];
        const int nig = WGM * nN, gid = Le / nig, fm = gid * WGM, gsz = (mt - fm) < WGM ? (mt - fm) : WGM;
        u.pm = tb[e] + fm + ((Le % nig) % gsz); u.pn = e * nN + (Le % nig) / gsz; return true;
    }
    __device__ __forceinline__ void a_ready(const Unit&) const {}
    __device__ __forceinline__ void done(const Unit&) const {}
};

template <bool SRCIN, bool FUSE> struct EpiResGate {
    static constexpr bool PERM = true, AFTER_DRAIN = false;
    const float* xin; float* xout; const float* modbase; int compact;
    const float* xsrc_lat; const float* xsrc_ctx; bf16_t* hraw; const float* gnext; const float* nscale; float* ssq;
    __device__ __forceinline__ void operator()(const f32x4 (&acc)[2][2][4][2], const Unit& u, int wr, int wc, int fr, int fq) const {
        const int b = u.pm / 9, pj = u.pm - 9 * b; const int mrow = (pj == 0) ? 8 : b;
        const float* g = modbase + (size_t)mrow * 6144;
        const int col0 = u.pn * BM + wc * 32 + 8 * fq;
        f32x4 gv[2][2];
#pragma unroll
        for (int bj = 0; bj < 2; ++bj)
#pragma unroll
            for (int n = 0; n < 2; ++n) gv[bj][n] = *(const f32x4*)(g + col0 + bj * HALF + n * 4);
        const int row0 = u.pm * BM + wr * 64 + fr; const int oshift = compact ? 256 * (b + 1) : 0;
        const float* xbase = SRCIN ? (pj == 0 ? xsrc_ctx + (size_t)b * 256 * 1024 : xsrc_lat + ((size_t)b * 2048 + (pj - 1) * 256) * 1024) - (size_t)u.pm * BM * 1024 : xin;
        const float* ns = nscale + (size_t)mrow * 6144;
#pragma unroll
        for (int am = 0; am < 4; ++am) { const int ai = am >> 1;
            f32x4 xv[2][2][2];
#pragma unroll
            for (int mm = 0; mm < 2; ++mm) { const int m = (am & 1) * 2 + mm; const float* xi = xbase + (size_t)(row0 + ai * HALF + m * 16) * 1024 + col0;
#pragma unroll
                for (int bj = 0; bj < 2; ++bj)
#pragma unroll
                    for (int n = 0; n < 2; ++n) xv[mm][bj][n] = *(const f32x4*)(xi + bj * HALF + n * 4); }
#pragma unroll
            for (int mm = 0; mm < 2; ++mm) { const int m = (am & 1) * 2 + mm; const int row = row0 + ai * HALF + m * 16; float* xo = xout + (size_t)(row - oshift) * 1024 + col0; float ss = 0.f;
#pragma unroll
                for (int bj = 0; bj < 2; ++bj)
#pragma unroll
                    for (int n = 0; n < 2; ++n) { const f32x4 v = xv[mm][bj][n] + gv[bj][n] * acc[ai][bj][m][n]; *(f32x4*)(xo + bj * HALF + n * 4) = v;
                        if (FUSE) { const int c = col0 + bj * HALF + n * 4; const f32x4 hv = v * (*(const f32x4*)(gnext + c) * (*(const f32x4*)(ns + c) + 1.f));
                            ss += (v[0] * v[0] + v[1] * v[1]) + (v[2] * v[2] + v[3] * v[3]);
                            u32x2 w; w.x = cvt_pk_bf16(hv[0], hv[1]); w.y = cvt_pk_bf16(hv[2], hv[3]); *(u32x2*)(hraw + (size_t)row * 1024 + c) = w; } }
                if (FUSE) { ss += __shfl_xor(ss, 16); ss += __shfl_xor(ss, 32); if (fq == 0) unsafeAtomicAdd(ssq + row, ss); } }
            asm volatile("" ::: "memory"); }
    }
};
struct EpiSwiGLU {
    static constexpr bool PERM = true, AFTER_DRAIN = false;
    bf16_t* O; int ldc; int npn; const float* ssq; const float* cbias; int cbld;
    __device__ __forceinline__ void operator()(const f32x4 (&acc)[2][2][4][2], const Unit& u, int wr, int wc, int fr, int fq) const {
        const int row0 = u.pm * BM + wr * 64 + fr; const int col0 = (u.pn % npn) * HALF + wc * 32 + 8 * fq;
        f32x4 cb[2][2];
        if (ssq) { const int b = u.pm / 9; const int mrow = (u.pm - 9 * b == 0) ? 8 : b; const float* cp = cbias + (size_t)mrow * cbld + u.pn * BM + wc * 32 + 8 * fq;
#pragma unroll
            for (int bj = 0; bj < 2; ++bj)
#pragma unroll
                for (int n = 0; n < 2; ++n) cb[bj][n] = *(const f32x4*)(cp + bj * HALF + 4 * n); }
        float rsv[2][4];
        if (ssq) {
#pragma unroll
            for (int ai = 0; ai < 2; ++ai)
#pragma unroll
                for (int m = 0; m < 4; ++m) rsv[ai][m] = ssq[row0 + ai * HALF + m * 16];
#pragma unroll
            for (int ai = 0; ai < 2; ++ai)
#pragma unroll
                for (int m = 0; m < 4; ++m) rsv[ai][m] = rsqrtf(rsv[ai][m] * (1.f / 1024.f) + 1e-6f); }
#pragma unroll
        for (int ai = 0; ai < 2; ++ai)
#pragma unroll
            for (int m = 0; m < 4; ++m) { const int row = row0 + ai * HALF + m * 16; bf16_t* rowp = O + (size_t)row * ldc + col0;
                f32x4 a0 = acc[ai][0][m][0], a1 = acc[ai][0][m][1], g0 = acc[ai][1][m][0], g1 = acc[ai][1][m][1];
                if (ssq) { const float rs = rsv[ai][m]; a0 = a0 * rs + cb[0][0]; a1 = a1 * rs + cb[0][1]; g0 = g0 * rs + cb[1][0]; g1 = g1 * rs + cb[1][1]; }
                u32x4 w; w.x = cvt_pk_bf16(fast_silu(a0[0]) * g0[0], fast_silu(a0[1]) * g0[1]); w.y = cvt_pk_bf16(fast_silu(a0[2]) * g0[2], fast_silu(a0[3]) * g0[3]);
                w.z = cvt_pk_bf16(fast_silu(a1[0]) * g1[0], fast_silu(a1[1]) * g1[1]); w.w = cvt_pk_bf16(fast_silu(a1[2]) * g1[2], fast_silu(a1[3]) * g1[3]);
                *(u32x4*)rowp = w; }
    }
};
struct EpiBf16Norm {
    static constexpr bool PERM = true, AFTER_DRAIN = false;
    bf16_t* O; int ldc; const float* ssq; const float* cbias; int cbld;
    __device__ __forceinline__ void operator()(const f32x4 (&acc)[2][2][4][2], const Unit& u, int wr, int wc, int fr, int fq) const {
        const int row0 = u.pm * BM + wr * 64 + fr; const int col0 = u.pn * BM + wc * 32 + 8 * fq;
        const int b = u.pm / 9; const int mrow = (u.pm - 9 * b == 0) ? 8 : b; const float* cp = cbias + (size_t)mrow * cbld + col0;
        f32x4 cb[2][2];
#pragma unroll
        for (int bj = 0; bj < 2; ++bj)
#pragma unroll
            for (int n = 0; n < 2; ++n) cb[bj][n] = *(const f32x4*)(cp + bj * HALF + 4 * n);
        float rsv[2][4];
#pragma unroll
        for (int ai = 0; ai < 2; ++ai)
#pragma unroll
            for (int m = 0; m < 4; ++m) rsv[ai][m] = ssq[row0 + ai * HALF + m * 16];
#pragma unroll
        for (int ai = 0; ai < 2; ++ai)
#pragma unroll
            for (int m = 0; m < 4; ++m) { const int row = row0 + ai * HALF + m * 16; bf16_t* rowp = O + (size_t)row * ldc + col0; const float rs = rsqrtf(rsv[ai][m] * (1.f / 1024.f) + 1e-6f);
#pragma unroll
                for (int bj = 0; bj < 2; ++bj) { const f32x4 v0 = acc[ai][bj][m][0] * rs + cb[bj][0], v1 = acc[ai][bj][m][1] * rs + cb[bj][1];
                    u32x4 w; w.x = cvt_pk_bf16(v0[0], v0[1]); w.y = cvt_pk_bf16(v0[2], v0[3]); w.z = cvt_pk_bf16(v1[0], v1[1]); w.w = cvt_pk_bf16(v1[2], v1[3]); *(u32x4*)(rowp + bj * HALF) = w; } }
    }
};
struct EpiMoeY2 {
    static constexpr bool PERM = true, AFTER_DRAIN = false;
    const float* slot_gate; bf16_t* Y2;
    __device__ __forceinline__ void operator()(const f32x4 (&acc)[2][2][4][2], const Unit& u, int wr, int wc, int fr, int fq) const {
        const int col0 = (u.pn & 3) * BM + wc * 32 + 8 * fq; const int slot0 = u.pm * BM + wr * 64 + fr;
#pragma unroll
        for (int ai = 0; ai < 2; ++ai)
#pragma unroll
            for (int m = 0; m < 4; ++m) { const int slot = slot0 + ai * HALF + m * 16; const float g = slot_gate[slot]; bf16_t* rowp = Y2 + (size_t)slot * 1024 + col0;
#pragma unroll
                for (int bj = 0; bj < 2; ++bj) { const f32x4 v0 = acc[ai][bj][m][0] * g, v1 = acc[ai][bj][m][1] * g;
                    u32x4 w; w.x = cvt_pk_bf16(v0[0], v0[1]); w.y = cvt_pk_bf16(v0[2], v0[3]); w.z = cvt_pk_bf16(v1[0], v1[1]); w.w = cvt_pk_bf16(v1[2], v1[3]);
                    *(u32x4*)(rowp + bj * HALF) = w; } }
    }
};
enum EpiMode { E_BF16 = 0, E_BF16NORM, E_RES, E_SWIGLU, E_MOEY2 };
struct EpiAny {
    static constexpr bool PERM = true, AFTER_DRAIN = false;
    int mode;
    bf16_t* O; int ldc, npn; const float* ssq; const float* cbias; int cbld;
    const float* xin; float* xout; const float* modbase; int compact, srcin, fuse; const float* xsrc_lat; const float* xsrc_ctx; const float* gnext; const float* nscale; float* ssqw;
    const float* slot_gate;
    __device__ __forceinline__ void res(const f32x4 (&acc)[2][2][4][2], const Unit& u, int wr, int wc, int fr, int fq) const {
        const int b = u.pm / 9, pj = u.pm - 9 * b; const int mrow = (pj == 0) ? 8 : b;
        const float* g = modbase + (size_t)mrow * 6144;
        const int col0 = u.pn * BM + wc * 32 + 8 * fq;
        f32x4 gv[2][2];
#pragma unroll
        for (int bj = 0; bj < 2; ++bj)
#pragma unroll
            for (int n = 0; n < 2; ++n) gv[bj][n] = *(const f32x4*)(g + col0 + bj * HALF + n * 4);
        const int row0 = u.pm * BM + wr * 64 + fr; const int oshift = compact ? 256 * (b + 1) : 0;
        const float* xbase = srcin ? (pj == 0 ? xsrc_ctx + (size_t)b * 256 * 1024 : xsrc_lat + ((size_t)b * 2048 + (pj - 1) * 256) * 1024) - (size_t)u.pm * BM * 1024 : xin;
        const float* ns = nscale + (size_t)mrow * 6144; bf16_t* hraw = O;
#pragma unroll
        for (int ai = 0; ai < 2; ++ai)
#pragma unroll
            for (int m = 0; m < 4; ++m) { const int row = row0 + ai * HALF + m * 16; const float* xi = xbase + (size_t)row * 1024 + col0; float* xo = xout + (size_t)(row - oshift) * 1024 + col0; float ss = 0.f;
#pragma unroll
                for (int bj = 0; bj < 2; ++bj)
#pragma unroll
                    for (int n = 0; n < 2; ++n) { const f32x4 v = *(const f32x4*)(xi + bj * HALF + n * 4) + gv[bj][n] * acc[ai][bj][m][n]; *(f32x4*)(xo + bj * HALF + n * 4) = v;
                        if (fuse) { const int c = col0 + bj * HALF + n * 4; const f32x4 hv = v * (*(const f32x4*)(gnext + c) * (*(const f32x4*)(ns + c) + 1.f));
                            ss += (v[0] * v[0] + v[1] * v[1]) + (v[2] * v[2] + v[3] * v[3]);
                            u32x2 w; w.x = cvt_pk_bf16(hv[0], hv[1]); w.y = cvt_pk_bf16(hv[2], hv[3]); *(u32x2*)(hraw + (size_t)row * 1024 + c) = w; } }
                if (fuse) { ss += __shfl_xor(ss, 16); ss += __shfl_xor(ss, 32); if (fq == 0) unsafeAtomicAdd(ssqw + row, ss); }
                if (m & 1) asm volatile("" ::: "memory"); }
    }
    __device__ __forceinline__ void operator()(const f32x4 (&acc)[2][2][4][2], const Unit& u, int wr, int wc, int fr, int fq) const {
        if (mode == E_BF16) { EpiBf16<0> e{O, ldc, nullptr, 0, 0, 1.f}; e(acc, u, wr, wc, fr, fq); }
        else if (mode == E_BF16NORM) { EpiBf16Norm e{O, ldc, ssq, cbias, cbld}; e(acc, u, wr, wc, fr, fq); }
        else if (mode == E_SWIGLU) { EpiSwiGLU e{O, ldc, npn, ssq, cbias, cbld}; e(acc, u, wr, wc, fr, fq); }
        else if (mode == E_MOEY2) { EpiMoeY2 e{slot_gate, O}; e(acc, u, wr, wc, fr, fq); }
        else res(acc, u, wr, wc, fr, fq);
    }
};
struct ChainOrder {
    int stage, c;
    __device__ __forceinline__ bool next(int i, Unit& u) const {
        const int x = c & 7, r = c >> 3; int lu = -1, nN = 4;
        if (stage == 0) { if (i == 0) lu = r; else if (i == 1 && r >= 16 && r < 20) lu = 16 + r; }
        else if (stage == 1) { nN = 22;
            if (i < 3) lu = 32 * i + r; else if (i == 3) { if (r < 30) lu = 96 + r; }
            else if (r < 28) { if (i < 6) lu = 126 + 28 * (i - 4) + r; else if (i == 6 && r < 16) lu = 182 + r; } }
        else if (stage == 2) { if (r >= 28) { if (i == 0) lu = r - 28; else if (i == 1) lu = r - 16; }
               else if (i == 0) { if (r < 16) lu = 20 + r; else { const int k = r - 16; lu = k < 8 ? 4 + k : 8 + k; } } }
        else {
            if (i < 2) lu = 32 * i + r; else if (i == 2 && r == 31) lu = 64;
            if (lu < 0) return false;
            if (lu == 64) { u.pm = 9 * x; u.pn = 7; } else { u.pm = 9 * x + 1 + (lu & 7); u.pn = lu >> 3; }
            return true; }
        if (lu < 0) return false;
        const unsigned long long perm = x == 6 ? 0x874310652ull : x == 7 ? 0x875421630ull : 0x876543210ull;
        const int g = lu / (3 * nN), w = lu - g * 3 * nN; u.pm = 9 * x + (int)((perm >> (4 * (3 * g + w % 3))) & 15ull); u.pn = w / 3; return true;
    }
};
struct MoeChainOrder {
    const PG8_LAS int* tb; int stage, c;
    __device__ __forceinline__ bool next(int i, Unit& u) const {
        const int x = c & 7, r = c >> 3, T = tb[8];
        const int t0 = (T * x) >> 3, n = ((T * (x + 1)) >> 3) - t0, j = r & 7, cc = r >> 3;
        int tile, col, nN;
        if (stage == 1) { nN = 4; tile = 8 * i + j; col = cc; if (tile >= n) return false; }
        else { nN = 28;
            const int kb = ((n & 7) == 1) ? 1 : 0, H = 4 * kb, tot = 28 * n + 12 * kb, A0 = tot >> 5, rem = tot & 31, ah = A0 - 3 * kb;
            const bool heavy = kb && j == 0;
            const int nr = r - (kb ? cc + (j > 0 ? 1 : 0) : 0);
            int m;
            if (i < ah) m = 32 * i + r;
            else { if (heavy) return false;
                   if (i < A0) m = 32 * ah + (32 - H) * (i - ah) + nr;
                   else if (i == A0 && nr < rem) m = 32 * ah + (32 - H) * (A0 - ah) + nr;
                   else return false; }
            if (m >= 28 * n) return false;
            const int g = m / 112, w = m - g * 112, gs = (n - 4 * g) < 4 ? (n - 4 * g) : 4; tile = 4 * g + w % gs; col = w / gs; }
        const int t = t0 + tile; int e = 0;
#pragma unroll
        for (int k = 1; k < 8; ++k) if (t >= tb[k]) e = k;
        u.pm = t; u.pn = e * nN + col; return true;
    }
};
struct OrderAny {
    int omode;
    DenseOrder d; MoeOrder m; ChainOrder ch; MoeChainOrder mch;
    mutable unsigned early, ew0, ew1, ew2, ew3;
    __device__ __forceinline__ bool next(int i, Unit& u) const {
        const bool ok = omode == 3 ? m.next(i, u) : omode == 4 ? ch.next(i, u) : omode == 5 ? mch.next(i, u) : d.next(i, u);
        if (ok && wcnt != nullptr) {
            early = __hip_atomic_load(wcnt + u.pm * 16, __ATOMIC_RELAXED, __HIP_MEMORY_SCOPE_AGENT);
            if (w2kind != 0) { int lo, hi; war_range(u, lo, hi);
                ew0 = __hip_atomic_load(w2cnt + (lo     <= hi ? lo     : u.pm) * 16, __ATOMIC_RELAXED, __HIP_MEMORY_SCOPE_AGENT);
                ew1 = __hip_atomic_load(w2cnt + (lo + 1 <= hi ? lo + 1 : u.pm) * 16, __ATOMIC_RELAXED, __HIP_MEMORY_SCOPE_AGENT);
                ew2 = __hip_atomic_load(w2cnt + (lo + 2 <= hi ? lo + 2 : u.pm) * 16, __ATOMIC_RELAXED, __HIP_MEMORY_SCOPE_AGENT);
                ew3 = __hip_atomic_load(w2cnt + (lo + 3 <= hi ? lo + 3 : u.pm) * 16, __ATOMIC_RELAXED, __HIP_MEMORY_SCOPE_AGENT); }
        }
        return ok;
    }
    unsigned* wcnt; unsigned wtarget; unsigned* dcnt; int rel_agent;
    unsigned* w2cnt; int w2kind;
    __device__ __forceinline__ void war_range(const Unit& u, int& lo, int& hi) const {
        if (w2kind == 1) { const int a0 = u.pm * 1441792 - 75497472, a1 = a0 + 1441791; lo = (a0 > 0 ? a0 : 0) >> 19; hi = a1 < 0 ? -1 : (a1 >> 19); }
        else { const int b0 = u.pm << 20; lo = b0 / 1441792; hi = (b0 + 1048575) / 1441792; }
    }
    __device__ __forceinline__ void a_ready(const Unit& u) const {
        if (wcnt != nullptr) {
            unsigned* p = wcnt + u.pm * 16; unsigned sp = 0u;
            unsigned mn = early;
            if (w2kind != 0) { const unsigned a = ew0 < ew1 ? ew0 : ew1, b = ew2 < ew3 ? ew2 : ew3, c2 = a < b ? a : b; mn = c2 < mn ? c2 : mn; }
            if (mn < wtarget) {
                while (__hip_atomic_load(p, __ATOMIC_RELAXED, __HIP_MEMORY_SCOPE_AGENT) < wtarget) { __builtin_amdgcn_s_sleep(1); if (++sp > (1u << 22)) break; }
                if (w2kind != 0) { int lo, hi; war_range(u, lo, hi);
                    for (int q = lo; q <= hi; ++q) while (__hip_atomic_load(w2cnt + q * 16, __ATOMIC_RELAXED, __HIP_MEMORY_SCOPE_AGENT) < wtarget) { __builtin_amdgcn_s_sleep(1); if (++sp > (1u << 22)) break; } }
            }
            if (rel_agent) __builtin_amdgcn_fence(__ATOMIC_ACQUIRE, "agent");
            asm volatile("" ::: "memory");
        }
    }
    __device__ __forceinline__ void done(const Unit& u) const {
        if (dcnt != nullptr) {
            if (rel_agent) __builtin_amdgcn_fence(__ATOMIC_RELEASE, "agent");
            asm volatile("s_waitcnt vmcnt(0)" ::: "memory");
            if ((threadIdx.x & 63) == 0) (void)__hip_atomic_fetch_add(dcnt + u.pm * 16, 1u, __ATOMIC_RELAXED, __HIP_MEMORY_SCOPE_AGENT);
        }
    }
};
}
#define GAS __attribute__((address_space(1)))
#define LAS __attribute__((address_space(3)))
typedef unsigned v4u __attribute__((ext_vector_type(4)));
typedef short bf16x8 __attribute__((ext_vector_type(8)));
namespace att {
using f32x16 = __attribute__((ext_vector_type(16))) float;
using s16x4 = __attribute__((ext_vector_type(4))) short;
typedef float f32x2_t __attribute__((ext_vector_type(2))); typedef __bf16 bf16x2_t __attribute__((ext_vector_type(2)));
__device__ __forceinline__ int crow(int r, int hi) { return (r & 3) + 8 * (r >> 2) + 4 * hi; }
__device__ __forceinline__ void glds16(const void* gsrc, unsigned lds_dst) { unsigned keep;
    asm volatile("s_mov_b32 %0, m0\n\ts_mov_b32 m0, %2\n\ts_nop 0\n\tglobal_load_lds_dwordx4 %1, off\n\ts_mov_b32 m0, %0" : "=&s"(keep) : "v"(gsrc), "s"(lds_dst) : "memory"); }
__device__ __forceinline__ unsigned cvtpk_s(float lo, float hi) { f32x2_t v = {lo, hi}; bf16x2_t b = __builtin_convertvector(v, bf16x2_t); return __builtin_bit_cast(unsigned, b); }
#define ATT_MX3(a, b, c) __builtin_fmaxf(__builtin_fmaxf((a), (b)), (c))
__device__ __forceinline__ float rowmax32(const f32x16& p0, const f32x16& p1) {
    float a = ATT_MX3(p0[0], p0[1], p1[0]), b = ATT_MX3(p0[2], p0[3], p1[1]); a = ATT_MX3(a, p1[2], p1[3]);
#pragma unroll
    for (int r = 4; r < 16; r += 4) { a = ATT_MX3(a, p0[r], p0[r + 1]); b = ATT_MX3(b, p0[r + 2], p0[r + 3]); a = ATT_MX3(a, p1[r], p1[r + 1]); b = ATT_MX3(b, p1[r + 2], p1[r + 3]); }
    a = __builtin_fmaxf(a, b);
    auto rr = __builtin_amdgcn_permlane32_swap(__float_as_uint(a), __float_as_uint(a), false, false);
    return fmaxf(__uint_as_float(rr[0]), __uint_as_float(rr[1]));
}
__device__ __forceinline__ void pv(f32x16* o, int vb, bf16x8 pa0, bf16x8 pa1, bf16x8 pa2, bf16x8 pa3) {
    s16x4 lo[2][4], hi[2][4];
#pragma unroll
    for (int d0 = 0; d0 < 2; ++d0)
#pragma unroll
        for (int ks = 0; ks < 4; ++ks) {
            asm volatile("ds_read_b64_tr_b16 %0,%1 offset:%c2" : "=&v"(lo[d0][ks]) : "v"(vb), "i"(d0 * 4096 + ks * 1024) : "memory");
            asm volatile("ds_read_b64_tr_b16 %0,%1 offset:%c2" : "=&v"(hi[d0][ks]) : "v"(vb), "i"(d0 * 4096 + ks * 1024 + 512) : "memory"); }
    asm volatile("s_waitcnt lgkmcnt(0)" ::: "memory"); __builtin_amdgcn_sched_barrier(0);
#define ATT_PK(d, k) (bf16x8){lo[d][k][0], lo[d][k][1], lo[d][k][2], lo[d][k][3], hi[d][k][0], hi[d][k][1], hi[d][k][2], hi[d][k][3]}
    o[0] = __builtin_amdgcn_mfma_f32_32x32x16_bf16(pa0, ATT_PK(0, 0), o[0], 0, 0, 0); o[1] = __builtin_amdgcn_mfma_f32_32x32x16_bf16(pa0, ATT_PK(1, 0), o[1], 0, 0, 0);
    o[0] = __builtin_amdgcn_mfma_f32_32x32x16_bf16(pa1, ATT_PK(0, 1), o[0], 0, 0, 0); o[1] = __builtin_amdgcn_mfma_f32_32x32x16_bf16(pa1, ATT_PK(1, 1), o[1], 0, 0, 0);
    o[0] = __builtin_amdgcn_mfma_f32_32x32x16_bf16(pa2, ATT_PK(0, 2), o[0], 0, 0, 0); o[1] = __builtin_amdgcn_mfma_f32_32x32x16_bf16(pa2, ATT_PK(1, 2), o[1], 0, 0, 0);
    o[0] = __builtin_amdgcn_mfma_f32_32x32x16_bf16(pa3, ATT_PK(0, 3), o[0], 0, 0, 0); o[1] = __builtin_amdgcn_mfma_f32_32x32x16_bf16(pa3, ATT_PK(1, 3), o[1], 0, 0, 0);
#undef ATT_PK
}
template <int DQ> struct Geo {
    static constexpr int NCH = DQ / 8, KSLOT = NCH * 1024, VSLOT = 8192;
    static constexpr int LDS_K = 0, LDS_V = 2 * KSLOT, LDS_WS = LDS_V + 2 * VSLOT, LDS_OST = LDS_WS + 8 * 256, LDS_BYTES = LDS_OST + 8 * 4096;
};
template <int DQ>
__device__ __forceinline__ void unit(int b, int hq, int hk, int qb, int NT, const bf16_t* __restrict__ Q, int ldq, const bf16_t* __restrict__ K, int ldk, const bf16_t* __restrict__ V, int ldv,
                                     bf16_t* __restrict__ O, int ldo, LAS unsigned char* shm) {
    typedef Geo<DQ> G; constexpr int ND0 = DQ / 16;
    const int tid = threadIdx.x, lane = tid & 63, r32 = lane & 31, hi = lane >> 5; const int wid = __builtin_amdgcn_readfirstlane(tid >> 6);
    const long rowbase = (long)b * RPB; const int q0 = qb * 256;
    const bf16_t* Qw = Q + (rowbase + q0 + wid * 32) * ldq + hq * DQ;
    const bf16_t* Kh = K + rowbase * ldk + hk * DQ; const bf16_t* Vh = V + rowbase * ldv + hk * 64;
    const unsigned lds0 = (unsigned)(uintptr_t)shm;
    LAS float* wsf = (LAS float*)(shm + G::LDS_WS) + wid * 64;
    const bf16_t* ksrc = Kh + (long)lane * ldk + wid * 8;
    const bf16_t* vsrc = Vh + (long)(16 * (wid & 3) + (lane >> 2)) * ldv + (wid >> 2) * 32 + (lane & 3) * 8;
    const unsigned kdst = lds0 + G::LDS_K + wid * 1024, vdst = lds0 + G::LDS_V + wid * 1024;
    const int vb0 = (int)(lds0 + G::LDS_V) + ((lane >> 4) & 1) * 32 + (lane & 3) * 8 + (4 * hi + ((lane & 15) >> 2)) * 64;
#define ATT_DMA(t, s) do { const bf16_t* kp_ = ksrc + (long)(t) * 64 * ldk; glds16(kp_, (unsigned)__builtin_amdgcn_readfirstlane(kdst + (s) * G::KSLOT)); \
        if (DQ == 96 && wid < 4) glds16(kp_ + 64, (unsigned)__builtin_amdgcn_readfirstlane(kdst + (s) * G::KSLOT + 8192)); \
        glds16(vsrc + (long)(t) * 64 * ldv, (unsigned)__builtin_amdgcn_readfirstlane(vdst + (s) * G::VSLOT)); } while (0)
    ATT_DMA(0, 0);
    bf16x8 qr[ND0];
#pragma unroll
    for (int d0 = 0; d0 < ND0; ++d0) qr[d0] = *reinterpret_cast<const bf16x8*>(&Qw[(long)r32 * ldq + d0 * 16 + hi * 8]);
    constexpr float THR = 8.f;
    float mref = 0.f, l_reg = 0.f; f32x16 o[2]; o[0] = f32x16{}; o[1] = f32x16{}; f32x16 negm = f32x16{};
    for (int t = 0; t < NT; ++t) {
        const int s = t & 1;
        asm volatile("s_waitcnt vmcnt(0) lgkmcnt(0)\n\ts_barrier" ::: "memory");
        if (t + 1 < NT) ATT_DMA(t + 1, s ^ 1);
        f32x16 p0, p1;
        { const LAS unsigned char* kb = shm + G::LDS_K + s * G::KSLOT + hi * 1024 + r32 * 16;
#pragma unroll
          for (int d0 = 0; d0 < ND0; ++d0) { const bf16x8 b0 = *(const LAS bf16x8*)(kb + d0 * 2048); const bf16x8 b1 = *(const LAS bf16x8*)(kb + d0 * 2048 + 512);
              p0 = __builtin_amdgcn_mfma_f32_32x32x16_bf16(b0, qr[d0], d0 == 0 ? negm : p0, 0, 0, 0); p1 = __builtin_amdgcn_mfma_f32_32x32x16_bf16(b1, qr[d0], d0 == 0 ? negm : p1, 0, 0, 0); } }
        const float rm = rowmax32(p0, p1);
        if (__builtin_expect(t == 0 || __any(rm > THR), 0)) {
            const float dl = t == 0 ? rm : __builtin_fmaxf(rm, 0.f); mref += dl;
#pragma unroll
            for (int r = 0; r < 16; ++r) { p0[r] -= dl; p1[r] -= dl; negm[r] = -mref; }
            const float alpha = t == 0 ? 1.f : __builtin_amdgcn_exp2f(-dl); l_reg *= alpha;
            if (hi == 0) wsf[r32] = alpha;
            asm volatile("s_waitcnt lgkmcnt(0)" ::: "memory");
#pragma unroll
            for (int r = 0; r < 16; ++r) { const float a = wsf[crow(r, hi)]; o[0][r] *= a; o[1][r] *= a; }
        }
        f32x2_t sacc = {0.f, 0.f};
#pragma unroll
        for (int r = 0; r < 16; r += 2) { p0[r] = __builtin_amdgcn_exp2f(p0[r]); p0[r + 1] = __builtin_amdgcn_exp2f(p0[r + 1]); p1[r] = __builtin_amdgcn_exp2f(p1[r]); p1[r + 1] = __builtin_amdgcn_exp2f(p1[r + 1]);
            sacc += (f32x2_t){p0[r], p0[r + 1]}; sacc += (f32x2_t){p1[r], p1[r + 1]}; }
        l_reg += sacc[0] + sacc[1];
        u32x4 pw0, pw1, pw2, pw3;
        pw0 = (u32x4){cvtpk_s(p0[0], p0[1]), cvtpk_s(p0[2], p0[3]), cvtpk_s(p0[4], p0[5]), cvtpk_s(p0[6], p0[7])};
        pw1 = (u32x4){cvtpk_s(p0[8], p0[9]), cvtpk_s(p0[10], p0[11]), cvtpk_s(p0[12], p0[13]), cvtpk_s(p0[14], p0[15])};
        pw2 = (u32x4){cvtpk_s(p1[0], p1[1]), cvtpk_s(p1[2], p1[3]), cvtpk_s(p1[4], p1[5]), cvtpk_s(p1[6], p1[7])};
        pw3 = (u32x4){cvtpk_s(p1[8], p1[9]), cvtpk_s(p1[10], p1[11]), cvtpk_s(p1[12], p1[13]), cvtpk_s(p1[14], p1[15])};
        pv(o, vb0 + s * G::VSLOT, __builtin_bit_cast(bf16x8, pw0), __builtin_bit_cast(bf16x8, pw1), __builtin_bit_cast(bf16x8, pw2), __builtin_bit_cast(bf16x8, pw3));
    }
#undef ATT_DMA
    { auto rr = __builtin_amdgcn_permlane32_swap(__float_as_uint(l_reg), __float_as_uint(l_reg), false, false); l_reg = __uint_as_float(rr[0]) + __uint_as_float(rr[1]); }
    if (hi == 0) wsf[32 + r32] = l_reg;
    asm volatile("s_waitcnt lgkmcnt(0)" ::: "memory");
    float rli[16];
#pragma unroll
    for (int r = 0; r < 16; ++r) rli[r] = __builtin_amdgcn_rcpf(wsf[32 + crow(r, hi)]);
    bf16_t* Ow = O + (rowbase + q0 + wid * 32) * ldo + hq * 64;
    { LAS bf16_t* stg = (LAS bf16_t*)(shm + G::LDS_OST) + wid * 2048;
#pragma unroll
      for (int r = 0; r < 16; ++r) { const int orow = crow(r, hi);
#pragma unroll
          for (int d0 = 0; d0 < 2; ++d0) stg[orow * 64 + d0 * 32 + r32] = f2bf(o[d0][r] * rli[r]); }
      asm volatile("s_waitcnt lgkmcnt(0)" ::: "memory");
#pragma unroll
      for (int i = 0; i < 4; ++i) { const int row = i * 8 + (lane >> 3), ch = lane & 7; const u32x4 v = *(const LAS u32x4*)(stg + row * 64 + ch * 8); *(u32x4*)(Ow + (long)row * ldo + ch * 8) = v; } }
    asm volatile("s_waitcnt lgkmcnt(0)\n\ts_barrier" ::: "memory");
}
}
#define LDS_WAIT() asm volatile("s_waitcnt lgkmcnt(0)" ::: "memory")
#define VM_WAIT() asm volatile("s_waitcnt vmcnt(0)" ::: "memory")
constexpr int NWAVES = 8, NTHREADS = 512;
constexpr int RING_OFF = 0, RING_BYTES = 131072;
constexpr int MISC_OFF = RING_BYTES;
constexpr int LDS_BYTES = 147456;

enum Phase { PH_P0 = 0, PH_NORM0, PH_G_IN0, PH_LRUPREP, PH_MIX0, PH_G_OUT0, PH_G_F1, PH_G_F2, PH_G_IN1, PH_PREP1, PH_G_QKVB, PH_PREP2, PH_MIX1, PH_G_OUT1,
             PH_ROUTE, PH_SLOT, PH_MOE1, PH_MOE2, PH_COMBINE, PH_COUNT,
             PH_G_QB = 100, PH_G_KVB = 101 };

struct Params { const float* i0; const float* i1; const float* i2; const float* i3; const float* i4; const float* i5; const float* i6; const float* i7; const float* i8; const float* i9; const float* i10; const float* i11; const float* i12; const float* i13; const float* i14; const float* i15; const float* i16; const float* i17; const float* i18; const float* i19; const float* i20; const float* i21; const float* i22; const float* i23; const float* i24; const float* i25; const float* i26; const float* i27; const float* i28; const float* i29; const float* i30; const float* i31; const float* i32; const float* i33; const float* i34; const float* i35; const float* i36; const float* i37; const float* i38; const float* i39; const float* i40; const float* i41; const float* i42; float* out; char* ws; int ph_lo, ph_hi; };
#define PIN(k) (P.i##k)
static_assert(sizeof(Params) == 43 * 8 + 8 + 8 + 8, "Params has no padding");

struct Frame { LAS unsigned char* lds; int tid, lane, wave, G, bid, even; char* ws; };

__device__ __forceinline__ void tr_item(const float* __restrict__ W, int N, bf16_t* __restrict__ WT, int ldk, int kb, int nb, int dst_row0, LAS float* scr, int lane) {
    const int k0 = 64 * kb, n0 = 32 * nb;
    f32x4 v[8]; const float* wp = W + (size_t)(k0 + (lane >> 3)) * N + n0 + 4 * (lane & 7);
#pragma unroll
    for (int i = 0; i < 8; ++i) v[i] = __builtin_nontemporal_load((const f32x4*)(wp + (size_t)(8 * i) * N));
#pragma unroll
    for (int i = 0; i < 8; ++i) { LAS float* sp = scr + (8 * i + (lane >> 3)) * 33 + 4 * (lane & 7); sp[0] = v[i][0]; sp[1] = v[i][1]; sp[2] = v[i][2]; sp[3] = v[i][3]; }
    LDS_WAIT(); asm volatile("" ::: "memory");
    const int c = lane & 7;
#pragma unroll
    for (int j = 0; j < 4; ++j) { const int n = (lane >> 3) + 8 * j; const LAS float* s = scr + (8 * c) * 33 + n;
        v4u o; o.x = pk2(s[0 * 33], s[1 * 33]); o.y = pk2(s[2 * 33], s[3 * 33]); o.z = pk2(s[4 * 33], s[5 * 33]); o.w = pk2(s[6 * 33], s[7 * 33]);
        *(v4u*)(WT + (size_t)(dst_row0 + n) * ldk + k0 + 8 * c) = o; }
    LDS_WAIT(); asm volatile("" ::: "memory");
}
constexpr int MOE_ITEMS = 8 * 3 * 1792, MOE_CHUNK = 32, MOE_NCHUNK = MOE_ITEMS / MOE_CHUNK;
__device__ __forceinline__ void moe_conv_item(const Frame& F, const Params& P, int it, LAS float* scr) {
    const int e = it / 5376, r = it % 5376, which = r / 1792, q = r % 1792; char* ws = F.ws;
    const float* src; bf16_t* dst; int N, ldk, kb, nb, dr;
    if (which < 2) { kb = q / 112; nb = q % 112; const int n0 = nb * 32; dr = (n0 >> 7) * 256 + (n0 & 127) + (which == 1 ? 128 : 0);
        src = (which == 0 ? PIN(40) : PIN(41)) + (size_t)e * 1024 * 3584; N = 3584; dst = (bf16_t*)(ws + WS_W13M) + (size_t)e * 7168 * 1024; ldk = 1024; }
    else { kb = q / 32; nb = q % 32; dr = nb * 32; src = PIN(42) + (size_t)e * 3584 * 1024; N = 1024; dst = (bf16_t*)(ws + WS_W2M) + (size_t)e * 1024 * 3584; ldk = 3584; }
    tr_item(src, N, dst, ldk, kb, nb, dr, scr, F.lane);
}
struct TrDesc { const float* src; bf16_t* dst; int N, ldk, kb, nb, dr; };
__device__ __forceinline__ void moe_desc(const Frame& F, const Params& P, int it, TrDesc& d) {
    const int e = it / 5376, r = it % 5376, which = r / 1792, q = r % 1792; char* ws = F.ws;
    if (which < 2) { d.kb = q / 112; d.nb = q % 112; const int n0 = d.nb * 32; d.dr = (n0 >> 7) * 256 + (n0 & 127) + (which == 1 ? 128 : 0);
        d.src = (which == 0 ? PIN(40) : PIN(41)) + (size_t)e * 1024 * 3584; d.N = 3584; d.dst = (bf16_t*)(ws + WS_W13M) + (size_t)e * 7168 * 1024; d.ldk = 1024; }
    else { d.kb = q / 32; d.nb = q % 32; d.dr = d.nb * 32; d.src = PIN(42) + (size_t)e * 3584 * 1024; d.N = 1024; d.dst = (bf16_t*)(ws + WS_W2M) + (size_t)e * 1024 * 3584; d.ldk = 3584; }
}
__device__ __forceinline__ void tr_load(const TrDesc& d, int lane, f32x4 (&v)[8]) {
    const float* wp = d.src + (size_t)(64 * d.kb + (lane >> 3)) * d.N + 32 * d.nb + 4 * (lane & 7);
#pragma unroll
    for (int i = 0; i < 8; ++i) v[i] = __builtin_nontemporal_load((const f32x4*)(wp + (size_t)(8 * i) * d.N));
}
__device__ __forceinline__ void tr_store(const TrDesc& d, const f32x4 (&v)[8], LAS float* scr, int lane) {
    const int k0 = 64 * d.kb;
#pragma unroll
    for (int i = 0; i < 8; ++i) { LAS float* sp = scr + (8 * i + (lane >> 3)) * 33 + 4 * (lane & 7); sp[0] = v[i][0]; sp[1] = v[i][1]; sp[2] = v[i][2]; sp[3] = v[i][3]; }
    LDS_WAIT(); asm volatile("" ::: "memory");
    const int c = lane & 7;
#pragma unroll
    for (int j = 0; j < 4; ++j) { const int n = (lane >> 3) + 8 * j; const LAS float* sq = scr + (8 * c) * 33 + n;
        v4u o; o.x = pk2(sq[0 * 33], sq[1 * 33]); o.y = pk2(sq[2 * 33], sq[3 * 33]); o.z = pk2(sq[4 * 33], sq[5 * 33]); o.w = pk2(sq[6 * 33], sq[7 * 33]);
        *(v4u*)(d.dst + (size_t)(d.dr + n) * d.ldk + k0 + 8 * c) = o; }
    LDS_WAIT(); asm volatile("" ::: "memory");
}
__device__ __forceinline__ void moe_conv_all(const Frame& F, const Params& P, int it0, int it1) {
    LAS float* scr = (LAS float*)(F.lds + RING_OFF + F.wave * 16384); const int gw = F.bid * NWAVES + F.wave, NGW = F.G * NWAVES;
    __syncthreads();
    TrDesc d0, d1; f32x4 v[8], w[8]; int it = it0 + gw;
    if (it < it1) { moe_desc(F, P, it, d0); tr_load(d0, F.lane, v); }
#pragma unroll 1
    for (; it < it1; it += NGW) {
        const bool more = it + NGW < it1;
        if (more) { moe_desc(F, P, it + NGW, d1); tr_load(d1, F.lane, w); }
        tr_store(d0, v, scr, F.lane);
        if (more) { d0 = d1;
#pragma unroll
            for (int i = 0; i < 8; ++i) v[i] = w[i]; }
    }
    __syncthreads();
}
struct ConvDesc { const float* src; bf16_t* dst; int N, ldk, nblk, start, il, pad; };
__device__ __forceinline__ void phase_conv(const Frame& F, const Params& P, bool moe) {
    LAS float* scr = (LAS float*)(F.lds + RING_OFF + F.wave * 16384); char* ws = F.ws;
    LAS ConvDesc* tab = (LAS ConvDesc*)(F.lds + MISC_OFF);
    if (F.tid < 41) { const int t = F.tid; ConvDesc d; d.il = 0; d.pad = 0;
        if (t == 0) { d.src = PIN(8); d.dst = (bf16_t*)(ws + WS_WIN0); d.N = 1792; d.ldk = 1024; d.start = 16 * 56; }
        else if (t == 1) { d.src = PIN(9); d.dst = (bf16_t*)(ws + WS_WOUT0); d.N = 1024; d.ldk = 1024; d.start = 16 * 32; }
        else if (t == 2) { d.src = PIN(19); d.dst = (bf16_t*)(ws + WS_WF13); d.N = 2816; d.ldk = 1024; d.start = 16 * 88; d.il = 1; }
        else if (t == 3) { d.src = PIN(20); d.dst = (bf16_t*)(ws + WS_WF13); d.N = 2816; d.ldk = 1024; d.start = 16 * 88; d.il = 2; }
        else if (t == 4) { d.src = PIN(21); d.dst = (bf16_t*)(ws + WS_WF2); d.N = 1024; d.ldk = 2816; d.start = 44 * 32; }
        else if (t == 5) { d.src = PIN(22); d.dst = (bf16_t*)(ws + WS_WIN1); d.N = 1952; d.ldk = 1024; d.start = 16 * 61; }
        else if (t == 6) { d.src = PIN(23); d.dst = (bf16_t*)(ws + WS_WOUT1); d.N = 1024; d.ldk = 1024; d.start = 16 * 32; }
        else if (t == 7) { d.src = PIN(34); d.dst = (bf16_t*)(ws + WS_WQB); d.N = 768; d.ldk = 256; d.start = 4 * 24; }
        else if (t == 8) { d.src = PIN(36); d.dst = (bf16_t*)(ws + WS_WKVB); d.N = 1024; d.ldk = 256; d.start = 2 * 32; }
        else { const int q = t - 9, dn = q >> 1, g = q & 1; d.src = (g ? PIN(14) : PIN(12)) + (size_t)dn * 4096; d.dst = (bf16_t*)(ws + WS_WLRU) + (size_t)(dn * 2 + g) * 4096; d.N = 64; d.ldk = 64; d.start = 2; }
        d.nblk = d.N / 32;
        tab[t].src = d.src; tab[t].dst = d.dst; tab[t].N = d.N; tab[t].ldk = d.ldk; tab[t].nblk = d.nblk; tab[t].start = d.start; tab[t].il = d.il; tab[t].pad = 0; }
    __syncthreads();
    if (F.tid == 0) { int s = 0; for (int t = 0; t < 41; ++t) { const int c = tab[t].start; tab[t].start = s; s += c; } tab[0].pad = s; }
    __syncthreads();
    const int total = tab[0].pad; const int gw = F.bid * NWAVES + F.wave, NGW = F.G * NWAVES;
#pragma unroll 1
    for (int it = gw; it < total; it += NGW) { int e = 0;
#pragma unroll 1
        for (int t = 1; t < 41; ++t) if (it >= tab[t].start) e = t;
        ConvDesc d; d.src = tab[e].src; d.dst = tab[e].dst; d.N = tab[e].N; d.ldk = tab[e].ldk; d.nblk = tab[e].nblk; d.start = tab[e].start; d.il = tab[e].il;
        const int loc = it - d.start, kb = loc / d.nblk, nb = loc % d.nblk, n0 = nb * 32;
        const int dr = d.il == 0 ? n0 : ((n0 >> 7) * 256 + (n0 & 127) + (d.il == 2 ? 128 : 0));
        tr_item(d.src, d.N, d.dst, d.ldk, kb, nb, dr, scr, F.lane); }
    const int gt = F.bid * NTHREADS + F.tid, NGT = F.G * NTHREADS;
    { v4u* z = (v4u*)((bf16_t*)(ws + WS_WIN1) + (size_t)1952 * 1024); for (int i = gt; i < 96 * 1024 / 8; i += NGT) z[i] = (v4u){0u, 0u, 0u, 0u}; }
    { bf16_t* wk = (bf16_t*)(ws + WS_WKVB); for (int i = gt; i < 1024 * 16; i += NGT) { const int r = i >> 4, cc = i & 15; *(v4u*)(wk + (size_t)r * 256 + 128 + cc * 8) = (v4u){0u, 0u, 0u, 0u}; } }
    __syncthreads();
}

constexpr size_t CT_TB = 64 * 1024;
enum GemmId { G_IN0 = 0, G_OUT0, G_F1, G_F2, G_IN1, G_QB, G_KVB, G_OUT1, G_MOE1, G_MOE2 };
__device__ __forceinline__ void run_gemm(const Frame& F, const Params& P, int gid) {
    char* ws = F.ws; float* MOD = (float*)(ws + WS_MOD); const float* MOD1 = MOD + 9 * MODLD; LAS unsigned char* lds = F.lds + RING_OFF;
    float* X = (float*)(ws + WS_X); bf16_t* H = (bf16_t*)(ws + WS_H); LAS int* tb = (LAS int*)(F.lds + MISC_OFF);
    pg8::Gemm g; pg8::OrderAny S; pg8::EpiAny E;
    E.mode = pg8::E_BF16; E.O = nullptr; E.ldc = 0; E.npn = 1; E.ssq = nullptr; E.cbias = nullptr; E.cbld = 0; E.xin = X; E.xout = X; E.modbase = MOD; E.compact = 0; E.srcin = 0; E.fuse = 0;
    E.xsrc_lat = PIN(0); E.xsrc_ctx = PIN(2); E.gnext = PIN(7); E.nscale = MOD; E.ssqw = (float*)(ws + WS_CTL + CT_SSQA); E.slot_gate = (const float*)(ws + WS_SLOTGATE);
    S.wcnt = nullptr; S.dcnt = nullptr; S.wtarget = 0u; S.w2cnt = nullptr; S.w2kind = 0; S.rel_agent = F.even ? 0 : 1; unsigned* PCNT = (unsigned*)(ws + WS_CTL + CT_PCNT);
    S.omode = 0; S.m.tb = tb; S.m.nN = 28; S.m.G = F.G; S.m.c = F.bid; g.M = MROWS; g.N = 0;
    if (gid == G_IN0) { g.A = H; g.Bt = (const bf16_t*)(ws + WS_WIN0); g.K = 1024; S.d.init(72, 7, F.G, F.bid, 0); E.O = (bf16_t*)(ws + WS_Z); E.ldc = 1792; }
    else if (gid == G_OUT0) { g.A = (const bf16_t*)(ws + WS_Y); g.Bt = (const bf16_t*)(ws + WS_WOUT0); g.K = 1024; S.d.init(72, 4, F.G, F.bid, 0); S.omode = 4; S.ch.stage = 0; S.ch.c = F.bid; S.dcnt = PCNT;
        E.mode = pg8::E_RES; E.modbase = MOD + 2 * DM; E.srcin = 1; E.fuse = 1; E.O = H; E.gnext = PIN(7); E.nscale = MOD + 4 * DM; E.ssqw = (float*)(ws + WS_CTL + CT_SSQA); }
    else if (gid == G_F1) { g.A = H; g.Bt = (const bf16_t*)(ws + WS_WF13); g.K = 1024; S.d.init(72, 22, F.G, F.bid, 0); S.omode = 4; S.ch.stage = 1; S.ch.c = F.bid; S.wcnt = PCNT; S.wtarget = 32u; S.dcnt = PCNT + 72 * 16; S.w2cnt = PCNT; S.w2kind = 1;
        E.mode = pg8::E_SWIGLU; E.O = (bf16_t*)(ws + WS_ACT); E.ldc = DFF; E.npn = 22; E.ssq = (const float*)(ws + WS_CTL + CT_SSQA); E.cbias = (const float*)(ws + WS_CBF1); E.cbld = 5632; }
    else if (gid == G_F2) { g.A = (const bf16_t*)(ws + WS_ACT); g.Bt = (const bf16_t*)(ws + WS_WF2); g.K = 2816; S.d.init(72, 4, F.G, F.bid, 0); S.omode = 4; S.ch.stage = 2; S.ch.c = F.bid; S.wcnt = PCNT + 72 * 16; S.wtarget = 176u; S.dcnt = PCNT + 144 * 16;
        E.mode = pg8::E_RES; E.modbase = MOD + 5 * DM; E.fuse = 1; E.O = H; E.gnext = PIN(6) + DM; E.nscale = MOD1 + 1 * DM; E.ssqw = (float*)(ws + WS_CTL + CT_SSQB); }
    else if (gid == G_IN1) { g.A = H; g.Bt = (const bf16_t*)(ws + WS_WIN1); g.K = 1024; S.d.init(64, 8, F.G, F.bid, 2); S.omode = 4; S.ch.stage = 3; S.ch.c = F.bid; S.wcnt = PCNT + 144 * 16; S.wtarget = 32u; S.w2cnt = PCNT + 144 * 16; S.w2kind = 2;
        E.mode = pg8::E_BF16NORM; E.O = (bf16_t*)(ws + WS_Z); E.ldc = 2048; E.ssq = (const float*)(ws + WS_CTL + CT_SSQB); E.cbias = (const float*)(ws + WS_CBIN1); E.cbld = 2048; }
    else if (gid == G_QB) { g.A = (const bf16_t*)(ws + WS_QA); g.Bt = (const bf16_t*)(ws + WS_WQB); g.K = 256; S.d.init(64, 3, F.G, F.bid, 1); S.omode = 1; E.O = (bf16_t*)(ws + WS_QR); E.ldc = 768; }
    else if (gid == G_KVB) { g.A = (const bf16_t*)(ws + WS_KVA); g.Bt = (const bf16_t*)(ws + WS_WKVB); g.K = 256; S.d.init(72, 4, F.G, F.bid, 0); E.O = (bf16_t*)(ws + WS_KVR); E.ldc = 1024; }
    else if (gid == G_OUT1) { g.A = (const bf16_t*)(ws + WS_Y); g.Bt = (const bf16_t*)(ws + WS_WOUT1); g.K = 1024; S.d.init(64, 4, F.G, F.bid, 1); S.omode = 1;
        E.mode = pg8::E_RES; E.xout = P.out; E.modbase = MOD1 + 2 * DM; E.compact = 1; }
    else { if (F.tid < 9) tb[F.tid] = ((const int*)(ws + WS_CTL + CT_TB))[F.tid];
        __syncthreads();
        S.omode = 5; S.d.init(1, 1, F.G, F.bid, 0); S.mch.tb = tb; S.mch.c = F.bid; unsigned* MCNT = (unsigned*)(ws + WS_CTL + CT_MCNT);
        if (gid == G_MOE1) { g.A = (const bf16_t*)(ws + WS_XG); g.Bt = (const bf16_t*)(ws + WS_W13M); g.K = 1024; S.m.nN = 28; S.mch.stage = 0; S.dcnt = MCNT; E.mode = pg8::E_SWIGLU; E.O = (bf16_t*)(ws + WS_ACT2); E.ldc = DFE; E.npn = 28; }
        else { g.A = (const bf16_t*)(ws + WS_ACT2); g.Bt = (const bf16_t*)(ws + WS_W2M); g.K = 3584; S.m.nN = 4; S.mch.stage = 1; S.wcnt = MCNT; S.wtarget = 224u; E.mode = pg8::E_MOEY2; E.O = (bf16_t*)(ws + WS_Y2); } }
    if (S.wcnt != nullptr) __builtin_amdgcn_fence(__ATOMIC_ACQUIRE, "agent");
    pg8::gemm_phase<pg8::EpiAny, pg8::OrderAny, true, true>(lds, g, S, E);
    __syncthreads();
}

__device__ __forceinline__ void phase_attn0(const Frame& F) {
    char* ws = F.ws; LAS unsigned char* lds = F.lds + RING_OFF;
    for (int i = 0;; ++i) { const int L = i * F.G + F.bid; if (L >= 576) break; const int b = L & 7, idx = L >> 3;
        const int h = idx < 64 ? (idx >> 3) : idx - 64, qb = idx < 64 ? 1 + (idx & 7) : 0, NT = idx < 64 ? 36 : 4;
        att::unit<64>(b, h, h >> 2, qb, NT, (const bf16_t*)(ws + WS_QB), 512, (const bf16_t*)(ws + WS_KB), 128, (const bf16_t*)(ws + WS_VB), 128, (bf16_t*)(ws + WS_Y) + 512, DM, lds); }
}
__device__ __forceinline__ void phase_attn1(const Frame& F, const Params& P) {
    char* ws = F.ws; char* dob = (char*)P.out; LAS unsigned char* lds = F.lds + RING_OFF;
    for (int i = 0;; ++i) { const int L = i * F.G + F.bid; if (L >= 512) break; const int b = L & 7, idx = L >> 3; const int h = idx >> 3, qb = 1 + (idx & 7);
        att::unit<96>(b, h, h, qb, 36, (const bf16_t*)(ws + WS_QM), 768, (const bf16_t*)(dob + DO_KM), 768, (const bf16_t*)(dob + DO_VM), 512, (bf16_t*)(ws + WS_Y) + 512, DM, lds); }
}

__device__ __forceinline__ void phase_route(const Frame& F, const Params& P) {
    char* ws = F.ws; const float* X = P.out; const float* g = PIN(7) + DM; const float* MODL = (const float*)(ws + WS_MOD) + 9 * MODLD; const float* router = PIN(39);
    bf16_t* H2 = (bf16_t*)(ws + WS_H2); int* SEL = (int*)(ws + WS_SEL); int* HIST = (int*)(ws + WS_CTL + CT_HIST);
    LAS int* hist = (LAS int*)(F.lds + MISC_OFF);
    if (F.tid < 8) hist[F.tid] = 0;
    __syncthreads();
    const int rpb = NLAT / F.G, rpw = rpb / NWAVES;
    const int lane = F.lane;
    f32x4 rw[4][4][2], gsc[4], shv[4];
    { const float* md = MODL + (size_t)((F.bid * rpb) / SEQ) * MODLD;
#pragma unroll
      for (int j4 = 0; j4 < 4; ++j4) { const int k = 4 * lane + 256 * j4; gsc[j4] = *(const f32x4*)(g + k) * (*(const f32x4*)(md + 4 * DM + k) + 1.f); shv[j4] = *(const f32x4*)(md + 3 * DM + k);
#pragma unroll
          for (int c = 0; c < 4; ++c) { rw[j4][c][0] = *(const f32x4*)(router + (size_t)(k + c) * 8); rw[j4][c][1] = *(const f32x4*)(router + (size_t)(k + c) * 8 + 4); } } }
#pragma unroll 1
    for (int q0 = 0; q0 < rpw; q0 += 2) {
      f32x4 vv[2][4];
#pragma unroll
      for (int qq = 0; qq < 2; ++qq) { const float* xr = X + (size_t)(F.bid * rpb + F.wave * rpw + q0 + qq) * DM;
#pragma unroll
          for (int j4 = 0; j4 < 4; ++j4) vv[qq][j4] = *(const f32x4*)(xr + 4 * lane + 256 * j4); }
#pragma unroll
      for (int qq = 0; qq < 2; ++qq) {
        const int m = F.bid * rpb + F.wave * rpw + q0 + qq;
        f32x4 (&v)[4] = vv[qq]; float ss = 0.f;
#pragma unroll
        for (int j4 = 0; j4 < 4; ++j4) ss += (v[j4][0] * v[j4][0] + v[j4][1] * v[j4][1]) + (v[j4][2] * v[j4][2] + v[j4][3] * v[j4][3]);
        const float rstd = rsqrtf(wave_sum(ss) / DM + EPS);
        f32x4 a03 = {0.f, 0.f, 0.f, 0.f}, a47 = {0.f, 0.f, 0.f, 0.f};
#pragma unroll
        for (int j4 = 0; j4 < 4; ++j4) { const int k = 4 * lane + 256 * j4; const f32x4 hv = v[j4] * rstd * gsc[j4] + shv[j4];
#pragma unroll
            for (int c = 0; c < 4; ++c) { a03 += rw[j4][c][0] * hv[c]; a47 += rw[j4][c][1] * hv[c]; }
            u32x2 w; w.x = pk2(hv[0], hv[1]); w.y = pk2(hv[2], hv[3]); *(u32x2*)(H2 + (size_t)m * DM + k) = w; }
        float acc[8] = {a03[0], a03[1], a03[2], a03[3], a47[0], a47[1], a47[2], a47[3]};
#pragma unroll
        for (int e = 0; e < 8; ++e) acc[e] = wave_sum(acc[e]);
        if (lane == 0) {
            int e0 = 0; float b0 = acc[0];
#pragma unroll
            for (int e = 1; e < 8; ++e) if (acc[e] > b0) { b0 = acc[e]; e0 = e; }
            int e1 = -1; float b1 = -INFINITY;
#pragma unroll
            for (int e = 0; e < 8; ++e) if (e != e0 && acc[e] > b1) { b1 = acc[e]; e1 = e; }
            const float ex = expf(b1 - b0); const float g0 = 1.f / (1.f + ex), g1 = ex / (1.f + ex);
            SEL[4 * m + 0] = e0; SEL[4 * m + 1] = e1; SEL[4 * m + 2] = __float_as_int(g0); SEL[4 * m + 3] = __float_as_int(g1);
            atomicAdd((int*)&hist[e0], 1); atomicAdd((int*)&hist[e1], 1);
        }
      }
    }
    __syncthreads();
    if (F.tid < 8) HIST[F.bid * 8 + F.tid] = hist[F.tid];
}
__device__ __forceinline__ void phase_slot(const Frame& F, const Params& P) {
    char* ws = F.ws; const int* HIST = (const int*)(ws + WS_CTL + CT_HIST); const int* SEL = (const int*)(ws + WS_SEL); int* TB = (int*)(ws + WS_CTL + CT_TB);
    const bf16_t* H2 = (const bf16_t*)(ws + WS_H2); bf16_t* XG = (bf16_t*)(ws + WS_XG); int* slot_tok = (int*)(ws + WS_SLOTTOK); float* slot_gate = (float*)(ws + WS_SLOTGATE);
    LAS int* sm = (LAS int*)(F.lds + MISC_OFF);
    if (F.tid < 16) sm[F.tid] = 0;
    { const int rpb0 = NLAT / F.G; for (int i = F.tid; i < 4 * rpb0; i += NTHREADS) sm[512 + i] = SEL[4 * F.bid * rpb0 + i]; }
    __syncthreads();
    for (int t = F.tid; t < 2 * F.G; t += NTHREADS) {
        const int j = t % F.G, hf = t / F.G; const int4 c = *(const int4*)(HIST + j * 8 + 4 * hf); const int mk = j < F.bid ? 1 : 0;
        int v[8] = {c.x, c.y, c.z, c.w, c.x * mk, c.y * mk, c.z * mk, c.w * mk};
#pragma unroll
        for (int q = 0; q < 8; ++q) {
#pragma unroll
            for (int o = 1; o < 64; o <<= 1) v[q] += __shfl_xor(v[q], o); }
        if (F.lane == 0) {
#pragma unroll
            for (int q = 0; q < 4; ++q) { atomicAdd((int*)&sm[4 * hf + q], v[q]); atomicAdd((int*)&sm[8 + 4 * hf + q], v[4 + q]); } }
    }
    __syncthreads();
    if (F.tid == 0) { int s = 0; for (int e = 0; e < 8; ++e) { sm[16 + e] = s; s += (sm[e] + 255) & ~255; } sm[24] = s; }
    __syncthreads();
    const int rpb = NLAT / F.G, na = 2 * rpb;
    if (F.tid == 0) { int run[8];
#pragma unroll
        for (int e = 0; e < 8; ++e) run[e] = sm[16 + e] + sm[8 + e];
        for (int a = 0; a < na; ++a) { const int e = sm[512 + 4 * (a >> 1) + (a & 1)]; int sl = 0;
#pragma unroll
            for (int q = 0; q < 8; ++q) if (q == e) { sl = run[q]; run[q] = sl + 1; }
            sm[32 + a] = sl; } }
    __syncthreads();
    for (int a0 = F.wave * 4; a0 < na; a0 += NWAVES * 4) { v4u va[4][2];
#pragma unroll
        for (int q = 0; q < 4; ++q) { const int a = a0 + q; const int m = F.bid * rpb + (a >> 1); const v4u* src = (const v4u*)(H2 + (size_t)m * DM); va[q][0] = src[F.lane]; va[q][1] = src[64 + F.lane]; }
#pragma unroll
        for (int q = 0; q < 4; ++q) { const int a = a0 + q; const int m = F.bid * rpb + (a >> 1), sl = sm[32 + a]; v4u* dst = (v4u*)(XG + (size_t)sl * DM); dst[F.lane] = va[q][0]; dst[64 + F.lane] = va[q][1];
            if (F.lane == 0) { slot_tok[sl] = m; ((int*)(ws + WS_TOKSLOT))[2 * m + (a & 1)] = sl; slot_gate[sl] = __int_as_float(sm[512 + 4 * (a >> 1) + 2 + (a & 1)]); } } }
    if (F.bid < 8) { const int e = F.bid; for (int sl = sm[16 + e] + sm[e] + F.tid; sl < sm[16 + e + 1]; sl += NTHREADS) slot_tok[sl] = -1; }
    if (F.bid == 0 && F.tid < 9) TB[F.tid] = sm[16 + F.tid] >> 8;
}
__device__ __forceinline__ void phase_combine(const Frame& F, const Params& P) {
    char* ws = F.ws; float* out = P.out; const bf16_t* Y2 = (const bf16_t*)(ws + WS_Y2); const int* TS = (const int*)(ws + WS_TOKSLOT); const float* mod5 = (const float*)(ws + WS_MOD) + 9 * MODLD + 5 * DM;
    const int gw = F.bid * NWAVES + F.wave, lane = F.lane; const int mb = gw * 8;
    f32x4 mv[2][2];
    { const float* md = mod5 + (size_t)(mb >> 11) * MODLD;
#pragma unroll
      for (int jj = 0; jj < 2; ++jj)
#pragma unroll
          for (int hlf = 0; hlf < 2; ++hlf) mv[jj][hlf] = *(const f32x4*)(md + 8 * lane + 512 * jj + 4 * hlf); }
#pragma unroll 1
    for (int q0 = 0; q0 < 8; q0 += 2) {
        f32x4 xv[2][4]; v4u ya[2][2], yb[2][2];
#pragma unroll
        for (int q = 0; q < 2; ++q) { const int m = mb + q0 + q; const int sa = TS[2 * m], sb = TS[2 * m + 1];
#pragma unroll
            for (int jj = 0; jj < 4; ++jj) xv[q][jj] = *(const f32x4*)(out + (size_t)m * DM + 8 * lane + 512 * (jj >> 1) + 4 * (jj & 1));
#pragma unroll
            for (int jj = 0; jj < 2; ++jj) { ya[q][jj] = *(const v4u*)(Y2 + (size_t)sa * DM + 8 * lane + 512 * jj); yb[q][jj] = *(const v4u*)(Y2 + (size_t)sb * DM + 8 * lane + 512 * jj); } }
#pragma unroll
        for (int q = 0; q < 2; ++q) { const int m = mb + q0 + q;
#pragma unroll
            for (int jj = 0; jj < 2; ++jj) { const int k = 8 * lane + 512 * jj;
#pragma unroll
                for (int hlf = 0; hlf < 2; ++hlf) { f32x4 o = xv[q][2 * jj + hlf]; const f32x4 mm = mv[jj][hlf];
                    const unsigned a0 = ya[q][jj][2 * hlf], a1 = ya[q][jj][2 * hlf + 1], b0 = yb[q][jj][2 * hlf], b1 = yb[q][jj][2 * hlf + 1];
                    o[0] += mm[0] * (__uint_as_float(a0 << 16) + __uint_as_float(b0 << 16)); o[1] += mm[1] * (__uint_as_float(a0 & 0xffff0000u) + __uint_as_float(b0 & 0xffff0000u));
                    o[2] += mm[2] * (__uint_as_float(a1 << 16) + __uint_as_float(b1 << 16)); o[3] += mm[3] * (__uint_as_float(a1 & 0xffff0000u) + __uint_as_float(b1 & 0xffff0000u));
                    *(f32x4*)(out + (size_t)m * DM + k + 4 * hlf) = o; } } }
    }
}

#define XB_TMO      128
#define XB_XCNT(j)  (256  + 64 * (j))
#define XB_XSUB(j)  (1280 + 64 * (j))
#define XB_XGEN(j)  (2304 + 64 * (j))
#define XB_TOP      3328
#define XB_TOPGEN   3392
#define XCD_BAR_WORDS 3456
#define XB_SPIN_CAP (1u << 18)

__device__ __forceinline__ unsigned xb_ld(unsigned* p)              { return __hip_atomic_load(p, __ATOMIC_RELAXED, __HIP_MEMORY_SCOPE_AGENT); }
__device__ __forceinline__ unsigned xb_add(unsigned* p, unsigned v) { return __hip_atomic_fetch_add(p, v, __ATOMIC_RELAXED, __HIP_MEMORY_SCOPE_AGENT); }
__device__ __forceinline__ unsigned xb_xcc_id() { return (unsigned)__builtin_amdgcn_s_getreg((3 << 11) | 20) & 0xFu; }
#define XB_SPIN(cond, bar) do { unsigned _sp = 0; while (cond) { __builtin_amdgcn_s_sleep(1); \
    if ((++_sp & 255u) == 0u) { if (xb_ld(&(bar)[XB_TMO])) break; if (_sp > XB_SPIN_CAP) { atomicAdd(&(bar)[XB_TMO], 1u); break; } } } } while (0)

struct XcdBarrier {
    unsigned* bar; unsigned x;
    volatile LAS unsigned* st;
};

__device__ __forceinline__ XcdBarrier xcd_barrier_post(unsigned* bar, volatile LAS unsigned* st) {
    XcdBarrier b; b.bar = bar; b.x = xb_xcc_id(); b.st = st;
    if (threadIdx.x == 0) st[2] = xb_add(&bar[XB_XCNT(b.x)], 1u);
    return b;
}
__device__ __forceinline__ void xcd_barrier_complete(unsigned* bar, unsigned x, unsigned& nloc, unsigned& nx, unsigned& even) {
    const unsigned G = gridDim.x * gridDim.y * gridDim.z;
    unsigned sum, cnt, mine, bal, sp = 0u;
    for (;;) {
        sum = 0u; cnt = 0u; mine = 0u; bal = 1u;
#pragma unroll
        for (unsigned j = 0; j < 16; ++j) { const unsigned c = xb_ld(&bar[XB_XCNT(j)]); sum += c; cnt += (c > 0u) ? 1u : 0u; mine = (j == x) ? c : mine; bal = (j < 8u && c * 8u != G) ? 0u : bal; }
        if (sum == G) break;
        __builtin_amdgcn_s_sleep(1);
        if ((++sp & 255u) == 0u) { if (xb_ld(&bar[XB_TMO])) break; if (sp > XB_SPIN_CAP) { atomicAdd(&bar[XB_TMO], 1u); break; } }
    }
    nloc = mine > 0u ? mine : 1u; nx = cnt > 0u ? cnt : 1u; even = (sum == G) ? bal : 0u;
}

__device__ __forceinline__ void xcd_barrier(const XcdBarrier& b) {
    asm volatile("s_waitcnt vmcnt(0)" ::: "memory");
    __syncthreads();
    if (threadIdx.x == 0) {
        unsigned* bar = b.bar;
        __builtin_amdgcn_s_waitcnt(0);
        unsigned nloc = b.st[0], nx = b.st[1];
        if (nloc == 0u) { unsigned ev; xcd_barrier_complete(bar, b.x, nloc, nx, ev); b.st[0] = nloc; b.st[1] = nx; b.st[3] = ev; }
        const unsigned old = xb_add(&bar[XB_XSUB(b.x)], 1u);
        const unsigned gen = old / nloc;
        if (old + 1u == (gen + 1u) * nloc) {
            __builtin_amdgcn_fence(__ATOMIC_RELEASE, "agent");
            asm volatile("s_waitcnt vmcnt(0)" ::: "memory");
            const unsigned og = xb_add(&bar[XB_TOP], 1u);
            const unsigned tg = og / nx;
            if (og + 1u == (tg + 1u) * nx) xb_add(&bar[XB_TOPGEN], 1u);
            else XB_SPIN(xb_ld(&bar[XB_TOPGEN]) == tg, bar);
            __builtin_amdgcn_fence(__ATOMIC_ACQUIRE, "agent");
            xb_add(&bar[XB_XGEN(b.x)], 1u);
            asm volatile("s_waitcnt vmcnt(0)" ::: "memory");
        } else {
            XB_SPIN(xb_ld(&bar[XB_XGEN(b.x)]) == gen, bar);
            __builtin_amdgcn_fence(__ATOMIC_ACQUIRE, "agent");
            asm volatile("s_waitcnt vmcnt(0)" ::: "memory");
        }
    }
    __syncthreads();
}
namespace hy {
using f32x16 = __attribute__((ext_vector_type(16))) float;
constexpr int UL = 2088, ULB = UL * 2;
constexpr int GOFF = 2064;
constexpr int L_U = 0, L_U2 = 8 * ULB, L_X = 2 * 8 * ULB, L_G0 = L_X + 8 * 2048 * 2, L_G1 = L_G0 + GT_LD * 2, L_END = L_G1 + GT_LD * 2;
static_assert(L_END <= RING_BYTES, "hyena LDS");
__device__ __forceinline__ void prep(const Frame& F, const Params& P) {
    char* ws = F.ws; const bf16_t* Z = (const bf16_t*)(ws + WS_Z); bf16_t* ZT = (bf16_t*)(ws + WS_ZT); const float* cw = PIN(24); const float* cb = PIN(25);
    const int gw = F.bid * NWAVES + F.wave, NGW = F.G * NWAVES, lane = F.lane; LAS unsigned char* tl = F.lds + RING_OFF + F.wave * 8192;
    for (int it = gw; it < 24 * 8 * 64; it += NGW) { const int cg = it % 24, b = (it / 24) & 7, tt = it / 192; const int c = cg * 64 + lane, t0 = tt * 32;
        const float w0 = cw[c], w1 = cw[1536 + c], w2 = cw[3072 + c], bias = cb[c];
        const bf16_t* zp = Z + ((size_t)b * RPB + CTX) * CD_LD + cg * 64;
        v4u pc[5];
#pragma unroll
        for (int k = 0; k < 5; ++k) { const int p = lane + 64 * k, row = p >> 3, c8 = p & 7, t = t0 - 1 + row; pc[k] = (p < 272 && t >= 0 && t < SEQ) ? *(const v4u*)(zp + (size_t)t * CD_LD + c8 * 8) : (v4u){0u, 0u, 0u, 0u}; }
#pragma unroll
        for (int k = 0; k < 5; ++k) { const int p = lane + 64 * k, row = p >> 3, c8 = p & 7; if (p < 272) *(LAS v4u*)(tl + row * 144 + c8 * 16) = pc[k]; }
        LDS_WAIT(); asm volatile("" ::: "memory");
        float xr[34];
#pragma unroll
        for (int i = 0; i < 34; ++i) xr[i] = bf2f(*(const LAS bf16_t*)(tl + i * 144 + lane * 2));
        LDS_WAIT(); asm volatile("" ::: "memory");
        bf16_t* op = ZT + ((size_t)c * NB + b) * SEQ + t0;
#pragma unroll
        for (int j8 = 0; j8 < 4; ++j8) { float y[8];
#pragma unroll
            for (int jj = 0; jj < 8; ++jj) { const int i = j8 * 8 + jj; y[jj] = bias + w0 * xr[i] + w1 * xr[i + 1] + w2 * xr[i + 2]; }
            v4u o; o.x = pk2(y[0], y[1]); o.y = pk2(y[2], y[3]); o.z = pk2(y[4], y[5]); o.w = pk2(y[6], y[7]); *(v4u*)(op + j8 * 8) = o; } }
}
__device__ __forceinline__ void filt(const Frame& F, const Params& P) {
    char* ws = F.ws; bf16_t* GT = (bf16_t*)(ws + WS_GT);
    const float *w1 = PIN(26), *b1 = PIN(27), *w2 = PIN(28), *b2 = PIN(29), *w3 = PIN(30), *freq = PIN(31);
    LAS float* z = (LAS float*)(F.lds + RING_OFF); LAS float* h1 = z + 9 * 64; LAS float* h2 = h1 + 9 * 64;
    const int tid = F.tid;
    for (int tb = F.bid; tb < SEQ / 8; tb += F.G) {
        const int t0 = tb * 8;
        __syncthreads();
        if (tid < 9 * 33) { const int tt = tid / 33, k = tid % 33, t = t0 + tt; float zv = (float)t / (float)(SEQ - 1);
            if (k > 0) { const int bi = (k - 1) & 15; const double band = 1e-4 + (15.0 - 1e-4) * (double)bi / 15.0; const double rev = (double)t * band * (1.0 / (double)SEQ);
                const float fr = (float)(rev - floor(rev)); zv = k <= 16 ? __builtin_amdgcn_cosf(fr) : -__builtin_amdgcn_sinf(fr); }
            z[tt * 64 + k] = zv; }
        __syncthreads();
        for (int idx = tid; idx < 9 * 64; idx += NTHREADS) { const int tt = idx >> 6, j = idx & 63; float a = b1[j];
#pragma unroll
            for (int i = 0; i < 33; ++i) a += z[tt * 64 + i] * w1[i * 64 + j];
            h1[idx] = __sinf(freq[j] * a); }
        __syncthreads();
        for (int idx = tid; idx < 9 * 64; idx += NTHREADS) { const int tt = idx >> 6, j = idx & 63; float a = b2[j];
#pragma unroll 16
            for (int i = 0; i < 64; ++i) a += h1[tt * 64 + i] * w2[i * 64 + j];
            h2[idx] = __sinf(freq[j] * a); }
        __syncthreads();
        float acc[4][9];
#pragma unroll
        for (int q = 0; q < 4; ++q)
#pragma unroll
            for (int tt = 0; tt < 9; ++tt) acc[q][tt] = 0.f;
#pragma unroll 16
        for (int i = 0; i < 64; ++i) { float wv[4];
#pragma unroll
            for (int q = 0; q < 4; ++q) wv[q] = w3[(size_t)i * 2048 + tid + 512 * q];
#pragma unroll
            for (int tt = 0; tt < 9; ++tt) { const float hv = h2[tt * 64 + i];
#pragma unroll
                for (int q = 0; q < 4; ++q) acc[q][tt] += hv * wv[q]; } }
        const double mind = log(1e-2) / 1.5, maxd = log(1e-2) / 0.3; const int ch = tid; const float delta = fabsf((float)(mind + (maxd - mind) * (double)ch / 511.0));
        float win[9];
#pragma unroll
        for (int tt = 0; tt < 9; ++tt) { const int t = t0 + tt; win[tt] = t < SEQ ? __expf(-((float)t / (float)(SEQ - 1)) * delta) + 0.05f : 0.f; }
#pragma unroll
        for (int ord = 0; ord < 2; ++ord) { bf16_t* gp = GT + ((size_t)ord * 512 + ch) * GT_LD + GOFF; float fw[9], bw[9];
#pragma unroll
            for (int tt = 0; tt < 9; ++tt) { fw[tt] = acc[2 * ord][tt] * win[tt]; bw[tt] = acc[2 * ord + 1][tt] * win[tt]; }
            if (t0 == 0) bw[0] = fw[0];
            v4u ob; ob.x = pk2(bw[0], bw[1]); ob.y = pk2(bw[2], bw[3]); ob.z = pk2(bw[4], bw[5]); ob.w = pk2(bw[6], bw[7]); *(v4u*)(gp + t0) = ob;
            v4u of; of.x = pk2(fw[8], fw[7]); of.y = pk2(fw[6], fw[5]); of.z = pk2(fw[4], fw[3]); of.w = pk2(fw[2], fw[1]); *(v4u*)(gp - t0 - 8) = of; }
    }
    const int gt = F.bid * NTHREADS + F.tid, NGT = F.G * NTHREADS; constexpr int NZ = 16 + (GT_LD - GOFF - 2048);
    for (int i = gt; i < 1024 * NZ; i += NGT) { const int oc = i / NZ, k = i % NZ; GT[(size_t)oc * GT_LD + (k < 16 ? k : GOFF + 2048 + (k - 16))] = 0; }
}
__device__ __forceinline__ void conv_mfma(f32x16 (&acc)[2], LAS unsigned char* Ub, LAS unsigned char* Gb, int wave, int lane) {
    const int n = lane & 31, h = lane >> 5, b = n >> 2, dl = n & 3;
    const LAS unsigned char* up = Ub + b * ULB + 16 * h;
    const int i = lane & 31;
    const LAS unsigned char* gp0 = Gb + 2 * (GOFF + 8 * h - 4 * i - 16 * (8 * (2 * wave) + 1));
    const LAS unsigned char* gp1 = gp0 - 2 * 16 * 8;
    acc[0] = f32x16{}; acc[1] = f32x16{};
    const bool sh2 = dl >= 2; const unsigned sb = (dl & 1) * 2;
    const LAS unsigned char* upq = up + 8 * (dl < 3 ? dl : 2);
    u32x4 ring[8];
#pragma unroll
    for (int b8 = 0; b8 < 8; ++b8) { const u32x2 a0 = *(const LAS u32x2*)(gp1 + 32 * b8), a1 = *(const LAS u32x2*)(gp1 + 32 * b8 + 8); ring[b8] = (u32x4){a0[0], a0[1], a1[0], a1[1]}; }
#define HY_STEP(J, b8) do { \
          \
        const u32x2 qx = *(const LAS u32x2*)(upq + 32 * (J)); \
        unsigned q[6]; \
        q[0] = __builtin_amdgcn_mov_dpp((int)qx[0], 0x00, 0xF, 0xF, false); q[1] = __builtin_amdgcn_mov_dpp((int)qx[1], 0x00, 0xF, 0xF, false); \
        q[2] = __builtin_amdgcn_mov_dpp((int)qx[0], 0x55, 0xF, 0xF, false); q[3] = __builtin_amdgcn_mov_dpp((int)qx[1], 0x55, 0xF, 0xF, false); \
        q[4] = __builtin_amdgcn_mov_dpp((int)qx[0], 0xAA, 0xF, 0xF, false); q[5] = __builtin_amdgcn_mov_dpp((int)qx[1], 0xAA, 0xF, 0xF, false); \
        u32x4 bw; \
        _Pragma("unroll") for (int w = 0; w < 4; ++w) { const unsigned lo = sh2 ? q[w + 1] : q[w], hi_ = sh2 ? q[w + 2] : q[w + 1]; bw[w] = __builtin_amdgcn_alignbyte(hi_, lo, sb); } \
        const u32x2 a00 = *(const LAS u32x2*)(gp0 + 32 * (J)), a01 = *(const LAS u32x2*)(gp0 + 32 * (J) + 8); \
        const u32x4 A1 = ring[b8]; const u32x4 A0 = {a00[0], a00[1], a01[0], a01[1]}; ring[b8] = A0; \
        acc[0] = __builtin_amdgcn_mfma_f32_32x32x16_bf16(__builtin_bit_cast(bf16x8, A0), __builtin_bit_cast(bf16x8, bw), acc[0], 0, 0, 0); \
        acc[1] = __builtin_amdgcn_mfma_f32_32x32x16_bf16(__builtin_bit_cast(bf16x8, A1), __builtin_bit_cast(bf16x8, bw), acc[1], 0, 0, 0); } while (0)
#pragma unroll 1
    for (int J8 = 0; J8 < 128; J8 += 8) {
#pragma unroll
        for (int b8 = 0; b8 < 8; ++b8) HY_STEP(J8 + b8, b8); }
    HY_STEP(128, 0);
#undef HY_STEP
}
__device__ __forceinline__ void main_phase(const Frame& F, const Params& P) {
    char* ws = F.ws; const bf16_t* ZT = (const bf16_t*)(ws + WS_ZT); const bf16_t* GT = (const bf16_t*)(ws + WS_GT); bf16_t* HT = (bf16_t*)(ws + WS_HT); const float* skip = PIN(32);
    LAS unsigned char* lds = F.lds + RING_OFF; const int tid = F.tid, lane = F.lane, wave = F.wave;
    const int n = lane & 31, h = lane >> 5, b = n >> 2, dl = n & 3;
    for (int c = F.bid; c < 512; c += F.G) {
        __syncthreads();
        for (int i = tid; i < 8 * 256; i += NTHREADS) { const int bb = i >> 8, k = i & 255; *(LAS v4u*)(lds + L_U + bb * ULB + 32 + k * 16) = *(const v4u*)(ZT + ((size_t)c * NB + bb) * SEQ + k * 8);
            *(LAS v4u*)(lds + L_X + (bb * 2048 + k * 8) * 2) = *(const v4u*)(ZT + ((size_t)(512 + c) * NB + bb) * SEQ + k * 8); }
        for (int i = tid; i < GT_LD / 8; i += NTHREADS) { *(LAS v4u*)(lds + L_G0 + i * 16) = *(const v4u*)(GT + (size_t)c * GT_LD + i * 8); *(LAS v4u*)(lds + L_G1 + i * 16) = *(const v4u*)(GT + (size_t)(512 + c) * GT_LD + i * 8); }
        if (tid < 80) { const int bb = tid / 10, k = tid % 10, which = k / 5, part = k % 5; const int off = bb * ULB + (part < 2 ? part * 16 : (16 + 2048) * 2 + (part - 2) * 16);
            *(LAS v4u*)(lds + (which ? L_U2 : L_U) + off) = (v4u){0u, 0u, 0u, 0u}; }
        __syncthreads();
        const float sk0 = skip[c], sk1 = skip[512 + c];
        f32x16 acc[2];
        conv_mfma(acc, lds + L_U, lds + L_G0, wave, lane);
#pragma unroll
        for (int ip = 0; ip < 2; ++ip)
#pragma unroll
            for (int r = 0; r < 16; ++r) { const int t = 128 * (2 * wave + ip) + 4 * att::crow(r, h) + dl;
                const float v = bf2f(*(const LAS bf16_t*)(lds + L_U + b * ULB + (16 + t) * 2)), x1 = bf2f(*(const LAS bf16_t*)(lds + L_X + (b * 2048 + t) * 2));
                *(LAS bf16_t*)(lds + L_U2 + b * ULB + (16 + t) * 2) = f2bf(x1 * (acc[ip][r] + sk0 * v)); }
        __syncthreads();
        for (int i = tid; i < 8 * 256; i += NTHREADS) { const int bb = i >> 8, k = i & 255; *(LAS v4u*)(lds + L_X + (bb * 2048 + k * 8) * 2) = *(const v4u*)(ZT + ((size_t)(1024 + c) * NB + bb) * SEQ + k * 8); }
        conv_mfma(acc, lds + L_U2, lds + L_G1, wave, lane);
        __syncthreads();
#pragma unroll
        for (int ip = 0; ip < 2; ++ip)
#pragma unroll
            for (int r = 0; r < 16; ++r) { const int t = 128 * (2 * wave + ip) + 4 * att::crow(r, h) + dl;
                const float y1 = bf2f(*(const LAS bf16_t*)(lds + L_U2 + b * ULB + (16 + t) * 2)), x2 = bf2f(*(const LAS bf16_t*)(lds + L_X + (b * 2048 + t) * 2));
                *(LAS bf16_t*)(lds + L_U + (b * 2048 + t) * 2) = f2bf(x2 * (acc[ip][r] + sk1 * y1)); }
        __syncthreads();
        for (int i = tid; i < 8 * 256; i += NTHREADS) *(v4u*)(HT + (size_t)c * NLAT + i * 8) = *(const LAS v4u*)(lds + L_U + i * 16);
    }
}
__device__ __forceinline__ void untranspose(const Frame& F) {
    char* ws = F.ws; const bf16_t* HT = (const bf16_t*)(ws + WS_HT); bf16_t* Y = (bf16_t*)(ws + WS_Y);
    const int gw = F.bid * NWAVES + F.wave, NGW = F.G * NWAVES, lane = F.lane; LAS unsigned char* tl = F.lds + RING_OFF + F.wave * 16384;
    __syncthreads();
    for (int it = gw; it < 8 * 8 * 32; it += NGW) { const int cg = it & 7, b = (it >> 3) & 7, tt = it >> 6; const int c = cg * 64 + lane, t0 = tt * 64;
        const bf16_t* hp = HT + ((size_t)c * NB + b) * SEQ + t0; bf16_t* yp = Y + ((size_t)b * RPB + CTX + t0) * DM + cg * 64;
        v4u q[8];
#pragma unroll
        for (int j8 = 0; j8 < 8; ++j8) q[j8] = *(const v4u*)(hp + j8 * 8);
#pragma unroll
        for (int j8 = 0; j8 < 8; ++j8)
#pragma unroll
            for (int jj = 0; jj < 4; ++jj) { *(LAS bf16_t*)(tl + (j8 * 8 + 2 * jj) * 144 + lane * 2) = (bf16_t)(q[j8][jj] & 0xffffu); *(LAS bf16_t*)(tl + (j8 * 8 + 2 * jj + 1) * 144 + lane * 2) = (bf16_t)(q[j8][jj] >> 16); }
        LDS_WAIT(); asm volatile("" ::: "memory");
#pragma unroll
        for (int k = 0; k < 8; ++k) { const int p = lane + 64 * k, row = p >> 3, c8 = p & 7; *(v4u*)(yp + (size_t)row * DM + c8 * 8) = *(const LAS v4u*)(tl + row * 144 + c8 * 16); }
        LDS_WAIT(); asm volatile("" ::: "memory"); }
}
}
namespace lru {
using f32x16 = __attribute__((ext_vector_type(16))) float;
typedef float f32x2 __attribute__((ext_vector_type(2)));
constexpr int T = 32, NCH = RPB / T;
constexpr int UPITCH = 1040;
constexpr int L_UT = 0, L_GL = 34816, L_END = L_GL + 2 * T * 512 * 2;
static_assert(L_END <= RING_BYTES, "lru LDS");
__device__ __forceinline__ float fsigmoid(float x) { return __builtin_amdgcn_rcpf(1.f + __builtin_amdgcn_exp2f(-LOG2E * x)); }
__device__ __forceinline__ float gelu_fast(float x) { const float y = 0.7978845608028654f * (x + 0.044715f * x * x * x); const float e = __builtin_amdgcn_exp2f(2.f * LOG2E * y); const float th = 1.f - 2.f * __builtin_amdgcn_rcpf(1.f + e); return 0.5f * x * (1.f + th); }
__device__ __forceinline__ int chunk_of_order(int d, int q) { return d == 0 ? q : (q < 8 ? 7 - q : 79 - q); }
__device__ __forceinline__ int order_of_chunk(int d, int j) { return d == 0 ? j : (j < 8 ? 7 - j : 79 - j); }

__device__ __forceinline__ void unit0(const Frame& F, const Params& P, int b, int j) {
    char* ws = F.ws; const bf16_t* Z = (const bf16_t*)(ws + WS_Z); float* AGG = (float*)(ws + WS_AGG); const bf16_t* WL = (const bf16_t*)(ws + WS_WLRU);
    bf16_t* LAB = (bf16_t*)P.out; bf16_t* BTB = (bf16_t*)(ws + WS_H);
    LAS unsigned char* lds = F.lds + RING_OFF; const int ch = F.tid, lane = F.lane, wave = F.wave;
    const int s0 = j * T, seg_lo = s0 < CTX ? 0 : CTX, seg_hi = s0 < CTX ? CTX : RPB; const size_t row0 = (size_t)b * RPB + s0;
    LDS_WAIT(); asm volatile("" ::: "memory");
    float u[T];
    { const float w0 = PIN(10)[ch], w1 = PIN(10)[512 + ch], w2 = PIN(10)[1024 + ch], w3 = PIN(10)[1536 + ch], cb = PIN(11)[ch];
      float xw[T + 3];
#pragma unroll
      for (int i = 0; i < T + 3; ++i) { const int s = s0 + i - 2; xw[i] = (s >= seg_lo && s < seg_hi) ? bf2f(Z[((size_t)b * RPB + s) * AB_IN + ch]) : 0.f; }
#pragma unroll
      for (int t = 0; t < T; ++t) { u[t] = cb + w0 * xw[t] + w1 * xw[t + 1] + w2 * xw[t + 2] + w3 * xw[t + 3]; *(LAS bf16_t*)(lds + L_UT + t * UPITCH + ch * 2) = f2bf(u[t]); } }
#pragma unroll
    for (int d = 0; d < 2; ++d) {
        LDS_WAIT(); asm volatile("" ::: "memory");
        { const int n = wave, r32 = lane & 31, h = lane >> 5; bf16x8 af[4];
#pragma unroll
          for (int ks = 0; ks < 4; ++ks) af[ks] = *(const LAS bf16x8*)(lds + L_UT + r32 * UPITCH + (64 * n + 16 * ks + 8 * h) * 2);
#pragma unroll
          for (int g = 0; g < 2; ++g)
#pragma unroll
              for (int cb = 0; cb < 2; ++cb) { f32x16 acc = f32x16{}; const bf16_t* wp = WL + ((size_t)((d * 8 + n) * 2 + g) * 64 + 32 * cb + r32) * 64 + 8 * h;
#pragma unroll
                  for (int ks = 0; ks < 4; ++ks) { const bf16x8 bfr = *(const bf16x8*)(wp + 16 * ks); acc = __builtin_amdgcn_mfma_f32_32x32x16_bf16(af[ks], bfr, acc, 0, 0, 0); }
                  const float bias = (g == 0 ? PIN(13) : PIN(15))[(d * 8 + n) * 64 + 32 * cb + r32];
#pragma unroll
                  for (int r = 0; r < 16; ++r) *(LAS bf16_t*)(lds + L_GL + ((g * T + att::crow(r, h)) * 512 + 64 * n + 32 * cb + r32) * 2) = f2bf(fsigmoid(acc[r] + bias)); } }
        LDS_WAIT(); asm volatile("" ::: "memory");
        const float cl = -8.f * softplus_f(-PIN(16)[d * 512 + ch]);
        float h = 0.f, sumlog = 0.f; bf16_t* lap = LAB + ((size_t)d * MROWS + row0) * 512 + ch; bf16_t* btp = BTB + ((size_t)d * MROWS + row0) * 512 + ch;
#pragma unroll
        for (int st = 0; st < T; ++st) { const int t = d == 0 ? st : T - 1 - st;
            const float rg = bf2f(*(const LAS bf16_t*)(lds + L_GL + (t * 512 + ch) * 2)), ig = bf2f(*(const LAS bf16_t*)(lds + L_GL + ((T + t) * 512 + ch) * 2));
            const bf16_t lab = f2bf(cl * rg); const float la = bf2f(lab); const float a = __builtin_amdgcn_exp2f(LOG2E * la);
            const bf16_t btb = f2bf(__builtin_amdgcn_sqrtf(fmaf(-a, a, 1.f)) * (ig * u[t])); const float bt = bf2f(btb);
            lap[(size_t)t * 512] = lab; btp[(size_t)t * 512] = btb;
            h = a * h + bt; sumlog += la; }
        { f32x2* ag = (f32x2*)AGG + ((size_t)(d * 8 + b) * NCH + j) * 512 + ch; *ag = (f32x2){sumlog, h}; }
    }
}
__device__ __forceinline__ void unit1(const Frame& F, const Params& P, int b, int j) {
    char* ws = F.ws; const bf16_t* Z = (const bf16_t*)(ws + WS_Z); bf16_t* Y = (bf16_t*)(ws + WS_Y); const float* AGG = (const float*)(ws + WS_AGG);
    const bf16_t* LAB = (const bf16_t*)P.out; const bf16_t* BTB = (const bf16_t*)(ws + WS_H);
    const int ch = F.tid; const size_t row0 = (size_t)b * RPB + j * T;
    float hf[T];
#pragma unroll
    for (int d = 0; d < 2; ++d) {
        const bf16_t* lap = LAB + ((size_t)d * MROWS + row0) * 512 + ch; const bf16_t* btp = BTB + ((size_t)d * MROWS + row0) * 512 + ch;
        bf16_t lav[T], btv[T]; bf16_t gv[T];
#pragma unroll
        for (int t = 0; t < T; ++t) { lav[t] = lap[(size_t)t * 512]; btv[t] = btp[(size_t)t * 512]; if (d == 1) gv[t] = Z[(row0 + t) * AB_IN + 512 + ch]; }
        float h = 0.f;
        { const int q = order_of_chunk(d, j); const f32x2* ag = (const f32x2*)AGG + (size_t)(d * 8 + b) * NCH * 512 + ch;
#pragma unroll 24
          for (int qq = 0; qq < q; ++qq) { const int jj = chunk_of_order(d, qq); const f32x2 av = ag[(size_t)jj * 512]; h = __builtin_amdgcn_exp2f(LOG2E * av[0]) * h + av[1]; } }
#pragma unroll
        for (int st = 0; st < T; ++st) { const int t = d == 0 ? st : T - 1 - st;
            h = __builtin_amdgcn_exp2f(LOG2E * bf2f(lav[t])) * h + bf2f(btv[t]);
            if (d == 0) hf[t] = h; else Y[(row0 + t) * DM + ch] = f2bf((hf[t] + h) * gelu_fast(bf2f(gv[t]))); }
    }
}
template <int MODE>
__device__ __forceinline__ void phase(const Frame& F, const Params& P) {
    const int first = MODE == 0 ? F.bid : (F.bid + 192) % F.G;
    for (int L = first; L < NB * NCH; L += F.G) { if (MODE == 0) unit0(F, P, L & 7, L >> 3); else unit1(F, P, L & 7, L >> 3); }
}
}
namespace el {
__device__ __forceinline__ void mod_phase(const Frame& F, const Params& P) {
    char* ws = F.ws; float* MOD = (float*)(ws + WS_MOD); const float* c = PIN(1); const float* cctx = PIN(3); const float* mw = PIN(4); const float* mb = PIN(5);
    LAS float* sc = (LAS float*)(F.lds + RING_OFF); LAS float* part = sc + 9 * DM;
    if (F.bid >= 192) return;
    for (int i = F.tid; i < 9 * DM; i += NTHREADS) { const int j = i >> 10, k = i & 1023; const float v = j < 8 ? c[j * DM + k] : cctx[k]; sc[i] = v / (1.f + expf(-v)); }
    __syncthreads();
    const int cg = F.lane & 15, kr = F.lane >> 4; const int col = F.bid * 64 + 4 * cg, l = col / MODLD, n = col % MODLD; const float* w = mw + (size_t)l * DM * MODLD + n; const int k0 = F.wave * 128 + kr;
    f32x4 acc[9];
#pragma unroll
    for (int j = 0; j < 9; ++j) acc[j] = (f32x4){0.f, 0.f, 0.f, 0.f};
#pragma unroll 8
    for (int i = 0; i < 32; ++i) { const int k = k0 + 4 * i; const f32x4 wv = __builtin_nontemporal_load((const f32x4*)(w + (size_t)k * MODLD));
#pragma unroll
        for (int j = 0; j < 9; ++j) acc[j] += wv * sc[j * DM + k]; }
#pragma unroll
    for (int j = 0; j < 9; ++j) {
#pragma unroll
        for (int c = 0; c < 4; ++c) { float v = acc[j][c]; v += __shfl_xor(v, 16); v += __shfl_xor(v, 32); acc[j][c] = v; }
        if (kr == 0) *(LAS f32x4*)(part + (F.wave * 9 + j) * 64 + 4 * cg) = acc[j]; }
    __syncthreads();
    for (int i = F.tid; i < 9 * 64; i += NTHREADS) { const int j = i >> 6, ln = i & 63; float s = 0.f;
#pragma unroll
        for (int wv = 0; wv < 8; ++wv) s += part[(wv * 9 + j) * 64 + ln];
        const int cc = F.bid * 64 + ln; MOD[((size_t)(cc / MODLD) * 9 + j) * MODLD + cc % MODLD] = s + mb[cc]; }
    __syncthreads();
}
__device__ __forceinline__ void bias_phase(const Frame& F, const Params& P) {
    char* ws = F.ws; const float* MOD = (const float*)(ws + WS_MOD);
    LAS float* sc = (LAS float*)(F.lds + RING_OFF); LAS float* part = sc + 9 * DM;
    if (F.bid >= 120) return;
    const bool f1 = F.bid < 88; const float* shb = f1 ? MOD + 3 * DM : MOD + 9 * MODLD;
    __syncthreads();
    for (int i = F.tid; i < 9 * DM; i += NTHREADS) sc[i] = shb[(size_t)(i >> 10) * MODLD + (i & 1023)];
    __syncthreads();
    const int cg = F.lane & 15, kr = F.lane >> 4; const int cc = (f1 ? F.bid : F.bid - 88) * 64 + 4 * cg; const float* w; int ldw; bool valid = true;
    if (f1) { const int pn = cc >> 8, c = cc & 255; w = (c < 128 ? PIN(19) : PIN(20)) + pn * 128 + (c & 127); ldw = DFF; } else { valid = cc < CD_IN; w = PIN(22) + (valid ? cc : 0); ldw = CD_IN; }
    const int k0 = F.wave * 128 + kr; f32x4 acc[9];
#pragma unroll
    for (int j = 0; j < 9; ++j) acc[j] = (f32x4){0.f, 0.f, 0.f, 0.f};
#pragma unroll 8
    for (int i = 0; i < 32; ++i) { const int k = k0 + 4 * i; const f32x4 wv = *(const f32x4*)(w + (size_t)k * ldw);
#pragma unroll
        for (int j = 0; j < 9; ++j) acc[j] += wv * sc[j * DM + k]; }
#pragma unroll
    for (int j = 0; j < 9; ++j) {
#pragma unroll
        for (int c = 0; c < 4; ++c) { float v = acc[j][c]; v += __shfl_xor(v, 16); v += __shfl_xor(v, 32); acc[j][c] = valid ? v : 0.f; }
        if (kr == 0) *(LAS f32x4*)(part + (F.wave * 9 + j) * 64 + 4 * cg) = acc[j]; }
    __syncthreads();
    for (int i = F.tid; i < 9 * 64; i += NTHREADS) { const int j = i >> 6, ln = i & 63; float s = 0.f;
#pragma unroll
        for (int wv = 0; wv < 8; ++wv) s += part[(wv * 9 + j) * 64 + ln];
        if (f1) ((float*)(ws + WS_CBF1))[(size_t)j * 5632 + F.bid * 64 + ln] = s; else ((float*)(ws + WS_CBIN1))[(size_t)j * 2048 + (F.bid - 88) * 64 + ln] = s; }
    __syncthreads();
}
template <int SRC>
__device__ __forceinline__ void norm_phase(const Frame& F, const Params& P, const float* g, const float* MODL, int ish, int isc) {
    char* ws = F.ws; bf16_t* H = (bf16_t*)(ws + WS_H); const int gw = F.bid * NWAVES + F.wave, lane = F.lane; const int rb = gw * 9;
    f32x4 gg[4], gs[4], sh[4]; int cur = -1;
#pragma unroll
    for (int j = 0; j < 4; ++j) gg[j] = *(const f32x4*)(g + 4 * lane + 256 * j);
#pragma unroll 1
    for (int r0 = rb; r0 < rb + 9; r0 += 3) {
        f32x4 v[3][4];
#pragma unroll
        for (int q = 0; q < 3; ++q) { const int r = r0 + q, b = r / RPB, s = r - b * RPB;
            const float* xr = s < CTX ? PIN(2) + ((size_t)b * CTX + s) * DM : PIN(0) + ((size_t)b * SEQ + (s - CTX)) * DM;
#pragma unroll
            for (int j = 0; j < 4; ++j) v[q][j] = *(const f32x4*)(xr + 4 * lane + 256 * j); }
#pragma unroll
        for (int q = 0; q < 3; ++q) { const int r = r0 + q, b = r / RPB, s = r - b * RPB; const int mrow = s < CTX ? 8 : b;
            if (mrow != cur) { cur = mrow; const float* md = MODL + (size_t)mrow * MODLD;
#pragma unroll
                for (int j = 0; j < 4; ++j) { const int k = 4 * lane + 256 * j; gs[j] = gg[j] * (*(const f32x4*)(md + isc * DM + k) + 1.f); sh[j] = *(const f32x4*)(md + ish * DM + k); } }
            float ss = 0.f;
#pragma unroll
            for (int j = 0; j < 4; ++j) ss += (v[q][j][0] * v[q][j][0] + v[q][j][1] * v[q][j][1]) + (v[q][j][2] * v[q][j][2] + v[q][j][3] * v[q][j][3]);
            const float rstd = rsqrtf(wave_sum(ss) / DM + EPS);
#pragma unroll
            for (int j = 0; j < 4; ++j) { const int k = 4 * lane + 256 * j; const f32x4 hv = v[q][j] * rstd * gs[j] + sh[j];
                u32x2 w; w.x = pk2(hv[0], hv[1]); w.y = pk2(hv[2], hv[3]); *(u32x2*)(H + (size_t)r * DM + k) = w; } }
    }
}
__device__ __forceinline__ void rope_tables(const Frame& F) {
    float* R0 = (float*)(F.ws + WS_ROPE0); float* R1 = (float*)(F.ws + WS_ROPE1); const int gt = F.bid * NTHREADS + F.tid, NGT = F.G * NTHREADS;
    for (int i = gt; i < SEQ * 48; i += NGT) { const int t = i / 48, k = i % 48; const float row = (float)(t >> 6), col = (float)(t & 63);
        const bool l0 = k < 32; const int kk = l0 ? k : k - 32; const int half = l0 ? 16 : 8;
        const float invf = exp2f(-(float)(kk & (half - 1)) * (13.287712379549449f / (float)half)); const float ang = (kk < half ? row : col) * invf; const float cv = cosf(ang), sv = sinf(ang);
        if (l0) { R0[t * 64 + kk] = cv; R0[t * 64 + 32 + kk] = sv; } else { R1[t * 32 + kk] = cv; R1[t * 32 + 16 + kk] = sv; } }
}
__device__ __forceinline__ void gqa_prep(const Frame& F, const Params& P) {
    char* ws = F.ws; const bf16_t* Z = (const bf16_t*)(ws + WS_Z); bf16_t* Q = (bf16_t*)(ws + WS_QB); bf16_t* K = (bf16_t*)(ws + WS_KB); bf16_t* V = (bf16_t*)(ws + WS_VB); const float* R0 = (const float*)(ws + WS_ROPE0);
    const int gw = F.bid * NWAVES + F.wave, NGW = F.G * NWAVES, lane = F.lane; const int d0 = 8 * (lane & 7), i0 = d0 & 31;
    float qn[8], kn[8];
#pragma unroll
    for (int e = 0; e < 8; ++e) { qn[e] = PIN(17)[d0 + e] * QSCALE0; kn[e] = PIN(18)[d0 + e]; }
    constexpr int R1 = 6912; const int nb2 = F.G - 64; const int gw2 = (F.bid - 64) * NWAVES + F.wave, NGW2 = nb2 * NWAVES;
    for (int pass = 0; pass < 2; ++pass) { const int base = pass == 0 ? 0 : R1, lim = pass == 0 ? R1 : MROWS, g0 = pass == 0 ? gw : gw2, ng = pass == 0 ? NGW : NGW2; if (pass == 1 && F.bid < 64) break;
    for (int r0 = base + g0; r0 < lim; r0 += 2 * ng) {
        v4u qv[2], kv[2]; f32x4 cs[2][2], sn[2][2];
#pragma unroll
        for (int q = 0; q < 2; ++q) { const int r = r0 + q * ng; if (r < lim) { const bf16_t* z = Z + (size_t)r * AB_IN + 1024; const int s = r % RPB;
            qv[q] = *(const v4u*)(z + 8 * lane); kv[q] = lane < 32 ? *(const v4u*)(z + 512 + 8 * lane) : (v4u){0u, 0u, 0u, 0u};
            if (s >= CTX) { const float* rp = R0 + (size_t)(s - CTX) * 64 + i0; cs[q][0] = *(const f32x4*)rp; cs[q][1] = *(const f32x4*)(rp + 4); sn[q][0] = *(const f32x4*)(rp + 32); sn[q][1] = *(const f32x4*)(rp + 36); } } }
#pragma unroll
        for (int q = 0; q < 2; ++q) { const int r = r0 + q * ng; if (r < lim) { const bool lat = (r % RPB) >= CTX;
#pragma unroll
            for (int ps = 0; ps < 2; ++ps) { const v4u raw = ps == 0 ? qv[q] : kv[q]; float x[8];
#pragma unroll
                for (int e = 0; e < 4; ++e) { x[2 * e] = __uint_as_float(raw[e] << 16); x[2 * e + 1] = __uint_as_float(raw[e] & 0xffff0000u); }
                float ss = 0.f;
#pragma unroll
                for (int e = 0; e < 8; ++e) ss += x[e] * x[e];
                ss += __shfl_xor(ss, 1); ss += __shfl_xor(ss, 2); ss += __shfl_xor(ss, 4);
                const float rs = rsqrtf(ss * (1.f / 64.f) + EPS); float y[8];
#pragma unroll
                for (int e = 0; e < 8; ++e) y[e] = x[e] * rs * (ps == 0 ? qn[e] : kn[e]);
                if (lat) {
#pragma unroll
                    for (int e = 0; e < 8; ++e) { const float other = __shfl_xor(y[e], 4); const float c = cs[q][e >> 2][e & 3], s_ = sn[q][e >> 2][e & 3]; y[e] = (lane & 4) ? (other * s_ + y[e] * c) : (y[e] * c - other * s_); } }
                v4u o; o.x = pk2(y[0], y[1]); o.y = pk2(y[2], y[3]); o.z = pk2(y[4], y[5]); o.w = pk2(y[6], y[7]);
                if (ps == 0) *(v4u*)(Q + (size_t)r * 512 + 8 * lane) = o;
                else if (lane < 16) *(v4u*)(K + (size_t)r * 128 + 8 * lane) = o;
                else if (lane < 32) *(v4u*)(V + (size_t)r * 128 + 8 * (lane - 16)) = raw; } } }
    } }
}
__device__ __forceinline__ void mla_prep1(const Frame& F, const Params& P) {
    char* ws = F.ws; const bf16_t* Z = (const bf16_t*)(ws + WS_Z); bf16_t* QA = (bf16_t*)(ws + WS_QA); bf16_t* KVA = (bf16_t*)(ws + WS_KVA); bf16_t* KR = (bf16_t*)(ws + WS_KR);
    const int gw = F.bid * NWAVES + F.wave, NGW = F.G * NWAVES, lane = F.lane; const float* gq = PIN(33); const float* gkv = PIN(35);
    const f32x4 g4 = *(const f32x4*)(gq + 4 * lane); const float gk0 = gkv[2 * lane], gk1 = gkv[2 * lane + 1];
    for (int r0 = gw; r0 < MROWS; r0 += 3 * NGW) {
        u32x2 qw[3]; unsigned kw[3], krw[3];
#pragma unroll
        for (int q = 0; q < 3; ++q) { const int r = r0 + q * NGW; if (r < MROWS) { const bf16_t* z = Z + (size_t)r * CD_LD; qw[q] = *(const u32x2*)(z + 1536 + 4 * lane); kw[q] = *(const unsigned*)(z + 1792 + 2 * lane); krw[q] = lane < 16 ? *(const unsigned*)(z + 1920 + 2 * lane) : 0u; } }
#pragma unroll
        for (int q = 0; q < 3; ++q) { const int r = r0 + q * NGW; if (r < MROWS) {
            const float q0 = __uint_as_float(qw[q].x << 16), q1 = __uint_as_float(qw[q].x & 0xffff0000u), q2 = __uint_as_float(qw[q].y << 16), q3 = __uint_as_float(qw[q].y & 0xffff0000u);
            const float k0 = __uint_as_float(kw[q] << 16), k1 = __uint_as_float(kw[q] & 0xffff0000u);
            const float rq = rsqrtf(wave_sum((q0 * q0 + q1 * q1) + (q2 * q2 + q3 * q3)) * (1.f / 256.f) + EPS), rk = rsqrtf(wave_sum(k0 * k0 + k1 * k1) * (1.f / 128.f) + EPS);
            u32x2 o; o.x = pk2(q0 * rq * g4[0], q1 * rq * g4[1]); o.y = pk2(q2 * rq * g4[2], q3 * rq * g4[3]); *(u32x2*)(QA + (size_t)r * 256 + 4 * lane) = o;
            *(unsigned*)(KVA + (size_t)r * 256 + 2 * lane) = pk2(k0 * rk * gk0, k1 * rk * gk1); *(unsigned*)(KVA + (size_t)r * 256 + 128 + 2 * lane) = 0u;
            if (lane < 16) *(unsigned*)(KR + (size_t)r * 32 + 2 * lane) = krw[q]; } }
    }
}
__device__ __forceinline__ void mla_prep2(const Frame& F, const Params& P) {
    char* ws = F.ws; char* dob = (char*)P.out; const bf16_t* QR = (const bf16_t*)(ws + WS_QR); const bf16_t* KVR = (const bf16_t*)(ws + WS_KVR); const bf16_t* KR = (const bf16_t*)(ws + WS_KR);
    bf16_t* QM = (bf16_t*)(ws + WS_QM); bf16_t* KM = (bf16_t*)(dob + DO_KM); bf16_t* VM = (bf16_t*)(dob + DO_VM); const float* R1 = (const float*)(ws + WS_ROPE1);
    const int gw = F.bid * NWAVES + F.wave, NGW = F.G * NWAVES, lane = F.lane; const int h = lane >> 3, sub = lane & 7; const bool rl = sub < 4; const int rs8 = 8 * (sub & 3), ti = rs8 & 15;
    float qn0[8], qn1[8], kn0[8], kn1[8];
#pragma unroll
    for (int e = 0; e < 8; ++e) { qn0[e] = PIN(37)[8 * sub + e] * QSCALE1; qn1[e] = PIN(37)[64 + rs8 + e] * QSCALE1; kn0[e] = PIN(38)[8 * sub + e]; kn1[e] = PIN(38)[64 + rs8 + e]; }
#define MP2_UNPK(raw, x) _Pragma("unroll") for (int e_ = 0; e_ < 4; ++e_) { x[2 * e_] = __uint_as_float(raw[e_] << 16); x[2 * e_ + 1] = __uint_as_float(raw[e_] & 0xffff0000u); }
#define MP2_PK(y) (v4u){pk2(y[0], y[1]), pk2(y[2], y[3]), pk2(y[4], y[5]), pk2(y[6], y[7])}
    for (int r = gw; r < MROWS; r += NGW) { const int s = r % RPB; const bool lat = s >= CTX;
        const v4u kraw = *(const v4u*)(KVR + (size_t)r * 1024 + h * 128 + 8 * sub), vraw = *(const v4u*)(KVR + (size_t)r * 1024 + h * 128 + 64 + 8 * sub);
        const v4u rraw = *(const v4u*)(KR + (size_t)r * 32 + rs8);
        v4u qraw = {0u, 0u, 0u, 0u}, qrr = {0u, 0u, 0u, 0u}; f32x4 cs[2], sn[2];
        if (lat) { qraw = *(const v4u*)(QR + (size_t)r * 768 + h * 96 + 8 * sub); qrr = *(const v4u*)(QR + (size_t)r * 768 + h * 96 + 64 + rs8);
            const float* rp = R1 + (size_t)(s - CTX) * 32 + ti; cs[0] = *(const f32x4*)rp; cs[1] = *(const f32x4*)(rp + 4); sn[0] = *(const f32x4*)(rp + 16); sn[1] = *(const f32x4*)(rp + 20); }
        *(v4u*)(VM + (size_t)r * 512 + h * 64 + 8 * sub) = vraw;
#pragma unroll
        for (int which = 0; which < 2; ++which) {
            if (which == 1 && !lat) break;
            float a[8], bq[8]; { const v4u ra = which == 0 ? kraw : qraw, rb = which == 0 ? rraw : qrr; MP2_UNPK(ra, a) MP2_UNPK(rb, bq) }
            float ss = 0.f;
#pragma unroll
            for (int e = 0; e < 8; ++e) ss += a[e] * a[e] + (rl ? bq[e] * bq[e] : 0.f);
            ss += __shfl_xor(ss, 1); ss += __shfl_xor(ss, 2); ss += __shfl_xor(ss, 4);
            const float rsd = rsqrtf(ss * (1.f / 96.f) + EPS);
#pragma unroll
            for (int e = 0; e < 8; ++e) { a[e] = a[e] * rsd * (which == 0 ? kn0[e] : qn0[e]); bq[e] = bq[e] * rsd * (which == 0 ? kn1[e] : qn1[e]); }
            if (lat) {
#pragma unroll
                for (int e = 0; e < 8; ++e) { const float other = __shfl_xor(bq[e], 2); const float c = cs[e >> 2][e & 3], sv = sn[e >> 2][e & 3]; bq[e] = (sub & 2) ? (other * sv + bq[e] * c) : (bq[e] * c - other * sv); } }
            bf16_t* o = (which == 0 ? KM : QM) + (size_t)r * 768 + h * 96;
            *(v4u*)(o + 8 * sub) = MP2_PK(a); if (rl) *(v4u*)(o + 64 + rs8) = MP2_PK(bq); }
    }
#undef MP2_UNPK
#undef MP2_PK
}
}
__global__ void __launch_bounds__(NTHREADS, 2) mk_kernel(Params prm) {
    extern __shared__ __attribute__((aligned(16))) unsigned char lds_raw[];
    Frame F; F.lds = (LAS unsigned char*)lds_raw; F.tid = threadIdx.x; F.lane = F.tid & 63; F.wave = __builtin_amdgcn_readfirstlane(F.tid >> 6);
    F.G = gridDim.x; F.bid = blockIdx.x; F.even = 0; F.ws = prm.ws;
    const Params& P = prm;
    const float* MOD0 = (const float*)(prm.ws + WS_MOD);
    const int lo = prm.ph_lo, hi = prm.ph_hi;
    volatile LAS unsigned* MISCW = (volatile LAS unsigned*)(F.lds + MISC_OFF + 8192);
    if (F.tid < 64) MISCW[F.tid] = 0u;
    __syncthreads();
    if (prm.ph_lo == 123456) cooperative_groups::this_grid().sync();
    XcdBarrier bar = xcd_barrier_post((unsigned*)(prm.ws + WS_CTL + CT_BAR), MISCW + 8);
#define RUN(k, body) if (lo <= (k) && (k) < hi) { body; if ((k) + 1 < hi) xcd_barrier(bar); }
#define RUN_GEMMS(PH0, NPH, G0) { _Pragma("unroll 1") for (int i_ = 0; i_ < (NPH); ++i_) { const int k_ = (PH0) + i_; if (lo <= k_ && k_ < hi) { run_gemm(F, prm, (G0) + i_); if (k_ + 1 < hi) xcd_barrier(bar); } } }
    RUN(PH_P0, { el::rope_tables(F); el::mod_phase(F, prm); phase_conv(F, prm, false); hy::filt(F, prm); })
    if (MISCW[8 + 3] != 0u) { F.bid = __builtin_amdgcn_readfirstlane((int)(MISCW[8 + 2] * 8u + bar.x)); F.even = 1; }
    RUN(PH_NORM0, { el::norm_phase<0>(F, prm, PIN(6), MOD0, 0, 1); el::bias_phase(F, prm); })
    RUN(PH_G_IN0, run_gemm(F, prm, G_IN0))
    RUN(PH_LRUPREP, { lru::phase<0>(F, prm); el::gqa_prep(F, prm); })
    RUN(PH_MIX0, { phase_attn0(F); lru::phase<1>(F, prm); })
    RUN(PH_G_OUT0, { run_gemm(F, prm, G_OUT0); run_gemm(F, prm, G_F1); moe_conv_all(F, prm, 0, MOE_ITEMS / 2); run_gemm(F, prm, G_F2); moe_conv_all(F, prm, MOE_ITEMS / 2, MOE_ITEMS); run_gemm(F, prm, G_IN1); })
    RUN(PH_PREP1, { hy::prep(F, prm); el::mla_prep1(F, prm); })
    RUN(PH_G_QKVB, { run_gemm(F, prm, G_QB); run_gemm(F, prm, G_KVB); })
    RUN(PH_PREP2, { el::mla_prep2(F, prm); hy::main_phase(F, prm); })
    RUN(PH_MIX1, { phase_attn1(F, prm); hy::untranspose(F); })
    RUN(PH_G_OUT1, run_gemm(F, prm, G_OUT1))
    RUN(PH_ROUTE, phase_route(F, prm))
    RUN(PH_SLOT, phase_slot(F, prm))
    RUN(PH_MOE1, { run_gemm(F, prm, G_MOE1); run_gemm(F, prm, G_MOE2); })
    RUN(PH_COMBINE, phase_combine(F, prm))
#undef RUN
#undef RUN_GEMMS
}
#ifndef SPLIT_LAUNCH
#define SPLIT_LAUNCH 0
#endif
extern "C" void kernel_launch(void* const* d_in, const int* in_sizes, int n_in, void* d_out, int out_size, void* d_ws, size_t ws_size, hipStream_t st) {
    static int grid = 0;
    if (grid == 0) {
        if (n_in != 43 || out_size != NLAT * DM || ws_size < WS_END) { fprintf(stderr, "kernel_launch: unexpected problem (n_in %d, out %d, ws %zu < %zu)\n", n_in, out_size, ws_size, (size_t)WS_END); grid = -1; return; }
        int dev = 0, cus = 0, per_cu = 0;
        (void)hipGetDevice(&dev); (void)hipDeviceGetAttribute(&cus, hipDeviceAttributeMultiprocessorCount, dev);
        (void)hipFuncSetAttribute((const void*)mk_kernel, hipFuncAttributeMaxDynamicSharedMemorySize, LDS_BYTES);
        (void)hipOccupancyMaxActiveBlocksPerMultiprocessor(&per_cu, (const void*)mk_kernel, NTHREADS, LDS_BYTES);
        grid = cus;
        if (grid != 256 || per_cu < 1) { fprintf(stderr, "kernel_launch: grid %d (CUs %d, occupancy query %d): this kernel is written for 256 resident workgroups; nothing launched\n", grid, cus, per_cu); grid = -1; return; }
    }
    if (grid < 0) return;
    (void)hipMemsetAsync((char*)d_ws + WS_CTL, 0, CTL_BYTES, st);
    Params prm{}; prm.i0 = (const float*)d_in[0]; prm.i1 = (const float*)d_in[1]; prm.i2 = (const float*)d_in[2]; prm.i3 = (const float*)d_in[3]; prm.i4 = (const float*)d_in[4]; prm.i5 = (const float*)d_in[5]; prm.i6 = (const float*)d_in[6]; prm.i7 = (const float*)d_in[7]; prm.i8 = (const float*)d_in[8]; prm.i9 = (const float*)d_in[9]; prm.i10 = (const float*)d_in[10]; prm.i11 = (const float*)d_in[11]; prm.i12 = (const float*)d_in[12]; prm.i13 = (const float*)d_in[13]; prm.i14 = (const float*)d_in[14]; prm.i15 = (const float*)d_in[15]; prm.i16 = (const float*)d_in[16]; prm.i17 = (const float*)d_in[17]; prm.i18 = (const float*)d_in[18]; prm.i19 = (const float*)d_in[19]; prm.i20 = (const float*)d_in[20]; prm.i21 = (const float*)d_in[21]; prm.i22 = (const float*)d_in[22]; prm.i23 = (const float*)d_in[23]; prm.i24 = (const float*)d_in[24]; prm.i25 = (const float*)d_in[25]; prm.i26 = (const float*)d_in[26]; prm.i27 = (const float*)d_in[27]; prm.i28 = (const float*)d_in[28]; prm.i29 = (const float*)d_in[29]; prm.i30 = (const float*)d_in[30]; prm.i31 = (const float*)d_in[31]; prm.i32 = (const float*)d_in[32]; prm.i33 = (const float*)d_in[33]; prm.i34 = (const float*)d_in[34]; prm.i35 = (const float*)d_in[35]; prm.i36 = (const float*)d_in[36]; prm.i37 = (const float*)d_in[37]; prm.i38 = (const float*)d_in[38]; prm.i39 = (const float*)d_in[39]; prm.i40 = (const float*)d_in[40]; prm.i41 = (const float*)d_in[41]; prm.i42 = (const float*)d_in[42]; prm.out = (float*)d_out; prm.ws = (char*)d_ws;
#if SPLIT_LAUNCH
    for (int ph = 0; ph < PH_COUNT; ++ph) { prm.ph_lo = ph; prm.ph_hi = ph + 1; hipLaunchKernelGGL(mk_kernel, dim3(grid), dim3(NTHREADS), LDS_BYTES, st, prm); }
#else
    prm.ph_lo = 0; prm.ph_hi = PH_COUNT;
    void* args[] = {&prm};
    hipError_t e = hipLaunchCooperativeKernel((const void*)mk_kernel, dim3(grid), dim3(NTHREADS), args, LDS_BYTES, st);
    if (e != hipSuccess) fprintf(stderr, "kernel_launch: cooperative launch failed: %s (grid %d)\n", hipGetErrorString(e), grid);
#endif
}
```

```cpp
#include <hip/hip_runtime.h>
#include <hip/hip_cooperative_groups.h>
#include <cstdio>
#include <cstdint>
#include <cmath>

constexpr int NB = 8, SEQ = 2048, CTX = 256, RPB = SEQ + CTX, MROWS = NB * RPB, DM = 1024, NLAT = NB * SEQ;
constexpr int NMOD = 6, MODLD = NMOD * DM;
constexpr int AB_IN = 1792, CD_IN = 1952, CD_LD = 2048, DFF = 2816, NEXP = 8, DFE = 3584;
constexpr float EPS = 1e-6f;
constexpr float LOG2E = 1.4426950408889634f;
constexpr float QSCALE0 = 0.125f * LOG2E;
constexpr float QSCALE1 = 0.10206207261596577f * LOG2E;

typedef unsigned short bf16_t;
typedef float f32x4 __attribute__((ext_vector_type(4)));
typedef unsigned u32x4 __attribute__((ext_vector_type(4)));
typedef unsigned u32x2 __attribute__((ext_vector_type(2)));

__device__ __forceinline__ int mod_row(int r) { int b = r / RPB, s = r % RPB; return s < CTX ? 8 : b; }
__device__ __forceinline__ int latent_row(int m) { return (m / SEQ) * RPB + CTX + (m % SEQ); }

__device__ __forceinline__ float bf2f(bf16_t v) { return __uint_as_float((unsigned)v << 16); }
typedef float hd_f32x2 __attribute__((ext_vector_type(2))); typedef __bf16 hd_bf16x2 __attribute__((ext_vector_type(2)));
__device__ __forceinline__ unsigned pk2(float lo, float hi) { hd_f32x2 v = {lo, hi}; hd_bf16x2 b = __builtin_convertvector(v, hd_bf16x2); return __builtin_bit_cast(unsigned, b); }
__device__ __forceinline__ bf16_t f2bf(float f) { return (bf16_t)(pk2(f, 0.f) & 0xffffu); }
__device__ __forceinline__ float ldf(const float* p) { return *p; }
__device__ __forceinline__ float ldf(const bf16_t* p) { return bf2f(*p); }
__device__ __forceinline__ void stf(float* p, float v) { *p = v; }
__device__ __forceinline__ void stf(bf16_t* p, float v) { *p = f2bf(v); }

__device__ __forceinline__ float silu_f(float x) { return x / (1.f + expf(-x)); }
__device__ __forceinline__ float sigmoid_f(float x) { return 1.f / (1.f + expf(-x)); }
__device__ __forceinline__ float gelu_tanh(float x) { return 0.5f * x * (1.f + tanhf(0.7978845608028654f * (x + 0.044715f * x * x * x))); }
__device__ __forceinline__ float softplus_f(float x) { return fmaxf(x, 0.f) + log1pf(expf(-fabsf(x))); }

__device__ __forceinline__ float wave_sum(float v) {
#pragma unroll
    for (int o = 1; o < 64; o <<= 1) v += __shfl_xor(v, o);
    return v;
}
__device__ __forceinline__ float wave_max(float v) {
#pragma unroll
    for (int o = 1; o < 64; o <<= 1) v = fmaxf(v, __shfl_xor(v, o));
    return v;
}

constexpr size_t MiB = 1ull << 20;
constexpr size_t WS_CTL = 0, CTL_BYTES = 256 * 1024;
constexpr size_t WS_MOD = 1 * MiB;
constexpr size_t WS_SC = WS_MOD + 512 * 1024;
constexpr size_t WS_W13M = 4 * MiB;
constexpr size_t WS_W2M = 116 * MiB;
constexpr size_t WS_WIN0 = 172 * MiB;
constexpr size_t WS_WOUT0 = WS_WIN0 + (size_t)1792 * 1024 * 2;
constexpr size_t WS_WF13 = WS_WOUT0 + (size_t)1024 * 1024 * 2;
constexpr size_t WS_WF2 = WS_WF13 + (size_t)5632 * 1024 * 2;
constexpr size_t WS_WIN1 = WS_WF2 + (size_t)1024 * 2816 * 2;
constexpr size_t WS_WOUT1 = WS_WIN1 + (size_t)2048 * 1024 * 2;
constexpr size_t WS_WQB = WS_WOUT1 + (size_t)1024 * 1024 * 2;
constexpr size_t WS_WKVB = WS_WQB + (size_t)768 * 256 * 2;
constexpr size_t WS_WLRU = WS_WKVB + (size_t)1024 * 256 * 2;
constexpr size_t WS_WEND = WS_WLRU + (size_t)2 * 8 * 2 * 64 * 64 * 2;
static_assert(WS_WEND <= 202 * MiB, "weights region");
constexpr size_t WS_X = 202 * MiB;
constexpr size_t WS_H = 274 * MiB;
constexpr size_t WS_Z = 310 * MiB;
constexpr size_t WS_Y = 382 * MiB;
constexpr size_t WS_ACT = WS_Z;
constexpr size_t WS_R2 = 418 * MiB;
constexpr size_t WS_END = 502 * MiB;
static_assert(WS_ACT + (size_t)MROWS * DFF * 2 <= WS_R2, "ACT overlay");
constexpr size_t WS_QB = WS_R2;
constexpr size_t WS_KB = WS_QB + (size_t)MROWS * 512 * 2;
constexpr size_t WS_VB = WS_KB + (size_t)MROWS * 128 * 2;
constexpr size_t WS_AGG = WS_VB + (size_t)MROWS * 128 * 2;
constexpr size_t WS_R2L0END = WS_AGG + (size_t)2 * 8 * 72 * 2 * 512 * 4;
constexpr size_t WS_ZT = WS_R2;
constexpr size_t WS_HT = WS_ZT + (size_t)1536 * NLAT * 2;
constexpr size_t WS_GT = WS_HT + (size_t)512 * NLAT * 2;
constexpr int GT_LD = 4224;
constexpr size_t WS_R2L1END = WS_GT + (size_t)2 * 512 * GT_LD * 2;
static_assert(WS_R2L0END <= WS_END && WS_R2L1END <= WS_END, "R2");
constexpr size_t WS_QA = WS_Y;
constexpr size_t WS_KVA = WS_QA + (size_t)MROWS * 256 * 2;
constexpr size_t WS_KR = WS_KVA + (size_t)MROWS * 256 * 2;
constexpr size_t WS_QR = WS_Z;
constexpr size_t WS_KVR = WS_QR + (size_t)MROWS * 768 * 2;
static_assert(WS_KVR + (size_t)MROWS * 1024 * 2 <= WS_Y && WS_KR + (size_t)MROWS * 32 * 2 <= WS_R2, "layer-1 overlays");
constexpr size_t WS_QM = WS_H;
static_assert((size_t)MROWS * 768 * 2 <= 36 * MiB, "QM in H");
constexpr size_t DO_KM = 0;
constexpr size_t DO_VM = (size_t)MROWS * 768 * 2;
static_assert(DO_VM + (size_t)MROWS * 512 * 2 <= (size_t)NLAT * DM * 4, "d_out scratch");
constexpr int MAXSLOT = 34816;
constexpr size_t WS_XG = WS_WIN0;
constexpr size_t WS_ACT2 = WS_XG + (size_t)MAXSLOT * 1024 * 2;
constexpr size_t WS_H2 = WS_ACT2 + (size_t)MAXSLOT * 3584 * 2 - (size_t)NLAT * 1024 * 2;
static_assert(WS_ACT2 + (size_t)MAXSLOT * 3584 * 2 <= WS_END, "MoE overlay");
constexpr size_t CT_BAR = 0;
constexpr size_t CT_PCNT = 16 * 1024;
constexpr size_t CT_MCNT = 48 * 1024;
constexpr size_t CT_HIST = 32 * 1024;
constexpr size_t CT_CNT = 48 * 1024;
constexpr size_t CT_CURSOR = 80 * 1024;
constexpr size_t CT_DONE = 80 * 1024 + 256;
constexpr size_t CT_SSQA = 96 * 1024;
constexpr size_t CT_SSQB = CT_SSQA + (size_t)MROWS * 4;
static_assert(CT_SSQB + (size_t)MROWS * 4 <= CTL_BYTES, "ssq in the zeroed control region");
constexpr size_t WS_SLOTTOK = 2 * MiB;
constexpr size_t WS_SLOTGATE = WS_SLOTTOK + (size_t)MAXSLOT * 4;
constexpr size_t WS_SEL = WS_SLOTGATE + (size_t)MAXSLOT * 4;
constexpr size_t WS_TOKSLOT = WS_SEL + (size_t)NLAT * 16;
static_assert(WS_TOKSLOT + (size_t)NLAT * 8 <= WS_W13M, "small tables");
constexpr size_t WS_ROPE0 = 3 * MiB;
constexpr size_t WS_ROPE1 = 3 * MiB + 512 * 1024;
static_assert(WS_TOKSLOT + (size_t)NLAT * 8 <= WS_ROPE0 && WS_ROPE1 + 256 * 1024 <= WS_W13M, "rope tables");
constexpr size_t WS_CBF1 = WS_SC + 64 * 1024;
constexpr size_t WS_CBIN1 = WS_CBF1 + 9 * 5632 * 4;
static_assert(WS_CBIN1 + 9 * 2048 * 4 <= WS_SLOTTOK, "bias vectors");
constexpr size_t WS_Y2 = WS_XG;
namespace pg8 {
#define PG8_LAS __attribute__((address_space(3)))
typedef unsigned short bf16_t;
typedef short bf16x8 __attribute__((ext_vector_type(8)));
typedef float f32x4 __attribute__((ext_vector_type(4)));
typedef unsigned u32x4 __attribute__((ext_vector_type(4)));
constexpr int BM = 256, BK = 64, HALF = 128, HTB = HALF * BK * 2  , STAGE_BYTES = 8 * HTB, NXCD = 8, WGM = 8;

__host__ __device__ __forceinline__ int lds_byte(int r, int c) { const int st = (r >> 4) * 2 + (c >> 5), rr = r & 15, cc = c & 31, ob = rr * 64 + cc * 2; return st * 1024 + (ob ^ (((ob >> 9) & 1) << 5)); }
__host__ __device__ __forceinline__ void stage_rc(int b, int& R, int& C) { const int st = b / 1024, sb = b % 1024, swz = sb ^ (((sb >> 9) & 1) << 5); R = (st >> 1) * 16 + swz / 64; C = (st & 1) * 32 + (swz % 64) / 2; }
__host__ __device__ __forceinline__ int perm32(int rho) { const int n = rho >> 4, i = rho & 15; return 8 * (i >> 2) + 4 * n + (i & 3); }

struct Unit { int pm, pn; };
struct Gemm { const bf16_t* A; const bf16_t* Bt; int M, N, K; };

struct StaticOrder {
    int nM, nN, nwg, G, c;
    __host__ __device__ void init(int M, int N, int G_, int c_) { nM = M / BM; nN = N / BM; nwg = nM * nN; G = G_; c = c_; }
    __host__ __device__ bool next(int i, Unit& u) const {
        const long L = (long)i * G + c; if (L >= nwg) return false;
        int wgid = (int)L; { const int q = nwg / NXCD, r = nwg % NXCD, xcd = wgid % NXCD, off = wgid / NXCD; wgid = (xcd < r ? xcd * (q + 1) : r * (q + 1) + (xcd - r) * q) + off; }
        const int nig = WGM * nN, gid = wgid / nig, fm = gid * WGM, gsz = (nM - fm) < WGM ? (nM - fm) : WGM;
        u.pm = fm + ((wgid % nig) % gsz); u.pn = (wgid % nig) / gsz; return true;
    }
    __device__ __forceinline__ void a_ready(const Unit&) const {}
    __device__ __forceinline__ void done(const Unit&) const {}
};

__device__ __forceinline__ unsigned cvt_pk_bf16(float lo, float hi) { unsigned r; asm volatile("v_cvt_pk_bf16_f32 %0, %1, %2" : "=v"(r) : "v"(lo), "v"(hi)); return r; }
typedef float f32x2 __attribute__((ext_vector_type(2)));
__device__ __forceinline__ f32x2 gelu_pk(f32x2 v) {
    const f32x2 av = __builtin_elementwise_abs(v), d = av * 0.2316418882f + 1.0f;
    f32x2 t; t.x = __builtin_amdgcn_rcpf(d.x); t.y = __builtin_amdgcn_rcpf(d.y);
    f32x2 q = t * 0.5307027145f + (-0.7265760135f); q = q * t + 0.7107068705f; q = q * t + (-0.142248368f); q = q * t + 0.127414796f; q = q * t;
    const f32x2 s = (v * v) * (-0.72134752044f);
    f32x2 e; e.x = __builtin_amdgcn_exp2f(s.x); e.y = __builtin_amdgcn_exp2f(s.y);
    const f32x2 m = v * (q * e), r = v - m;
    f32x2 o; o.x = v.x < 0.f ? m.x : r.x; o.y = v.y < 0.f ? m.y : r.y; return o;
}

template <int ACT  > struct EpiBf16 {
    static constexpr bool PERM = true, AFTER_DRAIN = false; static_assert(ACT == 0 || ACT == 1, "EpiBf16: ACT is 0 (none) or 1 (gelu_pk)");
    bf16_t* O; int ldc; const float* bias; int split_cols; size_t split_stride; float scale0;
    __device__ __forceinline__ void operator()(const f32x4 (&acc)[2][2][4][2], const Unit& u, int wr, int wc, int fr, int fq) const {
        const int row0 = u.pm * BM + wr * 64 + fr; int colt = u.pn * BM; bf16_t* base = O;
        float sc = 1.f; if (split_cols) { const int t = colt / split_cols; base += (size_t)t * split_stride; colt -= t * split_cols; if (t == 0) sc = scale0; }
        const int col0 = colt + wc * 32 + 8 * fq, bcol0 = u.pn * BM + wc * 32 + 8 * fq;
        f32x4 bv[2][2];
#pragma unroll
        for (int bj = 0; bj < 2; ++bj)
#pragma unroll
            for (int n = 0; n < 2; ++n) bv[bj][n] = bias ? *(const f32x4*)(bias + bcol0 + bj * HALF + 4 * n) : (f32x4){0.f, 0.f, 0.f, 0.f};
#pragma unroll
        for (int ai = 0; ai < 2; ++ai)
#pragma unroll
            for (int m = 0; m < 4; ++m) { bf16_t* rowp = base + (size_t)(row0 + ai * HALF + m * 16) * ldc + col0;
#pragma unroll
                for (int bj = 0; bj < 2; ++bj) { f32x4 v0 = acc[ai][bj][m][0] + bv[bj][0], v1 = acc[ai][bj][m][1] + bv[bj][1];
                    if (ACT == 1) { f32x2 a = gelu_pk((f32x2){v0[0], v0[1]}), b = gelu_pk((f32x2){v0[2], v0[3]}), c = gelu_pk((f32x2){v1[0], v1[1]}), d = gelu_pk((f32x2){v1[2], v1[3]});
                        v0 = (f32x4){a.x, a.y, b.x, b.y}; v1 = (f32x4){c.x, c.y, d.x, d.y}; }
                    v0 = v0 * sc; v1 = v1 * sc; u32x4 w; w.x = cvt_pk_bf16(v0[0], v0[1]); w.y = cvt_pk_bf16(v0[2], v0[3]); w.z = cvt_pk_bf16(v1[0], v1[1]); w.w = cvt_pk_bf16(v1[2], v1[3]);
                    *(u32x4*)(rowp + bj * HALF) = w; } }
    }
};

template <class Epi, class Sched, bool ALIGN_EPI = false, bool SP2 = false>
__device__ __forceinline__ void gemm_phase(PG8_LAS unsigned char* lds, const Gemm g, const Sched& S, const Epi& E) {
    int tid_ = threadIdx.x; asm volatile("" : "+v"(tid_));
    const int tid = tid_, wid = __builtin_amdgcn_readfirstlane(tid >> 6), lane = tid & 63, wr = wid >> 2, wc = wid & 3, fr = lane & 15, fq = lane >> 4;
    const int K = g.K, nt = K / BK;
    unsigned voffA[2], voffB[2];
#pragma unroll
    for (int i = 0; i < 2; ++i) { int R, C; stage_rc(tid * 16 + i * 8192, R, C); const int Rb = Epi::PERM ? ((R & ~31) + perm32(R & 31)) : R;
        voffA[i] = (unsigned)(R * K + C) * 2u; voffB[i] = (unsigned)(Rb * K + C) * 2u; }
    const size_t kstep = (size_t)(BK * 2);
    const size_t hstep = (size_t)HALF * K * 2;
    const size_t tstep = 2 * hstep;
    const unsigned ldsw = (unsigned)wid * 1024u;
    const int aoff = lds_byte(wr * 64 + fr, fq * 8), boff = lds_byte(wc * 32 + fr, fq * 8);
#define PG8_SA(b, h) (((b) * 2 + (h)) * HTB)
#define PG8_SB(b, h) ((4 + (b) * 2 + (h)) * HTB)
#define PG8_STAGE(bufoff, gbase, voff) do { _Pragma("unroll") for (int _i = 0; _i < 2; ++_i) \
        __builtin_amdgcn_global_load_lds((const unsigned*)((const char*)(gbase) + (voff)[_i]), (PG8_LAS unsigned*)(lds + (bufoff) + ldsw + _i * 8192), 16, 0, 0); } while (0)
#define PG8_LDA(dst, b, h) do { _Pragma("unroll") for (int m = 0; m < 4; ++m) _Pragma("unroll") for (int k = 0; k < 2; ++k) dst[m][k] = *(const PG8_LAS bf16x8*)(lds + PG8_SA(b, h) + aoff + m * 2048 + k * 1024); } while (0)
#define PG8_LDB(dst, b, h) do { _Pragma("unroll") for (int n = 0; n < 2; ++n) _Pragma("unroll") for (int k = 0; k < 2; ++k) dst[n][k] = *(const PG8_LAS bf16x8*)(lds + PG8_SB(b, h) + boff + n * 2048 + k * 1024); } while (0)
#define PG8_MMA(ai, bj, At, Bt) do { __builtin_amdgcn_s_setprio(1); _Pragma("unroll") for (int m = 0; m < 4; ++m) _Pragma("unroll") for (int n = 0; n < 2; ++n) _Pragma("unroll") for (int k = 0; k < 2; ++k) \
        acc[ai][bj][m][n] = __builtin_amdgcn_mfma_f32_16x16x32_bf16(Bt[n][k], At[m][k], acc[ai][bj][m][n], 0, 0, 0); __builtin_amdgcn_s_setprio(0); } while (0)
#define PG8_WAIT_V(n) asm volatile("s_waitcnt vmcnt(" #n ")" ::: "memory")
#define PG8_WAIT_L(n) asm volatile("s_waitcnt lgkmcnt(" #n ")" ::: "memory")
#define PG8_BAR __builtin_amdgcn_s_barrier()
#define PG8_SCHED __builtin_amdgcn_sched_barrier(0)
    Unit cur, nxt; int ui = 0;
    if (!S.next(0, cur)) return;
    f32x4 acc[2][2][4][2];
#pragma unroll
    for (int a = 0; a < 2; ++a)
#pragma unroll
        for (int b = 0; b < 2; ++b)
#pragma unroll
            for (int m = 0; m < 4; ++m)
#pragma unroll
                for (int n = 0; n < 2; ++n) acc[a][b][m][n] = (f32x4){0.f, 0.f, 0.f, 0.f};
    bf16x8 At[4][2], B0[2][2], B1[2][2];
    const char* cA = (const char*)g.A + (size_t)cur.pm * tstep; const char* cB = (const char*)g.Bt + (size_t)cur.pn * tstep;
    S.a_ready(cur);
    if constexpr (SP2) {
        PG8_STAGE(PG8_SB(0, 0), cB, voffB); PG8_STAGE(PG8_SB(0, 1), cB + hstep, voffB); PG8_STAGE(PG8_SA(0, 0), cA, voffA); PG8_STAGE(PG8_SA(0, 1), cA + hstep, voffA);
        if (wr == 1) PG8_BAR;
        PG8_WAIT_V(2); PG8_BAR;
        PG8_STAGE(PG8_SB(1, 0), cB + kstep, voffB); PG8_STAGE(PG8_SA(1, 0), cA + kstep, voffA); PG8_STAGE(PG8_SB(1, 1), cB + hstep + kstep, voffB);
        PG8_WAIT_V(6); PG8_BAR;
    } else {
        PG8_STAGE(PG8_SB(0, 0), cB, voffB); PG8_STAGE(PG8_SA(0, 0), cA, voffA); PG8_STAGE(PG8_SB(0, 1), cB + hstep, voffB); PG8_STAGE(PG8_SA(0, 1), cA + hstep, voffA);
        if (wr == 1) PG8_BAR;
        PG8_WAIT_V(4); PG8_BAR;
        PG8_STAGE(PG8_SB(1, 0), cB + kstep, voffB); PG8_STAGE(PG8_SA(1, 0), cA + kstep, voffA); PG8_STAGE(PG8_SB(1, 1), cB + hstep + kstep, voffB);
        PG8_WAIT_V(6); PG8_BAR;
    }
    for (;;) {
        const bool has_next = S.next(ui + 1, nxt);
        const char* nA = has_next ? (const char*)g.A + (size_t)nxt.pm * tstep : cA; const char* nB = has_next ? (const char*)g.Bt + (size_t)nxt.pn * tstep : cB;
        for (int t = 0; t < nt; t += 2) {
            const bool last = (t == nt - 2);
            const char* a1 = cA + (size_t)(t + 1) * kstep;
            const char* a2 = last ? nA : cA + (size_t)(t + 2) * kstep; const char* b2 = last ? nB : cB + (size_t)(t + 2) * kstep;
            const char* a3 = a2 + kstep; const char* b3 = b2 + kstep;
            if (last && has_next) S.a_ready(nxt);
            if constexpr (SP2) {
            PG8_LDB(B0, 0, 0); PG8_LDB(B1, 0, 1); PG8_SCHED; PG8_LDA(At, 0, 0); PG8_STAGE(PG8_SA(1, 1), a1 + hstep, voffA);
            PG8_WAIT_V(8); PG8_WAIT_L(0); PG8_BAR; PG8_MMA(0, 0, At, B0); PG8_MMA(0, 1, At, B1); PG8_BAR; PG8_SCHED;
            PG8_LDA(At, 0, 1); PG8_STAGE(PG8_SB(0, 0), b2, voffB); PG8_STAGE(PG8_SB(0, 1), b2 + hstep, voffB); PG8_STAGE(PG8_SA(0, 0), a2, voffA);
            PG8_WAIT_V(8); PG8_WAIT_L(0); PG8_BAR; PG8_MMA(1, 0, At, B0); PG8_MMA(1, 1, At, B1); PG8_BAR; PG8_SCHED;
            PG8_LDB(B0, 1, 0); PG8_LDB(B1, 1, 1); PG8_SCHED; PG8_LDA(At, 1, 0); PG8_STAGE(PG8_SA(0, 1), a2 + hstep, voffA);
            PG8_WAIT_V(8); PG8_WAIT_L(0); PG8_BAR; PG8_MMA(0, 0, At, B0); PG8_MMA(0, 1, At, B1); PG8_BAR; PG8_SCHED;
            PG8_LDA(At, 1, 1); PG8_STAGE(PG8_SB(1, 0), b3, voffB); PG8_STAGE(PG8_SB(1, 1), b3 + hstep, voffB); PG8_STAGE(PG8_SA(1, 0), a3, voffA);
            PG8_WAIT_V(8); PG8_WAIT_L(0); PG8_BAR; PG8_MMA(1, 0, At, B0); PG8_MMA(1, 1, At, B1); PG8_BAR; PG8_SCHED;
            } else {
            PG8_LDB(B0, 0, 0); PG8_SCHED; PG8_LDA(At, 0, 0); PG8_STAGE(PG8_SA(1, 1), a1 + hstep, voffA);
            PG8_WAIT_L(8); PG8_BAR; PG8_WAIT_L(0); PG8_MMA(0, 0, At, B0); PG8_BAR; PG8_SCHED;
            PG8_LDB(B1, 0, 1); PG8_STAGE(PG8_SB(0, 0), b2, voffB);
            PG8_BAR; PG8_WAIT_L(0); PG8_MMA(0, 1, At, B1); PG8_BAR;
            PG8_LDA(At, 0, 1); PG8_STAGE(PG8_SA(0, 0), a2, voffA);
            PG8_BAR; PG8_WAIT_L(0); PG8_MMA(1, 0, At, B0); PG8_BAR; PG8_SCHED;
            PG8_STAGE(PG8_SB(0, 1), b2 + hstep, voffB);
            PG8_WAIT_V(6); PG8_BAR; PG8_MMA(1, 1, At, B1); PG8_BAR;
            PG8_LDB(B0, 1, 0); PG8_SCHED; PG8_LDA(At, 1, 0); PG8_STAGE(PG8_SA(0, 1), a2 + hstep, voffA);
            PG8_WAIT_L(8); PG8_BAR; PG8_WAIT_L(0); PG8_MMA(0, 0, At, B0); PG8_BAR; PG8_SCHED;
            PG8_LDB(B1, 1, 1); PG8_STAGE(PG8_SB(1, 0), b3, voffB);
            PG8_BAR; PG8_WAIT_L(0); PG8_MMA(0, 1, At, B1); PG8_BAR;
            PG8_LDA(At, 1, 1); PG8_STAGE(PG8_SA(1, 0), a3, voffA);
            PG8_BAR; PG8_WAIT_L(0); PG8_MMA(1, 0, At, B0); PG8_BAR; PG8_SCHED;
            PG8_STAGE(PG8_SB(1, 1), b3 + hstep, voffB);
            PG8_WAIT_V(6); PG8_BAR; PG8_MMA(1, 1, At, B1); PG8_BAR;
            }
        }
        if constexpr (ALIGN_EPI) { if (wr == 0) PG8_BAR; }
        if constexpr (!Epi::AFTER_DRAIN) { E(acc, cur, wr, wc, fr, fq); S.done(cur); }
        if (!has_next) break;
#pragma unroll
        for (int a = 0; a < 2; ++a)
#pragma unroll
            for (int b = 0; b < 2; ++b)
#pragma unroll
                for (int m = 0; m < 4; ++m)
#pragma unroll
                    for (int n = 0; n < 2; ++n) acc[a][b][m][n] = (f32x4){0.f, 0.f, 0.f, 0.f};
        cur = nxt; cA = nA; cB = nB; ++ui;
        if constexpr (ALIGN_EPI) { if (wr == 1) PG8_BAR; }
    }
    PG8_WAIT_V(0);
    if constexpr (!ALIGN_EPI) { if (wr == 0) PG8_BAR; }
    PG8_BAR;
    if constexpr (Epi::AFTER_DRAIN) { E.fused(acc, cur, wr, wc, fr, fq, lds, wid, lane); S.done(cur); }
#undef PG8_SA
#undef PG8_SB
#undef PG8_STAGE
#undef PG8_LDA
#undef PG8_LDB
#undef PG8_MMA
#undef PG8_WAIT_V
#undef PG8_WAIT_L
#undef PG8_BAR
#undef PG8_SCHED
}
}
namespace pg8 {
__device__ __forceinline__ float fast_silu(float v) { return v * __builtin_amdgcn_rcpf(1.f + __builtin_amdgcn_exp2f(-1.4426950408889634f * v)); }

struct DenseOrder {
    int nM, nN, nreg, nwg, G, c, mode, wgm;
    __device__ __forceinline__ void init(int nM_, int nN_, int G_, int c_, int mode_) { nM = nM_; nN = nN_; G = G_; c = c_; mode = mode_; nreg = nM * nN; nwg = nreg + (mode == 2 ? 8 : 0); wgm = WGM; }
    __device__ __forceinline__ bool next(int i, Unit& u) const {
        const long L = (long)i * G + c; if (L >= nwg) return false;
        if (mode == 2 && L >= nreg) { u.pm = 9 * (int)(L - nreg); u.pn = nN - 1; return true; }
        int wgid = (int)L; { const int q = nreg / NXCD, r = nreg % NXCD, xcd = wgid % NXCD, off = wgid / NXCD; wgid = (xcd < r ? xcd * (q + 1) : r * (q + 1) + (xcd - r) * q) + off; }
        const int nig = wgm * nN, gid = wgid / nig, fm = gid * wgm, gsz = (nM - fm) < wgm ? (nM - fm) : wgm;
        int pm = fm + ((wgid % nig) % gsz); u.pn = (wgid % nig) / gsz;
        if (mode != 0) pm = 9 * (pm >> 3) + 1 + (pm & 7);
        u.pm = pm; return true;
    }
    __device__ __forceinline__ void a_ready(const Unit&) const {}
    __device__ __forceinline__ void done(const Unit&) const {}
};
struct MoeOrder {
    const PG8_LAS int* tb; int nN, G, c;
    __device__ __forceinline__ bool next(int i, Unit& u) const {
        const int nwg = tb[8] * nN; long L = (long)i * G + c; if (L >= nwg) return false;
        { const int wg = (int)L, q = nwg / NXCD, r = nwg % NXCD, xcd = wg % NXCD, off = wg / NXCD; L = (xcd < r ? xcd * (q + 1) : r * (q + 1) + (xcd - r) * q) + off; }
        int e = 0;
#pragma unroll
        for (int k = 1; k < 8; ++k) if (L >= (long)tb[k] * nN) e = k;
        const int Le = (int)(L - (long)tb[e] * nN), mt = tb[e + 1] - tb[e];
        const int nig = WGM * nN, gid = Le / nig, fm = gid * WGM, gsz = (mt - fm) < WGM ? (mt - fm) : WGM;
        u.pm = tb[e] + fm + ((Le % nig) % gsz); u.pn = e * nN + (Le % nig) / gsz; return true;
    }
    __device__ __forceinline__ void a_ready(const Unit&) const {}
    __device__ __forceinline__ void done(const Unit&) const {}
};

template <bool SRCIN, bool FUSE> struct EpiResGate {
    static constexpr bool PERM = true, AFTER_DRAIN = false;
    const float* xin; float* xout; const float* modbase; int compact;
    const float* xsrc_lat; const float* xsrc_ctx; bf16_t* hraw; const float* gnext; const float* nscale; float* ssq;
    __device__ __forceinline__ void operator()(const f32x4 (&acc)[2][2][4][2], const Unit& u, int wr, int wc, int fr, int fq) const {
        const int b = u.pm / 9, pj = u.pm - 9 * b; const int mrow = (pj == 0) ? 8 : b;
        const float* g = modbase + (size_t)mrow * 6144;
        const int col0 = u.pn * BM + wc * 32 + 8 * fq;
        f32x4 gv[2][2];
#pragma unroll
        for (int bj = 0; bj < 2; ++bj)
#pragma unroll
            for (int n = 0; n < 2; ++n) gv[bj][n] = *(const f32x4*)(g + col0 + bj * HALF + n * 4);
        const int row0 = u.pm * BM + wr * 64 + fr; const int oshift = compact ? 256 * (b + 1) : 0;
        const float* xbase = SRCIN ? (pj == 0 ? xsrc_ctx + (size_t)b * 256 * 1024 : xsrc_lat + ((size_t)b * 2048 + (pj - 1) * 256) * 1024) - (size_t)u.pm * BM * 1024 : xin;
        const float* ns = nscale + (size_t)mrow * 6144;
#pragma unroll
        for (int am = 0; am < 4; ++am) { const int ai = am >> 1;
            f32x4 xv[2][2][2];
#pragma unroll
            for (int mm = 0; mm < 2; ++mm) { const int m = (am & 1) * 2 + mm; const float* xi = xbase + (size_t)(row0 + ai * HALF + m * 16) * 1024 + col0;
#pragma unroll
                for (int bj = 0; bj < 2; ++bj)
#pragma unroll
                    for (int n = 0; n < 2; ++n) xv[mm][bj][n] = *(const f32x4*)(xi + bj * HALF + n * 4); }
#pragma unroll
            for (int mm = 0; mm < 2; ++mm) { const int m = (am & 1) * 2 + mm; const int row = row0 + ai * HALF + m * 16; float* xo = xout + (size_t)(row - oshift) * 1024 + col0; float ss = 0.f;
#pragma unroll
                for (int bj = 0; bj < 2; ++bj)
#pragma unroll
                    for (int n = 0; n < 2; ++n) { const f32x4 v = xv[mm][bj][n] + gv[bj][n] * acc[ai][bj][m][n]; *(f32x4*)(xo + bj * HALF + n * 4) = v;
                        if (FUSE) { const int c = col0 + bj * HALF + n * 4; const f32x4 hv = v * (*(const f32x4*)(gnext + c) * (*(const f32x4*)(ns + c) + 1.f));
                            ss += (v[0] * v[0] + v[1] * v[1]) + (v[2] * v[2] + v[3] * v[3]);
                            u32x2 w; w.x = cvt_pk_bf16(hv[0], hv[1]); w.y = cvt_pk_bf16(hv[2], hv[3]); *(u32x2*)(hraw + (size_t)row * 1024 + c) = w; } }
                if (FUSE) { ss += __shfl_xor(ss, 16); ss += __shfl_xor(ss, 32); if (fq == 0) unsafeAtomicAdd(ssq + row, ss); } }
            asm volatile("" ::: "memory"); }
    }
};
struct EpiSwiGLU {
    static constexpr bool PERM = true, AFTER_DRAIN = false;
    bf16_t* O; int ldc; int npn; const float* ssq; const float* cbias; int cbld;
    __device__ __forceinline__ void operator()(const f32x4 (&acc)[2][2][4][2], const Unit& u, int wr, int wc, int fr, int fq) const {
        const int row0 = u.pm * BM + wr * 64 + fr; const int col0 = (u.pn % npn) * HALF + wc * 32 + 8 * fq;
        f32x4 cb[2][2];
        if (ssq) { const int b = u.pm / 9; const int mrow = (u.pm - 9 * b == 0) ? 8 : b; const float* cp = cbias + (size_t)mrow * cbld + u.pn * BM + wc * 32 + 8 * fq;
#pragma unroll
            for (int bj = 0; bj < 2; ++bj)
#pragma unroll
                for (int n = 0; n < 2; ++n) cb[bj][n] = *(const f32x4*)(cp + bj * HALF + 4 * n); }
        float rsv[2][4];
        if (ssq) {
#pragma unroll
            for (int ai = 0; ai < 2; ++ai)
#pragma unroll
                for (int m = 0; m < 4; ++m) rsv[ai][m] = ssq[row0 + ai * HALF + m * 16];
#pragma unroll
            for (int ai = 0; ai < 2; ++ai)
#pragma unroll
                for (int m = 0; m < 4; ++m) rsv[ai][m] = rsqrtf(rsv[ai][m] * (1.f / 1024.f) + 1e-6f); }
#pragma unroll
        for (int ai = 0; ai < 2; ++ai)
#pragma unroll
            for (int m = 0; m < 4; ++m) { const int row = row0 + ai * HALF + m * 16; bf16_t* rowp = O + (size_t)row * ldc + col0;
                f32x4 a0 = acc[ai][0][m][0], a1 = acc[ai][0][m][1], g0 = acc[ai][1][m][0], g1 = acc[ai][1][m][1];
                if (ssq) { const float rs = rsv[ai][m]; a0 = a0 * rs + cb[0][0]; a1 = a1 * rs + cb[0][1]; g0 = g0 * rs + cb[1][0]; g1 = g1 * rs + cb[1][1]; }
                u32x4 w; w.x = cvt_pk_bf16(fast_silu(a0[0]) * g0[0], fast_silu(a0[1]) * g0[1]); w.y = cvt_pk_bf16(fast_silu(a0[2]) * g0[2], fast_silu(a0[3]) * g0[3]);
                w.z = cvt_pk_bf16(fast_silu(a1[0]) * g1[0], fast_silu(a1[1]) * g1[1]); w.w = cvt_pk_bf16(fast_silu(a1[2]) * g1[2], fast_silu(a1[3]) * g1[3]);
                *(u32x4*)rowp = w; }
    }
};
struct EpiBf16Norm {
    static constexpr bool PERM = true, AFTER_DRAIN = false;
    bf16_t* O; int ldc; const float* ssq; const float* cbias; int cbld;
    __device__ __forceinline__ void operator()(const f32x4 (&acc)[2][2][4][2], const Unit& u, int wr, int wc, int fr, int fq) const {
        const int row0 = u.pm * BM + wr * 64 + fr; const int col0 = u.pn * BM + wc * 32 + 8 * fq;
        const int b = u.pm / 9; const int mrow = (u.pm - 9 * b == 0) ? 8 : b; const float* cp = cbias + (size_t)mrow * cbld + col0;
        f32x4 cb[2][2];
#pragma unroll
        for (int bj = 0; bj < 2; ++bj)
#pragma unroll
            for (int n = 0; n < 2; ++n) cb[bj][n] = *(const f32x4*)(cp + bj * HALF + 4 * n);
        float rsv[2][4];
#pragma unroll
        for (int ai = 0; ai < 2; ++ai)
#pragma unroll
            for (int m = 0; m < 4; ++m) rsv[ai][m] = ssq[row0 + ai * HALF + m * 16];
#pragma unroll
        for (int ai = 0; ai < 2; ++ai)
#pragma unroll
            for (int m = 0; m < 4; ++m) { const int row = row0 + ai * HALF + m * 16; bf16_t* rowp = O + (size_t)row * ldc + col0; const float rs = rsqrtf(rsv[ai][m] * (1.f / 1024.f) + 1e-6f);
#pragma unroll
                for (int bj = 0; bj < 2; ++bj) { const f32x4 v0 = acc[ai][bj][m][0] * rs + cb[bj][0], v1 = acc[ai][bj][m][1] * rs + cb[bj][1];
                    u32x4 w; w.x = cvt_pk_bf16(v0[0], v0[1]); w.y = cvt_pk_bf16(v0[2], v0[3]); w.z = cvt_pk_bf16(v1[0], v1[1]); w.w = cvt_pk_bf16(v1[2], v1[3]); *(u32x4*)(rowp + bj * HALF) = w; } }
    }
};
struct EpiMoeY2 {
    static constexpr bool PERM = true, AFTER_DRAIN = false;
    const float* slot_gate; bf16_t* Y2;
    __device__ __forceinline__ void operator()(const f32x4 (&acc)[2][2][4][2], const Unit& u, int wr, int wc, int fr, int fq) const {
        const int col0 = (u.pn & 3) * BM + wc * 32 + 8 * fq; const int slot0 = u.pm * BM + wr * 64 + fr;
#pragma unroll
        for (int ai = 0; ai < 2; ++ai)
#pragma unroll
            for (int m = 0; m < 4; ++m) { const int slot = slot0 + ai * HALF + m * 16; const float g = slot_gate[slot]; bf16_t* rowp = Y2 + (size_t)slot * 1024 + col0;
#pragma unroll
                for (int bj = 0; bj < 2; ++bj) { const f32x4 v0 = acc[ai][bj][m][0] * g, v1 = acc[ai][bj][m][1] * g;
                    u32x4 w; w.x = cvt_pk_bf16(v0[0], v0[1]); w.y = cvt_pk_bf16(v0[2], v0[3]); w.z = cvt_pk_bf16(v1[0], v1[1]); w.w = cvt_pk_bf16(v1[2], v1[3]);
                    *(u32x4*)(rowp + bj * HALF) = w; } }
    }
};
enum EpiMode { E_BF16 = 0, E_BF16NORM, E_RES, E_SWIGLU, E_MOEY2 };
struct EpiAny {
    static constexpr bool PERM = true, AFTER_DRAIN = false;
    int mode;
    bf16_t* O; int ldc, npn; const float* ssq; const float* cbias; int cbld;
    const float* xin; float* xout; const float* modbase; int compact, srcin, fuse; const float* xsrc_lat; const float* xsrc_ctx; const float* gnext; const float* nscale; float* ssqw;
    const float* slot_gate;
    __device__ __forceinline__ void res(const f32x4 (&acc)[2][2][4][2], const Unit& u, int wr, int wc, int fr, int fq) const {
        const int b = u.pm / 9, pj = u.pm - 9 * b; const int mrow = (pj == 0) ? 8 : b;
        const float* g = modbase + (size_t)mrow * 6144;
        const int col0 = u.pn * BM + wc * 32 + 8 * fq;
        f32x4 gv[2][2];
#pragma unroll
        for (int bj = 0; bj < 2; ++bj)
#pragma unroll
            for (int n = 0; n < 2; ++n) gv[bj][n] = *(const f32x4*)(g + col0 + bj * HALF + n * 4);
        const int row0 = u.pm * BM + wr * 64 + fr; const int oshift = compact ? 256 * (b + 1) : 0;
        const float* xbase = srcin ? (pj == 0 ? xsrc_ctx + (size_t)b * 256 * 1024 : xsrc_lat + ((size_t)b * 2048 + (pj - 1) * 256) * 1024) - (size_t)u.pm * BM * 1024 : xin;
        const float* ns = nscale + (size_t)mrow * 6144; bf16_t* hraw = O;
#pragma unroll
        for (int ai = 0; ai < 2; ++ai)
#pragma unroll
            for (int m = 0; m < 4; ++m) { const int row = row0 + ai * HALF + m * 16; const float* xi = xbase + (size_t)row * 1024 + col0; float* xo = xout + (size_t)(row - oshift) * 1024 + col0; float ss = 0.f;
#pragma unroll
                for (int bj = 0; bj < 2; ++bj)
#pragma unroll
                    for (int n = 0; n < 2; ++n) { const f32x4 v = *(const f32x4*)(xi + bj * HALF + n * 4) + gv[bj][n] * acc[ai][bj][m][n]; *(f32x4*)(xo + bj * HALF + n * 4) = v;
                        if (fuse) { const int c = col0 + bj * HALF + n * 4; const f32x4 hv = v * (*(const f32x4*)(gnext + c) * (*(const f32x4*)(ns + c) + 1.f));
                            ss += (v[0] * v[0] + v[1] * v[1]) + (v[2] * v[2] + v[3] * v[3]);
                            u32x2 w; w.x = cvt_pk_bf16(hv[0], hv[1]); w.y = cvt_pk_bf16(hv[2], hv[3]); *(u32x2*)(hraw + (size_t)row * 1024 + c) = w; } }
                if (fuse) { ss += __shfl_xor(ss, 16); ss += __shfl_xor(ss, 32); if (fq == 0) unsafeAtomicAdd(ssqw + row, ss); }
                if (m & 1) asm volatile("" ::: "memory"); }
    }
    __device__ __forceinline__ void operator()(const f32x4 (&acc)[2][2][4][2], const Unit& u, int wr, int wc, int fr, int fq) const {
        if (mode == E_BF16) { EpiBf16<0> e{O, ldc, nullptr, 0, 0, 1.f}; e(acc, u, wr, wc, fr, fq); }
        else if (mode == E_BF16NORM) { EpiBf16Norm e{O, ldc, ssq, cbias, cbld}; e(acc, u, wr, wc, fr, fq); }
        else if (mode == E_SWIGLU) { EpiSwiGLU e{O, ldc, npn, ssq, cbias, cbld}; e(acc, u, wr, wc, fr, fq); }
        else if (mode == E_MOEY2) { EpiMoeY2 e{slot_gate, O}; e(acc, u, wr, wc, fr, fq); }
        else res(acc, u, wr, wc, fr, fq);
    }
};
struct ChainOrder {
    int stage, c;
    __device__ __forceinline__ bool next(int i, Unit& u) const {
        const int x = c & 7, r = c >> 3; int lu = -1, nN = 4;
        if (stage == 0) { if (i == 0) lu = r; else if (i == 1 && r >= 16 && r < 20) lu = 16 + r; }
        else if (stage == 1) { nN = 22;
            if (i < 3) lu = 32 * i + r; else if (i == 3) { if (r < 30) lu = 96 + r; }
            else if (r < 28) { if (i < 6) lu = 126 + 28 * (i - 4) + r; else if (i == 6 && r < 16) lu = 182 + r; } }
        else if (stage == 2) { if (r >= 28) { if (i == 0) lu = r - 28; else if (i == 1) lu = r - 16; }
               else if (i == 0) { if (r < 16) lu = 20 + r; else { const int k = r - 16; lu = k < 8 ? 4 + k : 8 + k; } } }
        else {
            if (i < 2) lu = 32 * i + r; else if (i == 2 && r == 31) lu = 64;
            if (lu < 0) return false;
            if (lu == 64) { u.pm = 9 * x; u.pn = 7; } else { u.pm = 9 * x + 1 + (lu & 7); u.pn = lu >> 3; }
            return true; }
        if (lu < 0) return false;
        const unsigned long long perm = x == 6 ? 0x874310652ull : x == 7 ? 0x875421630ull : 0x876543210ull;
        const int g = lu / (3 * nN), w = lu - g * 3 * nN; u.pm = 9 * x + (int)((perm >> (4 * (3 * g + w % 3))) & 15ull); u.pn = w / 3; return true;
    }
};
struct MoeChainOrder {
    const PG8_LAS int* tb; int stage, c;
    __device__ __forceinline__ bool next(int i, Unit& u) const {
        const int x = c & 7, r = c >> 3, T = tb[8];
        const int t0 = (T * x) >> 3, n = ((T * (x + 1)) >> 3) - t0, j = r & 7, cc = r >> 3;
        int tile, col, nN;
        if (stage == 1) { nN = 4; tile = 8 * i + j; col = cc; if (tile >= n) return false; }
        else { nN = 28;
            const int kb = ((n & 7) == 1) ? 1 : 0, H = 4 * kb, tot = 28 * n + 12 * kb, A0 = tot >> 5, rem = tot & 31, ah = A0 - 3 * kb;
            const bool heavy = kb && j == 0;
            const int nr = r - (kb ? cc + (j > 0 ? 1 : 0) : 0);
            int m;
            if (i < ah) m = 32 * i + r;
            else { if (heavy) return false;
                   if (i < A0) m = 32 * ah + (32 - H) * (i - ah) + nr;
                   else if (i == A0 && nr < rem) m = 32 * ah + (32 - H) * (A0 - ah) + nr;
                   else return false; }
            if (m >= 28 * n) return false;
            const int g = m / 112, w = m - g * 112, gs = (n - 4 * g) < 4 ? (n - 4 * g) : 4; tile = 4 * g + w % gs; col = w / gs; }
        const int t = t0 + tile; int e = 0;
#pragma unroll
        for (int k = 1; k < 8; ++k) if (t >= tb[k]) e = k;
        u.pm = t; u.pn = e * nN + col; return true;
    }
};
struct OrderAny {
    int omode;
    DenseOrder d; MoeOrder m; ChainOrder ch; MoeChainOrder mch;
    mutable unsigned early, ew0, ew1, ew2, ew3;
    __device__ __forceinline__ bool next(int i, Unit& u) const {
        const bool ok = omode == 3 ? m.next(i, u) : omode == 4 ? ch.next(i, u) : omode == 5 ? mch.next(i, u) : d.next(i, u);
        if (ok && wcnt != nullptr) {
            early = __hip_atomic_load(wcnt + u.pm * 16, __ATOMIC_RELAXED, __HIP_MEMORY_SCOPE_AGENT);
            if (w2kind != 0) { int lo, hi; war_range(u, lo, hi);
                ew0 = __hip_atomic_load(w2cnt + (lo     <= hi ? lo     : u.pm) * 16, __ATOMIC_RELAXED, __HIP_MEMORY_SCOPE_AGENT);
                ew1 = __hip_atomic_load(w2cnt + (lo + 1 <= hi ? lo + 1 : u.pm) * 16, __ATOMIC_RELAXED, __HIP_MEMORY_SCOPE_AGENT);
                ew2 = __hip_atomic_load(w2cnt + (lo + 2 <= hi ? lo + 2 : u.pm) * 16, __ATOMIC_RELAXED, __HIP_MEMORY_SCOPE_AGENT);
                ew3 = __hip_atomic_load(w2cnt + (lo + 3 <= hi ? lo + 3 : u.pm) * 16, __ATOMIC_RELAXED, __HIP_MEMORY_SCOPE_AGENT); }
        }
        return ok;
    }
    unsigned* wcnt; unsigned wtarget; unsigned* dcnt; int rel_agent;
    unsigned* w2cnt; int w2kind;
    __device__ __forceinline__ void war_range(const Unit& u, int& lo, int& hi) const {
        if (w2kind == 1) { const int a0 = u.pm * 1441792 - 75497472, a1 = a0 + 1441791; lo = (a0 > 0 ? a0 : 0) >> 19; hi = a1 < 0 ? -1 : (a1 >> 19); }
        else { const int b0 = u.pm << 20; lo = b0 / 1441792; hi = (b0 + 1048575) / 1441792; }
    }
    __device__ __forceinline__ void a_ready(const Unit& u) const {
        if (wcnt != nullptr) {
            unsigned* p = wcnt + u.pm * 16; unsigned sp = 0u;
            unsigned mn = early;
            if (w2kind != 0) { const unsigned a = ew0 < ew1 ? ew0 : ew1, b = ew2 < ew3 ? ew2 : ew3, c2 = a < b ? a : b; mn = c2 < mn ? c2 : mn; }
            if (mn < wtarget) {
                while (__hip_atomic_load(p, __ATOMIC_RELAXED, __HIP_MEMORY_SCOPE_AGENT) < wtarget) { __builtin_amdgcn_s_sleep(1); if (++sp > (1u << 22)) break; }
                if (w2kind != 0) { int lo, hi; war_range(u, lo, hi);
                    for (int q = lo; q <= hi; ++q) while (__hip_atomic_load(w2cnt + q * 16, __ATOMIC_RELAXED, __HIP_MEMORY_SCOPE_AGENT) < wtarget) { __builtin_amdgcn_s_sleep(1); if (++sp > (1u << 22)) break; } }
            }
            if (rel_agent) __builtin_amdgcn_fence(__ATOMIC_ACQUIRE, "agent");
            asm volatile("" ::: "memory");
        }
    }
    __device__ __forceinline__ void done(const Unit& u) const {
        if (dcnt != nullptr) {
            if (rel_agent) __builtin_amdgcn_fence(__ATOMIC_RELEASE, "agent");
            asm volatile("s_waitcnt vmcnt(0)" ::: "memory");
            if ((threadIdx.x & 63) == 0) (void)__hip_atomic_fetch_add(dcnt + u.pm * 16, 1u, __ATOMIC_RELAXED, __HIP_MEMORY_SCOPE_AGENT);
        }
    }
};
}
#define GAS __attribute__((address_space(1)))
#define LAS __attribute__((address_space(3)))
typedef unsigned v4u __attribute__((ext_vector_type(4)));
typedef short bf16x8 __attribute__((ext_vector_type(8)));
namespace att {
using f32x16 = __attribute__((ext_vector_type(16))) float;
using s16x4 = __attribute__((ext_vector_type(4))) short;
typedef float f32x2_t __attribute__((ext_vector_type(2))); typedef __bf16 bf16x2_t __attribute__((ext_vector_type(2)));
__device__ __forceinline__ int crow(int r, int hi) { return (r & 3) + 8 * (r >> 2) + 4 * hi; }
__device__ __forceinline__ void glds16(const void* gsrc, unsigned lds_dst) { unsigned keep;
    asm volatile("s_mov_b32 %0, m0\n\ts_mov_b32 m0, %2\n\ts_nop 0\n\tglobal_load_lds_dwordx4 %1, off\n\ts_mov_b32 m0, %0" : "=&s"(keep) : "v"(gsrc), "s"(lds_dst) : "memory"); }
__device__ __forceinline__ unsigned cvtpk_s(float lo, float hi) { f32x2_t v = {lo, hi}; bf16x2_t b = __builtin_convertvector(v, bf16x2_t); return __builtin_bit_cast(unsigned, b); }
#define ATT_MX3(a, b, c) __builtin_fmaxf(__builtin_fmaxf((a), (b)), (c))
__device__ __forceinline__ float rowmax32(const f32x16& p0, const f32x16& p1) {
    float a = ATT_MX3(p0[0], p0[1], p1[0]), b = ATT_MX3(p0[2], p0[3], p1[1]); a = ATT_MX3(a, p1[2], p1[3]);
#pragma unroll
    for (int r = 4; r < 16; r += 4) { a = ATT_MX3(a, p0[r], p0[r + 1]); b = ATT_MX3(b, p0[r + 2], p0[r + 3]); a = ATT_MX3(a, p1[r], p1[r + 1]); b = ATT_MX3(b, p1[r + 2], p1[r + 3]); }
    a = __builtin_fmaxf(a, b);
    auto rr = __builtin_amdgcn_permlane32_swap(__float_as_uint(a), __float_as_uint(a), false, false);
    return fmaxf(__uint_as_float(rr[0]), __uint_as_float(rr[1]));
}
__device__ __forceinline__ void pv(f32x16* o, int vb, bf16x8 pa0, bf16x8 pa1, bf16x8 pa2, bf16x8 pa3) {
    s16x4 lo[2][4], hi[2][4];
#pragma unroll
    for (int d0 = 0; d0 < 2; ++d0)
#pragma unroll
        for (int ks = 0; ks < 4; ++ks) {
            asm volatile("ds_read_b64_tr_b16 %0,%1 offset:%c2" : "=&v"(lo[d0][ks]) : "v"(vb), "i"(d0 * 4096 + ks * 1024) : "memory");
            asm volatile("ds_read_b64_tr_b16 %0,%1 offset:%c2" : "=&v"(hi[d0][ks]) : "v"(vb), "i"(d0 * 4096 + ks * 1024 + 512) : "memory"); }
    asm volatile("s_waitcnt lgkmcnt(0)" ::: "memory"); __builtin_amdgcn_sched_barrier(0);
#define ATT_PK(d, k) (bf16x8){lo[d][k][0], lo[d][k][1], lo[d][k][2], lo[d][k][3], hi[d][k][0], hi[d][k][1], hi[d][k][2], hi[d][k][3]}
    o[0] = __builtin_amdgcn_mfma_f32_32x32x16_bf16(pa0, ATT_PK(0, 0), o[0], 0, 0, 0); o[1] = __builtin_amdgcn_mfma_f32_32x32x16_bf16(pa0, ATT_PK(1, 0), o[1], 0, 0, 0);
    o[0] = __builtin_amdgcn_mfma_f32_32x32x16_bf16(pa1, ATT_PK(0, 1), o[0], 0, 0, 0); o[1] = __builtin_amdgcn_mfma_f32_32x32x16_bf16(pa1, ATT_PK(1, 1), o[1], 0, 0, 0);
    o[0] = __builtin_amdgcn_mfma_f32_32x32x16_bf16(pa2, ATT_PK(0, 2), o[0], 0, 0, 0); o[1] = __builtin_amdgcn_mfma_f32_32x32x16_bf16(pa2, ATT_PK(1, 2), o[1], 0, 0, 0);
    o[0] = __builtin_amdgcn_mfma_f32_32x32x16_bf16(pa3, ATT_PK(0, 3), o[0], 0, 0, 0); o[1] = __builtin_amdgcn_mfma_f32_32x32x16_bf16(pa3, ATT_PK(1, 3), o[1], 0, 0, 0);
#undef ATT_PK
}
template <int DQ> struct Geo {
    static constexpr int NCH = DQ / 8, KSLOT = NCH * 1024, VSLOT = 8192;
    static constexpr int LDS_K = 0, LDS_V = 2 * KSLOT, LDS_WS = LDS_V + 2 * VSLOT, LDS_OST = LDS_WS + 8 * 256, LDS_BYTES = LDS_OST + 8 * 4096;
};
template <int DQ>
__device__ __forceinline__ void unit(int b, int hq, int hk, int qb, int NT, const bf16_t* __restrict__ Q, int ldq, const bf16_t* __restrict__ K, int ldk, const bf16_t* __restrict__ V, int ldv,
                                     bf16_t* __restrict__ O, int ldo, LAS unsigned char* shm) {
    typedef Geo<DQ> G; constexpr int ND0 = DQ / 16;
    const int tid = threadIdx.x, lane = tid & 63, r32 = lane & 31, hi = lane >> 5; const int wid = __builtin_amdgcn_readfirstlane(tid >> 6);
    const long rowbase = (long)b * RPB; const int q0 = qb * 256;
    const bf16_t* Qw = Q + (rowbase + q0 + wid * 32) * ldq + hq * DQ;
    const bf16_t* Kh = K + rowbase * ldk + hk * DQ; const bf16_t* Vh = V + rowbase * ldv + hk * 64;
    const unsigned lds0 = (unsigned)(uintptr_t)shm;
    LAS float* wsf = (LAS float*)(shm + G::LDS_WS) + wid * 64;
    const bf16_t* ksrc = Kh + (long)lane * ldk + wid * 8;
    const bf16_t* vsrc = Vh + (long)(16 * (wid & 3) + (lane >> 2)) * ldv + (wid >> 2) * 32 + (lane & 3) * 8;
    const unsigned kdst = lds0 + G::LDS_K + wid * 1024, vdst = lds0 + G::LDS_V + wid * 1024;
    const int vb0 = (int)(lds0 + G::LDS_V) + ((lane >> 4) & 1) * 32 + (lane & 3) * 8 + (4 * hi + ((lane & 15) >> 2)) * 64;
#define ATT_DMA(t, s) do { const bf16_t* kp_ = ksrc + (long)(t) * 64 * ldk; glds16(kp_, (unsigned)__builtin_amdgcn_readfirstlane(kdst + (s) * G::KSLOT)); \
        if (DQ == 96 && wid < 4) glds16(kp_ + 64, (unsigned)__builtin_amdgcn_readfirstlane(kdst + (s) * G::KSLOT + 8192)); \
        glds16(vsrc + (long)(t) * 64 * ldv, (unsigned)__builtin_amdgcn_readfirstlane(vdst + (s) * G::VSLOT)); } while (0)
    ATT_DMA(0, 0);
    bf16x8 qr[ND0];
#pragma unroll
    for (int d0 = 0; d0 < ND0; ++d0) qr[d0] = *reinterpret_cast<const bf16x8*>(&Qw[(long)r32 * ldq + d0 * 16 + hi * 8]);
    constexpr float THR = 8.f;
    float mref = 0.f, l_reg = 0.f; f32x16 o[2]; o[0] = f32x16{}; o[1] = f32x16{}; f32x16 negm = f32x16{};
    for (int t = 0; t < NT; ++t) {
        const int s = t & 1;
        asm volatile("s_waitcnt vmcnt(0) lgkmcnt(0)\n\ts_barrier" ::: "memory");
        if (t + 1 < NT) ATT_DMA(t + 1, s ^ 1);
        f32x16 p0, p1;
        { const LAS unsigned char* kb = shm + G::LDS_K + s * G::KSLOT + hi * 1024 + r32 * 16;
#pragma unroll
          for (int d0 = 0; d0 < ND0; ++d0) { const bf16x8 b0 = *(const LAS bf16x8*)(kb + d0 * 2048); const bf16x8 b1 = *(const LAS bf16x8*)(kb + d0 * 2048 + 512);
              p0 = __builtin_amdgcn_mfma_f32_32x32x16_bf16(b0, qr[d0], d0 == 0 ? negm : p0, 0, 0, 0); p1 = __builtin_amdgcn_mfma_f32_32x32x16_bf16(b1, qr[d0], d0 == 0 ? negm : p1, 0, 0, 0); } }
        const float rm = rowmax32(p0, p1);
        if (__builtin_expect(t == 0 || __any(rm > THR), 0)) {
            const float dl = t == 0 ? rm : __builtin_fmaxf(rm, 0.f); mref += dl;
#pragma unroll
            for (int r = 0; r < 16; ++r) { p0[r] -= dl; p1[r] -= dl; negm[r] = -mref; }
            const float alpha = t == 0 ? 1.f : __builtin_amdgcn_exp2f(-dl); l_reg *= alpha;
            if (hi == 0) wsf[r32] = alpha;
            asm volatile("s_waitcnt lgkmcnt(0)" ::: "memory");
#pragma unroll
            for (int r = 0; r < 16; ++r) { const float a = wsf[crow(r, hi)]; o[0][r] *= a; o[1][r] *= a; }
        }
        f32x2_t sacc = {0.f, 0.f};
#pragma unroll
        for (int r = 0; r < 16; r += 2) { p0[r] = __builtin_amdgcn_exp2f(p0[r]); p0[r + 1] = __builtin_amdgcn_exp2f(p0[r + 1]); p1[r] = __builtin_amdgcn_exp2f(p1[r]); p1[r + 1] = __builtin_amdgcn_exp2f(p1[r + 1]);
            sacc += (f32x2_t){p0[r], p0[r + 1]}; sacc += (f32x2_t){p1[r], p1[r + 1]}; }
        l_reg += sacc[0] + sacc[1];
        u32x4 pw0, pw1, pw2, pw3;
        pw0 = (u32x4){cvtpk_s(p0[0], p0[1]), cvtpk_s(p0[2], p0[3]), cvtpk_s(p0[4], p0[5]), cvtpk_s(p0[6], p0[7])};
        pw1 = (u32x4){cvtpk_s(p0[8], p0[9]), cvtpk_s(p0[10], p0[11]), cvtpk_s(p0[12], p0[13]), cvtpk_s(p0[14], p0[15])};
        pw2 = (u32x4){cvtpk_s(p1[0], p1[1]), cvtpk_s(p1[2], p1[3]), cvtpk_s(p1[4], p1[5]), cvtpk_s(p1[6], p1[7])};
        pw3 = (u32x4){cvtpk_s(p1[8], p1[9]), cvtpk_s(p1[10], p1[11]), cvtpk_s(p1[12], p1[13]), cvtpk_s(p1[14], p1[15])};
        pv(o, vb0 + s * G::VSLOT, __builtin_bit_cast(bf16x8, pw0), __builtin_bit_cast(bf16x8, pw1), __builtin_bit_cast(bf16x8, pw2), __builtin_bit_cast(bf16x8, pw3));
    }
#undef ATT_DMA
    { auto rr = __builtin_amdgcn_permlane32_swap(__float_as_uint(l_reg), __float_as_uint(l_reg), false, false); l_reg = __uint_as_float(rr[0]) + __uint_as_float(rr[1]); }
    if (hi == 0) wsf[32 + r32] = l_reg;
    asm volatile("s_waitcnt lgkmcnt(0)" ::: "memory");
    float rli[16];
#pragma unroll
    for (int r = 0; r < 16; ++r) rli[r] = __builtin_amdgcn_rcpf(wsf[32 + crow(r, hi)]);
    bf16_t* Ow = O + (rowbase + q0 + wid * 32) * ldo + hq * 64;
    { LAS bf16_t* stg = (LAS bf16_t*)(shm + G::LDS_OST) + wid * 2048;
#pragma unroll
      for (int r = 0; r < 16; ++r) { const int orow = crow(r, hi);
#pragma unroll
          for (int d0 = 0; d0 < 2; ++d0) stg[orow * 64 + d0 * 32 + r32] = f2bf(o[d0][r] * rli[r]); }
      asm volatile("s_waitcnt lgkmcnt(0)" ::: "memory");
#pragma unroll
      for (int i = 0; i < 4; ++i) { const int row = i * 8 + (lane >> 3), ch = lane & 7; const u32x4 v = *(const LAS u32x4*)(stg + row * 64 + ch * 8); *(u32x4*)(Ow + (long)row * ldo + ch * 8) = v; } }
    asm volatile("s_waitcnt lgkmcnt(0)\n\ts_barrier" ::: "memory");
}
}
#define LDS_WAIT() asm volatile("s_waitcnt lgkmcnt(0)" ::: "memory")
#define VM_WAIT() asm volatile("s_waitcnt vmcnt(0)" ::: "memory")
constexpr int NWAVES = 8, NTHREADS = 512;
constexpr int RING_OFF = 0, RING_BYTES = 131072;
constexpr int MISC_OFF = RING_BYTES;
constexpr int LDS_BYTES = 147456;

enum Phase { PH_P0 = 0, PH_NORM0, PH_G_IN0, PH_LRUPREP, PH_MIX0, PH_G_OUT0, PH_G_F1, PH_G_F2, PH_G_IN1, PH_PREP1, PH_G_QKVB, PH_PREP2, PH_MIX1, PH_G_OUT1,
             PH_ROUTE, PH_SLOT, PH_MOE1, PH_MOE2, PH_COMBINE, PH_COUNT,
             PH_G_QB = 100, PH_G_KVB = 101 };

struct Params { const float* i0; const float* i1; const float* i2; const float* i3; const float* i4; const float* i5; const float* i6; const float* i7; const float* i8; const float* i9; const float* i10; const float* i11; const float* i12; const float* i13; const float* i14; const float* i15; const float* i16; const float* i17; const float* i18; const float* i19; const float* i20; const float* i21; const float* i22; const float* i23; const float* i24; const float* i25; const float* i26; const float* i27; const float* i28; const float* i29; const float* i30; const float* i31; const float* i32; const float* i33; const float* i34; const float* i35; const float* i36; const float* i37; const float* i38; const float* i39; const float* i40; const float* i41; const float* i42; float* out; char* ws; int ph_lo, ph_hi; };
#define PIN(k) (P.i##k)
static_assert(sizeof(Params) == 43 * 8 + 8 + 8 + 8, "Params has no padding");

struct Frame { LAS unsigned char* lds; int tid, lane, wave, G, bid, even; char* ws; };

__device__ __forceinline__ void tr_item(const float* __restrict__ W, int N, bf16_t* __restrict__ WT, int ldk, int kb, int nb, int dst_row0, LAS float* scr, int lane) {
    const int k0 = 64 * kb, n0 = 32 * nb;
    f32x4 v[8]; const float* wp = W + (size_t)(k0 + (lane >> 3)) * N + n0 + 4 * (lane & 7);
#pragma unroll
    for (int i = 0; i < 8; ++i) v[i] = __builtin_nontemporal_load((const f32x4*)(wp + (size_t)(8 * i) * N));
#pragma unroll
    for (int i = 0; i < 8; ++i) { LAS float* sp = scr + (8 * i + (lane >> 3)) * 33 + 4 * (lane & 7); sp[0] = v[i][0]; sp[1] = v[i][1]; sp[2] = v[i][2]; sp[3] = v[i][3]; }
    LDS_WAIT(); asm volatile("" ::: "memory");
    const int c = lane & 7;
#pragma unroll
    for (int j = 0; j < 4; ++j) { const int n = (lane >> 3) + 8 * j; const LAS float* s = scr + (8 * c) * 33 + n;
        v4u o; o.x = pk2(s[0 * 33], s[1 * 33]); o.y = pk2(s[2 * 33], s[3 * 33]); o.z = pk2(s[4 * 33], s[5 * 33]); o.w = pk2(s[6 * 33], s[7 * 33]);
        *(v4u*)(WT + (size_t)(dst_row0 + n) * ldk + k0 + 8 * c) = o; }
    LDS_WAIT(); asm volatile("" ::: "memory");
}
constexpr int MOE_ITEMS = 8 * 3 * 1792, MOE_CHUNK = 32, MOE_NCHUNK = MOE_ITEMS / MOE_CHUNK;
__device__ __forceinline__ void moe_conv_item(const Frame& F, const Params& P, int it, LAS float* scr) {
    const int e = it / 5376, r = it % 5376, which = r / 1792, q = r % 1792; char* ws = F.ws;
    const float* src; bf16_t* dst; int N, ldk, kb, nb, dr;
    if (which < 2) { kb = q / 112; nb = q % 112; const int n0 = nb * 32; dr = (n0 >> 7) * 256 + (n0 & 127) + (which == 1 ? 128 : 0);
        src = (which == 0 ? PIN(40) : PIN(41)) + (size_t)e * 1024 * 3584; N = 3584; dst = (bf16_t*)(ws + WS_W13M) + (size_t)e * 7168 * 1024; ldk = 1024; }
    else { kb = q / 32; nb = q % 32; dr = nb * 32; src = PIN(42) + (size_t)e * 3584 * 1024; N = 1024; dst = (bf16_t*)(ws + WS_W2M) + (size_t)e * 1024 * 3584; ldk = 3584; }
    tr_item(src, N, dst, ldk, kb, nb, dr, scr, F.lane);
}
struct TrDesc { const float* src; bf16_t* dst; int N, ldk, kb, nb, dr; };
__device__ __forceinline__ void moe_desc(const Frame& F, const Params& P, int it, TrDesc& d) {
    const int e = it / 5376, r = it % 5376, which = r / 1792, q = r % 1792; char* ws = F.ws;
    if (which < 2) { d.kb = q / 112; d.nb = q % 112; const int n0 = d.nb * 32; d.dr = (n0 >> 7) * 256 + (n0 & 127) + (which == 1 ? 128 : 0);
        d.src = (which == 0 ? PIN(40) : PIN(41)) + (size_t)e * 1024 * 3584; d.N = 3584; d.dst = (bf16_t*)(ws + WS_W13M) + (size_t)e * 7168 * 1024; d.ldk = 1024; }
    else { d.kb = q / 32; d.nb = q % 32; d.dr = d.nb * 32; d.src = PIN(42) + (size_t)e * 3584 * 1024; d.N = 1024; d.dst = (bf16_t*)(ws + WS_W2M) + (size_t)e * 1024 * 3584; d.ldk = 3584; }
}
__device__ __forceinline__ void tr_load(const TrDesc& d, int lane, f32x4 (&v)[8]) {
    const float* wp = d.src + (size_t)(64 * d.kb + (lane >> 3)) * d.N + 32 * d.nb + 4 * (lane & 7);
#pragma unroll
    for (int i = 0; i < 8; ++i) v[i] = __builtin_nontemporal_load((const f32x4*)(wp + (size_t)(8 * i) * d.N));
}
__device__ __forceinline__ void tr_store(const TrDesc& d, const f32x4 (&v)[8], LAS float* scr, int lane) {
    const int k0 = 64 * d.kb;
#pragma unroll
    for (int i = 0; i < 8; ++i) { LAS float* sp = scr + (8 * i + (lane >> 3)) * 33 + 4 * (lane & 7); sp[0] = v[i][0]; sp[1] = v[i][1]; sp[2] = v[i][2]; sp[3] = v[i][3]; }
    LDS_WAIT(); asm volatile("" ::: "memory");
    const int c = lane & 7;
#pragma unroll
    for (int j = 0; j < 4; ++j) { const int n = (lane >> 3) + 8 * j; const LAS float* sq = scr + (8 * c) * 33 + n;
        v4u o; o.x = pk2(sq[0 * 33], sq[1 * 33]); o.y = pk2(sq[2 * 33], sq[3 * 33]); o.z = pk2(sq[4 * 33], sq[5 * 33]); o.w = pk2(sq[6 * 33], sq[7 * 33]);
        *(v4u*)(d.dst + (size_t)(d.dr + n) * d.ldk + k0 + 8 * c) = o; }
    LDS_WAIT(); asm volatile("" ::: "memory");
}
__device__ __forceinline__ void moe_conv_all(const Frame& F, const Params& P, int it0, int it1) {
    LAS float* scr = (LAS float*)(F.lds + RING_OFF + F.wave * 16384); const int gw = F.bid * NWAVES + F.wave, NGW = F.G * NWAVES;
    __syncthreads();
    TrDesc d0, d1, d2; f32x4 v[8], w[8], y[8]; int it = it0 + gw;
    if (it < it1) { moe_desc(F, P, it, d0); tr_load(d0, F.lane, v); }
    if (it + NGW < it1) { moe_desc(F, P, it + NGW, d1); tr_load(d1, F.lane, w); }
#pragma unroll 1
    for (; it < it1; it += NGW) {
        const bool more2 = it + 2 * NGW < it1;
        if (more2) { moe_desc(F, P, it + 2 * NGW, d2); tr_load(d2, F.lane, y); }
        tr_store(d0, v, scr, F.lane);
        d0 = d1; d1 = d2;
#pragma unroll
        for (int i = 0; i < 8; ++i) { v[i] = w[i]; w[i] = y[i]; }
    }
    __syncthreads();
}
struct ConvDesc { const float* src; bf16_t* dst; int N, ldk, nblk, start, il, pad; };
__device__ __forceinline__ void phase_conv(const Frame& F, const Params& P, bool moe) {
    LAS float* scr = (LAS float*)(F.lds + RING_OFF + F.wave * 16384); char* ws = F.ws;
    LAS ConvDesc* tab = (LAS ConvDesc*)(F.lds + MISC_OFF);
    if (F.tid < 41) { const int t = F.tid; ConvDesc d; d.il = 0; d.pad = 0;
        if (t == 0) { d.src = PIN(8); d.dst = (bf16_t*)(ws + WS_WIN0); d.N = 1792; d.ldk = 1024; d.start = 16 * 56; }
        else if (t == 1) { d.src = PIN(9); d.dst = (bf16_t*)(ws + WS_WOUT0); d.N = 1024; d.ldk = 1024; d.start = 16 * 32; }
        else if (t == 2) { d.src = PIN(19); d.dst = (bf16_t*)(ws + WS_WF13); d.N = 2816; d.ldk = 1024; d.start = 16 * 88; d.il = 1; }
        else if (t == 3) { d.src = PIN(20); d.dst = (bf16_t*)(ws + WS_WF13); d.N = 2816; d.ldk = 1024; d.start = 16 * 88; d.il = 2; }
        else if (t == 4) { d.src = PIN(21); d.dst = (bf16_t*)(ws + WS_WF2); d.N = 1024; d.ldk = 2816; d.start = 44 * 32; }
        else if (t == 5) { d.src = PIN(22); d.dst = (bf16_t*)(ws + WS_WIN1); d.N = 1952; d.ldk = 1024; d.start = 16 * 61; }
        else if (t == 6) { d.src = PIN(23); d.dst = (bf16_t*)(ws + WS_WOUT1); d.N = 1024; d.ldk = 1024; d.start = 16 * 32; }
        else if (t == 7) { d.src = PIN(34); d.dst = (bf16_t*)(ws + WS_WQB); d.N = 768; d.ldk = 256; d.start = 4 * 24; }
        else if (t == 8) { d.src = PIN(36); d.dst = (bf16_t*)(ws + WS_WKVB); d.N = 1024; d.ldk = 256; d.start = 2 * 32; }
        else { const int q = t - 9, dn = q >> 1, g = q & 1; d.src = (g ? PIN(14) : PIN(12)) + (size_t)dn * 4096; d.dst = (bf16_t*)(ws + WS_WLRU) + (size_t)(dn * 2 + g) * 4096; d.N = 64; d.ldk = 64; d.start = 2; }
        d.nblk = d.N / 32;
        tab[t].src = d.src; tab[t].dst = d.dst; tab[t].N = d.N; tab[t].ldk = d.ldk; tab[t].nblk = d.nblk; tab[t].start = d.start; tab[t].il = d.il; tab[t].pad = 0; }
    __syncthreads();
    if (F.tid == 0) { int s = 0; for (int t = 0; t < 41; ++t) { const int c = tab[t].start; tab[t].start = s; s += c; } tab[0].pad = s; }
    __syncthreads();
    const int total = tab[0].pad; const int gw = F.bid * NWAVES + F.wave, NGW = F.G * NWAVES;
    auto mk = [&](int it, TrDesc& o) { int e = 0;
#pragma unroll 1
        for (int t = 1; t < 41; ++t) if (it >= tab[t].start) e = t;
        const int nblk = tab[e].nblk, il = tab[e].il, loc = it - tab[e].start; o.kb = loc / nblk; o.nb = loc % nblk; const int n0 = o.nb * 32;
        o.src = tab[e].src; o.dst = tab[e].dst; o.N = tab[e].N; o.ldk = tab[e].ldk; o.dr = il == 0 ? n0 : ((n0 >> 7) * 256 + (n0 & 127) + (il == 2 ? 128 : 0)); };
    { TrDesc d0, d1; f32x4 v[8], w[8]; int it = gw;
      if (it < total) { mk(it, d0); tr_load(d0, F.lane, v); }
#pragma unroll 1
      for (; it < total; it += NGW) {
          const bool more = it + NGW < total;
          if (more) { mk(it + NGW, d1); tr_load(d1, F.lane, w); }
          tr_store(d0, v, scr, F.lane);
          d0 = d1;
#pragma unroll
          for (int i = 0; i < 8; ++i) v[i] = w[i]; } }
    const int gt = F.bid * NTHREADS + F.tid, NGT = F.G * NTHREADS;
    { v4u* z = (v4u*)((bf16_t*)(ws + WS_WIN1) + (size_t)1952 * 1024); for (int i = gt; i < 96 * 1024 / 8; i += NGT) z[i] = (v4u){0u, 0u, 0u, 0u}; }
    { bf16_t* wk = (bf16_t*)(ws + WS_WKVB); for (int i = gt; i < 1024 * 16; i += NGT) { const int r = i >> 4, cc = i & 15; *(v4u*)(wk + (size_t)r * 256 + 128 + cc * 8) = (v4u){0u, 0u, 0u, 0u}; } }
    __syncthreads();
}

constexpr size_t CT_TB = 64 * 1024;
enum GemmId { G_IN0 = 0, G_OUT0, G_F1, G_F2, G_IN1, G_QB, G_KVB, G_OUT1, G_MOE1, G_MOE2 };
__device__ __forceinline__ void run_gemm(const Frame& F, const Params& P, int gid) {
    char* ws = F.ws; float* MOD = (float*)(ws + WS_MOD); const float* MOD1 = MOD + 9 * MODLD; LAS unsigned char* lds = F.lds + RING_OFF;
    float* X = (float*)(ws + WS_X); bf16_t* H = (bf16_t*)(ws + WS_H); LAS int* tb = (LAS int*)(F.lds + MISC_OFF);
    pg8::Gemm g; pg8::OrderAny S; pg8::EpiAny E;
    E.mode = pg8::E_BF16; E.O = nullptr; E.ldc = 0; E.npn = 1; E.ssq = nullptr; E.cbias = nullptr; E.cbld = 0; E.xin = X; E.xout = X; E.modbase = MOD; E.compact = 0; E.srcin = 0; E.fuse = 0;
    E.xsrc_lat = PIN(0); E.xsrc_ctx = PIN(2); E.gnext = PIN(7); E.nscale = MOD; E.ssqw = (float*)(ws + WS_CTL + CT_SSQA); E.slot_gate = (const float*)(ws + WS_SLOTGATE);
    S.wcnt = nullptr; S.dcnt = nullptr; S.wtarget = 0u; S.w2cnt = nullptr; S.w2kind = 0; S.rel_agent = F.even ? 0 : 1; unsigned* PCNT = (unsigned*)(ws + WS_CTL + CT_PCNT);
    S.omode = 0; S.m.tb = tb; S.m.nN = 28; S.m.G = F.G; S.m.c = F.bid; g.M = MROWS; g.N = 0;
    if (gid == G_IN0) { g.A = H; g.Bt = (const bf16_t*)(ws + WS_WIN0); g.K = 1024; S.d.init(72, 7, F.G, F.bid, 0); E.O = (bf16_t*)(ws + WS_Z); E.ldc = 1792; }
    else if (gid == G_OUT0) { g.A = (const bf16_t*)(ws + WS_Y); g.Bt = (const bf16_t*)(ws + WS_WOUT0); g.K = 1024; S.d.init(72, 4, F.G, F.bid, 0); S.omode = 4; S.ch.stage = 0; S.ch.c = F.bid; S.dcnt = PCNT;
        E.mode = pg8::E_RES; E.modbase = MOD + 2 * DM; E.srcin = 1; E.fuse = 1; E.O = H; E.gnext = PIN(7); E.nscale = MOD + 4 * DM; E.ssqw = (float*)(ws + WS_CTL + CT_SSQA); }
    else if (gid == G_F1) { g.A = H; g.Bt = (const bf16_t*)(ws + WS_WF13); g.K = 1024; S.d.init(72, 22, F.G, F.bid, 0); S.omode = 4; S.ch.stage = 1; S.ch.c = F.bid; S.wcnt = PCNT; S.wtarget = 32u; S.dcnt = PCNT + 72 * 16; S.w2cnt = PCNT; S.w2kind = 1;
        E.mode = pg8::E_SWIGLU; E.O = (bf16_t*)(ws + WS_ACT); E.ldc = DFF; E.npn = 22; E.ssq = (const float*)(ws + WS_CTL + CT_SSQA); E.cbias = (const float*)(ws + WS_CBF1); E.cbld = 5632; }
    else if (gid == G_F2) { g.A = (const bf16_t*)(ws + WS_ACT); g.Bt = (const bf16_t*)(ws + WS_WF2); g.K = 2816; S.d.init(72, 4, F.G, F.bid, 0); S.omode = 4; S.ch.stage = 2; S.ch.c = F.bid; S.wcnt = PCNT + 72 * 16; S.wtarget = 176u; S.dcnt = PCNT + 144 * 16;
        E.mode = pg8::E_RES; E.modbase = MOD + 5 * DM; E.fuse = 1; E.O = H; E.gnext = PIN(6) + DM; E.nscale = MOD1 + 1 * DM; E.ssqw = (float*)(ws + WS_CTL + CT_SSQB); }
    else if (gid == G_IN1) { g.A = H; g.Bt = (const bf16_t*)(ws + WS_WIN1); g.K = 1024; S.d.init(64, 8, F.G, F.bid, 2); S.omode = 4; S.ch.stage = 3; S.ch.c = F.bid; S.wcnt = PCNT + 144 * 16; S.wtarget = 32u; S.w2cnt = PCNT + 144 * 16; S.w2kind = 2;
        E.mode = pg8::E_BF16NORM; E.O = (bf16_t*)(ws + WS_Z); E.ldc = 2048; E.ssq = (const float*)(ws + WS_CTL + CT_SSQB); E.cbias = (const float*)(ws + WS_CBIN1); E.cbld = 2048; }
    else if (gid == G_QB) { g.A = (const bf16_t*)(ws + WS_QA); g.Bt = (const bf16_t*)(ws + WS_WQB); g.K = 256; S.d.init(64, 3, F.G, F.bid, 1); S.omode = 1; E.O = (bf16_t*)(ws + WS_QR); E.ldc = 768; }
    else if (gid == G_KVB) { g.A = (const bf16_t*)(ws + WS_KVA); g.Bt = (const bf16_t*)(ws + WS_WKVB); g.K = 256; S.d.init(72, 4, F.G, F.bid, 0); E.O = (bf16_t*)(ws + WS_KVR); E.ldc = 1024; }
    else if (gid == G_OUT1) { g.A = (const bf16_t*)(ws + WS_Y); g.Bt = (const bf16_t*)(ws + WS_WOUT1); g.K = 1024; S.d.init(64, 4, F.G, F.bid, 1); S.omode = 1;
        E.mode = pg8::E_RES; E.xout = P.out; E.modbase = MOD1 + 2 * DM; E.compact = 1; }
    else { if (F.tid < 9) tb[F.tid] = ((const int*)(ws + WS_CTL + CT_TB))[F.tid];
        __syncthreads();
        S.omode = 5; S.d.init(1, 1, F.G, F.bid, 0); S.mch.tb = tb; S.mch.c = F.bid; unsigned* MCNT = (unsigned*)(ws + WS_CTL + CT_MCNT);
        if (gid == G_MOE1) { g.A = (const bf16_t*)(ws + WS_XG); g.Bt = (const bf16_t*)(ws + WS_W13M); g.K = 1024; S.m.nN = 28; S.mch.stage = 0; S.dcnt = MCNT; E.mode = pg8::E_SWIGLU; E.O = (bf16_t*)(ws + WS_ACT2); E.ldc = DFE; E.npn = 28; }
        else { g.A = (const bf16_t*)(ws + WS_ACT2); g.Bt = (const bf16_t*)(ws + WS_W2M); g.K = 3584; S.m.nN = 4; S.mch.stage = 1; S.wcnt = MCNT; S.wtarget = 224u; E.mode = pg8::E_MOEY2; E.O = (bf16_t*)(ws + WS_Y2); } }
    if (S.wcnt != nullptr) __builtin_amdgcn_fence(__ATOMIC_ACQUIRE, "agent");
    pg8::gemm_phase<pg8::EpiAny, pg8::OrderAny, true, true>(lds, g, S, E);
    __syncthreads();
}

__device__ __forceinline__ void phase_attn0(const Frame& F) {
    char* ws = F.ws; LAS unsigned char* lds = F.lds + RING_OFF;
    for (int i = 0;; ++i) { const int L = i * F.G + F.bid; if (L >= 576) break; const int b = L & 7, idx = L >> 3;
        const int h = idx < 64 ? (idx >> 3) : idx - 64, qb = idx < 64 ? 1 + (idx & 7) : 0, NT = idx < 64 ? 36 : 4;
        att::unit<64>(b, h, h >> 2, qb, NT, (const bf16_t*)(ws + WS_QB), 512, (const bf16_t*)(ws + WS_KB), 128, (const bf16_t*)(ws + WS_VB), 128, (bf16_t*)(ws + WS_Y) + 512, DM, lds); }
}
__device__ __forceinline__ void phase_attn1(const Frame& F, const Params& P) {
    char* ws = F.ws; char* dob = (char*)P.out; LAS unsigned char* lds = F.lds + RING_OFF;
    for (int i = 0;; ++i) { const int L = i * F.G + F.bid; if (L >= 512) break; const int b = L & 7, idx = L >> 3; const int h = idx >> 3, qb = 1 + (idx & 7);
        att::unit<96>(b, h, h, qb, 36, (const bf16_t*)(ws + WS_QM), 768, (const bf16_t*)(dob + DO_KM), 768, (const bf16_t*)(dob + DO_VM), 512, (bf16_t*)(ws + WS_Y) + 512, DM, lds); }
}

__device__ __forceinline__ void phase_route(const Frame& F, const Params& P) {
    char* ws = F.ws; const float* X = P.out; const float* g = PIN(7) + DM; const float* MODL = (const float*)(ws + WS_MOD) + 9 * MODLD; const float* router = PIN(39);
    bf16_t* H2 = (bf16_t*)(ws + WS_H2); int* SEL = (int*)(ws + WS_SEL); int* HIST = (int*)(ws + WS_CTL + CT_HIST);
    LAS int* hist = (LAS int*)(F.lds + MISC_OFF);
    if (F.tid < 8) hist[F.tid] = 0;
    __syncthreads();
    const int rpb = NLAT / F.G, rpw = rpb / NWAVES;
    const int lane = F.lane;
    f32x4 rw[4][4][2], gsc[4], shv[4];
    { const float* md = MODL + (size_t)((F.bid * rpb) / SEQ) * MODLD;
#pragma unroll
      for (int j4 = 0; j4 < 4; ++j4) { const int k = 4 * lane + 256 * j4; gsc[j4] = *(const f32x4*)(g + k) * (*(const f32x4*)(md + 4 * DM + k) + 1.f); shv[j4] = *(const f32x4*)(md + 3 * DM + k);
#pragma unroll
          for (int c = 0; c < 4; ++c) { rw[j4][c][0] = *(const f32x4*)(router + (size_t)(k + c) * 8); rw[j4][c][1] = *(const f32x4*)(router + (size_t)(k + c) * 8 + 4); } } }
#pragma unroll 1
    for (int q0 = 0; q0 < rpw; q0 += 2) {
      f32x4 vv[2][4];
#pragma unroll
      for (int qq = 0; qq < 2; ++qq) { const float* xr = X + (size_t)(F.bid * rpb + F.wave * rpw + q0 + qq) * DM;
#pragma unroll
          for (int j4 = 0; j4 < 4; ++j4) vv[qq][j4] = *(const f32x4*)(xr + 4 * lane + 256 * j4); }
#pragma unroll
      for (int qq = 0; qq < 2; ++qq) {
        const int m = F.bid * rpb + F.wave * rpw + q0 + qq;
        f32x4 (&v)[4] = vv[qq]; float ss = 0.f;
#pragma unroll
        for (int j4 = 0; j4 < 4; ++j4) ss += (v[j4][0] * v[j4][0] + v[j4][1] * v[j4][1]) + (v[j4][2] * v[j4][2] + v[j4][3] * v[j4][3]);
        const float rstd = rsqrtf(wave_sum(ss) / DM + EPS);
        f32x4 a03 = {0.f, 0.f, 0.f, 0.f}, a47 = {0.f, 0.f, 0.f, 0.f};
#pragma unroll
        for (int j4 = 0; j4 < 4; ++j4) { const int k = 4 * lane + 256 * j4; const f32x4 hv = v[j4] * rstd * gsc[j4] + shv[j4];
#pragma unroll
            for (int c = 0; c < 4; ++c) { a03 += rw[j4][c][0] * hv[c]; a47 += rw[j4][c][1] * hv[c]; }
            u32x2 w; w.x = pk2(hv[0], hv[1]); w.y = pk2(hv[2], hv[3]); *(u32x2*)(H2 + (size_t)m * DM + k) = w; }
        float acc[8] = {a03[0], a03[1], a03[2], a03[3], a47[0], a47[1], a47[2], a47[3]};
#pragma unroll
        for (int e = 0; e < 8; ++e) acc[e] = wave_sum(acc[e]);
        if (lane == 0) {
            int e0 = 0; float b0 = acc[0];
#pragma unroll
            for (int e = 1; e < 8; ++e) if (acc[e] > b0) { b0 = acc[e]; e0 = e; }
            int e1 = -1; float b1 = -INFINITY;
#pragma unroll
            for (int e = 0; e < 8; ++e) if (e != e0 && acc[e] > b1) { b1 = acc[e]; e1 = e; }
            const float ex = expf(b1 - b0); const float g0 = 1.f / (1.f + ex), g1 = ex / (1.f + ex);
            SEL[4 * m + 0] = e0; SEL[4 * m + 1] = e1; SEL[4 * m + 2] = __float_as_int(g0); SEL[4 * m + 3] = __float_as_int(g1);
            atomicAdd((int*)&hist[e0], 1); atomicAdd((int*)&hist[e1], 1);
        }
      }
    }
    __syncthreads();
    if (F.tid < 8) HIST[F.bid * 8 + F.tid] = hist[F.tid];
}
__device__ __forceinline__ void phase_slot(const Frame& F, const Params& P) {
    char* ws = F.ws; const int* HIST = (const int*)(ws + WS_CTL + CT_HIST); const int* SEL = (const int*)(ws + WS_SEL); int* TB = (int*)(ws + WS_CTL + CT_TB);
    const bf16_t* H2 = (const bf16_t*)(ws + WS_H2); bf16_t* XG = (bf16_t*)(ws + WS_XG); int* slot_tok = (int*)(ws + WS_SLOTTOK); float* slot_gate = (float*)(ws + WS_SLOTGATE);
    LAS int* sm = (LAS int*)(F.lds + MISC_OFF);
    if (F.tid < 16) sm[F.tid] = 0;
    { const int rpb0 = NLAT / F.G; for (int i = F.tid; i < 4 * rpb0; i += NTHREADS) sm[512 + i] = SEL[4 * F.bid * rpb0 + i]; }
    __syncthreads();
    for (int t = F.tid; t < 2 * F.G; t += NTHREADS) {
        const int j = t % F.G, hf = t / F.G; const int4 c = *(const int4*)(HIST + j * 8 + 4 * hf); const int mk = j < F.bid ? 1 : 0;
        int v[8] = {c.x, c.y, c.z, c.w, c.x * mk, c.y * mk, c.z * mk, c.w * mk};
#pragma unroll
        for (int q = 0; q < 8; ++q) {
#pragma unroll
            for (int o = 1; o < 64; o <<= 1) v[q] += __shfl_xor(v[q], o); }
        if (F.lane == 0) {
#pragma unroll
            for (int q = 0; q < 4; ++q) { atomicAdd((int*)&sm[4 * hf + q], v[q]); atomicAdd((int*)&sm[8 + 4 * hf + q], v[4 + q]); } }
    }
    __syncthreads();
    if (F.tid == 0) { int s = 0; for (int e = 0; e < 8; ++e) { sm[16 + e] = s; s += (sm[e] + 255) & ~255; } sm[24] = s; }
    __syncthreads();
    const int rpb = NLAT / F.G, na = 2 * rpb;
    if (F.tid == 0) { int run[8];
#pragma unroll
        for (int e = 0; e < 8; ++e) run[e] = sm[16 + e] + sm[8 + e];
        for (int a = 0; a < na; ++a) { const int e = sm[512 + 4 * (a >> 1) + (a & 1)]; int sl = 0;
#pragma unroll
            for (int q = 0; q < 8; ++q) if (q == e) { sl = run[q]; run[q] = sl + 1; }
            sm[32 + a] = sl; } }
    __syncthreads();
    for (int a0 = F.wave * 4; a0 < na; a0 += NWAVES * 4) { v4u va[4][2];
#pragma unroll
        for (int q = 0; q < 4; ++q) { const int a = a0 + q; const int m = F.bid * rpb + (a >> 1); const v4u* src = (const v4u*)(H2 + (size_t)m * DM); va[q][0] = src[F.lane]; va[q][1] = src[64 + F.lane]; }
#pragma unroll
        for (int q = 0; q < 4; ++q) { const int a = a0 + q; const int m = F.bid * rpb + (a >> 1), sl = sm[32 + a]; v4u* dst = (v4u*)(XG + (size_t)sl * DM); dst[F.lane] = va[q][0]; dst[64 + F.lane] = va[q][1];
            if (F.lane == 0) { slot_tok[sl] = m; ((int*)(ws + WS_TOKSLOT))[2 * m + (a & 1)] = sl; slot_gate[sl] = __int_as_float(sm[512 + 4 * (a >> 1) + 2 + (a & 1)]); } } }
    if (F.bid < 8) { const int e = F.bid; for (int sl = sm[16 + e] + sm[e] + F.tid; sl < sm[16 + e + 1]; sl += NTHREADS) slot_tok[sl] = -1; }
    if (F.bid == 0 && F.tid < 9) TB[F.tid] = sm[16 + F.tid] >> 8;
}
__device__ __forceinline__ void phase_combine(const Frame& F, const Params& P) {
    char* ws = F.ws; float* out = P.out; const bf16_t* Y2 = (const bf16_t*)(ws + WS_Y2); const int* TS = (const int*)(ws + WS_TOKSLOT); const float* mod5 = (const float*)(ws + WS_MOD) + 9 * MODLD + 5 * DM;
    const int gw = F.bid * NWAVES + F.wave, lane = F.lane; const int mb = gw * 8;
    f32x4 mv[2][2];
    { const float* md = mod5 + (size_t)(mb >> 11) * MODLD;
#pragma unroll
      for (int jj = 0; jj < 2; ++jj)
#pragma unroll
          for (int hlf = 0; hlf < 2; ++hlf) mv[jj][hlf] = *(const f32x4*)(md + 8 * lane + 512 * jj + 4 * hlf); }
#pragma unroll 1
    for (int q0 = 0; q0 < 8; q0 += 2) {
        f32x4 xv[2][4]; v4u ya[2][2], yb[2][2];
#pragma unroll
        for (int q = 0; q < 2; ++q) { const int m = mb + q0 + q; const int sa = TS[2 * m], sb = TS[2 * m + 1];
#pragma unroll
            for (int jj = 0; jj < 4; ++jj) xv[q][jj] = *(const f32x4*)(out + (size_t)m * DM + 8 * lane + 512 * (jj >> 1) + 4 * (jj & 1));
#pragma unroll
            for (int jj = 0; jj < 2; ++jj) { ya[q][jj] = *(const v4u*)(Y2 + (size_t)sa * DM + 8 * lane + 512 * jj); yb[q][jj] = *(const v4u*)(Y2 + (size_t)sb * DM + 8 * lane + 512 * jj); } }
#pragma unroll
        for (int q = 0; q < 2; ++q) { const int m = mb + q0 + q;
#pragma unroll
            for (int jj = 0; jj < 2; ++jj) { const int k = 8 * lane + 512 * jj;
#pragma unroll
                for (int hlf = 0; hlf < 2; ++hlf) { f32x4 o = xv[q][2 * jj + hlf]; const f32x4 mm = mv[jj][hlf];
                    const unsigned a0 = ya[q][jj][2 * hlf], a1 = ya[q][jj][2 * hlf + 1], b0 = yb[q][jj][2 * hlf], b1 = yb[q][jj][2 * hlf + 1];
                    o[0] += mm[0] * (__uint_as_float(a0 << 16) + __uint_as_float(b0 << 16)); o[1] += mm[1] * (__uint_as_float(a0 & 0xffff0000u) + __uint_as_float(b0 & 0xffff0000u));
                    o[2] += mm[2] * (__uint_as_float(a1 << 16) + __uint_as_float(b1 << 16)); o[3] += mm[3] * (__uint_as_float(a1 & 0xffff0000u) + __uint_as_float(b1 & 0xffff0000u));
                    *(f32x4*)(out + (size_t)m * DM + k + 4 * hlf) = o; } } }
    }
}

#define XB_TMO      128
#define XB_XCNT(j)  (256  + 64 * (j))
#define XB_XSUB(j)  (1280 + 64 * (j))
#define XB_XGEN(j)  (2304 + 64 * (j))
#define XB_TOP      3328
#define XB_TOPGEN   3392
#define XCD_BAR_WORDS 3456
#define XB_SPIN_CAP (1u << 18)

__device__ __forceinline__ unsigned xb_ld(unsigned* p)              { return __hip_atomic_load(p, __ATOMIC_RELAXED, __HIP_MEMORY_SCOPE_AGENT); }
__device__ __forceinline__ unsigned xb_add(unsigned* p, unsigned v) { return __hip_atomic_fetch_add(p, v, __ATOMIC_RELAXED, __HIP_MEMORY_SCOPE_AGENT); }
__device__ __forceinline__ unsigned xb_xcc_id() { return (unsigned)__builtin_amdgcn_s_getreg((3 << 11) | 20) & 0xFu; }
#define XB_SPIN(cond, bar) do { unsigned _sp = 0; while (cond) { __builtin_amdgcn_s_sleep(1); \
    if ((++_sp & 255u) == 0u) { if (xb_ld(&(bar)[XB_TMO])) break; if (_sp > XB_SPIN_CAP) { atomicAdd(&(bar)[XB_TMO], 1u); break; } } } } while (0)

struct XcdBarrier {
    unsigned* bar; unsigned x;
    volatile LAS unsigned* st;
};

__device__ __forceinline__ XcdBarrier xcd_barrier_post(unsigned* bar, volatile LAS unsigned* st) {
    XcdBarrier b; b.bar = bar; b.x = xb_xcc_id(); b.st = st;
    if (threadIdx.x == 0) st[2] = xb_add(&bar[XB_XCNT(b.x)], 1u);
    return b;
}
__device__ __forceinline__ void xcd_barrier_complete(unsigned* bar, unsigned x, unsigned& nloc, unsigned& nx, unsigned& even) {
    const unsigned G = gridDim.x * gridDim.y * gridDim.z;
    unsigned sum, cnt, mine, bal, sp = 0u;
    for (;;) {
        sum = 0u; cnt = 0u; mine = 0u; bal = 1u;
#pragma unroll
        for (unsigned j = 0; j < 16; ++j) { const unsigned c = xb_ld(&bar[XB_XCNT(j)]); sum += c; cnt += (c > 0u) ? 1u : 0u; mine = (j == x) ? c : mine; bal = (j < 8u && c * 8u != G) ? 0u : bal; }
        if (sum == G) break;
        __builtin_amdgcn_s_sleep(1);
        if ((++sp & 255u) == 0u) { if (xb_ld(&bar[XB_TMO])) break; if (sp > XB_SPIN_CAP) { atomicAdd(&bar[XB_TMO], 1u); break; } }
    }
    nloc = mine > 0u ? mine : 1u; nx = cnt > 0u ? cnt : 1u; even = (sum == G) ? bal : 0u;
}

__device__ __forceinline__ void xcd_barrier(const XcdBarrier& b) {
    asm volatile("s_waitcnt vmcnt(0)" ::: "memory");
    __syncthreads();
    if (threadIdx.x == 0) {
        unsigned* bar = b.bar;
        __builtin_amdgcn_s_waitcnt(0);
        unsigned nloc = b.st[0], nx = b.st[1];
        if (nloc == 0u) { unsigned ev; xcd_barrier_complete(bar, b.x, nloc, nx, ev); b.st[0] = nloc; b.st[1] = nx; b.st[3] = ev; }
        const unsigned old = xb_add(&bar[XB_XSUB(b.x)], 1u);
        const unsigned gen = old / nloc;
        if (old + 1u == (gen + 1u) * nloc) {
            __builtin_amdgcn_fence(__ATOMIC_RELEASE, "agent");
            asm volatile("s_waitcnt vmcnt(0)" ::: "memory");
            const unsigned og = xb_add(&bar[XB_TOP], 1u);
            const unsigned tg = og / nx;
            if (og + 1u == (tg + 1u) * nx) xb_add(&bar[XB_TOPGEN], 1u);
            else XB_SPIN(xb_ld(&bar[XB_TOPGEN]) == tg, bar);
            __builtin_amdgcn_fence(__ATOMIC_ACQUIRE, "agent");
            xb_add(&bar[XB_XGEN(b.x)], 1u);
            asm volatile("s_waitcnt vmcnt(0)" ::: "memory");
        } else {
            XB_SPIN(xb_ld(&bar[XB_XGEN(b.x)]) == gen, bar);
            __builtin_amdgcn_fence(__ATOMIC_ACQUIRE, "agent");
            asm volatile("s_waitcnt vmcnt(0)" ::: "memory");
        }
    }
    __syncthreads();
}
namespace hy {
using f32x16 = __attribute__((ext_vector_type(16))) float;
constexpr int UL = 2088, ULB = UL * 2;
constexpr int GOFF = 2064;
constexpr int L_U = 0, L_U2 = 8 * ULB, L_X = 2 * 8 * ULB, L_G0 = L_X + 8 * 2048 * 2, L_G1 = L_G0 + GT_LD * 2, L_END = L_G1 + GT_LD * 2;
static_assert(L_END <= RING_BYTES, "hyena LDS");
__device__ __forceinline__ void prep(const Frame& F, const Params& P) {
    char* ws = F.ws; const bf16_t* Z = (const bf16_t*)(ws + WS_Z); bf16_t* ZT = (bf16_t*)(ws + WS_ZT); const float* cw = PIN(24); const float* cb = PIN(25);
    const int gw = F.bid * NWAVES + F.wave, NGW = F.G * NWAVES, lane = F.lane; LAS unsigned char* tl = F.lds + RING_OFF + F.wave * 8192;
    for (int it = gw; it < 24 * 8 * 64; it += NGW) { const int cg = it % 24, b = (it / 24) & 7, tt = it / 192; const int c = cg * 64 + lane, t0 = tt * 32;
        const float w0 = cw[c], w1 = cw[1536 + c], w2 = cw[3072 + c], bias = cb[c];
        const bf16_t* zp = Z + ((size_t)b * RPB + CTX) * CD_LD + cg * 64;
        v4u pc[5];
#pragma unroll
        for (int k = 0; k < 5; ++k) { const int p = lane + 64 * k, row = p >> 3, c8 = p & 7, t = t0 - 1 + row; pc[k] = (p < 272 && t >= 0 && t < SEQ) ? *(const v4u*)(zp + (size_t)t * CD_LD + c8 * 8) : (v4u){0u, 0u, 0u, 0u}; }
#pragma unroll
        for (int k = 0; k < 5; ++k) { const int p = lane + 64 * k, row = p >> 3, c8 = p & 7; if (p < 272) *(LAS v4u*)(tl + row * 144 + c8 * 16) = pc[k]; }
        LDS_WAIT(); asm volatile("" ::: "memory");
        float xr[34];
#pragma unroll
        for (int i = 0; i < 34; ++i) xr[i] = bf2f(*(const LAS bf16_t*)(tl + i * 144 + lane * 2));
        LDS_WAIT(); asm volatile("" ::: "memory");
        bf16_t* op = ZT + ((size_t)c * NB + b) * SEQ + t0;
#pragma unroll
        for (int j8 = 0; j8 < 4; ++j8) { float y[8];
#pragma unroll
            for (int jj = 0; jj < 8; ++jj) { const int i = j8 * 8 + jj; y[jj] = bias + w0 * xr[i] + w1 * xr[i + 1] + w2 * xr[i + 2]; }
            v4u o; o.x = pk2(y[0], y[1]); o.y = pk2(y[2], y[3]); o.z = pk2(y[4], y[5]); o.w = pk2(y[6], y[7]); *(v4u*)(op + j8 * 8) = o; } }
}
__device__ __forceinline__ void filt(const Frame& F, const Params& P) {
    char* ws = F.ws; bf16_t* GT = (bf16_t*)(ws + WS_GT);
    const float *w1 = PIN(26), *b1 = PIN(27), *w2 = PIN(28), *b2 = PIN(29), *w3 = PIN(30), *freq = PIN(31);
    LAS float* z = (LAS float*)(F.lds + RING_OFF); LAS float* h1 = z + 9 * 64; LAS float* h2 = h1 + 9 * 64;
    const int tid = F.tid;
    for (int tb = F.bid; tb < SEQ / 8; tb += F.G) {
        const int t0 = tb * 8;
        __syncthreads();
        if (tid < 9 * 33) { const int tt = tid / 33, k = tid % 33, t = t0 + tt; float zv = (float)t / (float)(SEQ - 1);
            if (k > 0) { const int bi = (k - 1) & 15; const double band = 1e-4 + (15.0 - 1e-4) * (double)bi / 15.0; const double rev = (double)t * band * (1.0 / (double)SEQ);
                const float fr = (float)(rev - floor(rev)); zv = k <= 16 ? __builtin_amdgcn_cosf(fr) : -__builtin_amdgcn_sinf(fr); }
            z[tt * 64 + k] = zv; }
        __syncthreads();
        for (int idx = tid; idx < 9 * 64; idx += NTHREADS) { const int tt = idx >> 6, j = idx & 63; float a = b1[j];
#pragma unroll
            for (int i = 0; i < 33; ++i) a += z[tt * 64 + i] * w1[i * 64 + j];
            h1[idx] = __sinf(freq[j] * a); }
        __syncthreads();
        for (int idx = tid; idx < 9 * 64; idx += NTHREADS) { const int tt = idx >> 6, j = idx & 63; float a = b2[j];
#pragma unroll 16
            for (int i = 0; i < 64; ++i) a += h1[tt * 64 + i] * w2[i * 64 + j];
            h2[idx] = __sinf(freq[j] * a); }
        __syncthreads();
        float acc[4][9];
#pragma unroll
        for (int q = 0; q < 4; ++q)
#pragma unroll
            for (int tt = 0; tt < 9; ++tt) acc[q][tt] = 0.f;
#pragma unroll 16
        for (int i = 0; i < 64; ++i) { float wv[4];
#pragma unroll
            for (int q = 0; q < 4; ++q) wv[q] = w3[(size_t)i * 2048 + tid + 512 * q];
#pragma unroll
            for (int tt = 0; tt < 9; ++tt) { const float hv = h2[tt * 64 + i];
#pragma unroll
                for (int q = 0; q < 4; ++q) acc[q][tt] += hv * wv[q]; } }
        const double mind = log(1e-2) / 1.5, maxd = log(1e-2) / 0.3; const int ch = tid; const float delta = fabsf((float)(mind + (maxd - mind) * (double)ch / 511.0));
        float win[9];
#pragma unroll
        for (int tt = 0; tt < 9; ++tt) { const int t = t0 + tt; win[tt] = t < SEQ ? __expf(-((float)t / (float)(SEQ - 1)) * delta) + 0.05f : 0.f; }
#pragma unroll
        for (int ord = 0; ord < 2; ++ord) { bf16_t* gp = GT + ((size_t)ord * 512 + ch) * GT_LD + GOFF; float fw[9], bw[9];
#pragma unroll
            for (int tt = 0; tt < 9; ++tt) { fw[tt] = acc[2 * ord][tt] * win[tt]; bw[tt] = acc[2 * ord + 1][tt] * win[tt]; }
            if (t0 == 0) bw[0] = fw[0];
            v4u ob; ob.x = pk2(bw[0], bw[1]); ob.y = pk2(bw[2], bw[3]); ob.z = pk2(bw[4], bw[5]); ob.w = pk2(bw[6], bw[7]); *(v4u*)(gp + t0) = ob;
            v4u of; of.x = pk2(fw[8], fw[7]); of.y = pk2(fw[6], fw[5]); of.z = pk2(fw[4], fw[3]); of.w = pk2(fw[2], fw[1]); *(v4u*)(gp - t0 - 8) = of; }
    }
    const int gt = F.bid * NTHREADS + F.tid, NGT = F.G * NTHREADS; constexpr int NZ = 16 + (GT_LD - GOFF - 2048);
    for (int i = gt; i < 1024 * NZ; i += NGT) { const int oc = i / NZ, k = i % NZ; GT[(size_t)oc * GT_LD + (k < 16 ? k : GOFF + 2048 + (k - 16))] = 0; }
}
__device__ __forceinline__ void conv_mfma(f32x16 (&acc)[2], LAS unsigned char* Ub, LAS unsigned char* Gb, int wave, int lane) {
    const int n = lane & 31, h = lane >> 5, b = n >> 2, dl = n & 3;
    const LAS unsigned char* up = Ub + b * ULB + 16 * h;
    const int i = lane & 31;
    const LAS unsigned char* gp0 = Gb + 2 * (GOFF + 8 * h - 4 * i - 16 * (8 * (2 * wave) + 1));
    const LAS unsigned char* gp1 = gp0 - 2 * 16 * 8;
    acc[0] = f32x16{}; acc[1] = f32x16{};
    const bool sh2 = dl >= 2; const unsigned sb = (dl & 1) * 2;
    const LAS unsigned char* upq = up + 8 * (dl < 3 ? dl : 2);
    u32x4 ring[8];
#pragma unroll
    for (int b8 = 0; b8 < 8; ++b8) { const u32x2 a0 = *(const LAS u32x2*)(gp1 + 32 * b8), a1 = *(const LAS u32x2*)(gp1 + 32 * b8 + 8); ring[b8] = (u32x4){a0[0], a0[1], a1[0], a1[1]}; }
#define HY_STEP(J, b8) do { \
          \
        const u32x2 qx = *(const LAS u32x2*)(upq + 32 * (J)); \
        unsigned q[6]; \
        q[0] = __builtin_amdgcn_mov_dpp((int)qx[0], 0x00, 0xF, 0xF, false); q[1] = __builtin_amdgcn_mov_dpp((int)qx[1], 0x00, 0xF, 0xF, false); \
        q[2] = __builtin_amdgcn_mov_dpp((int)qx[0], 0x55, 0xF, 0xF, false); q[3] = __builtin_amdgcn_mov_dpp((int)qx[1], 0x55, 0xF, 0xF, false); \
        q[4] = __builtin_amdgcn_mov_dpp((int)qx[0], 0xAA, 0xF, 0xF, false); q[5] = __builtin_amdgcn_mov_dpp((int)qx[1], 0xAA, 0xF, 0xF, false); \
        u32x4 bw; \
        _Pragma("unroll") for (int w = 0; w < 4; ++w) { const unsigned lo = sh2 ? q[w + 1] : q[w], hi_ = sh2 ? q[w + 2] : q[w + 1]; bw[w] = __builtin_amdgcn_alignbyte(hi_, lo, sb); } \
        const u32x2 a00 = *(const LAS u32x2*)(gp0 + 32 * (J)), a01 = *(const LAS u32x2*)(gp0 + 32 * (J) + 8); \
        const u32x4 A1 = ring[b8]; const u32x4 A0 = {a00[0], a00[1], a01[0], a01[1]}; ring[b8] = A0; \
        acc[0] = __builtin_amdgcn_mfma_f32_32x32x16_bf16(__builtin_bit_cast(bf16x8, A0), __builtin_bit_cast(bf16x8, bw), acc[0], 0, 0, 0); \
        acc[1] = __builtin_amdgcn_mfma_f32_32x32x16_bf16(__builtin_bit_cast(bf16x8, A1), __builtin_bit_cast(bf16x8, bw), acc[1], 0, 0, 0); } while (0)
#pragma unroll 1
    for (int J8 = 0; J8 < 128; J8 += 8) {
#pragma unroll
        for (int b8 = 0; b8 < 8; ++b8) HY_STEP(J8 + b8, b8); }
    HY_STEP(128, 0);
#undef HY_STEP
}
__device__ __forceinline__ void main_phase(const Frame& F, const Params& P) {
    char* ws = F.ws; const bf16_t* ZT = (const bf16_t*)(ws + WS_ZT); const bf16_t* GT = (const bf16_t*)(ws + WS_GT); bf16_t* HT = (bf16_t*)(ws + WS_HT); const float* skip = PIN(32);
    LAS unsigned char* lds = F.lds + RING_OFF; const int tid = F.tid, lane = F.lane, wave = F.wave;
    const int n = lane & 31, h = lane >> 5, b = n >> 2, dl = n & 3;
    for (int c = F.bid; c < 512; c += F.G) {
        __syncthreads();
        for (int i = tid; i < 8 * 256; i += NTHREADS) { const int bb = i >> 8, k = i & 255; *(LAS v4u*)(lds + L_U + bb * ULB + 32 + k * 16) = *(const v4u*)(ZT + ((size_t)c * NB + bb) * SEQ + k * 8);
            *(LAS v4u*)(lds + L_X + (bb * 2048 + k * 8) * 2) = *(const v4u*)(ZT + ((size_t)(512 + c) * NB + bb) * SEQ + k * 8); }
        for (int i = tid; i < GT_LD / 8; i += NTHREADS) { *(LAS v4u*)(lds + L_G0 + i * 16) = *(const v4u*)(GT + (size_t)c * GT_LD + i * 8); *(LAS v4u*)(lds + L_G1 + i * 16) = *(const v4u*)(GT + (size_t)(512 + c) * GT_LD + i * 8); }
        if (tid < 80) { const int bb = tid / 10, k = tid % 10, which = k / 5, part = k % 5; const int off = bb * ULB + (part < 2 ? part * 16 : (16 + 2048) * 2 + (part - 2) * 16);
            *(LAS v4u*)(lds + (which ? L_U2 : L_U) + off) = (v4u){0u, 0u, 0u, 0u}; }
        __syncthreads();
        const float sk0 = skip[c], sk1 = skip[512 + c];
        f32x16 acc[2];
        conv_mfma(acc, lds + L_U, lds + L_G0, wave, lane);
#pragma unroll
        for (int ip = 0; ip < 2; ++ip)
#pragma unroll
            for (int r = 0; r < 16; ++r) { const int t = 128 * (2 * wave + ip) + 4 * att::crow(r, h) + dl;
                const float v = bf2f(*(const LAS bf16_t*)(lds + L_U + b * ULB + (16 + t) * 2)), x1 = bf2f(*(const LAS bf16_t*)(lds + L_X + (b * 2048 + t) * 2));
                *(LAS bf16_t*)(lds + L_U2 + b * ULB + (16 + t) * 2) = f2bf(x1 * (acc[ip][r] + sk0 * v)); }
        __syncthreads();
        for (int i = tid; i < 8 * 256; i += NTHREADS) { const int bb = i >> 8, k = i & 255; *(LAS v4u*)(lds + L_X + (bb * 2048 + k * 8) * 2) = *(const v4u*)(ZT + ((size_t)(1024 + c) * NB + bb) * SEQ + k * 8); }
        conv_mfma(acc, lds + L_U2, lds + L_G1, wave, lane);
        __syncthreads();
#pragma unroll
        for (int ip = 0; ip < 2; ++ip)
#pragma unroll
            for (int r = 0; r < 16; ++r) { const int t = 128 * (2 * wave + ip) + 4 * att::crow(r, h) + dl;
                const float y1 = bf2f(*(const LAS bf16_t*)(lds + L_U2 + b * ULB + (16 + t) * 2)), x2 = bf2f(*(const LAS bf16_t*)(lds + L_X + (b * 2048 + t) * 2));
                *(LAS bf16_t*)(lds + L_U + (b * 2048 + t) * 2) = f2bf(x2 * (acc[ip][r] + sk1 * y1)); }
        __syncthreads();
        for (int i = tid; i < 8 * 256; i += NTHREADS) *(v4u*)(HT + (size_t)c * NLAT + i * 8) = *(const LAS v4u*)(lds + L_U + i * 16);
    }
}
__device__ __forceinline__ void untranspose(const Frame& F) {
    char* ws = F.ws; const bf16_t* HT = (const bf16_t*)(ws + WS_HT); bf16_t* Y = (bf16_t*)(ws + WS_Y);
    const int gw = F.bid * NWAVES + F.wave, NGW = F.G * NWAVES, lane = F.lane; LAS unsigned char* tl = F.lds + RING_OFF + F.wave * 16384;
    __syncthreads();
    for (int it = gw; it < 8 * 8 * 32; it += NGW) { const int cg = it & 7, b = (it >> 3) & 7, tt = it >> 6; const int c = cg * 64 + lane, t0 = tt * 64;
        const bf16_t* hp = HT + ((size_t)c * NB + b) * SEQ + t0; bf16_t* yp = Y + ((size_t)b * RPB + CTX + t0) * DM + cg * 64;
        v4u q[8];
#pragma unroll
        for (int j8 = 0; j8 < 8; ++j8) q[j8] = *(const v4u*)(hp + j8 * 8);
#pragma unroll
        for (int j8 = 0; j8 < 8; ++j8)
#pragma unroll
            for (int jj = 0; jj < 4; ++jj) { *(LAS bf16_t*)(tl + (j8 * 8 + 2 * jj) * 144 + lane * 2) = (bf16_t)(q[j8][jj] & 0xffffu); *(LAS bf16_t*)(tl + (j8 * 8 + 2 * jj + 1) * 144 + lane * 2) = (bf16_t)(q[j8][jj] >> 16); }
        LDS_WAIT(); asm volatile("" ::: "memory");
#pragma unroll
        for (int k = 0; k < 8; ++k) { const int p = lane + 64 * k, row = p >> 3, c8 = p & 7; *(v4u*)(yp + (size_t)row * DM + c8 * 8) = *(const LAS v4u*)(tl + row * 144 + c8 * 16); }
        LDS_WAIT(); asm volatile("" ::: "memory"); }
}
}
namespace lru {
using f32x16 = __attribute__((ext_vector_type(16))) float;
typedef float f32x2 __attribute__((ext_vector_type(2)));
constexpr int T = 32, NCH = RPB / T;
constexpr int UPITCH = 1040;
constexpr int L_UT = 0, L_GL = 34816, L_END = L_GL + 2 * T * 512 * 2;
static_assert(L_END <= RING_BYTES, "lru LDS");
__device__ __forceinline__ float fsigmoid(float x) { return __builtin_amdgcn_rcpf(1.f + __builtin_amdgcn_exp2f(-LOG2E * x)); }
__device__ __forceinline__ float gelu_fast(float x) { const float y = 0.7978845608028654f * (x + 0.044715f * x * x * x); const float e = __builtin_amdgcn_exp2f(2.f * LOG2E * y); const float th = 1.f - 2.f * __builtin_amdgcn_rcpf(1.f + e); return 0.5f * x * (1.f + th); }
__device__ __forceinline__ int chunk_of_order(int d, int q) { return d == 0 ? q : (q < 8 ? 7 - q : 79 - q); }
__device__ __forceinline__ int order_of_chunk(int d, int j) { return d == 0 ? j : (j < 8 ? 7 - j : 79 - j); }

__device__ __forceinline__ void unit0(const Frame& F, const Params& P, int b, int j) {
    char* ws = F.ws; const bf16_t* Z = (const bf16_t*)(ws + WS_Z); float* AGG = (float*)(ws + WS_AGG); const bf16_t* WL = (const bf16_t*)(ws + WS_WLRU);
    bf16_t* LAB = (bf16_t*)P.out; bf16_t* BTB = (bf16_t*)(ws + WS_H);
    LAS unsigned char* lds = F.lds + RING_OFF; const int ch = F.tid, lane = F.lane, wave = F.wave;
    const int s0 = j * T, seg_lo = s0 < CTX ? 0 : CTX, seg_hi = s0 < CTX ? CTX : RPB; const size_t row0 = (size_t)b * RPB + s0;
    LDS_WAIT(); asm volatile("" ::: "memory");
    float u[T];
    { const float w0 = PIN(10)[ch], w1 = PIN(10)[512 + ch], w2 = PIN(10)[1024 + ch], w3 = PIN(10)[1536 + ch], cb = PIN(11)[ch];
      float xw[T + 3];
#pragma unroll
      for (int i = 0; i < T + 3; ++i) { const int s = s0 + i - 2; xw[i] = (s >= seg_lo && s < seg_hi) ? bf2f(Z[((size_t)b * RPB + s) * AB_IN + ch]) : 0.f; }
#pragma unroll
      for (int t = 0; t < T; ++t) { u[t] = cb + w0 * xw[t] + w1 * xw[t + 1] + w2 * xw[t + 2] + w3 * xw[t + 3]; *(LAS bf16_t*)(lds + L_UT + t * UPITCH + ch * 2) = f2bf(u[t]); } }
#pragma unroll
    for (int d = 0; d < 2; ++d) {
        LDS_WAIT(); asm volatile("" ::: "memory");
        { const int n = wave, r32 = lane & 31, h = lane >> 5; bf16x8 af[4];
#pragma unroll
          for (int ks = 0; ks < 4; ++ks) af[ks] = *(const LAS bf16x8*)(lds + L_UT + r32 * UPITCH + (64 * n + 16 * ks + 8 * h) * 2);
#pragma unroll
          for (int g = 0; g < 2; ++g)
#pragma unroll
              for (int cb = 0; cb < 2; ++cb) { f32x16 acc = f32x16{}; const bf16_t* wp = WL + ((size_t)((d * 8 + n) * 2 + g) * 64 + 32 * cb + r32) * 64 + 8 * h;
#pragma unroll
                  for (int ks = 0; ks < 4; ++ks) { const bf16x8 bfr = *(const bf16x8*)(wp + 16 * ks); acc = __builtin_amdgcn_mfma_f32_32x32x16_bf16(af[ks], bfr, acc, 0, 0, 0); }
                  const float bias = (g == 0 ? PIN(13) : PIN(15))[(d * 8 + n) * 64 + 32 * cb + r32];
#pragma unroll
                  for (int r = 0; r < 16; ++r) *(LAS bf16_t*)(lds + L_GL + ((g * T + att::crow(r, h)) * 512 + 64 * n + 32 * cb + r32) * 2) = f2bf(fsigmoid(acc[r] + bias)); } }
        LDS_WAIT(); asm volatile("" ::: "memory");
        const float cl = -8.f * softplus_f(-PIN(16)[d * 512 + ch]);
        float h = 0.f, sumlog = 0.f; bf16_t* lap = LAB + ((size_t)d * MROWS + row0) * 512 + ch; bf16_t* btp = BTB + ((size_t)d * MROWS + row0) * 512 + ch;
#pragma unroll
        for (int st = 0; st < T; ++st) { const int t = d == 0 ? st : T - 1 - st;
            const float rg = bf2f(*(const LAS bf16_t*)(lds + L_GL + (t * 512 + ch) * 2)), ig = bf2f(*(const LAS bf16_t*)(lds + L_GL + ((T + t) * 512 + ch) * 2));
            const bf16_t lab = f2bf(cl * rg); const float la = bf2f(lab); const float a = __builtin_amdgcn_exp2f(LOG2E * la);
            const bf16_t btb = f2bf(__builtin_amdgcn_sqrtf(fmaf(-a, a, 1.f)) * (ig * u[t])); const float bt = bf2f(btb);
            lap[(size_t)t * 512] = lab; btp[(size_t)t * 512] = btb;
            h = a * h + bt; sumlog += la; }
        { f32x2* ag = (f32x2*)AGG + ((size_t)(d * 8 + b) * NCH + j) * 512 + ch; *ag = (f32x2){sumlog, h}; }
    }
}
__device__ __forceinline__ void unit1(const Frame& F, const Params& P, int b, int j) {
    char* ws = F.ws; const bf16_t* Z = (const bf16_t*)(ws + WS_Z); bf16_t* Y = (bf16_t*)(ws + WS_Y); const float* AGG = (const float*)(ws + WS_AGG);
    const bf16_t* LAB = (const bf16_t*)P.out; const bf16_t* BTB = (const bf16_t*)(ws + WS_H);
    const int ch = F.tid; const size_t row0 = (size_t)b * RPB + j * T;
    float hf[T];
#pragma unroll
    for (int d = 0; d < 2; ++d) {
        const bf16_t* lap = LAB + ((size_t)d * MROWS + row0) * 512 + ch; const bf16_t* btp = BTB + ((size_t)d * MROWS + row0) * 512 + ch;
        bf16_t lav[T], btv[T]; bf16_t gv[T];
#pragma unroll
        for (int t = 0; t < T; ++t) { lav[t] = lap[(size_t)t * 512]; btv[t] = btp[(size_t)t * 512]; if (d == 1) gv[t] = Z[(row0 + t) * AB_IN + 512 + ch]; }
        float h = 0.f;
        { const int q = order_of_chunk(d, j); const f32x2* ag = (const f32x2*)AGG + (size_t)(d * 8 + b) * NCH * 512 + ch;
#pragma unroll 24
          for (int qq = 0; qq < q; ++qq) { const int jj = chunk_of_order(d, qq); const f32x2 av = ag[(size_t)jj * 512]; h = __builtin_amdgcn_exp2f(LOG2E * av[0]) * h + av[1]; } }
#pragma unroll
        for (int st = 0; st < T; ++st) { const int t = d == 0 ? st : T - 1 - st;
            h = __builtin_amdgcn_exp2f(LOG2E * bf2f(lav[t])) * h + bf2f(btv[t]);
            if (d == 0) hf[t] = h; else Y[(row0 + t) * DM + ch] = f2bf((hf[t] + h) * gelu_fast(bf2f(gv[t]))); }
    }
}
template <int MODE>
__device__ __forceinline__ void phase(const Frame& F, const Params& P) {
    const int first = MODE == 0 ? F.bid : (F.bid + 192) % F.G;
    for (int L = first; L < NB * NCH; L += F.G) { if (MODE == 0) unit0(F, P, L & 7, L >> 3); else unit1(F, P, L & 7, L >> 3); }
}
}
namespace el {
__device__ __forceinline__ void mod_phase(const Frame& F, const Params& P) {
    char* ws = F.ws; float* MOD = (float*)(ws + WS_MOD); const float* c = PIN(1); const float* cctx = PIN(3); const float* mw = PIN(4); const float* mb = PIN(5);
    LAS float* sc = (LAS float*)(F.lds + RING_OFF); LAS float* part = sc + 9 * DM;
    if (F.bid >= 192) return;
    for (int i = F.tid; i < 9 * DM; i += NTHREADS) { const int j = i >> 10, k = i & 1023; const float v = j < 8 ? c[j * DM + k] : cctx[k]; sc[i] = v / (1.f + expf(-v)); }
    __syncthreads();
    const int cg = F.lane & 15, kr = F.lane >> 4; const int col = F.bid * 64 + 4 * cg, l = col / MODLD, n = col % MODLD; const float* w = mw + (size_t)l * DM * MODLD + n; const int k0 = F.wave * 128 + kr;
    f32x4 acc[9];
#pragma unroll
    for (int j = 0; j < 9; ++j) acc[j] = (f32x4){0.f, 0.f, 0.f, 0.f};
#pragma unroll 8
    for (int i = 0; i < 32; ++i) { const int k = k0 + 4 * i; const f32x4 wv = __builtin_nontemporal_load((const f32x4*)(w + (size_t)k * MODLD));
#pragma unroll
        for (int j = 0; j < 9; ++j) acc[j] += wv * sc[j * DM + k]; }
#pragma unroll
    for (int j = 0; j < 9; ++j) {
#pragma unroll
        for (int c = 0; c < 4; ++c) { float v = acc[j][c]; v += __shfl_xor(v, 16); v += __shfl_xor(v, 32); acc[j][c] = v; }
        if (kr == 0) *(LAS f32x4*)(part + (F.wave * 9 + j) * 64 + 4 * cg) = acc[j]; }
    __syncthreads();
    for (int i = F.tid; i < 9 * 64; i += NTHREADS) { const int j = i >> 6, ln = i & 63; float s = 0.f;
#pragma unroll
        for (int wv = 0; wv < 8; ++wv) s += part[(wv * 9 + j) * 64 + ln];
        const int cc = F.bid * 64 + ln; MOD[((size_t)(cc / MODLD) * 9 + j) * MODLD + cc % MODLD] = s + mb[cc]; }
    __syncthreads();
}
__device__ __forceinline__ void bias_phase(const Frame& F, const Params& P) {
    char* ws = F.ws; const float* MOD = (const float*)(ws + WS_MOD);
    LAS float* sc = (LAS float*)(F.lds + RING_OFF); LAS float* part = sc + 9 * DM;
    if (F.bid >= 120) return;
    const bool f1 = F.bid < 88; const float* shb = f1 ? MOD + 3 * DM : MOD + 9 * MODLD;
    __syncthreads();
    for (int i = F.tid; i < 9 * DM; i += NTHREADS) sc[i] = shb[(size_t)(i >> 10) * MODLD + (i & 1023)];
    __syncthreads();
    const int cg = F.lane & 15, kr = F.lane >> 4; const int cc = (f1 ? F.bid : F.bid - 88) * 64 + 4 * cg; const float* w; int ldw; bool valid = true;
    if (f1) { const int pn = cc >> 8, c = cc & 255; w = (c < 128 ? PIN(19) : PIN(20)) + pn * 128 + (c & 127); ldw = DFF; } else { valid = cc < CD_IN; w = PIN(22) + (valid ? cc : 0); ldw = CD_IN; }
    const int k0 = F.wave * 128 + kr; f32x4 acc[9];
#pragma unroll
    for (int j = 0; j < 9; ++j) acc[j] = (f32x4){0.f, 0.f, 0.f, 0.f};
#pragma unroll 8
    for (int i = 0; i < 32; ++i) { const int k = k0 + 4 * i; const f32x4 wv = *(const f32x4*)(w + (size_t)k * ldw);
#pragma unroll
        for (int j = 0; j < 9; ++j) acc[j] += wv * sc[j * DM + k]; }
#pragma unroll
    for (int j = 0; j < 9; ++j) {
#pragma unroll
        for (int c = 0; c < 4; ++c) { float v = acc[j][c]; v += __shfl_xor(v, 16); v += __shfl_xor(v, 32); acc[j][c] = valid ? v : 0.f; }
        if (kr == 0) *(LAS f32x4*)(part + (F.wave * 9 + j) * 64 + 4 * cg) = acc[j]; }
    __syncthreads();
    for (int i = F.tid; i < 9 * 64; i += NTHREADS) { const int j = i >> 6, ln = i & 63; float s = 0.f;
#pragma unroll
        for (int wv = 0; wv < 8; ++wv) s += part[(wv * 9 + j) * 64 + ln];
        if (f1) ((float*)(ws + WS_CBF1))[(size_t)j * 5632 + F.bid * 64 + ln] = s; else ((float*)(ws + WS_CBIN1))[(size_t)j * 2048 + (F.bid - 88) * 64 + ln] = s; }
    __syncthreads();
}
template <int SRC>
__device__ __forceinline__ void norm_phase(const Frame& F, const Params& P, const float* g, const float* MODL, int ish, int isc) {
    char* ws = F.ws; bf16_t* H = (bf16_t*)(ws + WS_H); const int gw = F.bid * NWAVES + F.wave, lane = F.lane; const int rb = gw * 9;
    f32x4 gg[4], gs[4], sh[4]; int cur = -1;
#pragma unroll
    for (int j = 0; j < 4; ++j) gg[j] = *(const f32x4*)(g + 4 * lane + 256 * j);
#pragma unroll 1
    for (int r0 = rb; r0 < rb + 9; r0 += 3) {
        f32x4 v[3][4];
#pragma unroll
        for (int q = 0; q < 3; ++q) { const int r = r0 + q, b = r / RPB, s = r - b * RPB;
            const float* xr = s < CTX ? PIN(2) + ((size_t)b * CTX + s) * DM : PIN(0) + ((size_t)b * SEQ + (s - CTX)) * DM;
#pragma unroll
            for (int j = 0; j < 4; ++j) v[q][j] = *(const f32x4*)(xr + 4 * lane + 256 * j); }
#pragma unroll
        for (int q = 0; q < 3; ++q) { const int r = r0 + q, b = r / RPB, s = r - b * RPB; const int mrow = s < CTX ? 8 : b;
            if (mrow != cur) { cur = mrow; const float* md = MODL + (size_t)mrow * MODLD;
#pragma unroll
                for (int j = 0; j < 4; ++j) { const int k = 4 * lane + 256 * j; gs[j] = gg[j] * (*(const f32x4*)(md + isc * DM + k) + 1.f); sh[j] = *(const f32x4*)(md + ish * DM + k); } }
            float ss = 0.f;
#pragma unroll
            for (int j = 0; j < 4; ++j) ss += (v[q][j][0] * v[q][j][0] + v[q][j][1] * v[q][j][1]) + (v[q][j][2] * v[q][j][2] + v[q][j][3] * v[q][j][3]);
            const float rstd = rsqrtf(wave_sum(ss) / DM + EPS);
#pragma unroll
            for (int j = 0; j < 4; ++j) { const int k = 4 * lane + 256 * j; const f32x4 hv = v[q][j] * rstd * gs[j] + sh[j];
                u32x2 w; w.x = pk2(hv[0], hv[1]); w.y = pk2(hv[2], hv[3]); *(u32x2*)(H + (size_t)r * DM + k) = w; } }
    }
}
__device__ __forceinline__ void rope_tables(const Frame& F) {
    float* R0 = (float*)(F.ws + WS_ROPE0); float* R1 = (float*)(F.ws + WS_ROPE1); const int gt = F.bid * NTHREADS + F.tid, NGT = F.G * NTHREADS;
    for (int i = gt; i < SEQ * 48; i += NGT) { const int t = i / 48, k = i % 48; const float row = (float)(t >> 6), col = (float)(t & 63);
        const bool l0 = k < 32; const int kk = l0 ? k : k - 32; const int half = l0 ? 16 : 8;
        const float invf = exp2f(-(float)(kk & (half - 1)) * (13.287712379549449f / (float)half)); const float ang = (kk < half ? row : col) * invf; const float cv = cosf(ang), sv = sinf(ang);
        if (l0) { R0[t * 64 + kk] = cv; R0[t * 64 + 32 + kk] = sv; } else { R1[t * 32 + kk] = cv; R1[t * 32 + 16 + kk] = sv; } }
}
__device__ __forceinline__ void gqa_prep(const Frame& F, const Params& P) {
    char* ws = F.ws; const bf16_t* Z = (const bf16_t*)(ws + WS_Z); bf16_t* Q = (bf16_t*)(ws + WS_QB); bf16_t* K = (bf16_t*)(ws + WS_KB); bf16_t* V = (bf16_t*)(ws + WS_VB); const float* R0 = (const float*)(ws + WS_ROPE0);
    const int gw = F.bid * NWAVES + F.wave, NGW = F.G * NWAVES, lane = F.lane; const int d0 = 8 * (lane & 7), i0 = d0 & 31;
    float qn[8], kn[8];
#pragma unroll
    for (int e = 0; e < 8; ++e) { qn[e] = PIN(17)[d0 + e] * QSCALE0; kn[e] = PIN(18)[d0 + e]; }
    constexpr int R1 = 6912; const int nb2 = F.G - 64; const int gw2 = (F.bid - 64) * NWAVES + F.wave, NGW2 = nb2 * NWAVES;
    for (int pass = 0; pass < 2; ++pass) { const int base = pass == 0 ? 0 : R1, lim = pass == 0 ? R1 : MROWS, g0 = pass == 0 ? gw : gw2, ng = pass == 0 ? NGW : NGW2; if (pass == 1 && F.bid < 64) break;
    for (int r0 = base + g0; r0 < lim; r0 += 2 * ng) {
        v4u qv[2], kv[2]; f32x4 cs[2][2], sn[2][2];
#pragma unroll
        for (int q = 0; q < 2; ++q) { const int r = r0 + q * ng; if (r < lim) { const bf16_t* z = Z + (size_t)r * AB_IN + 1024; const int s = r % RPB;
            qv[q] = *(const v4u*)(z + 8 * lane); kv[q] = lane < 32 ? *(const v4u*)(z + 512 + 8 * lane) : (v4u){0u, 0u, 0u, 0u};
            if (s >= CTX) { const float* rp = R0 + (size_t)(s - CTX) * 64 + i0; cs[q][0] = *(const f32x4*)rp; cs[q][1] = *(const f32x4*)(rp + 4); sn[q][0] = *(const f32x4*)(rp + 32); sn[q][1] = *(const f32x4*)(rp + 36); } } }
#pragma unroll
        for (int q = 0; q < 2; ++q) { const int r = r0 + q * ng; if (r < lim) { const bool lat = (r % RPB) >= CTX;
#pragma unroll
            for (int ps = 0; ps < 2; ++ps) { const v4u raw = ps == 0 ? qv[q] : kv[q]; float x[8];
#pragma unroll
                for (int e = 0; e < 4; ++e) { x[2 * e] = __uint_as_float(raw[e] << 16); x[2 * e + 1] = __uint_as_float(raw[e] & 0xffff0000u); }
                float ss = 0.f;
#pragma unroll
                for (int e = 0; e < 8; ++e) ss += x[e] * x[e];
                ss += __shfl_xor(ss, 1); ss += __shfl_xor(ss, 2); ss += __shfl_xor(ss, 4);
                const float rs = rsqrtf(ss * (1.f / 64.f) + EPS); float y[8];
#pragma unroll
                for (int e = 0; e < 8; ++e) y[e] = x[e] * rs * (ps == 0 ? qn[e] : kn[e]);
                if (lat) {
#pragma unroll
                    for (int e = 0; e < 8; ++e) { const float other = __shfl_xor(y[e], 4); const float c = cs[q][e >> 2][e & 3], s_ = sn[q][e >> 2][e & 3]; y[e] = (lane & 4) ? (other * s_ + y[e] * c) : (y[e] * c - other * s_); } }
                v4u o; o.x = pk2(y[0], y[1]); o.y = pk2(y[2], y[3]); o.z = pk2(y[4], y[5]); o.w = pk2(y[6], y[7]);
                if (ps == 0) *(v4u*)(Q + (size_t)r * 512 + 8 * lane) = o;
                else if (lane < 16) *(v4u*)(K + (size_t)r * 128 + 8 * lane) = o;
                else if (lane < 32) *(v4u*)(V + (size_t)r * 128 + 8 * (lane - 16)) = raw; } } }
    } }
}
__device__ __forceinline__ void mla_prep1(const Frame& F, const Params& P) {
    char* ws = F.ws; const bf16_t* Z = (const bf16_t*)(ws + WS_Z); bf16_t* QA = (bf16_t*)(ws + WS_QA); bf16_t* KVA = (bf16_t*)(ws + WS_KVA); bf16_t* KR = (bf16_t*)(ws + WS_KR);
    const int gw = F.bid * NWAVES + F.wave, NGW = F.G * NWAVES, lane = F.lane; const float* gq = PIN(33); const float* gkv = PIN(35);
    const f32x4 g4 = *(const f32x4*)(gq + 4 * lane); const float gk0 = gkv[2 * lane], gk1 = gkv[2 * lane + 1];
    for (int r0 = gw; r0 < MROWS; r0 += 3 * NGW) {
        u32x2 qw[3]; unsigned kw[3], krw[3];
#pragma unroll
        for (int q = 0; q < 3; ++q) { const int r = r0 + q * NGW; if (r < MROWS) { const bf16_t* z = Z + (size_t)r * CD_LD; qw[q] = *(const u32x2*)(z + 1536 + 4 * lane); kw[q] = *(const unsigned*)(z + 1792 + 2 * lane); krw[q] = lane < 16 ? *(const unsigned*)(z + 1920 + 2 * lane) : 0u; } }
#pragma unroll
        for (int q = 0; q < 3; ++q) { const int r = r0 + q * NGW; if (r < MROWS) {
            const float q0 = __uint_as_float(qw[q].x << 16), q1 = __uint_as_float(qw[q].x & 0xffff0000u), q2 = __uint_as_float(qw[q].y << 16), q3 = __uint_as_float(qw[q].y & 0xffff0000u);
            const float k0 = __uint_as_float(kw[q] << 16), k1 = __uint_as_float(kw[q] & 0xffff0000u);
            const float rq = rsqrtf(wave_sum((q0 * q0 + q1 * q1) + (q2 * q2 + q3 * q3)) * (1.f / 256.f) + EPS), rk = rsqrtf(wave_sum(k0 * k0 + k1 * k1) * (1.f / 128.f) + EPS);
            u32x2 o; o.x = pk2(q0 * rq * g4[0], q1 * rq * g4[1]); o.y = pk2(q2 * rq * g4[2], q3 * rq * g4[3]); *(u32x2*)(QA + (size_t)r * 256 + 4 * lane) = o;
            *(unsigned*)(KVA + (size_t)r * 256 + 2 * lane) = pk2(k0 * rk * gk0, k1 * rk * gk1); *(unsigned*)(KVA + (size_t)r * 256 + 128 + 2 * lane) = 0u;
            if (lane < 16) *(unsigned*)(KR + (size_t)r * 32 + 2 * lane) = krw[q]; } }
    }
}
__device__ __forceinline__ void mla_prep2(const Frame& F, const Params& P) {
    char* ws = F.ws; char* dob = (char*)P.out; const bf16_t* QR = (const bf16_t*)(ws + WS_QR); const bf16_t* KVR = (const bf16_t*)(ws + WS_KVR); const bf16_t* KR = (const bf16_t*)(ws + WS_KR);
    bf16_t* QM = (bf16_t*)(ws + WS_QM); bf16_t* KM = (bf16_t*)(dob + DO_KM); bf16_t* VM = (bf16_t*)(dob + DO_VM); const float* R1 = (const float*)(ws + WS_ROPE1);
    const int gw = F.bid * NWAVES + F.wave, NGW = F.G * NWAVES, lane = F.lane; const int h = lane >> 3, sub = lane & 7; const bool rl = sub < 4; const int rs8 = 8 * (sub & 3), ti = rs8 & 15;
    float qn0[8], qn1[8], kn0[8], kn1[8];
#pragma unroll
    for (int e = 0; e < 8; ++e) { qn0[e] = PIN(37)[8 * sub + e] * QSCALE1; qn1[e] = PIN(37)[64 + rs8 + e] * QSCALE1; kn0[e] = PIN(38)[8 * sub + e]; kn1[e] = PIN(38)[64 + rs8 + e]; }
#define MP2_UNPK(raw, x) _Pragma("unroll") for (int e_ = 0; e_ < 4; ++e_) { x[2 * e_] = __uint_as_float(raw[e_] << 16); x[2 * e_ + 1] = __uint_as_float(raw[e_] & 0xffff0000u); }
#define MP2_PK(y) (v4u){pk2(y[0], y[1]), pk2(y[2], y[3]), pk2(y[4], y[5]), pk2(y[6], y[7])}
    for (int r = gw; r < MROWS; r += NGW) { const int s = r % RPB; const bool lat = s >= CTX;
        const v4u kraw = *(const v4u*)(KVR + (size_t)r * 1024 + h * 128 + 8 * sub), vraw = *(const v4u*)(KVR + (size_t)r * 1024 + h * 128 + 64 + 8 * sub);
        const v4u rraw = *(const v4u*)(KR + (size_t)r * 32 + rs8);
        v4u qraw = {0u, 0u, 0u, 0u}, qrr = {0u, 0u, 0u, 0u}; f32x4 cs[2], sn[2];
        if (lat) { qraw = *(const v4u*)(QR + (size_t)r * 768 + h * 96 + 8 * sub); qrr = *(const v4u*)(QR + (size_t)r * 768 + h * 96 + 64 + rs8);
            const float* rp = R1 + (size_t)(s - CTX) * 32 + ti; cs[0] = *(const f32x4*)rp; cs[1] = *(const f32x4*)(rp + 4); sn[0] = *(const f32x4*)(rp + 16); sn[1] = *(const f32x4*)(rp + 20); }
        *(v4u*)(VM + (size_t)r * 512 + h * 64 + 8 * sub) = vraw;
#pragma unroll
        for (int which = 0; which < 2; ++which) {
            if (which == 1 && !lat) break;
            float a[8], bq[8]; { const v4u ra = which == 0 ? kraw : qraw, rb = which == 0 ? rraw : qrr; MP2_UNPK(ra, a) MP2_UNPK(rb, bq) }
            float ss = 0.f;
#pragma unroll
            for (int e = 0; e < 8; ++e) ss += a[e] * a[e] + (rl ? bq[e] * bq[e] : 0.f);
            ss += __shfl_xor(ss, 1); ss += __shfl_xor(ss, 2); ss += __shfl_xor(ss, 4);
            const float rsd = rsqrtf(ss * (1.f / 96.f) + EPS);
#pragma unroll
            for (int e = 0; e < 8; ++e) { a[e] = a[e] * rsd * (which == 0 ? kn0[e] : qn0[e]); bq[e] = bq[e] * rsd * (which == 0 ? kn1[e] : qn1[e]); }
            if (lat) {
#pragma unroll
                for (int e = 0; e < 8; ++e) { const float other = __shfl_xor(bq[e], 2); const float c = cs[e >> 2][e & 3], sv = sn[e >> 2][e & 3]; bq[e] = (sub & 2) ? (other * sv + bq[e] * c) : (bq[e] * c - other * sv); } }
            bf16_t* o = (which == 0 ? KM : QM) + (size_t)r * 768 + h * 96;
            *(v4u*)(o + 8 * sub) = MP2_PK(a); if (rl) *(v4u*)(o + 64 + rs8) = MP2_PK(bq); }
    }
#undef MP2_UNPK
#undef MP2_PK
}
}
__global__ void __launch_bounds__(NTHREADS, 2) mk_kernel(Params prm) {
    extern __shared__ __attribute__((aligned(16))) unsigned char lds_raw[];
    Frame F; F.lds = (LAS unsigned char*)lds_raw; F.tid = threadIdx.x; F.lane = F.tid & 63; F.wave = __builtin_amdgcn_readfirstlane(F.tid >> 6);
    F.G = gridDim.x; F.bid = blockIdx.x; F.even = 0; F.ws = prm.ws;
    const Params& P = prm;
    const float* MOD0 = (const float*)(prm.ws + WS_MOD);
    const int lo = prm.ph_lo, hi = prm.ph_hi;
    volatile LAS unsigned* MISCW = (volatile LAS unsigned*)(F.lds + MISC_OFF + 8192);
    if (F.tid < 64) MISCW[F.tid] = 0u;
    __syncthreads();
    if (prm.ph_lo == 123456) cooperative_groups::this_grid().sync();
    XcdBarrier bar = xcd_barrier_post((unsigned*)(prm.ws + WS_CTL + CT_BAR), MISCW + 8);
#define RUN(k, body) if (lo <= (k) && (k) < hi) { body; if ((k) + 1 < hi) xcd_barrier(bar); }
#define RUN_GEMMS(PH0, NPH, G0) { _Pragma("unroll 1") for (int i_ = 0; i_ < (NPH); ++i_) { const int k_ = (PH0) + i_; if (lo <= k_ && k_ < hi) { run_gemm(F, prm, (G0) + i_); if (k_ + 1 < hi) xcd_barrier(bar); } } }
    RUN(PH_P0, { el::rope_tables(F); el::mod_phase(F, prm); phase_conv(F, prm, false); hy::filt(F, prm); })
    if (MISCW[8 + 3] != 0u) { F.bid = __builtin_amdgcn_readfirstlane((int)(MISCW[8 + 2] * 8u + bar.x)); F.even = 1; }
    RUN(PH_NORM0, { el::norm_phase<0>(F, prm, PIN(6), MOD0, 0, 1); el::bias_phase(F, prm); })
    RUN(PH_G_IN0, run_gemm(F, prm, G_IN0))
    RUN(PH_LRUPREP, { lru::phase<0>(F, prm); el::gqa_prep(F, prm); })
    RUN(PH_MIX0, { phase_attn0(F); lru::phase<1>(F, prm); })
    RUN(PH_G_OUT0, { run_gemm(F, prm, G_OUT0); run_gemm(F, prm, G_F1); moe_conv_all(F, prm, 0, MOE_ITEMS / 2); run_gemm(F, prm, G_F2); moe_conv_all(F, prm, MOE_ITEMS / 2, MOE_ITEMS); run_gemm(F, prm, G_IN1); })
    RUN(PH_PREP1, { hy::prep(F, prm); el::mla_prep1(F, prm); })
    RUN(PH_G_QKVB, { run_gemm(F, prm, G_QB); run_gemm(F, prm, G_KVB); })
    RUN(PH_PREP2, { el::mla_prep2(F, prm); hy::main_phase(F, prm); })
    RUN(PH_MIX1, { phase_attn1(F, prm); hy::untranspose(F); })
    RUN(PH_G_OUT1, run_gemm(F, prm, G_OUT1))
    RUN(PH_ROUTE, phase_route(F, prm))
    RUN(PH_SLOT, phase_slot(F, prm))
    RUN(PH_MOE1, { run_gemm(F, prm, G_MOE1); run_gemm(F, prm, G_MOE2); })
    RUN(PH_COMBINE, phase_combine(F, prm))
#undef RUN
#undef RUN_GEMMS
}
#ifndef SPLIT_LAUNCH
#define SPLIT_LAUNCH 0
#endif
extern "C" void kernel_launch(void* const* d_in, const int* in_sizes, int n_in, void* d_out, int out_size, void* d_ws, size_t ws_size, hipStream_t st) {
    static int grid = 0;
    if (grid == 0) {
        if (n_in != 43 || out_size != NLAT * DM || ws_size < WS_END) { fprintf(stderr, "kernel_launch: unexpected problem (n_in %d, out %d, ws %zu < %zu)\n", n_in, out_size, ws_size, (size_t)WS_END); grid = -1; return; }
        int dev = 0, cus = 0, per_cu = 0;
        (void)hipGetDevice(&dev); (void)hipDeviceGetAttribute(&cus, hipDeviceAttributeMultiprocessorCount, dev);
        (void)hipFuncSetAttribute((const void*)mk_kernel, hipFuncAttributeMaxDynamicSharedMemorySize, LDS_BYTES);
        (void)hipOccupancyMaxActiveBlocksPerMultiprocessor(&per_cu, (const void*)mk_kernel, NTHREADS, LDS_BYTES);
        grid = cus;
        if (grid != 256 || per_cu < 1) { fprintf(stderr, "kernel_launch: grid %d (CUs %d, occupancy query %d): this kernel is written for 256 resident workgroups; nothing launched\n", grid, cus, per_cu); grid = -1; return; }
    }
    if (grid < 0) return;
    (void)hipMemsetAsync((char*)d_ws + WS_CTL, 0, CTL_BYTES, st);
    Params prm{}; prm.i0 = (const float*)d_in[0]; prm.i1 = (const float*)d_in[1]; prm.i2 = (const float*)d_in[2]; prm.i3 = (const float*)d_in[3]; prm.i4 = (const float*)d_in[4]; prm.i5 = (const float*)d_in[5]; prm.i6 = (const float*)d_in[6]; prm.i7 = (const float*)d_in[7]; prm.i8 = (const float*)d_in[8]; prm.i9 = (const float*)d_in[9]; prm.i10 = (const float*)d_in[10]; prm.i11 = (const float*)d_in[11]; prm.i12 = (const float*)d_in[12]; prm.i13 = (const float*)d_in[13]; prm.i14 = (const float*)d_in[14]; prm.i15 = (const float*)d_in[15]; prm.i16 = (const float*)d_in[16]; prm.i17 = (const float*)d_in[17]; prm.i18 = (const float*)d_in[18]; prm.i19 = (const float*)d_in[19]; prm.i20 = (const float*)d_in[20]; prm.i21 = (const float*)d_in[21]; prm.i22 = (const float*)d_in[22]; prm.i23 = (const float*)d_in[23]; prm.i24 = (const float*)d_in[24]; prm.i25 = (const float*)d_in[25]; prm.i26 = (const float*)d_in[26]; prm.i27 = (const float*)d_in[27]; prm.i28 = (const float*)d_in[28]; prm.i29 = (const float*)d_in[29]; prm.i30 = (const float*)d_in[30]; prm.i31 = (const float*)d_in[31]; prm.i32 = (const float*)d_in[32]; prm.i33 = (const float*)d_in[33]; prm.i34 = (const float*)d_in[34]; prm.i35 = (const float*)d_in[35]; prm.i36 = (const float*)d_in[36]; prm.i37 = (const float*)d_in[37]; prm.i38 = (const float*)d_in[38]; prm.i39 = (const float*)d_in[39]; prm.i40 = (const float*)d_in[40]; prm.i41 = (const float*)d_in[41]; prm.i42 = (const float*)d_in[42]; prm.out = (float*)d_out; prm.ws = (char*)d_ws;
#if SPLIT_LAUNCH
    for (int ph = 0; ph < PH_COUNT; ++ph) { prm.ph_lo = ph; prm.ph_hi = ph + 1; hipLaunchKernelGGL(mk_kernel, dim3(grid), dim3(NTHREADS), LDS_BYTES, st, prm); }
#else
    prm.ph_lo = 0; prm.ph_hi = PH_COUNT;
    void* args[] = {&prm};
    hipError_t e = hipLaunchCooperativeKernel((const void*)mk_kernel, dim3(grid), dim3(NTHREADS), args, LDS_BYTES, st);
    if (e != hipSuccess) fprintf(stderr, "kernel_launch: cooperative launch failed: %s (grid %d)\n", hipGetErrorString(e), grid);
#endif
}
```

```cpp
#include <hip/hip_runtime.h>
#include <hip/hip_cooperative_groups.h>
#include <cstdio>
#include <cstdint>
#include <cmath>

constexpr int NB = 8, SEQ = 2048, CTX = 256, RPB = SEQ + CTX, MROWS = NB * RPB, DM = 1024, NLAT = NB * SEQ;
constexpr int NMOD = 6, MODLD = NMOD * DM;
constexpr int AB_IN = 1792, CD_IN = 1952, CD_LD = 2048, DFF = 2816, NEXP = 8, DFE = 3584;
constexpr float EPS = 1e-6f;
constexpr float LOG2E = 1.4426950408889634f;
constexpr float QSCALE0 = 0.125f * LOG2E;
constexpr float QSCALE1 = 0.10206207261596577f * LOG2E;

typedef unsigned short bf16_t;
typedef float f32x4 __attribute__((ext_vector_type(4)));
typedef unsigned u32x4 __attribute__((ext_vector_type(4)));
typedef unsigned u32x2 __attribute__((ext_vector_type(2)));

__device__ __forceinline__ int mod_row(int r) { int b = r / RPB, s = r % RPB; return s < CTX ? 8 : b; }
__device__ __forceinline__ int latent_row(int m) { return (m / SEQ) * RPB + CTX + (m % SEQ); }

__device__ __forceinline__ float bf2f(bf16_t v) { return __uint_as_float((unsigned)v << 16); }
typedef float hd_f32x2 __attribute__((ext_vector_type(2))); typedef __bf16 hd_bf16x2 __attribute__((ext_vector_type(2)));
__device__ __forceinline__ unsigned pk2(float lo, float hi) { hd_f32x2 v = {lo, hi}; hd_bf16x2 b = __builtin_convertvector(v, hd_bf16x2); return __builtin_bit_cast(unsigned, b); }
__device__ __forceinline__ bf16_t f2bf(float f) { return (bf16_t)(pk2(f, 0.f) & 0xffffu); }
__device__ __forceinline__ float ldf(const float* p) { return *p; }
__device__ __forceinline__ float ldf(const bf16_t* p) { return bf2f(*p); }
__device__ __forceinline__ void stf(float* p, float v) { *p = v; }
__device__ __forceinline__ void stf(bf16_t* p, float v) { *p = f2bf(v); }

__device__ __forceinline__ float silu_f(float x) { return x / (1.f + expf(-x)); }
__device__ __forceinline__ float sigmoid_f(float x) { return 1.f / (1.f + expf(-x)); }
__device__ __forceinline__ float gelu_tanh(float x) { return 0.5f * x * (1.f + tanhf(0.7978845608028654f * (x + 0.044715f * x * x * x))); }
__device__ __forceinline__ float softplus_f(float x) { return fmaxf(x, 0.f) + log1pf(expf(-fabsf(x))); }

__device__ __forceinline__ float wave_sum(float v) {
#pragma unroll
    for (int o = 1; o < 64; o <<= 1) v += __shfl_xor(v, o);
    return v;
}
__device__ __forceinline__ float wave_max(float v) {
#pragma unroll
    for (int o = 1; o < 64; o <<= 1) v = fmaxf(v, __shfl_xor(v, o));
    return v;
}

constexpr size_t MiB = 1ull << 20;
constexpr size_t WS_CTL = 0, CTL_BYTES = 256 * 1024;
constexpr size_t WS_MOD = 1 * MiB;
constexpr size_t WS_SC = WS_MOD + 512 * 1024;
constexpr size_t WS_W13M = 4 * MiB;
constexpr size_t WS_W2M = 116 * MiB;
constexpr size_t WS_WIN0 = 172 * MiB;
constexpr size_t WS_WOUT0 = WS_WIN0 + (size_t)1792 * 1024 * 2;
constexpr size_t WS_WF13 = WS_WOUT0 + (size_t)1024 * 1024 * 2;
constexpr size_t WS_WF2 = WS_WF13 + (size_t)5632 * 1024 * 2;
constexpr size_t WS_WIN1 = WS_WF2 + (size_t)1024 * 2816 * 2;
constexpr size_t WS_WOUT1 = WS_WIN1 + (size_t)2048 * 1024 * 2;
constexpr size_t WS_WQB = WS_WOUT1 + (size_t)1024 * 1024 * 2;
constexpr size_t WS_WKVB = WS_WQB + (size_t)768 * 256 * 2;
constexpr size_t WS_WLRU = WS_WKVB + (size_t)1024 * 256 * 2;
constexpr size_t WS_WEND = WS_WLRU + (size_t)2 * 8 * 2 * 64 * 64 * 2;
static_assert(WS_WEND <= 202 * MiB, "weights region");
constexpr size_t WS_X = 202 * MiB;
constexpr size_t WS_H = 274 * MiB;
constexpr size_t WS_Z = 310 * MiB;
constexpr size_t WS_Y = 382 * MiB;
constexpr size_t WS_ACT = WS_Z;
constexpr size_t WS_R2 = 418 * MiB;
constexpr size_t WS_END = 502 * MiB;
static_assert(WS_ACT + (size_t)MROWS * DFF * 2 <= WS_R2, "ACT overlay");
constexpr size_t WS_QB = WS_R2;
constexpr size_t WS_KB = WS_QB + (size_t)MROWS * 512 * 2;
constexpr size_t WS_VB = WS_KB + (size_t)MROWS * 128 * 2;
constexpr size_t WS_AGG = WS_VB + (size_t)MROWS * 128 * 2;
constexpr size_t WS_R2L0END = WS_AGG + (size_t)2 * 8 * 72 * 2 * 512 * 4;
constexpr size_t WS_ZT = WS_R2;
constexpr size_t WS_HT = WS_ZT + (size_t)1536 * NLAT * 2;
constexpr size_t WS_GT = WS_HT + (size_t)512 * NLAT * 2;
constexpr int GT_LD = 4224;
constexpr size_t WS_R2L1END = WS_GT + (size_t)2 * 512 * GT_LD * 2;
static_assert(WS_R2L0END <= WS_END && WS_R2L1END <= WS_END, "R2");
constexpr size_t WS_QA = WS_Y;
constexpr size_t WS_KVA = WS_QA + (size_t)MROWS * 256 * 2;
constexpr size_t WS_KR = WS_KVA + (size_t)MROWS * 256 * 2;
constexpr size_t WS_QR = WS_Z;
constexpr size_t WS_KVR = WS_QR + (size_t)MROWS * 768 * 2;
static_assert(WS_KVR + (size_t)MROWS * 1024 * 2 <= WS_Y && WS_KR + (size_t)MROWS * 32 * 2 <= WS_R2, "layer-1 overlays");
constexpr size_t WS_QM = WS_H;
static_assert((size_t)MROWS * 768 * 2 <= 36 * MiB, "QM in H");
constexpr size_t DO_KM = 0;
constexpr size_t DO_VM = (size_t)MROWS * 768 * 2;
static_assert(DO_VM + (size_t)MROWS * 512 * 2 <= (size_t)NLAT * DM * 4, "d_out scratch");
constexpr int MAXSLOT = 34816;
constexpr size_t WS_XG = WS_WIN0;
constexpr size_t WS_ACT2 = WS_XG + (size_t)MAXSLOT * 1024 * 2;
constexpr size_t WS_H2 = WS_ACT2 + (size_t)MAXSLOT * 3584 * 2 - (size_t)NLAT * 1024 * 2;
static_assert(WS_ACT2 + (size_t)MAXSLOT * 3584 * 2 <= WS_END, "MoE overlay");
constexpr size_t CT_BAR = 0;
constexpr size_t CT_PCNT = 16 * 1024;
constexpr size_t CT_MCNT = 48 * 1024;
constexpr size_t CT_HIST = 32 * 1024;
constexpr size_t CT_CNT = 48 * 1024;
constexpr size_t CT_CURSOR = 80 * 1024;
constexpr size_t CT_DONE = 80 * 1024 + 256;
constexpr size_t CT_SSQA = 96 * 1024;
constexpr size_t CT_SSQB = CT_SSQA + (size_t)MROWS * 4;
static_assert(CT_SSQB + (size_t)MROWS * 4 <= CTL_BYTES, "ssq in the zeroed control region");
constexpr size_t WS_SLOTTOK = 2 * MiB;
constexpr size_t WS_SLOTGATE = WS_SLOTTOK + (size_t)MAXSLOT * 4;
constexpr size_t WS_SEL = WS_SLOTGATE + (size_t)MAXSLOT * 4;
constexpr size_t WS_TOKSLOT = WS_SEL + (size_t)NLAT * 16;
static_assert(WS_TOKSLOT + (size_t)NLAT * 8 <= WS_W13M, "small tables");
constexpr size_t WS_ROPE0 = 3 * MiB;
constexpr size_t WS_ROPE1 = 3 * MiB + 512 * 1024;
static_assert(WS_TOKSLOT + (size_t)NLAT * 8 <= WS_ROPE0 && WS_ROPE1 + 256 * 1024 <= WS_W13M, "rope tables");
constexpr size_t WS_CBF1 = WS_SC + 64 * 1024;
constexpr size_t WS_CBIN1 = WS_CBF1 + 9 * 5632 * 4;
static_assert(WS_CBIN1 + 9 * 2048 * 4 <= WS_SLOTTOK, "bias vectors");
constexpr size_t WS_Y2 = WS_XG;
namespace pg8 {
#define PG8_LAS __attribute__((address_space(3)))
typedef unsigned short bf16_t;
typedef short bf16x8 __attribute__((ext_vector_type(8)));
typedef float f32x4 __attribute__((ext_vector_type(4)));
typedef unsigned u32x4 __attribute__((ext_vector_type(4)));
constexpr int BM = 256, BK = 64, HALF = 128, HTB = HALF * BK * 2  , STAGE_BYTES = 8 * HTB, NXCD = 8, WGM = 8;

__host__ __device__ __forceinline__ int lds_byte(int r, int c) { const int st = (r >> 4) * 2 + (c >> 5), rr = r & 15, cc = c & 31, ob = rr * 64 + cc * 2; return st * 1024 + (ob ^ (((ob >> 9) & 1) << 5)); }
__host__ __device__ __forceinline__ void stage_rc(int b, int& R, int& C) { const int st = b / 1024, sb = b % 1024, swz = sb ^ (((sb >> 9) & 1) << 5); R = (st >> 1) * 16 + swz / 64; C = (st & 1) * 32 + (swz % 64) / 2; }
__host__ __device__ __forceinline__ int perm32(int rho) { const int n = rho >> 4, i = rho & 15; return 8 * (i >> 2) + 4 * n + (i & 3); }

struct Unit { int pm, pn; };
struct Gemm { const bf16_t* A; const bf16_t* Bt; int M, N, K; };

struct StaticOrder {
    int nM, nN, nwg, G, c;
    __host__ __device__ void init(int M, int N, int G_, int c_) { nM = M / BM; nN = N / BM; nwg = nM * nN; G = G_; c = c_; }
    __host__ __device__ bool next(int i, Unit& u) const {
        const long L = (long)i * G + c; if (L >= nwg) return false;
        int wgid = (int)L; { const int q = nwg / NXCD, r = nwg % NXCD, xcd = wgid % NXCD, off = wgid / NXCD; wgid = (xcd < r ? xcd * (q + 1) : r * (q + 1) + (xcd - r) * q) + off; }
        const int nig = WGM * nN, gid = wgid / nig, fm = gid * WGM, gsz = (nM - fm) < WGM ? (nM - fm) : WGM;
        u.pm = fm + ((wgid % nig) % gsz); u.pn = (wgid % nig) / gsz; return true;
    }
    __device__ __forceinline__ void a_ready(const Unit&) const {}
    __device__ __forceinline__ void done(const Unit&) const {}
};

__device__ __forceinline__ unsigned cvt_pk_bf16(float lo, float hi) { unsigned r; asm volatile("v_cvt_pk_bf16_f32 %0, %1, %2" : "=v"(r) : "v"(lo), "v"(hi)); return r; }
typedef float f32x2 __attribute__((ext_vector_type(2)));
__device__ __forceinline__ f32x2 gelu_pk(f32x2 v) {
    const f32x2 av = __builtin_elementwise_abs(v), d = av * 0.2316418882f + 1.0f;
    f32x2 t; t.x = __builtin_amdgcn_rcpf(d.x); t.y = __builtin_amdgcn_rcpf(d.y);
    f32x2 q = t * 0.5307027145f + (-0.7265760135f); q = q * t + 0.7107068705f; q = q * t + (-0.142248368f); q = q * t + 0.127414796f; q = q * t;
    const f32x2 s = (v * v) * (-0.72134752044f);
    f32x2 e; e.x = __builtin_amdgcn_exp2f(s.x); e.y = __builtin_amdgcn_exp2f(s.y);
    const f32x2 m = v * (q * e), r = v - m;
    f32x2 o; o.x = v.x < 0.f ? m.x : r.x; o.y = v.y < 0.f ? m.y : r.y; return o;
}

template <int ACT  > struct EpiBf16 {
    static constexpr bool PERM = true, AFTER_DRAIN = false; static_assert(ACT == 0 || ACT == 1, "EpiBf16: ACT is 0 (none) or 1 (gelu_pk)");
    bf16_t* O; int ldc; const float* bias; int split_cols; size_t split_stride; float scale0;
    __device__ __forceinline__ void operator()(const f32x4 (&acc)[2][2][4][2], const Unit& u, int wr, int wc, int fr, int fq) const {
        const int row0 = u.pm * BM + wr * 64 + fr; int colt = u.pn * BM; bf16_t* base = O;
        float sc = 1.f; if (split_cols) { const int t = colt / split_cols; base += (size_t)t * split_stride; colt -= t * split_cols; if (t == 0) sc = scale0; }
        const int col0 = colt + wc * 32 + 8 * fq, bcol0 = u.pn * BM + wc * 32 + 8 * fq;
        f32x4 bv[2][2];
#pragma unroll
        for (int bj = 0; bj < 2; ++bj)
#pragma unroll
            for (int n = 0; n < 2; ++n) bv[bj][n] = bias ? *(const f32x4*)(bias + bcol0 + bj * HALF + 4 * n) : (f32x4){0.f, 0.f, 0.f, 0.f};
#pragma unroll
        for (int ai = 0; ai < 2; ++ai)
#pragma unroll
            for (int m = 0; m < 4; ++m) { bf16_t* rowp = base + (size_t)(row0 + ai * HALF + m * 16) * ldc + col0;
#pragma unroll
                for (int bj = 0; bj < 2; ++bj) { f32x4 v0 = acc[ai][bj][m][0] + bv[bj][0], v1 = acc[ai][bj][m][1] + bv[bj][1];
                    if (ACT == 1) { f32x2 a = gelu_pk((f32x2){v0[0], v0[1]}), b = gelu_pk((f32x2){v0[2], v0[3]}), c = gelu_pk((f32x2){v1[0], v1[1]}), d = gelu_pk((f32x2){v1[2], v1[3]});
                        v0 = (f32x4){a.x, a.y, b.x, b.y}; v1 = (f32x4){c.x, c.y, d.x, d.y}; }
                    v0 = v0 * sc; v1 = v1 * sc; u32x4 w; w.x = cvt_pk_bf16(v0[0], v0[1]); w.y = cvt_pk_bf16(v0[2], v0[3]); w.z = cvt_pk_bf16(v1[0], v1[1]); w.w = cvt_pk_bf16(v1[2], v1[3]);
                    *(u32x4*)(rowp + bj * HALF) = w; } }
    }
};

template <class Epi, class Sched, bool ALIGN_EPI = false, bool SP2 = false>
__device__ __forceinline__ void gemm_phase(PG8_LAS unsigned char* lds, const Gemm g, const Sched& S, const Epi& E) {
    int tid_ = threadIdx.x; asm volatile("" : "+v"(tid_));
    const int tid = tid_, wid = __builtin_amdgcn_readfirstlane(tid >> 6), lane = tid & 63, wr = wid >> 2, wc = wid & 3, fr = lane & 15, fq = lane >> 4;
    const int K = g.K, nt = K / BK;
    unsigned voffA[2], voffB[2];
#pragma unroll
    for (int i = 0; i < 2; ++i) { int R, C; stage_rc(tid * 16 + i * 8192, R, C); const int Rb = Epi::PERM ? ((R & ~31) + perm32(R & 31)) : R;
        voffA[i] = (unsigned)(R * K + C) * 2u; voffB[i] = (unsigned)(Rb * K + C) * 2u; }
    const size_t kstep = (size_t)(BK * 2);
    const size_t hstep = (size_t)HALF * K * 2;
    const size_t tstep = 2 * hstep;
    const unsigned ldsw = (unsigned)wid * 1024u;
    const int aoff = lds_byte(wr * 64 + fr, fq * 8), boff = lds_byte(wc * 32 + fr, fq * 8);
#define PG8_SA(b, h) (((b) * 2 + (h)) * HTB)
#define PG8_SB(b, h) ((4 + (b) * 2 + (h)) * HTB)
#define PG8_STAGE(bufoff, gbase, voff) do { _Pragma("unroll") for (int _i = 0; _i < 2; ++_i) \
        __builtin_amdgcn_global_load_lds((const unsigned*)((const char*)(gbase) + (voff)[_i]), (PG8_LAS unsigned*)(lds + (bufoff) + ldsw + _i * 8192), 16, 0, 0); } while (0)
#define PG8_LDA(dst, b, h) do { _Pragma("unroll") for (int m = 0; m < 4; ++m) _Pragma("unroll") for (int k = 0; k < 2; ++k) dst[m][k] = *(const PG8_LAS bf16x8*)(lds + PG8_SA(b, h) + aoff + m * 2048 + k * 1024); } while (0)
#define PG8_LDB(dst, b, h) do { _Pragma("unroll") for (int n = 0; n < 2; ++n) _Pragma("unroll") for (int k = 0; k < 2; ++k) dst[n][k] = *(const PG8_LAS bf16x8*)(lds + PG8_SB(b, h) + boff + n * 2048 + k * 1024); } while (0)
#define PG8_MMA(ai, bj, At, Bt) do { __builtin_amdgcn_s_setprio(1); _Pragma("unroll") for (int m = 0; m < 4; ++m) _Pragma("unroll") for (int n = 0; n < 2; ++n) _Pragma("unroll") for (int k = 0; k < 2; ++k) \
        acc[ai][bj][m][n] = __builtin_amdgcn_mfma_f32_16x16x32_bf16(Bt[n][k], At[m][k], acc[ai][bj][m][n], 0, 0, 0); __builtin_amdgcn_s_setprio(0); } while (0)
#define PG8_WAIT_V(n) asm volatile("s_waitcnt vmcnt(" #n ")" ::: "memory")
#define PG8_WAIT_L(n) asm volatile("s_waitcnt lgkmcnt(" #n ")" ::: "memory")
#define PG8_BAR __builtin_amdgcn_s_barrier()
#define PG8_SCHED __builtin_amdgcn_sched_barrier(0)
    Unit cur, nxt; int ui = 0;
    if (!S.next(0, cur)) return;
    f32x4 acc[2][2][4][2];
#pragma unroll
    for (int a = 0; a < 2; ++a)
#pragma unroll
        for (int b = 0; b < 2; ++b)
#pragma unroll
            for (int m = 0; m < 4; ++m)
#pragma unroll
                for (int n = 0; n < 2; ++n) acc[a][b][m][n] = (f32x4){0.f, 0.f, 0.f, 0.f};
    bf16x8 At[4][2], B0[2][2], B1[2][2];
    const char* cA = (const char*)g.A + (size_t)cur.pm * tstep; const char* cB = (const char*)g.Bt + (size_t)cur.pn * tstep;
    S.a_ready(cur);
    if constexpr (SP2) {
        PG8_STAGE(PG8_SB(0, 0), cB, voffB); PG8_STAGE(PG8_SB(0, 1), cB + hstep, voffB); PG8_STAGE(PG8_SA(0, 0), cA, voffA); PG8_STAGE(PG8_SA(0, 1), cA + hstep, voffA);
        if (wr == 1) PG8_BAR;
        PG8_WAIT_V(2); PG8_BAR;
        PG8_STAGE(PG8_SB(1, 0), cB + kstep, voffB); PG8_STAGE(PG8_SA(1, 0), cA + kstep, voffA); PG8_STAGE(PG8_SB(1, 1), cB + hstep + kstep, voffB);
        PG8_WAIT_V(6); PG8_BAR;
    } else {
        PG8_STAGE(PG8_SB(0, 0), cB, voffB); PG8_STAGE(PG8_SA(0, 0), cA, voffA); PG8_STAGE(PG8_SB(0, 1), cB + hstep, voffB); PG8_STAGE(PG8_SA(0, 1), cA + hstep, voffA);
        if (wr == 1) PG8_BAR;
        PG8_WAIT_V(4); PG8_BAR;
        PG8_STAGE(PG8_SB(1, 0), cB + kstep, voffB); PG8_STAGE(PG8_SA(1, 0), cA + kstep, voffA); PG8_STAGE(PG8_SB(1, 1), cB + hstep + kstep, voffB);
        PG8_WAIT_V(6); PG8_BAR;
    }
    for (;;) {
        const bool has_next = S.next(ui + 1, nxt);
        const char* nA = has_next ? (const char*)g.A + (size_t)nxt.pm * tstep : cA; const char* nB = has_next ? (const char*)g.Bt + (size_t)nxt.pn * tstep : cB;
        for (int t = 0; t < nt; t += 2) {
            const bool last = (t == nt - 2);
            const char* a1 = cA + (size_t)(t + 1) * kstep;
            const char* a2 = last ? nA : cA + (size_t)(t + 2) * kstep; const char* b2 = last ? nB : cB + (size_t)(t + 2) * kstep;
            const char* a3 = a2 + kstep; const char* b3 = b2 + kstep;
            if (last && has_next) S.a_ready(nxt);
            if constexpr (SP2) {
            PG8_LDB(B0, 0, 0); PG8_LDB(B1, 0, 1); PG8_SCHED; PG8_LDA(At, 0, 0); PG8_STAGE(PG8_SA(1, 1), a1 + hstep, voffA);
            PG8_WAIT_V(8); PG8_WAIT_L(0); PG8_BAR; PG8_MMA(0, 0, At, B0); PG8_MMA(0, 1, At, B1); PG8_BAR; PG8_SCHED;
            PG8_LDA(At, 0, 1); PG8_STAGE(PG8_SB(0, 0), b2, voffB); PG8_STAGE(PG8_SB(0, 1), b2 + hstep, voffB); PG8_STAGE(PG8_SA(0, 0), a2, voffA);
            PG8_WAIT_V(8); PG8_WAIT_L(0); PG8_BAR; PG8_MMA(1, 0, At, B0); PG8_MMA(1, 1, At, B1); PG8_BAR; PG8_SCHED;
            PG8_LDB(B0, 1, 0); PG8_LDB(B1, 1, 1); PG8_SCHED; PG8_LDA(At, 1, 0); PG8_STAGE(PG8_SA(0, 1), a2 + hstep, voffA);
            PG8_WAIT_V(8); PG8_WAIT_L(0); PG8_BAR; PG8_MMA(0, 0, At, B0); PG8_MMA(0, 1, At, B1); PG8_BAR; PG8_SCHED;
            PG8_LDA(At, 1, 1); PG8_STAGE(PG8_SB(1, 0), b3, voffB); PG8_STAGE(PG8_SB(1, 1), b3 + hstep, voffB); PG8_STAGE(PG8_SA(1, 0), a3, voffA);
            PG8_WAIT_V(8); PG8_WAIT_L(0); PG8_BAR; PG8_MMA(1, 0, At, B0); PG8_MMA(1, 1, At, B1); PG8_BAR; PG8_SCHED;
            } else {
            PG8_LDB(B0, 0, 0); PG8_SCHED; PG8_LDA(At, 0, 0); PG8_STAGE(PG8_SA(1, 1), a1 + hstep, voffA);
            PG8_WAIT_L(8); PG8_BAR; PG8_WAIT_L(0); PG8_MMA(0, 0, At, B0); PG8_BAR; PG8_SCHED;
            PG8_LDB(B1, 0, 1); PG8_STAGE(PG8_SB(0, 0), b2, voffB);
            PG8_BAR; PG8_WAIT_L(0); PG8_MMA(0, 1, At, B1); PG8_BAR;
            PG8_LDA(At, 0, 1); PG8_STAGE(PG8_SA(0, 0), a2, voffA);
            PG8_BAR; PG8_WAIT_L(0); PG8_MMA(1, 0, At, B0); PG8_BAR; PG8_SCHED;
            PG8_STAGE(PG8_SB(0, 1), b2 + hstep, voffB);
            PG8_WAIT_V(6); PG8_BAR; PG8_MMA(1, 1, At, B1); PG8_BAR;
            PG8_LDB(B0, 1, 0); PG8_SCHED; PG8_LDA(At, 1, 0); PG8_STAGE(PG8_SA(0, 1), a2 + hstep, voffA);
            PG8_WAIT_L(8); PG8_BAR; PG8_WAIT_L(0); PG8_MMA(0, 0, At, B0); PG8_BAR; PG8_SCHED;
            PG8_LDB(B1, 1, 1); PG8_STAGE(PG8_SB(1, 0), b3, voffB);
            PG8_BAR; PG8_WAIT_L(0); PG8_MMA(0, 1, At, B1); PG8_BAR;
            PG8_LDA(At, 1, 1); PG8_STAGE(PG8_SA(1, 0), a3, voffA);
            PG8_BAR; PG8_WAIT_L(0); PG8_MMA(1, 0, At, B0); PG8_BAR; PG8_SCHED;
            PG8_STAGE(PG8_SB(1, 1), b3 + hstep, voffB);
            PG8_WAIT_V(6); PG8_BAR; PG8_MMA(1, 1, At, B1); PG8_BAR;
            }
        }
        if constexpr (ALIGN_EPI) { if (wr == 0) PG8_BAR; }
        if constexpr (!Epi::AFTER_DRAIN) { E(acc, cur, wr, wc, fr, fq); S.done(cur); }
        if (!has_next) break;
#pragma unroll
        for (int a = 0; a < 2; ++a)
#pragma unroll
            for (int b = 0; b < 2; ++b)
#pragma unroll
                for (int m = 0; m < 4; ++m)
#pragma unroll
                    for (int n = 0; n < 2; ++n) acc[a][b][m][n] = (f32x4){0.f, 0.f, 0.f, 0.f};
        cur = nxt; cA = nA; cB = nB; ++ui;
        if constexpr (ALIGN_EPI) { if (wr == 1) PG8_BAR; }
    }
    PG8_WAIT_V(0);
    if constexpr (!ALIGN_EPI) { if (wr == 0) PG8_BAR; }
    PG8_BAR;
    if constexpr (Epi::AFTER_DRAIN) { E.fused(acc, cur, wr, wc, fr, fq, lds, wid, lane); S.done(cur); }
#undef PG8_SA
#undef PG8_SB
#undef PG8_STAGE
#undef PG8_LDA
#undef PG8_LDB
#undef PG8_MMA
#undef PG8_WAIT_V
#undef PG8_WAIT_L
#undef PG8_BAR
#undef PG8_SCHED
}
}
namespace pg8 {
__device__ __forceinline__ float fast_silu(float v) { return v * __builtin_amdgcn_rcpf(1.f + __builtin_amdgcn_exp2f(-1.4426950408889634f * v)); }

struct DenseOrder {
    int nM, nN, nreg, nwg, G, c, mode, wgm;
    __device__ __forceinline__ void init(int nM_, int nN_, int G_, int c_, int mode_) { nM = nM_; nN = nN_; G = G_; c = c_; mode = mode_; nreg = nM * nN; nwg = nreg + (mode == 2 ? 8 : 0); wgm = WGM; }
    __device__ __forceinline__ bool next(int i, Unit& u) const {
        const long L = (long)i * G + c; if (L >= nwg) return false;
        if (mode == 2 && L >= nreg) { u.pm = 9 * (int)(L - nreg); u.pn = nN - 1; return true; }
        int wgid = (int)L; { const int q = nreg / NXCD, r = nreg % NXCD, xcd = wgid % NXCD, off = wgid / NXCD; wgid = (xcd < r ? xcd * (q + 1) : r * (q + 1) + (xcd - r) * q) + off; }
        const int nig = wgm * nN, gid = wgid / nig, fm = gid * wgm, gsz = (nM - fm) < wgm ? (nM - fm) : wgm;
        int pm = fm + ((wgid % nig) % gsz); u.pn = (wgid % nig) / gsz;
        if (mode != 0) pm = 9 * (pm >> 3) + 1 + (pm & 7);
        u.pm = pm; return true;
    }
    __device__ __forceinline__ void a_ready(const Unit&) const {}
    __device__ __forceinline__ void done(const Unit&) const {}
};
struct MoeOrder {
    const PG8_LAS int* tb; int nN, G, c;
    __device__ __forceinline__ bool next(int i, Unit& u) const {
        const int nwg = tb[8] * nN; long L = (long)i * G + c; if (L >= nwg) return false;
        { const int wg = (int)L, q = nwg / NXCD, r = nwg % NXCD, xcd = wg % NXCD, off = wg / NXCD; L = (xcd < r ? xcd * (q + 1) : r * (q + 1) + (xcd - r) * q) + off; }
        int e = 0;
#pragma unroll
        for (int k = 1; k < 8; ++k) if (L >= (long)tb[k] * nN) e = k;
        const int Le = (int)(L - (long)tb[e] * nN), mt = tb[e + 1] - tb[e];
        const int nig = WGM * nN, gid = Le / nig, fm = gid * WGM, gsz = (mt - fm) < WGM ? (mt - fm) : WGM;
        u.pm = tb[e] + fm + ((Le % nig) % gsz); u.pn = e * nN + (Le % nig) / gsz; return true;
    }
    __device__ __forceinline__ void a_ready(const Unit&) const {}
    __device__ __forceinline__ void done(const Unit&) const {}
};

template <bool SRCIN, bool FUSE> struct EpiResGate {
    static constexpr bool PERM = true, AFTER_DRAIN = false;
    const float* xin; float* xout; const float* modbase; int compact;
    const float* xsrc_lat; const float* xsrc_ctx; bf16_t* hraw; const float* gnext; const float* nscale; float* ssq;
    __device__ __forceinline__ void operator()(const f32x4 (&acc)[2][2][4][2], const Unit& u, int wr, int wc, int fr, int fq) const {
        const int b = u.pm / 9, pj = u.pm - 9 * b; const int mrow = (pj == 0) ? 8 : b;
        const float* g = modbase + (size_t)mrow * 6144;
        const int col0 = u.pn * BM + wc * 32 + 8 * fq;
        f32x4 gv[2][2];
#pragma unroll
        for (int bj = 0; bj < 2; ++bj)
#pragma unroll
            for (int n = 0; n < 2; ++n) gv[bj][n] = *(const f32x4*)(g + col0 + bj * HALF + n * 4);
        const int row0 = u.pm * BM + wr * 64 + fr; const int oshift = compact ? 256 * (b + 1) : 0;
        const float* xbase = SRCIN ? (pj == 0 ? xsrc_ctx + (size_t)b * 256 * 1024 : xsrc_lat + ((size_t)b * 2048 + (pj - 1) * 256) * 1024) - (size_t)u.pm * BM * 1024 : xin;
        const float* ns = nscale + (size_t)mrow * 6144;
#pragma unroll
        for (int am = 0; am < 4; ++am) { const int ai = am >> 1;
            f32x4 xv[2][2][2];
#pragma unroll
            for (int mm = 0; mm < 2; ++mm) { const int m = (am & 1) * 2 + mm; const float* xi = xbase + (size_t)(row0 + ai * HALF + m * 16) * 1024 + col0;
#pragma unroll
                for (int bj = 0; bj < 2; ++bj)
#pragma unroll
                    for (int n = 0; n < 2; ++n) xv[mm][bj][n] = *(const f32x4*)(xi + bj * HALF + n * 4); }
#pragma unroll
            for (int mm = 0; mm < 2; ++mm) { const int m = (am & 1) * 2 + mm; const int row = row0 + ai * HALF + m * 16; float* xo = xout + (size_t)(row - oshift) * 1024 + col0; float ss = 0.f;
#pragma unroll
                for (int bj = 0; bj < 2; ++bj)
#pragma unroll
                    for (int n = 0; n < 2; ++n) { const f32x4 v = xv[mm][bj][n] + gv[bj][n] * acc[ai][bj][m][n]; *(f32x4*)(xo + bj * HALF + n * 4) = v;
                        if (FUSE) { const int c = col0 + bj * HALF + n * 4; const f32x4 hv = v * (*(const f32x4*)(gnext + c) * (*(const f32x4*)(ns + c) + 1.f));
                            ss += (v[0] * v[0] + v[1] * v[1]) + (v[2] * v[2] + v[3] * v[3]);
                            u32x2 w; w.x = cvt_pk_bf16(hv[0], hv[1]); w.y = cvt_pk_bf16(hv[2], hv[3]); *(u32x2*)(hraw + (size_t)row * 1024 + c) = w; } }
                if (FUSE) { ss += __shfl_xor(ss, 16); ss += __shfl_xor(ss, 32); if (fq == 0) unsafeAtomicAdd(ssq + row, ss); } }
            asm volatile("" ::: "memory"); }
    }
};
struct EpiSwiGLU {
    static constexpr bool PERM = true, AFTER_DRAIN = false;
    bf16_t* O; int ldc; int npn; const float* ssq; const float* cbias; int cbld;
    __device__ __forceinline__ void operator()(const f32x4 (&acc)[2][2][4][2], const Unit& u, int wr, int wc, int fr, int fq) const {
        const int row0 = u.pm * BM + wr * 64 + fr; const int col0 = (u.pn % npn) * HALF + wc * 32 + 8 * fq;
        f32x4 cb[2][2];
        if (ssq) { const int b = u.pm / 9; const int mrow = (u.pm - 9 * b == 0) ? 8 : b; const float* cp = cbias + (size_t)mrow * cbld + u.pn * BM + wc * 32 + 8 * fq;
#pragma unroll
            for (int bj = 0; bj < 2; ++bj)
#pragma unroll
                for (int n = 0; n < 2; ++n) cb[bj][n] = *(const f32x4*)(cp + bj * HALF + 4 * n); }
        float rsv[2][4];
        if (ssq) {
#pragma unroll
            for (int ai = 0; ai < 2; ++ai)
#pragma unroll
                for (int m = 0; m < 4; ++m) rsv[ai][m] = ssq[row0 + ai * HALF + m * 16];
#pragma unroll
            for (int ai = 0; ai < 2; ++ai)
#pragma unroll
                for (int m = 0; m < 4; ++m) rsv[ai][m] = rsqrtf(rsv[ai][m] * (1.f / 1024.f) + 1e-6f); }
#pragma unroll
        for (int ai = 0; ai < 2; ++ai)
#pragma unroll
            for (int m = 0; m < 4; ++m) { const int row = row0 + ai * HALF + m * 16; bf16_t* rowp = O + (size_t)row * ldc + col0;
                f32x4 a0 = acc[ai][0][m][0], a1 = acc[ai][0][m][1], g0 = acc[ai][1][m][0], g1 = acc[ai][1][m][1];
                if (ssq) { const float rs = rsv[ai][m]; a0 = a0 * rs + cb[0][0]; a1 = a1 * rs + cb[0][1]; g0 = g0 * rs + cb[1][0]; g1 = g1 * rs + cb[1][1]; }
                u32x4 w; w.x = cvt_pk_bf16(fast_silu(a0[0]) * g0[0], fast_silu(a0[1]) * g0[1]); w.y = cvt_pk_bf16(fast_silu(a0[2]) * g0[2], fast_silu(a0[3]) * g0[3]);
                w.z = cvt_pk_bf16(fast_silu(a1[0]) * g1[0], fast_silu(a1[1]) * g1[1]); w.w = cvt_pk_bf16(fast_silu(a1[2]) * g1[2], fast_silu(a1[3]) * g1[3]);
                *(u32x4*)rowp = w; }
    }
};
struct EpiBf16Norm {
    static constexpr bool PERM = true, AFTER_DRAIN = false;
    bf16_t* O; int ldc; const float* ssq; const float* cbias; int cbld;
    __device__ __forceinline__ void operator()(const f32x4 (&acc)[2][2][4][2], const Unit& u, int wr, int wc, int fr, int fq) const {
        const int row0 = u.pm * BM + wr * 64 + fr; const int col0 = u.pn * BM + wc * 32 + 8 * fq;
        const int b = u.pm / 9; const int mrow = (u.pm - 9 * b == 0) ? 8 : b; const float* cp = cbias + (size_t)mrow * cbld + col0;
        f32x4 cb[2][2];
#pragma unroll
        for (int bj = 0; bj < 2; ++bj)
#pragma unroll
            for (int n = 0; n < 2; ++n) cb[bj][n] = *(const f32x4*)(cp + bj * HALF + 4 * n);
        float rsv[2][4];
#pragma unroll
        for (int ai = 0; ai < 2; ++ai)
#pragma unroll
            for (int m = 0; m < 4; ++m) rsv[ai][m] = ssq[row0 + ai * HALF + m * 16];
#pragma unroll
        for (int ai = 0; ai < 2; ++ai)
#pragma unroll
            for (int m = 0; m < 4; ++m) { const int row = row0 + ai * HALF + m * 16; bf16_t* rowp = O + (size_t)row * ldc + col0; const float rs = rsqrtf(rsv[ai][m] * (1.f / 1024.f) + 1e-6f);
#pragma unroll
                for (int bj = 0; bj < 2; ++bj) { const f32x4 v0 = acc[ai][bj][m][0] * rs + cb[bj][0], v1 = acc[ai][bj][m][1] * rs + cb[bj][1];
                    u32x4 w; w.x = cvt_pk_bf16(v0[0], v0[1]); w.y = cvt_pk_bf16(v0[2], v0[3]); w.z = cvt_pk_bf16(v1[0], v1[1]); w.w = cvt_pk_bf16(v1[2], v1[3]); *(u32x4*)(rowp + bj * HALF) = w; } }
    }
};
struct EpiMoeY2 {
    static constexpr bool PERM = true, AFTER_DRAIN = false;
    const float* slot_gate; bf16_t* Y2;
    __device__ __forceinline__ void operator()(const f32x4 (&acc)[2][2][4][2], const Unit& u, int wr, int wc, int fr, int fq) const {
        const int col0 = (u.pn & 3) * BM + wc * 32 + 8 * fq; const int slot0 = u.pm * BM + wr * 64 + fr;
#pragma unroll
        for (int ai = 0; ai < 2; ++ai)
#pragma unroll
            for (int m = 0; m < 4; ++m) { const int slot = slot0 + ai * HALF + m * 16; const float g = slot_gate[slot]; bf16_t* rowp = Y2 + (size_t)slot * 1024 + col0;
#pragma unroll
                for (int bj = 0; bj < 2; ++bj) { const f32x4 v0 = acc[ai][bj][m][0] * g, v1 = acc[ai][bj][m][1] * g;
                    u32x4 w; w.x = cvt_pk_bf16(v0[0], v0[1]); w.y = cvt_pk_bf16(v0[2], v0[3]); w.z = cvt_pk_bf16(v1[0], v1[1]); w.w = cvt_pk_bf16(v1[2], v1[3]);
                    *(u32x4*)(rowp + bj * HALF) = w; } }
    }
};
enum EpiMode { E_BF16 = 0, E_BF16NORM, E_RES, E_SWIGLU, E_MOEY2 };
struct EpiAny {
    static constexpr bool PERM = true, AFTER_DRAIN = false;
    int mode;
    bf16_t* O; int ldc, npn; const float* ssq; const float* cbias; int cbld;
    const float* xin; float* xout; const float* modbase; int compact, srcin, fuse; const float* xsrc_lat; const float* xsrc_ctx; const float* gnext; const float* nscale; float* ssqw;
    const float* slot_gate;
    __device__ __forceinline__ void res(const f32x4 (&acc)[2][2][4][2], const Unit& u, int wr, int wc, int fr, int fq) const {
        const int b = u.pm / 9, pj = u.pm - 9 * b; const int mrow = (pj == 0) ? 8 : b;
        const float* g = modbase + (size_t)mrow * 6144;
        const int col0 = u.pn * BM + wc * 32 + 8 * fq;
        f32x4 gv[2][2];
#pragma unroll
        for (int bj = 0; bj < 2; ++bj)
#pragma unroll
            for (int n = 0; n < 2; ++n) gv[bj][n] = *(const f32x4*)(g + col0 + bj * HALF + n * 4);
        const int row0 = u.pm * BM + wr * 64 + fr; const int oshift = compact ? 256 * (b + 1) : 0;
        const float* xbase = srcin ? (pj == 0 ? xsrc_ctx + (size_t)b * 256 * 1024 : xsrc_lat + ((size_t)b * 2048 + (pj - 1) * 256) * 1024) - (size_t)u.pm * BM * 1024 : xin;
        const float* ns = nscale + (size_t)mrow * 6144; bf16_t* hraw = O;
#pragma unroll
        for (int ai = 0; ai < 2; ++ai)
#pragma unroll
            for (int m = 0; m < 4; ++m) { const int row = row0 + ai * HALF + m * 16; const float* xi = xbase + (size_t)row * 1024 + col0; float* xo = xout + (size_t)(row - oshift) * 1024 + col0; float ss = 0.f;
#pragma unroll
                for (int bj = 0; bj < 2; ++bj)
#pragma unroll
                    for (int n = 0; n < 2; ++n) { const f32x4 v = *(const f32x4*)(xi + bj * HALF + n * 4) + gv[bj][n] * acc[ai][bj][m][n]; *(f32x4*)(xo + bj * HALF + n * 4) = v;
                        if (fuse) { const int c = col0 + bj * HALF + n * 4; const f32x4 hv = v * (*(const f32x4*)(gnext + c) * (*(const f32x4*)(ns + c) + 1.f));
                            ss += (v[0] * v[0] + v[1] * v[1]) + (v[2] * v[2] + v[3] * v[3]);
                            u32x2 w; w.x = cvt_pk_bf16(hv[0], hv[1]); w.y = cvt_pk_bf16(hv[2], hv[3]); *(u32x2*)(hraw + (size_t)row * 1024 + c) = w; } }
                if (fuse) { ss += __shfl_xor(ss, 16); ss += __shfl_xor(ss, 32); if (fq == 0) unsafeAtomicAdd(ssqw + row, ss); }
                if (m & 1) asm volatile("" ::: "memory"); }
    }
    __device__ __forceinline__ void operator()(const f32x4 (&acc)[2][2][4][2], const Unit& u, int wr, int wc, int fr, int fq) const {
        if (mode == E_BF16) { EpiBf16<0> e{O, ldc, nullptr, 0, 0, 1.f}; e(acc, u, wr, wc, fr, fq); }
        else if (mode == E_BF16NORM) { EpiBf16Norm e{O, ldc, ssq, cbias, cbld}; e(acc, u, wr, wc, fr, fq); }
        else if (mode == E_SWIGLU) { EpiSwiGLU e{O, ldc, npn, ssq, cbias, cbld}; e(acc, u, wr, wc, fr, fq); }
        else if (mode == E_MOEY2) { EpiMoeY2 e{slot_gate, O}; e(acc, u, wr, wc, fr, fq); }
        else res(acc, u, wr, wc, fr, fq);
    }
};
struct ChainOrder {
    int stage, c;
    __device__ __forceinline__ bool next(int i, Unit& u) const {
        const int x = c & 7, r = c >> 3; int lu = -1, nN = 4;
        if (stage == 0) { if (i == 0) lu = r; else if (i == 1 && r >= 16 && r < 20) lu = 16 + r; }
        else if (stage == 1) { nN = 22;
            if (i < 3) lu = 32 * i + r; else if (i == 3) { if (r < 30) lu = 96 + r; }
            else if (r < 28) { if (i < 6) lu = 126 + 28 * (i - 4) + r; else if (i == 6 && r < 16) lu = 182 + r; } }
        else if (stage == 2) { if (r >= 28) { if (i == 0) lu = r - 28; else if (i == 1) lu = r - 16; }
               else if (i == 0) { if (r < 16) lu = 20 + r; else { const int k = r - 16; lu = k < 8 ? 4 + k : 8 + k; } } }
        else {
            if (i < 2) lu = 32 * i + r; else if (i == 2 && r == 31) lu = 64;
            if (lu < 0) return false;
            if (lu == 64) { u.pm = 9 * x; u.pn = 7; } else { u.pm = 9 * x + 1 + (lu & 7); u.pn = lu >> 3; }
            return true; }
        if (lu < 0) return false;
        const unsigned long long perm = x == 6 ? 0x874310652ull : x == 7 ? 0x875421630ull : 0x876543210ull;
        const int g = lu / (3 * nN), w = lu - g * 3 * nN; u.pm = 9 * x + (int)((perm >> (4 * (3 * g + w % 3))) & 15ull); u.pn = w / 3; return true;
    }
};
struct MoeChainOrder {
    const PG8_LAS int* tb; int stage, c;
    __device__ __forceinline__ bool next(int i, Unit& u) const {
        const int x = c & 7, r = c >> 3, T = tb[8];
        const int t0 = (T * x) >> 3, n = ((T * (x + 1)) >> 3) - t0, j = r & 7, cc = r >> 3;
        int tile, col, nN;
        if (stage == 1) { nN = 4; tile = 8 * i + j; col = cc; if (tile >= n) return false; }
        else { nN = 28;
            const int kb = ((n & 7) == 1) ? 1 : 0, H = 4 * kb, tot = 28 * n + 12 * kb, A0 = tot >> 5, rem = tot & 31, ah = A0 - 3 * kb;
            const bool heavy = kb && j == 0;
            const int nr = r - (kb ? cc + (j > 0 ? 1 : 0) : 0);
            int m;
            if (i < ah) m = 32 * i + r;
            else { if (heavy) return false;
                   if (i < A0) m = 32 * ah + (32 - H) * (i - ah) + nr;
                   else if (i == A0 && nr < rem) m = 32 * ah + (32 - H) * (A0 - ah) + nr;
                   else return false; }
            if (m >= 28 * n) return false;
            const int g = m / 112, w = m - g * 112, gs = (n - 4 * g) < 4 ? (n - 4 * g) : 4; tile = 4 * g + w % gs; col = w / gs; }
        const int t = t0 + tile; int e = 0;
#pragma unroll
        for (int k = 1; k < 8; ++k) if (t >= tb[k]) e = k;
        u.pm = t; u.pn = e * nN + col; return true;
    }
};
struct OrderAny {
    int omode;
    DenseOrder d; MoeOrder m; ChainOrder ch; MoeChainOrder mch;
    mutable unsigned early, ew0, ew1, ew2, ew3;
    __device__ __forceinline__ bool next(int i, Unit& u) const {
        const bool ok = omode == 3 ? m.next(i, u) : omode == 4 ? ch.next(i, u) : omode == 5 ? mch.next(i, u) : d.next(i, u);
        if (ok && wcnt != nullptr) {
            early = __hip_atomic_load(wcnt + u.pm * 16, __ATOMIC_RELAXED, __HIP_MEMORY_SCOPE_AGENT);
            if (w2kind != 0) { int lo, hi; war_range(u, lo, hi);
                ew0 = __hip_atomic_load(w2cnt + (lo     <= hi ? lo     : u.pm) * 16, __ATOMIC_RELAXED, __HIP_MEMORY_SCOPE_AGENT);
                ew1 = __hip_atomic_load(w2cnt + (lo + 1 <= hi ? lo + 1 : u.pm) * 16, __ATOMIC_RELAXED, __HIP_MEMORY_SCOPE_AGENT);
                ew2 = __hip_atomic_load(w2cnt + (lo + 2 <= hi ? lo + 2 : u.pm) * 16, __ATOMIC_RELAXED, __HIP_MEMORY_SCOPE_AGENT);
                ew3 = __hip_atomic_load(w2cnt + (lo + 3 <= hi ? lo + 3 : u.pm) * 16, __ATOMIC_RELAXED, __HIP_MEMORY_SCOPE_AGENT); }
        }
        return ok;
    }
    unsigned* wcnt; unsigned wtarget; unsigned* dcnt; int rel_agent;
    unsigned* w2cnt; int w2kind;
    __device__ __forceinline__ void war_range(const Unit& u, int& lo, int& hi) const {
        if (w2kind == 1) { const int a0 = u.pm * 1441792 - 75497472, a1 = a0 + 1441791; lo = (a0 > 0 ? a0 : 0) >> 19; hi = a1 < 0 ? -1 : (a1 >> 19); }
        else { const int b0 = u.pm << 20; lo = b0 / 1441792; hi = (b0 + 1048575) / 1441792; }
    }
    __device__ __forceinline__ void a_ready(const Unit& u) const {
        if (wcnt != nullptr) {
            unsigned* p = wcnt + u.pm * 16; unsigned sp = 0u;
            unsigned mn = early;
            if (w2kind != 0) { const unsigned a = ew0 < ew1 ? ew0 : ew1, b = ew2 < ew3 ? ew2 : ew3, c2 = a < b ? a : b; mn = c2 < mn ? c2 : mn; }
            if (mn < wtarget) {
                while (__hip_atomic_load(p, __ATOMIC_RELAXED, __HIP_MEMORY_SCOPE_AGENT) < wtarget) { __builtin_amdgcn_s_sleep(1); if (++sp > (1u << 22)) break; }
                if (w2kind != 0) { int lo, hi; war_range(u, lo, hi);
                    for (int q = lo; q <= hi; ++q) while (__hip_atomic_load(w2cnt + q * 16, __ATOMIC_RELAXED, __HIP_MEMORY_SCOPE_AGENT) < wtarget) { __builtin_amdgcn_s_sleep(1); if (++sp > (1u << 22)) break; } }
            }
            if (rel_agent) __builtin_amdgcn_fence(__ATOMIC_ACQUIRE, "agent");
            asm volatile("" ::: "memory");
        }
    }
    __device__ __forceinline__ void done(const Unit& u) const {
        if (dcnt != nullptr) {
            if (rel_agent) __builtin_amdgcn_fence(__ATOMIC_RELEASE, "agent");
            asm volatile("s_waitcnt vmcnt(0)" ::: "memory");
            if ((threadIdx.x & 63) == 0) (void)__hip_atomic_fetch_add(dcnt + u.pm * 16, 1u, __ATOMIC_RELAXED, __HIP_MEMORY_SCOPE_AGENT);
        }
    }
};
}
#define GAS __attribute__((address_space(1)))
#define LAS __attribute__((address_space(3)))
typedef unsigned v4u __attribute__((ext_vector_type(4)));
typedef short bf16x8 __attribute__((ext_vector_type(8)));
namespace att {
using f32x16 = __attribute__((ext_vector_type(16))) float;
using s16x4 = __attribute__((ext_vector_type(4))) short;
typedef float f32x2_t __attribute__((ext_vector_type(2))); typedef __bf16 bf16x2_t __attribute__((ext_vector_type(2)));
__device__ __forceinline__ int crow(int r, int hi) { return (r & 3) + 8 * (r >> 2) + 4 * hi; }
__device__ __forceinline__ void glds16(const void* gsrc, unsigned lds_dst) { unsigned keep;
    asm volatile("s_mov_b32 %0, m0\n\ts_mov_b32 m0, %2\n\ts_nop 0\n\tglobal_load_lds_dwordx4 %1, off\n\ts_mov_b32 m0, %0" : "=&s"(keep) : "v"(gsrc), "s"(lds_dst) : "memory"); }
__device__ __forceinline__ unsigned cvtpk_s(float lo, float hi) { f32x2_t v = {lo, hi}; bf16x2_t b = __builtin_convertvector(v, bf16x2_t); return __builtin_bit_cast(unsigned, b); }
#define ATT_MX3(a, b, c) __builtin_fmaxf(__builtin_fmaxf((a), (b)), (c))
__device__ __forceinline__ float rowmax32(const f32x16& p0, const f32x16& p1) {
    float a = ATT_MX3(p0[0], p0[1], p1[0]), b = ATT_MX3(p0[2], p0[3], p1[1]); a = ATT_MX3(a, p1[2], p1[3]);
#pragma unroll
    for (int r = 4; r < 16; r += 4) { a = ATT_MX3(a, p0[r], p0[r + 1]); b = ATT_MX3(b, p0[r + 2], p0[r + 3]); a = ATT_MX3(a, p1[r], p1[r + 1]); b = ATT_MX3(b, p1[r + 2], p1[r + 3]); }
    a = __builtin_fmaxf(a, b);
    auto rr = __builtin_amdgcn_permlane32_swap(__float_as_uint(a), __float_as_uint(a), false, false);
    return fmaxf(__uint_as_float(rr[0]), __uint_as_float(rr[1]));
}
__device__ __forceinline__ void pv(f32x16* o, int vb, bf16x8 pa0, bf16x8 pa1, bf16x8 pa2, bf16x8 pa3) {
    s16x4 lo[2][4], hi[2][4];
#pragma unroll
    for (int d0 = 0; d0 < 2; ++d0)
#pragma unroll
        for (int ks = 0; ks < 4; ++ks) {
            asm volatile("ds_read_b64_tr_b16 %0,%1 offset:%c2" : "=&v"(lo[d0][ks]) : "v"(vb), "i"(d0 * 4096 + ks * 1024) : "memory");
            asm volatile("ds_read_b64_tr_b16 %0,%1 offset:%c2" : "=&v"(hi[d0][ks]) : "v"(vb), "i"(d0 * 4096 + ks * 1024 + 512) : "memory"); }
    asm volatile("s_waitcnt lgkmcnt(0)" ::: "memory"); __builtin_amdgcn_sched_barrier(0);
#define ATT_PK(d, k) (bf16x8){lo[d][k][0], lo[d][k][1], lo[d][k][2], lo[d][k][3], hi[d][k][0], hi[d][k][1], hi[d][k][2], hi[d][k][3]}
    o[0] = __builtin_amdgcn_mfma_f32_32x32x16_bf16(pa0, ATT_PK(0, 0), o[0], 0, 0, 0); o[1] = __builtin_amdgcn_mfma_f32_32x32x16_bf16(pa0, ATT_PK(1, 0), o[1], 0, 0, 0);
    o[0] = __builtin_amdgcn_mfma_f32_32x32x16_bf16(pa1, ATT_PK(0, 1), o[0], 0, 0, 0); o[1] = __builtin_amdgcn_mfma_f32_32x32x16_bf16(pa1, ATT_PK(1, 1), o[1], 0, 0, 0);
    o[0] = __builtin_amdgcn_mfma_f32_32x32x16_bf16(pa2, ATT_PK(0, 2), o[0], 0, 0, 0); o[1] = __builtin_amdgcn_mfma_f32_32x32x16_bf16(pa2, ATT_PK(1, 2), o[1], 0, 0, 0);
    o[0] = __builtin_amdgcn_mfma_f32_32x32x16_bf16(pa3, ATT_PK(0, 3), o[0], 0, 0, 0); o[1] = __builtin_amdgcn_mfma_f32_32x32x16_bf16(pa3, ATT_PK(1, 3), o[1], 0, 0, 0);
#undef ATT_PK
}
template <int DQ> struct Geo {
    static constexpr int NCH = DQ / 8, KSLOT = NCH * 1024, VSLOT = 8192;
    static constexpr int LDS_K = 0, LDS_V = 2 * KSLOT, LDS_WS = LDS_V + 2 * VSLOT, LDS_OST = LDS_WS + 8 * 256, LDS_BYTES = LDS_OST + 8 * 4096;
};
template <int DQ>
__device__ __forceinline__ void unit(int b, int hq, int hk, int qb, int NT, const bf16_t* __restrict__ Q, int ldq, const bf16_t* __restrict__ K, int ldk, const bf16_t* __restrict__ V, int ldv,
                                     bf16_t* __restrict__ O, int ldo, LAS unsigned char* shm) {
    typedef Geo<DQ> G; constexpr int ND0 = DQ / 16;
    const int tid = threadIdx.x, lane = tid & 63, r32 = lane & 31, hi = lane >> 5; const int wid = __builtin_amdgcn_readfirstlane(tid >> 6);
    const long rowbase = (long)b * RPB; const int q0 = qb * 256;
    const bf16_t* Qw = Q + (rowbase + q0 + wid * 32) * ldq + hq * DQ;
    const bf16_t* Kh = K + rowbase * ldk + hk * DQ; const bf16_t* Vh = V + rowbase * ldv + hk * 64;
    const unsigned lds0 = (unsigned)(uintptr_t)shm;
    LAS float* wsf = (LAS float*)(shm + G::LDS_WS) + wid * 64;
    const bf16_t* ksrc = Kh + (long)lane * ldk + wid * 8;
    const bf16_t* vsrc = Vh + (long)(16 * (wid & 3) + (lane >> 2)) * ldv + (wid >> 2) * 32 + (lane & 3) * 8;
    const unsigned kdst = lds0 + G::LDS_K + wid * 1024, vdst = lds0 + G::LDS_V + wid * 1024;
    const int vb0 = (int)(lds0 + G::LDS_V) + ((lane >> 4) & 1) * 32 + (lane & 3) * 8 + (4 * hi + ((lane & 15) >> 2)) * 64;
#define ATT_DMA(t, s) do { const bf16_t* kp_ = ksrc + (long)(t) * 64 * ldk; glds16(kp_, (unsigned)__builtin_amdgcn_readfirstlane(kdst + (s) * G::KSLOT)); \
        if (DQ == 96 && wid < 4) glds16(kp_ + 64, (unsigned)__builtin_amdgcn_readfirstlane(kdst + (s) * G::KSLOT + 8192)); \
        glds16(vsrc + (long)(t) * 64 * ldv, (unsigned)__builtin_amdgcn_readfirstlane(vdst + (s) * G::VSLOT)); } while (0)
    ATT_DMA(0, 0);
    bf16x8 qr[ND0];
#pragma unroll
    for (int d0 = 0; d0 < ND0; ++d0) qr[d0] = *reinterpret_cast<const bf16x8*>(&Qw[(long)r32 * ldq + d0 * 16 + hi * 8]);
    constexpr float THR = 8.f;
    float mref = 0.f, l_reg = 0.f; f32x16 o[2]; o[0] = f32x16{}; o[1] = f32x16{}; f32x16 negm = f32x16{};
    if (wid >= 4) __builtin_amdgcn_s_setprio(1);
    for (int t = 0; t < NT; ++t) {
        const int s = t & 1;
        asm volatile("s_waitcnt vmcnt(0) lgkmcnt(0)\n\ts_barrier" ::: "memory");
        if (t + 1 < NT) ATT_DMA(t + 1, s ^ 1);
        f32x16 p0, p1;
        { const LAS unsigned char* kb = shm + G::LDS_K + s * G::KSLOT + hi * 1024 + r32 * 16;
#pragma unroll
          for (int d0 = 0; d0 < ND0; ++d0) { const bf16x8 b0 = *(const LAS bf16x8*)(kb + d0 * 2048); const bf16x8 b1 = *(const LAS bf16x8*)(kb + d0 * 2048 + 512);
              p0 = __builtin_amdgcn_mfma_f32_32x32x16_bf16(b0, qr[d0], d0 == 0 ? negm : p0, 0, 0, 0); p1 = __builtin_amdgcn_mfma_f32_32x32x16_bf16(b1, qr[d0], d0 == 0 ? negm : p1, 0, 0, 0); } }
        const float rm = rowmax32(p0, p1);
        if (__builtin_expect(t == 0 || __any(rm > THR), 0)) {
            const float dl = t == 0 ? rm : __builtin_fmaxf(rm, 0.f); mref += dl;
#pragma unroll
            for (int r = 0; r < 16; ++r) { p0[r] -= dl; p1[r] -= dl; negm[r] = -mref; }
            const float alpha = t == 0 ? 1.f : __builtin_amdgcn_exp2f(-dl); l_reg *= alpha;
            if (hi == 0) wsf[r32] = alpha;
            asm volatile("s_waitcnt lgkmcnt(0)" ::: "memory");
#pragma unroll
            for (int r = 0; r < 16; ++r) { const float a = wsf[crow(r, hi)]; o[0][r] *= a; o[1][r] *= a; }
        }
        f32x2_t sacc = {0.f, 0.f};
#pragma unroll
        for (int r = 0; r < 16; r += 2) { p0[r] = __builtin_amdgcn_exp2f(p0[r]); p0[r + 1] = __builtin_amdgcn_exp2f(p0[r + 1]); p1[r] = __builtin_amdgcn_exp2f(p1[r]); p1[r + 1] = __builtin_amdgcn_exp2f(p1[r + 1]);
            sacc += (f32x2_t){p0[r], p0[r + 1]}; sacc += (f32x2_t){p1[r], p1[r + 1]}; }
        l_reg += sacc[0] + sacc[1];
        u32x4 pw0, pw1, pw2, pw3;
        pw0 = (u32x4){cvtpk_s(p0[0], p0[1]), cvtpk_s(p0[2], p0[3]), cvtpk_s(p0[4], p0[5]), cvtpk_s(p0[6], p0[7])};
        pw1 = (u32x4){cvtpk_s(p0[8], p0[9]), cvtpk_s(p0[10], p0[11]), cvtpk_s(p0[12], p0[13]), cvtpk_s(p0[14], p0[15])};
        pw2 = (u32x4){cvtpk_s(p1[0], p1[1]), cvtpk_s(p1[2], p1[3]), cvtpk_s(p1[4], p1[5]), cvtpk_s(p1[6], p1[7])};
        pw3 = (u32x4){cvtpk_s(p1[8], p1[9]), cvtpk_s(p1[10], p1[11]), cvtpk_s(p1[12], p1[13]), cvtpk_s(p1[14], p1[15])};
        pv(o, vb0 + s * G::VSLOT, __builtin_bit_cast(bf16x8, pw0), __builtin_bit_cast(bf16x8, pw1), __builtin_bit_cast(bf16x8, pw2), __builtin_bit_cast(bf16x8, pw3));
    }
#undef ATT_DMA
    __builtin_amdgcn_s_setprio(0);
    { auto rr = __builtin_amdgcn_permlane32_swap(__float_as_uint(l_reg), __float_as_uint(l_reg), false, false); l_reg = __uint_as_float(rr[0]) + __uint_as_float(rr[1]); }
    if (hi == 0) wsf[32 + r32] = l_reg;
    asm volatile("s_waitcnt lgkmcnt(0)" ::: "memory");
    float rli[16];
#pragma unroll
    for (int r = 0; r < 16; ++r) rli[r] = __builtin_amdgcn_rcpf(wsf[32 + crow(r, hi)]);
    bf16_t* Ow = O + (rowbase + q0 + wid * 32) * ldo + hq * 64;
    { LAS bf16_t* stg = (LAS bf16_t*)(shm + G::LDS_OST) + wid * 2048;
#pragma unroll
      for (int r = 0; r < 16; ++r) { const int orow = crow(r, hi);
#pragma unroll
          for (int d0 = 0; d0 < 2; ++d0) stg[orow * 64 + d0 * 32 + r32] = f2bf(o[d0][r] * rli[r]); }
      asm volatile("s_waitcnt lgkmcnt(0)" ::: "memory");
#pragma unroll
      for (int i = 0; i < 4; ++i) { const int row = i * 8 + (lane >> 3), ch = lane & 7; const u32x4 v = *(const LAS u32x4*)(stg + row * 64 + ch * 8); *(u32x4*)(Ow + (long)row * ldo + ch * 8) = v; } }
    asm volatile("s_waitcnt lgkmcnt(0)\n\ts_barrier" ::: "memory");
}
}
#define LDS_WAIT() asm volatile("s_waitcnt lgkmcnt(0)" ::: "memory")
#define VM_WAIT() asm volatile("s_waitcnt vmcnt(0)" ::: "memory")
constexpr int NWAVES = 8, NTHREADS = 512;
constexpr int RING_OFF = 0, RING_BYTES = 131072;
constexpr int MISC_OFF = RING_BYTES;
constexpr int LDS_BYTES = 147456;

enum Phase { PH_P0 = 0, PH_NORM0, PH_G_IN0, PH_LRUPREP, PH_MIX0, PH_G_OUT0, PH_G_F1, PH_G_F2, PH_G_IN1, PH_PREP1, PH_G_QKVB, PH_PREP2, PH_MIX1, PH_G_OUT1,
             PH_ROUTE, PH_SLOT, PH_MOE1, PH_MOE2, PH_COMBINE, PH_COUNT,
             PH_G_QB = 100, PH_G_KVB = 101 };

struct Params { const float* i0; const float* i1; const float* i2; const float* i3; const float* i4; const float* i5; const float* i6; const float* i7; const float* i8; const float* i9; const float* i10; const float* i11; const float* i12; const float* i13; const float* i14; const float* i15; const float* i16; const float* i17; const float* i18; const float* i19; const float* i20; const float* i21; const float* i22; const float* i23; const float* i24; const float* i25; const float* i26; const float* i27; const float* i28; const float* i29; const float* i30; const float* i31; const float* i32; const float* i33; const float* i34; const float* i35; const float* i36; const float* i37; const float* i38; const float* i39; const float* i40; const float* i41; const float* i42; float* out; char* ws; int ph_lo, ph_hi; };
#define PIN(k) (P.i##k)
static_assert(sizeof(Params) == 43 * 8 + 8 + 8 + 8, "Params has no padding");

struct Frame { LAS unsigned char* lds; int tid, lane, wave, G, bid, even; char* ws; };

__device__ __forceinline__ void tr_item(const float* __restrict__ W, int N, bf16_t* __restrict__ WT, int ldk, int kb, int nb, int dst_row0, LAS float* scr, int lane) {
    const int k0 = 64 * kb, n0 = 32 * nb;
    f32x4 v[8]; const float* wp = W + (size_t)(k0 + (lane >> 3)) * N + n0 + 4 * (lane & 7);
#pragma unroll
    for (int i = 0; i < 8; ++i) v[i] = __builtin_nontemporal_load((const f32x4*)(wp + (size_t)(8 * i) * N));
#pragma unroll
    for (int i = 0; i < 8; ++i) { LAS float* sp = scr + (8 * i + (lane >> 3)) * 33 + 4 * (lane & 7); sp[0] = v[i][0]; sp[1] = v[i][1]; sp[2] = v[i][2]; sp[3] = v[i][3]; }
    LDS_WAIT(); asm volatile("" ::: "memory");
    const int c = lane & 7;
#pragma unroll
    for (int j = 0; j < 4; ++j) { const int n = (lane >> 3) + 8 * j; const LAS float* s = scr + (8 * c) * 33 + n;
        v4u o; o.x = pk2(s[0 * 33], s[1 * 33]); o.y = pk2(s[2 * 33], s[3 * 33]); o.z = pk2(s[4 * 33], s[5 * 33]); o.w = pk2(s[6 * 33], s[7 * 33]);
        *(v4u*)(WT + (size_t)(dst_row0 + n) * ldk + k0 + 8 * c) = o; }
    LDS_WAIT(); asm volatile("" ::: "memory");
}
constexpr int MOE_ITEMS = 8 * 3 * 1792, MOE_CHUNK = 32, MOE_NCHUNK = MOE_ITEMS / MOE_CHUNK;
__device__ __forceinline__ void moe_conv_item(const Frame& F, const Params& P, int it, LAS float* scr) {
    const int e = it / 5376, r = it % 5376, which = r / 1792, q = r % 1792; char* ws = F.ws;
    const float* src; bf16_t* dst; int N, ldk, kb, nb, dr;
    if (which < 2) { kb = q / 112; nb = q % 112; const int n0 = nb * 32; dr = (n0 >> 7) * 256 + (n0 & 127) + (which == 1 ? 128 : 0);
        src = (which == 0 ? PIN(40) : PIN(41)) + (size_t)e * 1024 * 3584; N = 3584; dst = (bf16_t*)(ws + WS_W13M) + (size_t)e * 7168 * 1024; ldk = 1024; }
    else { kb = q / 32; nb = q % 32; dr = nb * 32; src = PIN(42) + (size_t)e * 3584 * 1024; N = 1024; dst = (bf16_t*)(ws + WS_W2M) + (size_t)e * 1024 * 3584; ldk = 3584; }
    tr_item(src, N, dst, ldk, kb, nb, dr, scr, F.lane);
}
struct TrDesc { const float* src; bf16_t* dst; int N, ldk, kb, nb, dr; };
__device__ __forceinline__ void moe_desc(const Frame& F, const Params& P, int it, TrDesc& d) {
    const int e = it / 5376, r = it % 5376, which = r / 1792, q = r % 1792; char* ws = F.ws;
    if (which < 2) { d.kb = q / 112; d.nb = q % 112; const int n0 = d.nb * 32; d.dr = (n0 >> 7) * 256 + (n0 & 127) + (which == 1 ? 128 : 0);
        d.src = (which == 0 ? PIN(40) : PIN(41)) + (size_t)e * 1024 * 3584; d.N = 3584; d.dst = (bf16_t*)(ws + WS_W13M) + (size_t)e * 7168 * 1024; d.ldk = 1024; }
    else { d.kb = q / 32; d.nb = q % 32; d.dr = d.nb * 32; d.src = PIN(42) + (size_t)e * 3584 * 1024; d.N = 1024; d.dst = (bf16_t*)(ws + WS_W2M) + (size_t)e * 1024 * 3584; d.ldk = 3584; }
}
__device__ __forceinline__ void tr_load(const TrDesc& d, int lane, f32x4 (&v)[8]) {
    const float* wp = d.src + (size_t)(64 * d.kb + (lane >> 3)) * d.N + 32 * d.nb + 4 * (lane & 7);
#pragma unroll
    for (int i = 0; i < 8; ++i) v[i] = __builtin_nontemporal_load((const f32x4*)(wp + (size_t)(8 * i) * d.N));
}
__device__ __forceinline__ void tr_store(const TrDesc& d, const f32x4 (&v)[8], LAS float* scr, int lane) {
    const int k0 = 64 * d.kb;
#pragma unroll
    for (int i = 0; i < 8; ++i) { LAS float* sp = scr + (8 * i + (lane >> 3)) * 33 + 4 * (lane & 7); sp[0] = v[i][0]; sp[1] = v[i][1]; sp[2] = v[i][2]; sp[3] = v[i][3]; }
    LDS_WAIT(); asm volatile("" ::: "memory");
    const int c = lane & 7;
#pragma unroll
    for (int j = 0; j < 4; ++j) { const int n = (lane >> 3) + 8 * j; const LAS float* sq = scr + (8 * c) * 33 + n;
        v4u o; o.x = pk2(sq[0 * 33], sq[1 * 33]); o.y = pk2(sq[2 * 33], sq[3 * 33]); o.z = pk2(sq[4 * 33], sq[5 * 33]); o.w = pk2(sq[6 * 33], sq[7 * 33]);
        *(v4u*)(d.dst + (size_t)(d.dr + n) * d.ldk + k0 + 8 * c) = o; }
    LDS_WAIT(); asm volatile("" ::: "memory");
}
__device__ __forceinline__ void moe_conv_all(const Frame& F, const Params& P, int it0, int it1) {
    LAS float* scr = (LAS float*)(F.lds + RING_OFF + F.wave * 16384); const int gw = F.bid * NWAVES + F.wave, NGW = F.G * NWAVES;
    __syncthreads();
    TrDesc d0, d1, d2; f32x4 v[8], w[8], y[8]; int it = it0 + gw;
    if (it < it1) { moe_desc(F, P, it, d0); tr_load(d0, F.lane, v); }
    if (it + NGW < it1) { moe_desc(F, P, it + NGW, d1); tr_load(d1, F.lane, w); }
#pragma unroll 1
    for (; it < it1; it += NGW) {
        const bool more2 = it + 2 * NGW < it1;
        if (more2) { moe_desc(F, P, it + 2 * NGW, d2); tr_load(d2, F.lane, y); }
        tr_store(d0, v, scr, F.lane);
        d0 = d1; d1 = d2;
#pragma unroll
        for (int i = 0; i < 8; ++i) { v[i] = w[i]; w[i] = y[i]; }
    }
    __syncthreads();
}
struct ConvDesc { const float* src; bf16_t* dst; int N, ldk, nblk, start, il, pad; };
__device__ __forceinline__ void phase_conv(const Frame& F, const Params& P, bool moe) {
    LAS float* scr = (LAS float*)(F.lds + RING_OFF + F.wave * 16384); char* ws = F.ws;
    LAS ConvDesc* tab = (LAS ConvDesc*)(F.lds + MISC_OFF);
    if (F.tid < 41) { const int t = F.tid; ConvDesc d; d.il = 0; d.pad = 0;
        if (t == 0) { d.src = PIN(8); d.dst = (bf16_t*)(ws + WS_WIN0); d.N = 1792; d.ldk = 1024; d.start = 16 * 56; }
        else if (t == 1) { d.src = PIN(9); d.dst = (bf16_t*)(ws + WS_WOUT0); d.N = 1024; d.ldk = 1024; d.start = 16 * 32; }
        else if (t == 2) { d.src = PIN(19); d.dst = (bf16_t*)(ws + WS_WF13); d.N = 2816; d.ldk = 1024; d.start = 16 * 88; d.il = 1; }
        else if (t == 3) { d.src = PIN(20); d.dst = (bf16_t*)(ws + WS_WF13); d.N = 2816; d.ldk = 1024; d.start = 16 * 88; d.il = 2; }
        else if (t == 4) { d.src = PIN(21); d.dst = (bf16_t*)(ws + WS_WF2); d.N = 1024; d.ldk = 2816; d.start = 44 * 32; }
        else if (t == 5) { d.src = PIN(22); d.dst = (bf16_t*)(ws + WS_WIN1); d.N = 1952; d.ldk = 1024; d.start = 16 * 61; }
        else if (t == 6) { d.src = PIN(23); d.dst = (bf16_t*)(ws + WS_WOUT1); d.N = 1024; d.ldk = 1024; d.start = 16 * 32; }
        else if (t == 7) { d.src = PIN(34); d.dst = (bf16_t*)(ws + WS_WQB); d.N = 768; d.ldk = 256; d.start = 4 * 24; }
        else if (t == 8) { d.src = PIN(36); d.dst = (bf16_t*)(ws + WS_WKVB); d.N = 1024; d.ldk = 128; d.start = 2 * 32; }
        else { const int q = t - 9, dn = q >> 1, g = q & 1; d.src = (g ? PIN(14) : PIN(12)) + (size_t)dn * 4096; d.dst = (bf16_t*)(ws + WS_WLRU) + (size_t)(dn * 2 + g) * 4096; d.N = 64; d.ldk = 64; d.start = 2; }
        d.nblk = d.N / 32;
        tab[t].src = d.src; tab[t].dst = d.dst; tab[t].N = d.N; tab[t].ldk = d.ldk; tab[t].nblk = d.nblk; tab[t].start = d.start; tab[t].il = d.il; tab[t].pad = 0; }
    __syncthreads();
    if (F.tid == 0) { int s = 0; for (int t = 0; t < 41; ++t) { const int c = tab[t].start; tab[t].start = s; s += c; } tab[0].pad = s; }
    __syncthreads();
    const int total = tab[0].pad; const int gw = F.bid * NWAVES + F.wave, NGW = F.G * NWAVES;
    auto mk = [&](int it, TrDesc& o) { int e = 0;
#pragma unroll 1
        for (int t = 1; t < 41; ++t) if (it >= tab[t].start) e = t;
        const int nblk = tab[e].nblk, il = tab[e].il, loc = it - tab[e].start; o.kb = loc / nblk; o.nb = loc % nblk; const int n0 = o.nb * 32;
        o.src = tab[e].src; o.dst = tab[e].dst; o.N = tab[e].N; o.ldk = tab[e].ldk; o.dr = il == 0 ? n0 : ((n0 >> 7) * 256 + (n0 & 127) + (il == 2 ? 128 : 0)); };
    { TrDesc d0, d1; f32x4 v[8], w[8]; int it = gw;
      if (it < total) { mk(it, d0); tr_load(d0, F.lane, v); }
#pragma unroll 1
      for (; it < total; it += NGW) {
          const bool more = it + NGW < total;
          if (more) { mk(it + NGW, d1); tr_load(d1, F.lane, w); }
          tr_store(d0, v, scr, F.lane);
          d0 = d1;
#pragma unroll
          for (int i = 0; i < 8; ++i) v[i] = w[i]; } }
    const int gt = F.bid * NTHREADS + F.tid, NGT = F.G * NTHREADS;
    { v4u* z = (v4u*)((bf16_t*)(ws + WS_WIN1) + (size_t)1952 * 1024); for (int i = gt; i < 96 * 1024 / 8; i += NGT) z[i] = (v4u){0u, 0u, 0u, 0u}; }
    __syncthreads();
}

constexpr size_t CT_TB = 64 * 1024;
enum GemmId { G_IN0 = 0, G_OUT0, G_F1, G_F2, G_IN1, G_QB, G_KVB, G_OUT1, G_MOE1, G_MOE2 };
__device__ __forceinline__ void run_gemm(const Frame& F, const Params& P, int gid) {
    char* ws = F.ws; float* MOD = (float*)(ws + WS_MOD); const float* MOD1 = MOD + 9 * MODLD; LAS unsigned char* lds = F.lds + RING_OFF;
    float* X = (float*)(ws + WS_X); bf16_t* H = (bf16_t*)(ws + WS_H); LAS int* tb = (LAS int*)(F.lds + MISC_OFF);
    pg8::Gemm g; pg8::OrderAny S; pg8::EpiAny E;
    E.mode = pg8::E_BF16; E.O = nullptr; E.ldc = 0; E.npn = 1; E.ssq = nullptr; E.cbias = nullptr; E.cbld = 0; E.xin = X; E.xout = X; E.modbase = MOD; E.compact = 0; E.srcin = 0; E.fuse = 0;
    E.xsrc_lat = PIN(0); E.xsrc_ctx = PIN(2); E.gnext = PIN(7); E.nscale = MOD; E.ssqw = (float*)(ws + WS_CTL + CT_SSQA); E.slot_gate = (const float*)(ws + WS_SLOTGATE);
    S.wcnt = nullptr; S.dcnt = nullptr; S.wtarget = 0u; S.w2cnt = nullptr; S.w2kind = 0; S.rel_agent = F.even ? 0 : 1; unsigned* PCNT = (unsigned*)(ws + WS_CTL + CT_PCNT);
    S.omode = 0; S.m.tb = tb; S.m.nN = 28; S.m.G = F.G; S.m.c = F.bid; g.M = MROWS; g.N = 0;
    if (gid == G_IN0) { g.A = H; g.Bt = (const bf16_t*)(ws + WS_WIN0); g.K = 1024; S.d.init(72, 7, F.G, F.bid, 0); E.O = (bf16_t*)(ws + WS_Z); E.ldc = 1792; }
    else if (gid == G_OUT0) { g.A = (const bf16_t*)(ws + WS_Y); g.Bt = (const bf16_t*)(ws + WS_WOUT0); g.K = 1024; S.d.init(72, 4, F.G, F.bid, 0); S.omode = 4; S.ch.stage = 0; S.ch.c = F.bid; S.dcnt = PCNT;
        E.mode = pg8::E_RES; E.modbase = MOD + 2 * DM; E.srcin = 1; E.fuse = 1; E.O = H; E.gnext = PIN(7); E.nscale = MOD + 4 * DM; E.ssqw = (float*)(ws + WS_CTL + CT_SSQA); }
    else if (gid == G_F1) { g.A = H; g.Bt = (const bf16_t*)(ws + WS_WF13); g.K = 1024; S.d.init(72, 22, F.G, F.bid, 0); S.omode = 4; S.ch.stage = 1; S.ch.c = F.bid; S.wcnt = PCNT; S.wtarget = 32u; S.dcnt = PCNT + 72 * 16; S.w2cnt = PCNT; S.w2kind = 1;
        E.mode = pg8::E_SWIGLU; E.O = (bf16_t*)(ws + WS_ACT); E.ldc = DFF; E.npn = 22; E.ssq = (const float*)(ws + WS_CTL + CT_SSQA); E.cbias = (const float*)(ws + WS_CBF1); E.cbld = 5632; }
    else if (gid == G_F2) { g.A = (const bf16_t*)(ws + WS_ACT); g.Bt = (const bf16_t*)(ws + WS_WF2); g.K = 2816; S.d.init(72, 4, F.G, F.bid, 0); S.omode = 4; S.ch.stage = 2; S.ch.c = F.bid; S.wcnt = PCNT + 72 * 16; S.wtarget = 176u; S.dcnt = PCNT + 144 * 16;
        E.mode = pg8::E_RES; E.modbase = MOD + 5 * DM; E.fuse = 1; E.O = H; E.gnext = PIN(6) + DM; E.nscale = MOD1 + 1 * DM; E.ssqw = (float*)(ws + WS_CTL + CT_SSQB); }
    else if (gid == G_IN1) { g.A = H; g.Bt = (const bf16_t*)(ws + WS_WIN1); g.K = 1024; S.d.init(64, 8, F.G, F.bid, 2); S.omode = 4; S.ch.stage = 3; S.ch.c = F.bid; S.wcnt = PCNT + 144 * 16; S.wtarget = 32u; S.w2cnt = PCNT + 144 * 16; S.w2kind = 2;
        E.mode = pg8::E_BF16NORM; E.O = (bf16_t*)(ws + WS_Z); E.ldc = 2048; E.ssq = (const float*)(ws + WS_CTL + CT_SSQB); E.cbias = (const float*)(ws + WS_CBIN1); E.cbld = 2048; }
    else if (gid == G_QB) { g.A = (const bf16_t*)(ws + WS_QA); g.Bt = (const bf16_t*)(ws + WS_WQB); g.K = 256; S.d.init(64, 3, F.G, F.bid, 1); S.omode = 1; E.O = (bf16_t*)(ws + WS_QR); E.ldc = 768; }
    else if (gid == G_KVB) { g.A = (const bf16_t*)(ws + WS_KVA); g.Bt = (const bf16_t*)(ws + WS_WKVB); g.K = 128; S.d.init(72, 4, F.G, (F.bid + 64) & 255, 0);   E.O = (bf16_t*)(ws + WS_KVR); E.ldc = 1024; }
    else if (gid == G_OUT1) { g.A = (const bf16_t*)(ws + WS_Y); g.Bt = (const bf16_t*)(ws + WS_WOUT1); g.K = 1024; S.d.init(64, 4, F.G, F.bid, 1); S.omode = 1;
        E.mode = pg8::E_RES; E.xout = P.out; E.modbase = MOD1 + 2 * DM; E.compact = 1; }
    else { if (F.tid < 9) tb[F.tid] = ((const int*)(ws + WS_CTL + CT_TB))[F.tid];
        __syncthreads();
        S.omode = 5; S.d.init(1, 1, F.G, F.bid, 0); S.mch.tb = tb; S.mch.c = F.bid; unsigned* MCNT = (unsigned*)(ws + WS_CTL + CT_MCNT);
        if (gid == G_MOE1) { g.A = (const bf16_t*)(ws + WS_XG); g.Bt = (const bf16_t*)(ws + WS_W13M); g.K = 1024; S.m.nN = 28; S.mch.stage = 0; S.dcnt = MCNT; E.mode = pg8::E_SWIGLU; E.O = (bf16_t*)(ws + WS_ACT2); E.ldc = DFE; E.npn = 28; }
        else { g.A = (const bf16_t*)(ws + WS_ACT2); g.Bt = (const bf16_t*)(ws + WS_W2M); g.K = 3584; S.m.nN = 4; S.mch.stage = 1; S.wcnt = MCNT; S.wtarget = 224u; E.mode = pg8::E_MOEY2; E.O = (bf16_t*)(ws + WS_Y2); } }
    if (S.wcnt != nullptr) __builtin_amdgcn_fence(__ATOMIC_ACQUIRE, "agent");
    pg8::gemm_phase<pg8::EpiAny, pg8::OrderAny, true, true>(lds, g, S, E);
    __syncthreads();
}

__device__ __forceinline__ void phase_attn0(const Frame& F) {
    char* ws = F.ws; LAS unsigned char* lds = F.lds + RING_OFF;
    for (int i = 0;; ++i) { const int L = i * F.G + F.bid; if (L >= 576) break; const int b = L & 7, idx = L >> 3;
        const int h = idx < 64 ? (idx >> 3) : idx - 64, qb = idx < 64 ? 1 + (idx & 7) : 0, NT = idx < 64 ? 36 : 4;
        att::unit<64>(b, h, h >> 2, qb, NT, (const bf16_t*)(ws + WS_QB), 512, (const bf16_t*)(ws + WS_KB), 128, (const bf16_t*)(ws + WS_VB), 128, (bf16_t*)(ws + WS_Y) + 512, DM, lds); }
}
__device__ __forceinline__ void phase_attn1(const Frame& F, const Params& P) {
    char* ws = F.ws; char* dob = (char*)P.out; LAS unsigned char* lds = F.lds + RING_OFF;
    for (int i = 0;; ++i) { const int L = i * F.G + F.bid; if (L >= 512) break; const int b = L & 7, idx = L >> 3; const int h = idx >> 3, qb = 1 + (idx & 7);
        att::unit<96>(b, h, h, qb, 36, (const bf16_t*)(ws + WS_QM), 768, (const bf16_t*)(dob + DO_KM), 768, (const bf16_t*)(dob + DO_VM), 512, (bf16_t*)(ws + WS_Y) + 512, DM, lds); }
}

__device__ __forceinline__ void phase_route(const Frame& F, const Params& P) {
    char* ws = F.ws; const float* X = P.out; const float* g = PIN(7) + DM; const float* MODL = (const float*)(ws + WS_MOD) + 9 * MODLD; const float* router = PIN(39);
    bf16_t* H2 = (bf16_t*)(ws + WS_H2); int* SEL = (int*)(ws + WS_SEL); int* HIST = (int*)(ws + WS_CTL + CT_HIST);
    LAS int* hist = (LAS int*)(F.lds + MISC_OFF);
    if (F.tid < 8) hist[F.tid] = 0;
    __syncthreads();
    const int rpb = NLAT / F.G, rpw = rpb / NWAVES;
    const int lane = F.lane;
    f32x4 rw[4][4][2], gsc[4], shv[4];
    { const float* md = MODL + (size_t)((F.bid * rpb) / SEQ) * MODLD;
#pragma unroll
      for (int j4 = 0; j4 < 4; ++j4) { const int k = 4 * lane + 256 * j4; gsc[j4] = *(const f32x4*)(g + k) * (*(const f32x4*)(md + 4 * DM + k) + 1.f); shv[j4] = *(const f32x4*)(md + 3 * DM + k);
#pragma unroll
          for (int c = 0; c < 4; ++c) { rw[j4][c][0] = *(const f32x4*)(router + (size_t)(k + c) * 8); rw[j4][c][1] = *(const f32x4*)(router + (size_t)(k + c) * 8 + 4); } } }
#pragma unroll 1
    for (int q0 = 0; q0 < rpw; q0 += 2) {
      f32x4 vv[2][4];
#pragma unroll
      for (int qq = 0; qq < 2; ++qq) { const float* xr = X + (size_t)(F.bid * rpb + F.wave * rpw + q0 + qq) * DM;
#pragma unroll
          for (int j4 = 0; j4 < 4; ++j4) vv[qq][j4] = *(const f32x4*)(xr + 4 * lane + 256 * j4); }
#pragma unroll
      for (int qq = 0; qq < 2; ++qq) {
        const int m = F.bid * rpb + F.wave * rpw + q0 + qq;
        f32x4 (&v)[4] = vv[qq]; float ss = 0.f;
#pragma unroll
        for (int j4 = 0; j4 < 4; ++j4) ss += (v[j4][0] * v[j4][0] + v[j4][1] * v[j4][1]) + (v[j4][2] * v[j4][2] + v[j4][3] * v[j4][3]);
        const float rstd = rsqrtf(wave_sum(ss) / DM + EPS);
        f32x4 a03 = {0.f, 0.f, 0.f, 0.f}, a47 = {0.f, 0.f, 0.f, 0.f};
#pragma unroll
        for (int j4 = 0; j4 < 4; ++j4) { const int k = 4 * lane + 256 * j4; const f32x4 hv = v[j4] * rstd * gsc[j4] + shv[j4];
#pragma unroll
            for (int c = 0; c < 4; ++c) { a03 += rw[j4][c][0] * hv[c]; a47 += rw[j4][c][1] * hv[c]; }
            u32x2 w; w.x = pk2(hv[0], hv[1]); w.y = pk2(hv[2], hv[3]); *(u32x2*)(H2 + (size_t)m * DM + k) = w; }
        float acc[8] = {a03[0], a03[1], a03[2], a03[3], a47[0], a47[1], a47[2], a47[3]};
#pragma unroll
        for (int e = 0; e < 8; ++e) acc[e] = wave_sum(acc[e]);
        if (lane == 0) {
            int e0 = 0; float b0 = acc[0];
#pragma unroll
            for (int e = 1; e < 8; ++e) if (acc[e] > b0) { b0 = acc[e]; e0 = e; }
            int e1 = -1; float b1 = -INFINITY;
#pragma unroll
            for (int e = 0; e < 8; ++e) if (e != e0 && acc[e] > b1) { b1 = acc[e]; e1 = e; }
            const float ex = expf(b1 - b0); const float g0 = 1.f / (1.f + ex), g1 = ex / (1.f + ex);
            SEL[4 * m + 0] = e0; SEL[4 * m + 1] = e1; SEL[4 * m + 2] = __float_as_int(g0); SEL[4 * m + 3] = __float_as_int(g1);
            atomicAdd((int*)&hist[e0], 1); atomicAdd((int*)&hist[e1], 1);
        }
      }
    }
    __syncthreads();
    if (F.tid < 8) HIST[F.bid * 8 + F.tid] = hist[F.tid];
}
__device__ __forceinline__ void phase_slot(const Frame& F, const Params& P) {
    char* ws = F.ws; const int* HIST = (const int*)(ws + WS_CTL + CT_HIST); const int* SEL = (const int*)(ws + WS_SEL); int* TB = (int*)(ws + WS_CTL + CT_TB);
    const bf16_t* H2 = (const bf16_t*)(ws + WS_H2); bf16_t* XG = (bf16_t*)(ws + WS_XG); int* slot_tok = (int*)(ws + WS_SLOTTOK); float* slot_gate = (float*)(ws + WS_SLOTGATE);
    LAS int* sm = (LAS int*)(F.lds + MISC_OFF);
    if (F.tid < 16) sm[F.tid] = 0;
    { const int rpb0 = NLAT / F.G; for (int i = F.tid; i < 4 * rpb0; i += NTHREADS) sm[512 + i] = SEL[4 * F.bid * rpb0 + i]; }
    v4u vr[8][2];
#pragma unroll
    for (int q = 0; q < 8; ++q) { const v4u* src = (const v4u*)(H2 + (size_t)(F.bid * (NLAT / F.G) + F.wave * 8 + q) * DM); vr[q][0] = src[F.lane]; vr[q][1] = src[64 + F.lane]; }
    __syncthreads();
    for (int t = F.tid; t < 2 * F.G; t += NTHREADS) {
        const int j = t % F.G, hf = t / F.G; const int4 c = *(const int4*)(HIST + j * 8 + 4 * hf); const int mk = j < F.bid ? 1 : 0;
        int v[8] = {c.x, c.y, c.z, c.w, c.x * mk, c.y * mk, c.z * mk, c.w * mk};
#pragma unroll
        for (int q = 0; q < 8; ++q) {
#pragma unroll
            for (int o = 1; o < 64; o <<= 1) v[q] += __shfl_xor(v[q], o); }
        if (F.lane == 0) {
#pragma unroll
            for (int q = 0; q < 4; ++q) { atomicAdd((int*)&sm[4 * hf + q], v[q]); atomicAdd((int*)&sm[8 + 4 * hf + q], v[4 + q]); } }
    }
    __syncthreads();
    if (F.tid == 0) { int s = 0; for (int e = 0; e < 8; ++e) { sm[16 + e] = s; s += (sm[e] + 255) & ~255; } sm[24] = s; }
    __syncthreads();
    const int rpb = NLAT / F.G, na = 2 * rpb;
    if (F.wave == 0) { const int a0 = F.lane, a1 = 64 + F.lane; const int e0 = sm[512 + 4 * (a0 >> 1) + (a0 & 1)], e1 = sm[512 + 4 * (a1 >> 1) + (a1 & 1)];
        const unsigned long long below = (1ull << F.lane) - 1ull; int sl0 = 0, sl1 = 0;
#pragma unroll
        for (int e = 0; e < 8; ++e) { const unsigned long long m0 = __ballot(e0 == e), m1 = __ballot(e1 == e); const int run = sm[16 + e] + sm[8 + e];
            if (e0 == e) sl0 = run + __popcll(m0 & below);
            if (e1 == e) sl1 = run + __popcll(m0) + __popcll(m1 & below); }
        sm[32 + a0] = sl0; sm[32 + a1] = sl1; }
    __syncthreads();
    {
#pragma unroll
        for (int q = 0; q < 8; ++q) { const int rl = F.wave * 8 + q, m = F.bid * rpb + rl;
#pragma unroll
            for (int k = 0; k < 2; ++k) { const int a = 2 * rl + k, sl = sm[32 + a]; v4u* dst = (v4u*)(XG + (size_t)sl * DM); dst[F.lane] = vr[q][0]; dst[64 + F.lane] = vr[q][1];
                if (F.lane == 0) { slot_tok[sl] = m; ((int*)(ws + WS_TOKSLOT))[2 * m + k] = sl; slot_gate[sl] = __int_as_float(sm[512 + 4 * rl + 2 + k]); } } } }
    if (F.bid < 8) { const int e = F.bid; for (int sl = sm[16 + e] + sm[e] + F.tid; sl < sm[16 + e + 1]; sl += NTHREADS) slot_tok[sl] = -1; }
    if (F.bid == 0 && F.tid < 9) TB[F.tid] = sm[16 + F.tid] >> 8;
}
__device__ __forceinline__ void phase_combine(const Frame& F, const Params& P) {
    char* ws = F.ws; float* out = P.out; const bf16_t* Y2 = (const bf16_t*)(ws + WS_Y2); const int* TS = (const int*)(ws + WS_TOKSLOT); const float* mod5 = (const float*)(ws + WS_MOD) + 9 * MODLD + 5 * DM;
    const int gw = F.bid * NWAVES + F.wave, lane = F.lane; const int mb = gw * 8;
    f32x4 mv[2][2];
    { const float* md = mod5 + (size_t)(mb >> 11) * MODLD;
#pragma unroll
      for (int jj = 0; jj < 2; ++jj)
#pragma unroll
          for (int hlf = 0; hlf < 2; ++hlf) mv[jj][hlf] = *(const f32x4*)(md + 8 * lane + 512 * jj + 4 * hlf); }
#pragma unroll 1
    for (int q0 = 0; q0 < 8; q0 += 2) {
        f32x4 xv[2][4]; v4u ya[2][2], yb[2][2];
#pragma unroll
        for (int q = 0; q < 2; ++q) { const int m = mb + q0 + q; const int sa = TS[2 * m], sb = TS[2 * m + 1];
#pragma unroll
            for (int jj = 0; jj < 4; ++jj) xv[q][jj] = *(const f32x4*)(out + (size_t)m * DM + 8 * lane + 512 * (jj >> 1) + 4 * (jj & 1));
#pragma unroll
            for (int jj = 0; jj < 2; ++jj) { ya[q][jj] = *(const v4u*)(Y2 + (size_t)sa * DM + 8 * lane + 512 * jj); yb[q][jj] = *(const v4u*)(Y2 + (size_t)sb * DM + 8 * lane + 512 * jj); } }
#pragma unroll
        for (int q = 0; q < 2; ++q) { const int m = mb + q0 + q;
#pragma unroll
            for (int jj = 0; jj < 2; ++jj) { const int k = 8 * lane + 512 * jj;
#pragma unroll
                for (int hlf = 0; hlf < 2; ++hlf) { f32x4 o = xv[q][2 * jj + hlf]; const f32x4 mm = mv[jj][hlf];
                    const unsigned a0 = ya[q][jj][2 * hlf], a1 = ya[q][jj][2 * hlf + 1], b0 = yb[q][jj][2 * hlf], b1 = yb[q][jj][2 * hlf + 1];
                    o[0] += mm[0] * (__uint_as_float(a0 << 16) + __uint_as_float(b0 << 16)); o[1] += mm[1] * (__uint_as_float(a0 & 0xffff0000u) + __uint_as_float(b0 & 0xffff0000u));
                    o[2] += mm[2] * (__uint_as_float(a1 << 16) + __uint_as_float(b1 << 16)); o[3] += mm[3] * (__uint_as_float(a1 & 0xffff0000u) + __uint_as_float(b1 & 0xffff0000u));
                    *(f32x4*)(out + (size_t)m * DM + k + 4 * hlf) = o; } } }
    }
}

#define XB_TMO      128
#define XB_XCNT(j)  (256  + 64 * (j))
#define XB_XSUB(j)  (1280 + 64 * (j))
#define XB_XGEN(j)  (2304 + 64 * (j))
#define XB_TOP      3328
#define XB_TOPGEN   3392
#define XCD_BAR_WORDS 3456
#define XB_SPIN_CAP (1u << 18)

__device__ __forceinline__ unsigned xb_ld(unsigned* p)              { return __hip_atomic_load(p, __ATOMIC_RELAXED, __HIP_MEMORY_SCOPE_AGENT); }
__device__ __forceinline__ unsigned xb_add(unsigned* p, unsigned v) { return __hip_atomic_fetch_add(p, v, __ATOMIC_RELAXED, __HIP_MEMORY_SCOPE_AGENT); }
__device__ __forceinline__ unsigned xb_xcc_id() { return (unsigned)__builtin_amdgcn_s_getreg((3 << 11) | 20) & 0xFu; }
#define XB_SPIN(cond, bar) do { unsigned _sp = 0; while (cond) { __builtin_amdgcn_s_sleep(1); \
    if ((++_sp & 255u) == 0u) { if (xb_ld(&(bar)[XB_TMO])) break; if (_sp > XB_SPIN_CAP) { atomicAdd(&(bar)[XB_TMO], 1u); break; } } } } while (0)

struct XcdBarrier {
    unsigned* bar; unsigned x;
    volatile LAS unsigned* st;
};

__device__ __forceinline__ XcdBarrier xcd_barrier_post(unsigned* bar, volatile LAS unsigned* st) {
    XcdBarrier b; b.bar = bar; b.x = xb_xcc_id(); b.st = st;
    if (threadIdx.x == 0) st[2] = xb_add(&bar[XB_XCNT(b.x)], 1u);
    return b;
}
__device__ __forceinline__ void xcd_barrier_complete(unsigned* bar, unsigned x, unsigned& nloc, unsigned& nx, unsigned& even) {
    const unsigned G = gridDim.x * gridDim.y * gridDim.z;
    unsigned sum, cnt, mine, bal, sp = 0u;
    for (;;) {
        sum = 0u; cnt = 0u; mine = 0u; bal = 1u;
#pragma unroll
        for (unsigned j = 0; j < 16; ++j) { const unsigned c = xb_ld(&bar[XB_XCNT(j)]); sum += c; cnt += (c > 0u) ? 1u : 0u; mine = (j == x) ? c : mine; bal = (j < 8u && c * 8u != G) ? 0u : bal; }
        if (sum == G) break;
        __builtin_amdgcn_s_sleep(1);
        if ((++sp & 255u) == 0u) { if (xb_ld(&bar[XB_TMO])) break; if (sp > XB_SPIN_CAP) { atomicAdd(&bar[XB_TMO], 1u); break; } }
    }
    nloc = mine > 0u ? mine : 1u; nx = cnt > 0u ? cnt : 1u; even = (sum == G) ? bal : 0u;
}

__device__ __forceinline__ void xcd_barrier(const XcdBarrier& b) {
    asm volatile("s_waitcnt vmcnt(0)" ::: "memory");
    __syncthreads();
    if (threadIdx.x == 0) {
        unsigned* bar = b.bar;
        __builtin_amdgcn_s_waitcnt(0);
        unsigned nloc = b.st[0], nx = b.st[1];
        if (nloc == 0u) { unsigned ev; xcd_barrier_complete(bar, b.x, nloc, nx, ev); b.st[0] = nloc; b.st[1] = nx; b.st[3] = ev; }
        const unsigned old = xb_add(&bar[XB_XSUB(b.x)], 1u);
        const unsigned gen = old / nloc;
        if (old + 1u == (gen + 1u) * nloc) {
            __builtin_amdgcn_fence(__ATOMIC_RELEASE, "agent");
            asm volatile("s_waitcnt vmcnt(0)" ::: "memory");
            const unsigned og = xb_add(&bar[XB_TOP], 1u);
            const unsigned tg = og / nx;
            if (og + 1u == (tg + 1u) * nx) xb_add(&bar[XB_TOPGEN], 1u);
            else XB_SPIN(xb_ld(&bar[XB_TOPGEN]) == tg, bar);
            __builtin_amdgcn_fence(__ATOMIC_ACQUIRE, "agent");
            xb_add(&bar[XB_XGEN(b.x)], 1u);
            asm volatile("s_waitcnt vmcnt(0)" ::: "memory");
        } else {
            XB_SPIN(xb_ld(&bar[XB_XGEN(b.x)]) == gen, bar);
            __builtin_amdgcn_fence(__ATOMIC_ACQUIRE, "agent");
            asm volatile("s_waitcnt vmcnt(0)" ::: "memory");
        }
    }
    __syncthreads();
}
namespace hy {
using f32x16 = __attribute__((ext_vector_type(16))) float;
constexpr int UL = 2088, ULB = UL * 2;
constexpr int GOFF = 2064;
constexpr int L_U = 0, L_U2 = 8 * ULB, L_X = 2 * 8 * ULB, L_G0 = L_X + 8 * 2048 * 2, L_G1 = L_G0 + GT_LD * 2, L_END = L_G1 + GT_LD * 2;
static_assert(L_END <= RING_BYTES, "hyena LDS");
__device__ __forceinline__ void prep(const Frame& F, const Params& P) {
    char* ws = F.ws; const bf16_t* Z = (const bf16_t*)(ws + WS_Z); bf16_t* ZT = (bf16_t*)(ws + WS_ZT); const float* cw = PIN(24); const float* cb = PIN(25);
    const int gw = F.bid * NWAVES + F.wave, NGW = F.G * NWAVES, lane = F.lane; LAS unsigned char* tl = F.lds + RING_OFF + F.wave * 8192;
    for (int it = gw; it < 24 * 8 * 64; it += NGW) { const int cg = it % 24, b = (it / 24) & 7, tt = it / 192; const int c = cg * 64 + lane, t0 = tt * 32;
        const float w0 = cw[c], w1 = cw[1536 + c], w2 = cw[3072 + c], bias = cb[c];
        const bf16_t* zp = Z + ((size_t)b * RPB + CTX) * CD_LD + cg * 64;
        v4u pc[5];
#pragma unroll
        for (int k = 0; k < 5; ++k) { const int p = lane + 64 * k, row = p >> 3, c8 = p & 7, t = t0 - 1 + row; pc[k] = (p < 272 && t >= 0 && t < SEQ) ? *(const v4u*)(zp + (size_t)t * CD_LD + c8 * 8) : (v4u){0u, 0u, 0u, 0u}; }
#pragma unroll
        for (int k = 0; k < 5; ++k) { const int p = lane + 64 * k, row = p >> 3, c8 = p & 7; if (p < 272) *(LAS v4u*)(tl + row * 144 + c8 * 16) = pc[k]; }
        LDS_WAIT(); asm volatile("" ::: "memory");
        float xr[34];
#pragma unroll
        for (int i = 0; i < 34; ++i) xr[i] = bf2f(*(const LAS bf16_t*)(tl + i * 144 + lane * 2));
        LDS_WAIT(); asm volatile("" ::: "memory");
        bf16_t* op = ZT + ((size_t)c * NB + b) * SEQ + t0;
#pragma unroll
        for (int j8 = 0; j8 < 4; ++j8) { float y[8];
#pragma unroll
            for (int jj = 0; jj < 8; ++jj) { const int i = j8 * 8 + jj; y[jj] = bias + w0 * xr[i] + w1 * xr[i + 1] + w2 * xr[i + 2]; }
            v4u o; o.x = pk2(y[0], y[1]); o.y = pk2(y[2], y[3]); o.z = pk2(y[4], y[5]); o.w = pk2(y[6], y[7]); *(v4u*)(op + j8 * 8) = o; } }
}
__device__ __forceinline__ void filt(const Frame& F, const Params& P) {
    char* ws = F.ws; bf16_t* GT = (bf16_t*)(ws + WS_GT);
    const float *w1 = PIN(26), *b1 = PIN(27), *w2 = PIN(28), *b2 = PIN(29), *w3 = PIN(30), *freq = PIN(31);
    LAS float* z = (LAS float*)(F.lds + RING_OFF); LAS float* h1 = z + 9 * 64; LAS float* h2 = h1 + 9 * 64;
    const int tid = F.tid;
    for (int tb = F.bid; tb < SEQ / 8; tb += F.G) {
        const int t0 = tb * 8;
        __syncthreads();
        if (tid < 9 * 33) { const int tt = tid / 33, k = tid % 33, t = t0 + tt; float zv = (float)t / (float)(SEQ - 1);
            if (k > 0) { const int bi = (k - 1) & 15; const double band = 1e-4 + (15.0 - 1e-4) * (double)bi / 15.0; const double rev = (double)t * band * (1.0 / (double)SEQ);
                const float fr = (float)(rev - floor(rev)); zv = k <= 16 ? __builtin_amdgcn_cosf(fr) : -__builtin_amdgcn_sinf(fr); }
            z[tt * 64 + k] = zv; }
        __syncthreads();
        for (int idx = tid; idx < 9 * 64; idx += NTHREADS) { const int tt = idx >> 6, j = idx & 63; float a = b1[j];
#pragma unroll
            for (int i = 0; i < 33; ++i) a += z[tt * 64 + i] * w1[i * 64 + j];
            h1[idx] = __sinf(freq[j] * a); }
        __syncthreads();
        for (int idx = tid; idx < 9 * 64; idx += NTHREADS) { const int tt = idx >> 6, j = idx & 63; float a = b2[j];
#pragma unroll 16
            for (int i = 0; i < 64; ++i) a += h1[tt * 64 + i] * w2[i * 64 + j];
            h2[idx] = __sinf(freq[j] * a); }
        __syncthreads();
        float acc[4][9];
#pragma unroll
        for (int q = 0; q < 4; ++q)
#pragma unroll
            for (int tt = 0; tt < 9; ++tt) acc[q][tt] = 0.f;
#pragma unroll 16
        for (int i = 0; i < 64; ++i) { float wv[4];
#pragma unroll
            for (int q = 0; q < 4; ++q) wv[q] = w3[(size_t)i * 2048 + tid + 512 * q];
#pragma unroll
            for (int tt = 0; tt < 9; ++tt) { const float hv = h2[tt * 64 + i];
#pragma unroll
                for (int q = 0; q < 4; ++q) acc[q][tt] += hv * wv[q]; } }
        const double mind = log(1e-2) / 1.5, maxd = log(1e-2) / 0.3; const int ch = tid; const float delta = fabsf((float)(mind + (maxd - mind) * (double)ch / 511.0));
        float win[9];
#pragma unroll
        for (int tt = 0; tt < 9; ++tt) { const int t = t0 + tt; win[tt] = t < SEQ ? __expf(-((float)t / (float)(SEQ - 1)) * delta) + 0.05f : 0.f; }
#pragma unroll
        for (int ord = 0; ord < 2; ++ord) { bf16_t* gp = GT + ((size_t)ord * 512 + ch) * GT_LD + GOFF; float fw[9], bw[9];
#pragma unroll
            for (int tt = 0; tt < 9; ++tt) { fw[tt] = acc[2 * ord][tt] * win[tt]; bw[tt] = acc[2 * ord + 1][tt] * win[tt]; }
            if (t0 == 0) bw[0] = fw[0];
            v4u ob; ob.x = pk2(bw[0], bw[1]); ob.y = pk2(bw[2], bw[3]); ob.z = pk2(bw[4], bw[5]); ob.w = pk2(bw[6], bw[7]); *(v4u*)(gp + t0) = ob;
            v4u of; of.x = pk2(fw[8], fw[7]); of.y = pk2(fw[6], fw[5]); of.z = pk2(fw[4], fw[3]); of.w = pk2(fw[2], fw[1]); *(v4u*)(gp - t0 - 8) = of; }
    }
    const int gt = F.bid * NTHREADS + F.tid, NGT = F.G * NTHREADS; constexpr int NZ = 16 + (GT_LD - GOFF - 2048);
    for (int i = gt; i < 1024 * NZ; i += NGT) { const int oc = i / NZ, k = i % NZ; GT[(size_t)oc * GT_LD + (k < 16 ? k : GOFF + 2048 + (k - 16))] = 0; }
}
__device__ __forceinline__ void conv_mfma(f32x16 (&acc)[2], LAS unsigned char* Ub, LAS unsigned char* Gb, int wave, int lane) {
    const int n = lane & 31, h = lane >> 5, b = n >> 2, dl = n & 3;
    const LAS unsigned char* up = Ub + b * ULB + 16 * h;
    const int i = lane & 31;
    const LAS unsigned char* gp0 = Gb + 2 * (GOFF + 8 * h - 4 * i - 16 * (8 * (2 * wave) + 1));
    const LAS unsigned char* gp1 = gp0 - 2 * 16 * 8;
    acc[0] = f32x16{}; acc[1] = f32x16{};
    const bool sh2 = dl >= 2; const unsigned sb = (dl & 1) * 2;
    const LAS unsigned char* upq = up + 8 * (dl < 3 ? dl : 2);
    u32x4 ring[8];
#pragma unroll
    for (int b8 = 0; b8 < 8; ++b8) { const u32x2 a0 = *(const LAS u32x2*)(gp1 + 32 * b8), a1 = *(const LAS u32x2*)(gp1 + 32 * b8 + 8); ring[b8] = (u32x4){a0[0], a0[1], a1[0], a1[1]}; }
#define HY_STEP(J, b8) do { \
          \
        const u32x2 qx = *(const LAS u32x2*)(upq + 32 * (J)); \
        unsigned q[6]; \
        q[0] = __builtin_amdgcn_mov_dpp((int)qx[0], 0x00, 0xF, 0xF, false); q[1] = __builtin_amdgcn_mov_dpp((int)qx[1], 0x00, 0xF, 0xF, false); \
        q[2] = __builtin_amdgcn_mov_dpp((int)qx[0], 0x55, 0xF, 0xF, false); q[3] = __builtin_amdgcn_mov_dpp((int)qx[1], 0x55, 0xF, 0xF, false); \
        q[4] = __builtin_amdgcn_mov_dpp((int)qx[0], 0xAA, 0xF, 0xF, false); q[5] = __builtin_amdgcn_mov_dpp((int)qx[1], 0xAA, 0xF, 0xF, false); \
        u32x4 bw; \
        _Pragma("unroll") for (int w = 0; w < 4; ++w) { const unsigned lo = sh2 ? q[w + 1] : q[w], hi_ = sh2 ? q[w + 2] : q[w + 1]; bw[w] = __builtin_amdgcn_alignbyte(hi_, lo, sb); } \
        const u32x2 a00 = *(const LAS u32x2*)(gp0 + 32 * (J)), a01 = *(const LAS u32x2*)(gp0 + 32 * (J) + 8); \
        const u32x4 A1 = ring[b8]; const u32x4 A0 = {a00[0], a00[1], a01[0], a01[1]}; ring[b8] = A0; \
        acc[0] = __builtin_amdgcn_mfma_f32_32x32x16_bf16(__builtin_bit_cast(bf16x8, A0), __builtin_bit_cast(bf16x8, bw), acc[0], 0, 0, 0); \
        acc[1] = __builtin_amdgcn_mfma_f32_32x32x16_bf16(__builtin_bit_cast(bf16x8, A1), __builtin_bit_cast(bf16x8, bw), acc[1], 0, 0, 0); } while (0)
#pragma unroll 1
    for (int J8 = 0; J8 < 128; J8 += 8) {
#pragma unroll
        for (int b8 = 0; b8 < 8; ++b8) HY_STEP(J8 + b8, b8); }
    HY_STEP(128, 0);
#undef HY_STEP
}
__device__ __forceinline__ void main_phase(const Frame& F, const Params& P) {
    char* ws = F.ws; const bf16_t* ZT = (const bf16_t*)(ws + WS_ZT); const bf16_t* GT = (const bf16_t*)(ws + WS_GT); bf16_t* HT = (bf16_t*)(ws + WS_HT); const float* skip = PIN(32);
    LAS unsigned char* lds = F.lds + RING_OFF; const int tid = F.tid, lane = F.lane, wave = F.wave;
    const int n = lane & 31, h = lane >> 5, b = n >> 2, dl = n & 3;
    for (int c = F.bid; c < 512; c += F.G) {
        __syncthreads();
        for (int i = tid; i < 8 * 256; i += NTHREADS) { const int bb = i >> 8, k = i & 255; *(LAS v4u*)(lds + L_U + bb * ULB + 32 + k * 16) = *(const v4u*)(ZT + ((size_t)c * NB + bb) * SEQ + k * 8);
            *(LAS v4u*)(lds + L_X + (bb * 2048 + k * 8) * 2) = *(const v4u*)(ZT + ((size_t)(512 + c) * NB + bb) * SEQ + k * 8); }
        for (int i = tid; i < GT_LD / 8; i += NTHREADS) { *(LAS v4u*)(lds + L_G0 + i * 16) = *(const v4u*)(GT + (size_t)c * GT_LD + i * 8); *(LAS v4u*)(lds + L_G1 + i * 16) = *(const v4u*)(GT + (size_t)(512 + c) * GT_LD + i * 8); }
        if (tid < 80) { const int bb = tid / 10, k = tid % 10, which = k / 5, part = k % 5; const int off = bb * ULB + (part < 2 ? part * 16 : (16 + 2048) * 2 + (part - 2) * 16);
            *(LAS v4u*)(lds + (which ? L_U2 : L_U) + off) = (v4u){0u, 0u, 0u, 0u}; }
        __syncthreads();
        const float sk0 = skip[c], sk1 = skip[512 + c];
        f32x16 acc[2];
        conv_mfma(acc, lds + L_U, lds + L_G0, wave, lane);
#pragma unroll
        for (int ip = 0; ip < 2; ++ip)
#pragma unroll
            for (int r = 0; r < 16; ++r) { const int t = 128 * (2 * wave + ip) + 4 * att::crow(r, h) + dl;
                const float v = bf2f(*(const LAS bf16_t*)(lds + L_U + b * ULB + (16 + t) * 2)), x1 = bf2f(*(const LAS bf16_t*)(lds + L_X + (b * 2048 + t) * 2));
                *(LAS bf16_t*)(lds + L_U2 + b * ULB + (16 + t) * 2) = f2bf(x1 * (acc[ip][r] + sk0 * v)); }
        __syncthreads();
        for (int i = tid; i < 8 * 256; i += NTHREADS) { const int bb = i >> 8, k = i & 255; *(LAS v4u*)(lds + L_X + (bb * 2048 + k * 8) * 2) = *(const v4u*)(ZT + ((size_t)(1024 + c) * NB + bb) * SEQ + k * 8); }
        conv_mfma(acc, lds + L_U2, lds + L_G1, wave, lane);
        __syncthreads();
#pragma unroll
        for (int ip = 0; ip < 2; ++ip)
#pragma unroll
            for (int r = 0; r < 16; ++r) { const int t = 128 * (2 * wave + ip) + 4 * att::crow(r, h) + dl;
                const float y1 = bf2f(*(const LAS bf16_t*)(lds + L_U2 + b * ULB + (16 + t) * 2)), x2 = bf2f(*(const LAS bf16_t*)(lds + L_X + (b * 2048 + t) * 2));
                *(LAS bf16_t*)(lds + L_U + (b * 2048 + t) * 2) = f2bf(x2 * (acc[ip][r] + sk1 * y1)); }
        __syncthreads();
        for (int i = tid; i < 8 * 256; i += NTHREADS) *(v4u*)(HT + (size_t)c * NLAT + i * 8) = *(const LAS v4u*)(lds + L_U + i * 16);
    }
}
__device__ __forceinline__ void untranspose(const Frame& F) {
    char* ws = F.ws; const bf16_t* HT = (const bf16_t*)(ws + WS_HT); bf16_t* Y = (bf16_t*)(ws + WS_Y);
    const int gw = F.bid * NWAVES + F.wave, NGW = F.G * NWAVES, lane = F.lane; LAS unsigned char* tl = F.lds + RING_OFF + F.wave * 16384;
    __syncthreads();
    for (int it = gw; it < 8 * 8 * 32; it += NGW) { const int cg = it & 7, b = (it >> 3) & 7, tt = it >> 6; const int c = cg * 64 + lane, t0 = tt * 64;
        const bf16_t* hp = HT + ((size_t)c * NB + b) * SEQ + t0; bf16_t* yp = Y + ((size_t)b * RPB + CTX + t0) * DM + cg * 64;
        v4u q[8];
#pragma unroll
        for (int j8 = 0; j8 < 8; ++j8) q[j8] = *(const v4u*)(hp + j8 * 8);
#pragma unroll
        for (int j8 = 0; j8 < 8; ++j8)
#pragma unroll
            for (int jj = 0; jj < 4; ++jj) { *(LAS bf16_t*)(tl + (j8 * 8 + 2 * jj) * 144 + lane * 2) = (bf16_t)(q[j8][jj] & 0xffffu); *(LAS bf16_t*)(tl + (j8 * 8 + 2 * jj + 1) * 144 + lane * 2) = (bf16_t)(q[j8][jj] >> 16); }
        LDS_WAIT(); asm volatile("" ::: "memory");
#pragma unroll
        for (int k = 0; k < 8; ++k) { const int p = lane + 64 * k, row = p >> 3, c8 = p & 7; *(v4u*)(yp + (size_t)row * DM + c8 * 8) = *(const LAS v4u*)(tl + row * 144 + c8 * 16); }
        LDS_WAIT(); asm volatile("" ::: "memory"); }
}
}
namespace lru {
using f32x16 = __attribute__((ext_vector_type(16))) float;
typedef float f32x2 __attribute__((ext_vector_type(2)));
constexpr int T = 32, NCH = RPB / T;
constexpr int UPITCH = 1040;
constexpr int L_UT = 0, L_GL = 34816, L_END = L_GL + 2 * T * 512 * 2;
static_assert(L_END <= RING_BYTES, "lru LDS");
__device__ __forceinline__ float fsigmoid(float x) { return __builtin_amdgcn_rcpf(1.f + __builtin_amdgcn_exp2f(-LOG2E * x)); }
__device__ __forceinline__ float gelu_fast(float x) { const float y = 0.7978845608028654f * (x + 0.044715f * x * x * x); const float e = __builtin_amdgcn_exp2f(2.f * LOG2E * y); const float th = 1.f - 2.f * __builtin_amdgcn_rcpf(1.f + e); return 0.5f * x * (1.f + th); }
__device__ __forceinline__ int chunk_of_order(int d, int q) { return d == 0 ? q : (q < 8 ? 7 - q : 79 - q); }
__device__ __forceinline__ int order_of_chunk(int d, int j) { return d == 0 ? j : (j < 8 ? 7 - j : 79 - j); }

__device__ __forceinline__ void unit0(const Frame& F, const Params& P, int b, int j) {
    char* ws = F.ws; const bf16_t* Z = (const bf16_t*)(ws + WS_Z); float* AGG = (float*)(ws + WS_AGG); const bf16_t* WL = (const bf16_t*)(ws + WS_WLRU);
    bf16_t* LAB = (bf16_t*)P.out; bf16_t* BTB = (bf16_t*)(ws + WS_H);
    LAS unsigned char* lds = F.lds + RING_OFF; const int ch = F.tid, lane = F.lane, wave = F.wave;
    const int s0 = j * T, seg_lo = s0 < CTX ? 0 : CTX, seg_hi = s0 < CTX ? CTX : RPB; const size_t row0 = (size_t)b * RPB + s0;
    LDS_WAIT(); asm volatile("" ::: "memory");
    float u[T];
    { const float w0 = PIN(10)[ch], w1 = PIN(10)[512 + ch], w2 = PIN(10)[1024 + ch], w3 = PIN(10)[1536 + ch], cb = PIN(11)[ch];
      float xw[T + 3];
#pragma unroll
      for (int i = 0; i < T + 3; ++i) { const int s = s0 + i - 2; xw[i] = (s >= seg_lo && s < seg_hi) ? bf2f(Z[((size_t)b * RPB + s) * AB_IN + ch]) : 0.f; }
#pragma unroll
      for (int t = 0; t < T; ++t) { u[t] = cb + w0 * xw[t] + w1 * xw[t + 1] + w2 * xw[t + 2] + w3 * xw[t + 3]; *(LAS bf16_t*)(lds + L_UT + t * UPITCH + ch * 2) = f2bf(u[t]); } }
#pragma unroll
    for (int d = 0; d < 2; ++d) {
        LDS_WAIT(); asm volatile("" ::: "memory");
        { const int n = wave, r32 = lane & 31, h = lane >> 5; bf16x8 af[4];
#pragma unroll
          for (int ks = 0; ks < 4; ++ks) af[ks] = *(const LAS bf16x8*)(lds + L_UT + r32 * UPITCH + (64 * n + 16 * ks + 8 * h) * 2);
#pragma unroll
          for (int g = 0; g < 2; ++g)
#pragma unroll
              for (int cb = 0; cb < 2; ++cb) { f32x16 acc = f32x16{}; const bf16_t* wp = WL + ((size_t)((d * 8 + n) * 2 + g) * 64 + 32 * cb + r32) * 64 + 8 * h;
#pragma unroll
                  for (int ks = 0; ks < 4; ++ks) { const bf16x8 bfr = *(const bf16x8*)(wp + 16 * ks); acc = __builtin_amdgcn_mfma_f32_32x32x16_bf16(af[ks], bfr, acc, 0, 0, 0); }
                  const float bias = (g == 0 ? PIN(13) : PIN(15))[(d * 8 + n) * 64 + 32 * cb + r32];
#pragma unroll
                  for (int r = 0; r < 16; ++r) *(LAS bf16_t*)(lds + L_GL + ((g * T + att::crow(r, h)) * 512 + 64 * n + 32 * cb + r32) * 2) = f2bf(fsigmoid(acc[r] + bias)); } }
        LDS_WAIT(); asm volatile("" ::: "memory");
        const float cl = -8.f * softplus_f(-PIN(16)[d * 512 + ch]);
        float h = 0.f, sumlog = 0.f; bf16_t* lap = LAB + ((size_t)d * MROWS + row0) * 512 + ch; bf16_t* btp = BTB + ((size_t)d * MROWS + row0) * 512 + ch;
#pragma unroll
        for (int st = 0; st < T; ++st) { const int t = d == 0 ? st : T - 1 - st;
            const float rg = bf2f(*(const LAS bf16_t*)(lds + L_GL + (t * 512 + ch) * 2)), ig = bf2f(*(const LAS bf16_t*)(lds + L_GL + ((T + t) * 512 + ch) * 2));
            const bf16_t lab = f2bf(cl * rg); const float la = bf2f(lab); const float a = __builtin_amdgcn_exp2f(LOG2E * la);
            const bf16_t btb = f2bf(__builtin_amdgcn_sqrtf(fmaf(-a, a, 1.f)) * (ig * u[t])); const float bt = bf2f(btb);
            lap[(size_t)t * 512] = lab; btp[(size_t)t * 512] = btb;
            h = a * h + bt; sumlog += la; }
        { f32x2* ag = (f32x2*)AGG + ((size_t)(d * 8 + b) * NCH + j) * 512 + ch; *ag = (f32x2){sumlog, h}; }
    }
}
__device__ __forceinline__ void unit1(const Frame& F, const Params& P, int b, int j) {
    char* ws = F.ws; const bf16_t* Z = (const bf16_t*)(ws + WS_Z); bf16_t* Y = (bf16_t*)(ws + WS_Y); const float* AGG = (const float*)(ws + WS_AGG);
    const bf16_t* LAB = (const bf16_t*)P.out; const bf16_t* BTB = (const bf16_t*)(ws + WS_H);
    const int ch = F.tid; const size_t row0 = (size_t)b * RPB + j * T;
    float hf[T];
#pragma unroll
    for (int d = 0; d < 2; ++d) {
        const bf16_t* lap = LAB + ((size_t)d * MROWS + row0) * 512 + ch; const bf16_t* btp = BTB + ((size_t)d * MROWS + row0) * 512 + ch;
        bf16_t lav[T], btv[T]; bf16_t gv[T];
#pragma unroll
        for (int t = 0; t < T; ++t) { lav[t] = lap[(size_t)t * 512]; btv[t] = btp[(size_t)t * 512]; if (d == 1) gv[t] = Z[(row0 + t) * AB_IN + 512 + ch]; }
        float h = 0.f;
        { const int q = order_of_chunk(d, j); const f32x2* ag = (const f32x2*)AGG + (size_t)(d * 8 + b) * NCH * 512 + ch;
#pragma unroll 24
          for (int qq = 0; qq < q; ++qq) { const int jj = chunk_of_order(d, qq); const f32x2 av = ag[(size_t)jj * 512]; h = __builtin_amdgcn_exp2f(LOG2E * av[0]) * h + av[1]; } }
#pragma unroll
        for (int st = 0; st < T; ++st) { const int t = d == 0 ? st : T - 1 - st;
            h = __builtin_amdgcn_exp2f(LOG2E * bf2f(lav[t])) * h + bf2f(btv[t]);
            if (d == 0) hf[t] = h; else Y[(row0 + t) * DM + ch] = f2bf((hf[t] + h) * gelu_fast(bf2f(gv[t]))); }
    }
}
__device__ __forceinline__ void unit1x(const Frame& F, const Params& P, int b, int j) {
    char* ws = F.ws; const bf16_t* Z = (const bf16_t*)(ws + WS_Z); bf16_t* Y = (bf16_t*)(ws + WS_Y); const float* AGG = (const float*)(ws + WS_AGG);
    const bf16_t* LAB = (const bf16_t*)P.out; const bf16_t* BTB = (const bf16_t*)(ws + WS_H);
    const int ch = (F.tid & 255) * 2; const size_t row0 = (size_t)b * RPB + j * T;
    float hf0[T], hf1[T];
#pragma unroll
    for (int d = 0; d < 2; ++d) {
        const bf16_t* lap = LAB + ((size_t)d * MROWS + row0) * 512 + ch; const bf16_t* btp = BTB + ((size_t)d * MROWS + row0) * 512 + ch;
        unsigned lav[T], btv[T], gv[T];
#pragma unroll
        for (int t = 0; t < T; ++t) { lav[t] = *(const unsigned*)(lap + (size_t)t * 512); btv[t] = *(const unsigned*)(btp + (size_t)t * 512); if (d == 1) gv[t] = *(const unsigned*)(Z + (row0 + t) * AB_IN + 512 + ch); }
        float h0 = 0.f, h1 = 0.f;
        { const int q = order_of_chunk(d, j); const f32x4* ag = (const f32x4*)((const f32x2*)AGG + (size_t)(d * 8 + b) * NCH * 512 + ch);
#pragma unroll 24
          for (int qq = 0; qq < q; ++qq) { const int jj = chunk_of_order(d, qq); const f32x4 av = ag[(size_t)jj * 256];
              h0 = __builtin_amdgcn_exp2f(LOG2E * av[0]) * h0 + av[1]; h1 = __builtin_amdgcn_exp2f(LOG2E * av[2]) * h1 + av[3]; } }
#pragma unroll
        for (int st = 0; st < T; ++st) { const int t = d == 0 ? st : T - 1 - st;
            h0 = __builtin_amdgcn_exp2f(LOG2E * __uint_as_float(lav[t] << 16)) * h0 + __uint_as_float(btv[t] << 16);
            h1 = __builtin_amdgcn_exp2f(LOG2E * __uint_as_float(lav[t] & 0xffff0000u)) * h1 + __uint_as_float(btv[t] & 0xffff0000u);
            if (d == 0) { hf0[t] = h0; hf1[t] = h1; }
            else *(unsigned*)(Y + (row0 + t) * DM + ch) = pk2((hf0[t] + h0) * gelu_fast(__uint_as_float(gv[t] << 16)), (hf1[t] + h1) * gelu_fast(__uint_as_float(gv[t] & 0xffff0000u))); }
    }
}
template <int MODE>
__device__ __forceinline__ void phase(const Frame& F, const Params& P) {
    const int first = MODE == 0 ? F.bid : (F.bid + 192) % F.G;
    if (MODE == 0) { for (int L = first; L < NB * NCH; L += F.G) unit0(F, P, L & 7, L >> 3); }
    else { const int half = F.tid >> 8;
        for (int k = 0; first + k * F.G < NB * NCH; k += 2) { const int L = first + (k + half) * F.G; if (L < NB * NCH) unit1x(F, P, L & 7, L >> 3); } }
}
}
namespace el {
__device__ __forceinline__ void mod_phase(const Frame& F, const Params& P) {
    char* ws = F.ws; float* MOD = (float*)(ws + WS_MOD); const float* c = PIN(1); const float* cctx = PIN(3); const float* mw = PIN(4); const float* mb = PIN(5);
    LAS float* sc = (LAS float*)(F.lds + RING_OFF); LAS float* part = sc + 9 * DM;
    if (F.bid >= 192) return;
    for (int i = F.tid; i < 9 * DM; i += NTHREADS) { const int j = i >> 10, k = i & 1023; const float v = j < 8 ? c[j * DM + k] : cctx[k]; sc[i] = v / (1.f + expf(-v)); }
    __syncthreads();
    const int cg = F.lane & 15, kr = F.lane >> 4; const int col = F.bid * 64 + 4 * cg, l = col / MODLD, n = col % MODLD; const float* w = mw + (size_t)l * DM * MODLD + n; const int k0 = F.wave * 128 + kr;
    f32x4 acc[9];
#pragma unroll
    for (int j = 0; j < 9; ++j) acc[j] = (f32x4){0.f, 0.f, 0.f, 0.f};
#pragma unroll 8
    for (int i = 0; i < 32; ++i) { const int k = k0 + 4 * i; const f32x4 wv = __builtin_nontemporal_load((const f32x4*)(w + (size_t)k * MODLD));
#pragma unroll
        for (int j = 0; j < 9; ++j) acc[j] += wv * sc[j * DM + k]; }
#pragma unroll
    for (int j = 0; j < 9; ++j) {
#pragma unroll
        for (int c = 0; c < 4; ++c) { float v = acc[j][c]; v += __shfl_xor(v, 16); v += __shfl_xor(v, 32); acc[j][c] = v; }
        if (kr == 0) *(LAS f32x4*)(part + (F.wave * 9 + j) * 64 + 4 * cg) = acc[j]; }
    __syncthreads();
    for (int i = F.tid; i < 9 * 64; i += NTHREADS) { const int j = i >> 6, ln = i & 63; float s = 0.f;
#pragma unroll
        for (int wv = 0; wv < 8; ++wv) s += part[(wv * 9 + j) * 64 + ln];
        const int cc = F.bid * 64 + ln; MOD[((size_t)(cc / MODLD) * 9 + j) * MODLD + cc % MODLD] = s + mb[cc]; }
    __syncthreads();
}
__device__ __forceinline__ void bias_phase(const Frame& F, const Params& P) {
    char* ws = F.ws; const float* MOD = (const float*)(ws + WS_MOD);
    LAS float* sc = (LAS float*)(F.lds + RING_OFF); LAS float* part = sc + 9 * DM;
    if (F.bid >= 120) return;
    const bool f1 = F.bid < 88; const float* shb = f1 ? MOD + 3 * DM : MOD + 9 * MODLD;
    __syncthreads();
    for (int i = F.tid; i < 9 * DM; i += NTHREADS) sc[i] = shb[(size_t)(i >> 10) * MODLD + (i & 1023)];
    __syncthreads();
    const int cg = F.lane & 15, kr = F.lane >> 4; const int cc = (f1 ? F.bid : F.bid - 88) * 64 + 4 * cg; const float* w; int ldw; bool valid = true;
    if (f1) { const int pn = cc >> 8, c = cc & 255; w = (c < 128 ? PIN(19) : PIN(20)) + pn * 128 + (c & 127); ldw = DFF; } else { valid = cc < CD_IN; w = PIN(22) + (valid ? cc : 0); ldw = CD_IN; }
    const int k0 = F.wave * 128 + kr; f32x4 acc[9];
#pragma unroll
    for (int j = 0; j < 9; ++j) acc[j] = (f32x4){0.f, 0.f, 0.f, 0.f};
#pragma unroll 8
    for (int i = 0; i < 32; ++i) { const int k = k0 + 4 * i; const f32x4 wv = *(const f32x4*)(w + (size_t)k * ldw);
#pragma unroll
        for (int j = 0; j < 9; ++j) acc[j] += wv * sc[j * DM + k]; }
#pragma unroll
    for (int j = 0; j < 9; ++j) {
#pragma unroll
        for (int c = 0; c < 4; ++c) { float v = acc[j][c]; v += __shfl_xor(v, 16); v += __shfl_xor(v, 32); acc[j][c] = valid ? v : 0.f; }
        if (kr == 0) *(LAS f32x4*)(part + (F.wave * 9 + j) * 64 + 4 * cg) = acc[j]; }
    __syncthreads();
    for (int i = F.tid; i < 9 * 64; i += NTHREADS) { const int j = i >> 6, ln = i & 63; float s = 0.f;
#pragma unroll
        for (int wv = 0; wv < 8; ++wv) s += part[(wv * 9 + j) * 64 + ln];
        if (f1) ((float*)(ws + WS_CBF1))[(size_t)j * 5632 + F.bid * 64 + ln] = s; else ((float*)(ws + WS_CBIN1))[(size_t)j * 2048 + (F.bid - 88) * 64 + ln] = s; }
    __syncthreads();
}
template <int SRC>
__device__ __forceinline__ void norm_phase(const Frame& F, const Params& P, const float* g, const float* MODL, int ish, int isc) {
    char* ws = F.ws; bf16_t* H = (bf16_t*)(ws + WS_H); const int gw = F.bid * NWAVES + F.wave, lane = F.lane; const int rb = gw * 9;
    f32x4 gg[4], gs[4], sh[4]; int cur = -1;
#pragma unroll
    for (int j = 0; j < 4; ++j) gg[j] = *(const f32x4*)(g + 4 * lane + 256 * j);
#pragma unroll 1
    for (int r0 = rb; r0 < rb + 9; r0 += 3) {
        f32x4 v[3][4];
#pragma unroll
        for (int q = 0; q < 3; ++q) { const int r = r0 + q, b = r / RPB, s = r - b * RPB;
            const float* xr = s < CTX ? PIN(2) + ((size_t)b * CTX + s) * DM : PIN(0) + ((size_t)b * SEQ + (s - CTX)) * DM;
#pragma unroll
            for (int j = 0; j < 4; ++j) v[q][j] = *(const f32x4*)(xr + 4 * lane + 256 * j); }
#pragma unroll
        for (int q = 0; q < 3; ++q) { const int r = r0 + q, b = r / RPB, s = r - b * RPB; const int mrow = s < CTX ? 8 : b;
            if (mrow != cur) { cur = mrow; const float* md = MODL + (size_t)mrow * MODLD;
#pragma unroll
                for (int j = 0; j < 4; ++j) { const int k = 4 * lane + 256 * j; gs[j] = gg[j] * (*(const f32x4*)(md + isc * DM + k) + 1.f); sh[j] = *(const f32x4*)(md + ish * DM + k); } }
            float ss = 0.f;
#pragma unroll
            for (int j = 0; j < 4; ++j) ss += (v[q][j][0] * v[q][j][0] + v[q][j][1] * v[q][j][1]) + (v[q][j][2] * v[q][j][2] + v[q][j][3] * v[q][j][3]);
            const float rstd = rsqrtf(wave_sum(ss) / DM + EPS);
#pragma unroll
            for (int j = 0; j < 4; ++j) { const int k = 4 * lane + 256 * j; const f32x4 hv = v[q][j] * rstd * gs[j] + sh[j];
                u32x2 w; w.x = pk2(hv[0], hv[1]); w.y = pk2(hv[2], hv[3]); *(u32x2*)(H + (size_t)r * DM + k) = w; } }
    }
}
__device__ __forceinline__ void rope_tables(const Frame& F) {
    float* R0 = (float*)(F.ws + WS_ROPE0); float* R1 = (float*)(F.ws + WS_ROPE1); const int gt = F.bid * NTHREADS + F.tid, NGT = F.G * NTHREADS;
    for (int i = gt; i < SEQ * 48; i += NGT) { const int t = i / 48, k = i % 48; const float row = (float)(t >> 6), col = (float)(t & 63);
        const bool l0 = k < 32; const int kk = l0 ? k : k - 32; const int half = l0 ? 16 : 8;
        const float invf = exp2f(-(float)(kk & (half - 1)) * (13.287712379549449f / (float)half)); const float ang = (kk < half ? row : col) * invf; const float cv = cosf(ang), sv = sinf(ang);
        if (l0) { R0[t * 64 + kk] = cv; R0[t * 64 + 32 + kk] = sv; } else { R1[t * 32 + kk] = cv; R1[t * 32 + 16 + kk] = sv; } }
}
__device__ __forceinline__ void gqa_prep(const Frame& F, const Params& P) {
    char* ws = F.ws; const bf16_t* Z = (const bf16_t*)(ws + WS_Z); bf16_t* Q = (bf16_t*)(ws + WS_QB); bf16_t* K = (bf16_t*)(ws + WS_KB); bf16_t* V = (bf16_t*)(ws + WS_VB); const float* R0 = (const float*)(ws + WS_ROPE0);
    const int gw = F.bid * NWAVES + F.wave, NGW = F.G * NWAVES, lane = F.lane; const int d0 = 8 * (lane & 7), i0 = d0 & 31;
    float qn[8], kn[8];
#pragma unroll
    for (int e = 0; e < 8; ++e) { qn[e] = PIN(17)[d0 + e] * QSCALE0; kn[e] = PIN(18)[d0 + e]; }
    constexpr int R1 = 6912; const int nb2 = F.G - 64; const int gw2 = (F.bid - 64) * NWAVES + F.wave, NGW2 = nb2 * NWAVES;
    for (int pass = 0; pass < 2; ++pass) { const int base = pass == 0 ? 0 : R1, lim = pass == 0 ? R1 : MROWS, g0 = pass == 0 ? gw : gw2, ng = pass == 0 ? NGW : NGW2; if (pass == 1 && F.bid < 64) break;
    for (int r0 = base + g0; r0 < lim; r0 += 2 * ng) {
        v4u qv[2], kv[2]; f32x4 cs[2][2], sn[2][2];
#pragma unroll
        for (int q = 0; q < 2; ++q) { const int r = r0 + q * ng; if (r < lim) { const bf16_t* z = Z + (size_t)r * AB_IN + 1024; const int s = r % RPB;
            qv[q] = *(const v4u*)(z + 8 * lane); kv[q] = lane < 32 ? *(const v4u*)(z + 512 + 8 * lane) : (v4u){0u, 0u, 0u, 0u};
            if (s >= CTX) { const float* rp = R0 + (size_t)(s - CTX) * 64 + i0; cs[q][0] = *(const f32x4*)rp; cs[q][1] = *(const f32x4*)(rp + 4); sn[q][0] = *(const f32x4*)(rp + 32); sn[q][1] = *(const f32x4*)(rp + 36); } } }
#pragma unroll
        for (int q = 0; q < 2; ++q) { const int r = r0 + q * ng; if (r < lim) { const bool lat = (r % RPB) >= CTX;
#pragma unroll
            for (int ps = 0; ps < 2; ++ps) { const v4u raw = ps == 0 ? qv[q] : kv[q]; float x[8];
#pragma unroll
                for (int e = 0; e < 4; ++e) { x[2 * e] = __uint_as_float(raw[e] << 16); x[2 * e + 1] = __uint_as_float(raw[e] & 0xffff0000u); }
                float ss = 0.f;
#pragma unroll
                for (int e = 0; e < 8; ++e) ss += x[e] * x[e];
                ss += __shfl_xor(ss, 1); ss += __shfl_xor(ss, 2); ss += __shfl_xor(ss, 4);
                const float rs = rsqrtf(ss * (1.f / 64.f) + EPS); float y[8];
#pragma unroll
                for (int e = 0; e < 8; ++e) y[e] = x[e] * rs * (ps == 0 ? qn[e] : kn[e]);
                if (lat) {
#pragma unroll
                    for (int e = 0; e < 8; ++e) { const float other = __shfl_xor(y[e], 4); const float c = cs[q][e >> 2][e & 3], s_ = sn[q][e >> 2][e & 3]; y[e] = (lane & 4) ? (other * s_ + y[e] * c) : (y[e] * c - other * s_); } }
                v4u o; o.x = pk2(y[0], y[1]); o.y = pk2(y[2], y[3]); o.z = pk2(y[4], y[5]); o.w = pk2(y[6], y[7]);
                if (ps == 0) *(v4u*)(Q + (size_t)r * 512 + 8 * lane) = o;
                else if (lane < 16) *(v4u*)(K + (size_t)r * 128 + 8 * lane) = o;
                else if (lane < 32) *(v4u*)(V + (size_t)r * 128 + 8 * (lane - 16)) = raw; } } }
    } }
}
__device__ __forceinline__ void mla_prep1(const Frame& F, const Params& P) {
    char* ws = F.ws; const bf16_t* Z = (const bf16_t*)(ws + WS_Z); bf16_t* QA = (bf16_t*)(ws + WS_QA); bf16_t* KVA = (bf16_t*)(ws + WS_KVA); bf16_t* KR = (bf16_t*)(ws + WS_KR);
    const int gw = F.bid * NWAVES + F.wave, NGW = F.G * NWAVES, lane = F.lane; const float* gq = PIN(33); const float* gkv = PIN(35);
    const f32x4 g4 = *(const f32x4*)(gq + 4 * lane); const float gk0 = gkv[2 * lane], gk1 = gkv[2 * lane + 1];
    for (int r0 = gw; r0 < MROWS; r0 += 3 * NGW) {
        u32x2 qw[3]; unsigned kw[3], krw[3];
#pragma unroll
        for (int q = 0; q < 3; ++q) { const int r = r0 + q * NGW; if (r < MROWS) { const bf16_t* z = Z + (size_t)r * CD_LD; qw[q] = *(const u32x2*)(z + 1536 + 4 * lane); kw[q] = *(const unsigned*)(z + 1792 + 2 * lane); krw[q] = lane < 16 ? *(const unsigned*)(z + 1920 + 2 * lane) : 0u; } }
#pragma unroll
        for (int q = 0; q < 3; ++q) { const int r = r0 + q * NGW; if (r < MROWS) {
            const float q0 = __uint_as_float(qw[q].x << 16), q1 = __uint_as_float(qw[q].x & 0xffff0000u), q2 = __uint_as_float(qw[q].y << 16), q3 = __uint_as_float(qw[q].y & 0xffff0000u);
            const float k0 = __uint_as_float(kw[q] << 16), k1 = __uint_as_float(kw[q] & 0xffff0000u);
            const float rq = rsqrtf(wave_sum((q0 * q0 + q1 * q1) + (q2 * q2 + q3 * q3)) * (1.f / 256.f) + EPS), rk = rsqrtf(wave_sum(k0 * k0 + k1 * k1) * (1.f / 128.f) + EPS);
            u32x2 o; o.x = pk2(q0 * rq * g4[0], q1 * rq * g4[1]); o.y = pk2(q2 * rq * g4[2], q3 * rq * g4[3]); *(u32x2*)(QA + (size_t)r * 256 + 4 * lane) = o;
            *(unsigned*)(KVA + (size_t)r * 128 + 2 * lane) = pk2(k0 * rk * gk0, k1 * rk * gk1);
            if (lane < 16) *(unsigned*)(KR + (size_t)r * 32 + 2 * lane) = krw[q]; } }
    }
}
__device__ __forceinline__ void mla_prep2(const Frame& F, const Params& P) {
    char* ws = F.ws; char* dob = (char*)P.out; const bf16_t* QR = (const bf16_t*)(ws + WS_QR); const bf16_t* KVR = (const bf16_t*)(ws + WS_KVR); const bf16_t* KR = (const bf16_t*)(ws + WS_KR);
    bf16_t* QM = (bf16_t*)(ws + WS_QM); bf16_t* KM = (bf16_t*)(dob + DO_KM); bf16_t* VM = (bf16_t*)(dob + DO_VM); const float* R1 = (const float*)(ws + WS_ROPE1);
    const int gw = F.bid * NWAVES + F.wave, NGW = F.G * NWAVES, lane = F.lane; const int h = lane >> 3, sub = lane & 7; const bool rl = sub < 4; const int rs8 = 8 * (sub & 3), ti = rs8 & 15;
    float qn0[8], qn1[8], kn0[8], kn1[8];
#pragma unroll
    for (int e = 0; e < 8; ++e) { qn0[e] = PIN(37)[8 * sub + e] * QSCALE1; qn1[e] = PIN(37)[64 + rs8 + e] * QSCALE1; kn0[e] = PIN(38)[8 * sub + e]; kn1[e] = PIN(38)[64 + rs8 + e]; }
#define MP2_UNPK(raw, x) _Pragma("unroll") for (int e_ = 0; e_ < 4; ++e_) { x[2 * e_] = __uint_as_float(raw[e_] << 16); x[2 * e_ + 1] = __uint_as_float(raw[e_] & 0xffff0000u); }
#define MP2_PK(y) (v4u){pk2(y[0], y[1]), pk2(y[2], y[3]), pk2(y[4], y[5]), pk2(y[6], y[7])}
    for (int r = gw; r < MROWS; r += NGW) { const int s = r % RPB; const bool lat = s >= CTX;
        const v4u kraw = *(const v4u*)(KVR + (size_t)r * 1024 + h * 128 + 8 * sub), vraw = *(const v4u*)(KVR + (size_t)r * 1024 + h * 128 + 64 + 8 * sub);
        const v4u rraw = *(const v4u*)(KR + (size_t)r * 32 + rs8);
        v4u qraw = {0u, 0u, 0u, 0u}, qrr = {0u, 0u, 0u, 0u}; f32x4 cs[2], sn[2];
        if (lat) { qraw = *(const v4u*)(QR + (size_t)r * 768 + h * 96 + 8 * sub); qrr = *(const v4u*)(QR + (size_t)r * 768 + h * 96 + 64 + rs8);
            const float* rp = R1 + (size_t)(s - CTX) * 32 + ti; cs[0] = *(const f32x4*)rp; cs[1] = *(const f32x4*)(rp + 4); sn[0] = *(const f32x4*)(rp + 16); sn[1] = *(const f32x4*)(rp + 20); }
        *(v4u*)(VM + (size_t)r * 512 + h * 64 + 8 * sub) = vraw;
#pragma unroll
        for (int which = 0; which < 2; ++which) {
            if (which == 1 && !lat) break;
            float a[8], bq[8]; { const v4u ra = which == 0 ? kraw : qraw, rb = which == 0 ? rraw : qrr; MP2_UNPK(ra, a) MP2_UNPK(rb, bq) }
            float ss = 0.f;
#pragma unroll
            for (int e = 0; e < 8; ++e) ss += a[e] * a[e] + (rl ? bq[e] * bq[e] : 0.f);
            ss += __shfl_xor(ss, 1); ss += __shfl_xor(ss, 2); ss += __shfl_xor(ss, 4);
            const float rsd = rsqrtf(ss * (1.f / 96.f) + EPS);
#pragma unroll
            for (int e = 0; e < 8; ++e) { a[e] = a[e] * rsd * (which == 0 ? kn0[e] : qn0[e]); bq[e] = bq[e] * rsd * (which == 0 ? kn1[e] : qn1[e]); }
            if (lat) {
#pragma unroll
                for (int e = 0; e < 8; ++e) { const float other = __shfl_xor(bq[e], 2); const float c = cs[e >> 2][e & 3], sv = sn[e >> 2][e & 3]; bq[e] = (sub & 2) ? (other * sv + bq[e] * c) : (bq[e] * c - other * sv); } }
            bf16_t* o = (which == 0 ? KM : QM) + (size_t)r * 768 + h * 96;
            *(v4u*)(o + 8 * sub) = MP2_PK(a); if (rl) *(v4u*)(o + 64 + rs8) = MP2_PK(bq); }
    }
#undef MP2_UNPK
#undef MP2_PK
}
}
__global__ void __launch_bounds__(NTHREADS, 2) mk_kernel(Params prm) {
    extern __shared__ __attribute__((aligned(16))) unsigned char lds_raw[];
    Frame F; F.lds = (LAS unsigned char*)lds_raw; F.tid = threadIdx.x; F.lane = F.tid & 63; F.wave = __builtin_amdgcn_readfirstlane(F.tid >> 6);
    F.G = gridDim.x; F.bid = blockIdx.x; F.even = 0; F.ws = prm.ws;
    const Params& P = prm;
    const float* MOD0 = (const float*)(prm.ws + WS_MOD);
    const int lo = prm.ph_lo, hi = prm.ph_hi;
    volatile LAS unsigned* MISCW = (volatile LAS unsigned*)(F.lds + MISC_OFF + 8192);
    if (F.tid < 64) MISCW[F.tid] = 0u;
    __syncthreads();
    if (prm.ph_lo == 123456) cooperative_groups::this_grid().sync();
    XcdBarrier bar = xcd_barrier_post((unsigned*)(prm.ws + WS_CTL + CT_BAR), MISCW + 8);
#define RUN(k, body) if (lo <= (k) && (k) < hi) { body; if ((k) + 1 < hi) xcd_barrier(bar); }
#define RUN_GEMMS(PH0, NPH, G0) { _Pragma("unroll 1") for (int i_ = 0; i_ < (NPH); ++i_) { const int k_ = (PH0) + i_; if (lo <= k_ && k_ < hi) { run_gemm(F, prm, (G0) + i_); if (k_ + 1 < hi) xcd_barrier(bar); } } }
    RUN(PH_P0, { el::rope_tables(F); el::mod_phase(F, prm); phase_conv(F, prm, false); hy::filt(F, prm); })
    if (MISCW[8 + 3] != 0u) { F.bid = __builtin_amdgcn_readfirstlane((int)(MISCW[8 + 2] * 8u + bar.x)); F.even = 1; }
    RUN(PH_NORM0, { el::norm_phase<0>(F, prm, PIN(6), MOD0, 0, 1); el::bias_phase(F, prm); })
    RUN(PH_G_IN0, run_gemm(F, prm, G_IN0))
    RUN(PH_LRUPREP, { lru::phase<0>(F, prm); el::gqa_prep(F, prm); })
    RUN(PH_MIX0, { phase_attn0(F); lru::phase<1>(F, prm); })
    RUN(PH_G_OUT0, { run_gemm(F, prm, G_OUT0); run_gemm(F, prm, G_F1); moe_conv_all(F, prm, 0, MOE_ITEMS / 2); run_gemm(F, prm, G_F2); moe_conv_all(F, prm, MOE_ITEMS / 2, MOE_ITEMS); run_gemm(F, prm, G_IN1); })
    RUN(PH_PREP1, { hy::prep(F, prm); el::mla_prep1(F, prm); })
    RUN(PH_G_QKVB, { run_gemm(F, prm, G_QB); run_gemm(F, prm, G_KVB); })
    RUN(PH_PREP2, { el::mla_prep2(F, prm); hy::main_phase(F, prm); })
    RUN(PH_MIX1, { phase_attn1(F, prm); hy::untranspose(F); })
    RUN(PH_G_OUT1, run_gemm(F, prm, G_OUT1))
    RUN(PH_ROUTE, phase_route(F, prm))
    RUN(PH_SLOT, phase_slot(F, prm))
    RUN(PH_MOE1, { run_gemm(F, prm, G_MOE1); run_gemm(F, prm, G_MOE2); })
    RUN(PH_COMBINE, phase_combine(F, prm))
#undef RUN
#undef RUN_GEMMS
}
#ifndef SPLIT_LAUNCH
#define SPLIT_LAUNCH 0
#endif
extern "C" void kernel_launch(void* const* d_in, const int* in_sizes, int n_in, void* d_out, int out_size, void* d_ws, size_t ws_size, hipStream_t st) {
    static int grid = 0;
    if (grid == 0) {
        if (n_in != 43 || out_size != NLAT * DM || ws_size < WS_END) { fprintf(stderr, "kernel_launch: unexpected problem (n_in %d, out %d, ws %zu < %zu)\n", n_in, out_size, ws_size, (size_t)WS_END); grid = -1; return; }
        int dev = 0, cus = 0, per_cu = 0;
        (void)hipGetDevice(&dev); (void)hipDeviceGetAttribute(&cus, hipDeviceAttributeMultiprocessorCount, dev);
        (void)hipFuncSetAttribute((const void*)mk_kernel, hipFuncAttributeMaxDynamicSharedMemorySize, LDS_BYTES);
        (void)hipOccupancyMaxActiveBlocksPerMultiprocessor(&per_cu, (const void*)mk_kernel, NTHREADS, LDS_BYTES);
        grid = cus;
        if (grid != 256 || per_cu < 1) { fprintf(stderr, "kernel_launch: grid %d (CUs %d, occupancy query %d): this kernel is written for 256 resident workgroups; nothing launched\n", grid, cus, per_cu); grid = -1; return; }
    }
    if (grid < 0) return;
    (void)hipMemsetAsync((char*)d_ws + WS_CTL, 0, CTL_BYTES, st);
    Params prm{}; prm.i0 = (const float*)d_in[0]; prm.i1 = (const float*)d_in[1]; prm.i2 = (const float*)d_in[2]; prm.i3 = (const float*)d_in[3]; prm.i4 = (const float*)d_in[4]; prm.i5 = (const float*)d_in[5]; prm.i6 = (const float*)d_in[6]; prm.i7 = (const float*)d_in[7]; prm.i8 = (const float*)d_in[8]; prm.i9 = (const float*)d_in[9]; prm.i10 = (const float*)d_in[10]; prm.i11 = (const float*)d_in[11]; prm.i12 = (const float*)d_in[12]; prm.i13 = (const float*)d_in[13]; prm.i14 = (const float*)d_in[14]; prm.i15 = (const float*)d_in[15]; prm.i16 = (const float*)d_in[16]; prm.i17 = (const float*)d_in[17]; prm.i18 = (const float*)d_in[18]; prm.i19 = (const float*)d_in[19]; prm.i20 = (const float*)d_in[20]; prm.i21 = (const float*)d_in[21]; prm.i22 = (const float*)d_in[22]; prm.i23 = (const float*)d_in[23]; prm.i24 = (const float*)d_in[24]; prm.i25 = (const float*)d_in[25]; prm.i26 = (const float*)d_in[26]; prm.i27 = (const float*)d_in[27]; prm.i28 = (const float*)d_in[28]; prm.i29 = (const float*)d_in[29]; prm.i30 = (const float*)d_in[30]; prm.i31 = (const float*)d_in[31]; prm.i32 = (const float*)d_in[32]; prm.i33 = (const float*)d_in[33]; prm.i34 = (const float*)d_in[34]; prm.i35 = (const float*)d_in[35]; prm.i36 = (const float*)d_in[36]; prm.i37 = (const float*)d_in[37]; prm.i38 = (const float*)d_in[38]; prm.i39 = (const float*)d_in[39]; prm.i40 = (const float*)d_in[40]; prm.i41 = (const float*)d_in[41]; prm.i42 = (const float*)d_in[42]; prm.out = (float*)d_out; prm.ws = (char*)d_ws;
#if SPLIT_LAUNCH
    for (int ph = 0; ph < PH_COUNT; ++ph) { prm.ph_lo = ph; prm.ph_hi = ph + 1; hipLaunchKernelGGL(mk_kernel, dim3(grid), dim3(NTHREADS), LDS_BYTES, st, prm); }
#else
    prm.ph_lo = 0; prm.ph_hi = PH_COUNT;
    void* args[] = {&prm};
    hipError_t e = hipLaunchCooperativeKernel((const void*)mk_kernel, dim3(grid), dim3(NTHREADS), args, LDS_BYTES, st);
    if (e != hipSuccess) fprintf(stderr, "kernel_launch: cooperative launch failed: %s (grid %d)\n", hipGetErrorString(e), grid);
#endif
}
```
